# Optimizing an MI355X kernel written in HIP

```python
import math
import jax, jax.numpy as jnp
from jax import lax
import numpy as np

D_MODEL = 1024
BATCH = 16
SEQ = 4096
DEPTH = 4

PLE_DIM = 256
A_GROUPS = 8
A_GROUP_DIM = 128
A_WIDTH = A_GROUPS * A_GROUP_DIM
CHUNK = 128
B_HEADS = 8
B_HEAD_DIM = 64
B_V_DIM = 2 * B_HEAD_DIM
B_QK_WIDTH = B_HEADS * 2 * B_HEAD_DIM
B_WIDTH = B_HEADS * B_V_DIM
Q_BLOCK = 128
N_IN = 2 * A_WIDTH + 2 * B_QK_WIDTH + B_WIDTH + 2 * D_MODEL
D_FF = 2816
CONV_W = 3
EPS = 1e-6

kernel_name = "hybrid_gmlp_diffattn_convffn_ple"


def rmsnorm(x, g):
    xf = x.astype(jnp.float32)
    y = xf * lax.rsqrt(jnp.mean(xf * xf, axis=-1, keepdims=True) + EPS)
    return (y * g.astype(jnp.float32)).astype(x.dtype)


def layernorm(x, g, b):
    xf = x.astype(jnp.float32)
    mu = jnp.mean(xf, axis=-1, keepdims=True)
    var = jnp.mean(jnp.square(xf - mu), axis=-1, keepdims=True)
    y = (xf - mu) * lax.rsqrt(var + EPS)
    return (y * g.astype(jnp.float32) + b.astype(jnp.float32)).astype(x.dtype)


def gelu(x):
    return jax.nn.gelu(x, approximate=True)


def spatial_gating_mixer(z, ln_g, ln_b, w_s, b_s):
    z = gelu(z)
    u, v = jnp.split(z, 2, axis=-1)
    v = layernorm(v, ln_g, ln_b)
    bsz, s_len, _ = v.shape
    n_chunks = s_len // CHUNK
    v = v.reshape(bsz, n_chunks, CHUNK, A_GROUPS, A_GROUP_DIM)
    causal = jnp.tril(jnp.ones((CHUNK, CHUNK), dtype=bool))
    w = jnp.where(causal[None], w_s, jnp.zeros((), w_s.dtype))
    s = jnp.einsum('gts,bnsgc->bntgc', w, v) + b_s.T[:, :, None]
    return u * s.reshape(bsz, s_len, A_WIDTH)


def diff_attention(q, k, v, lam, g_sub, lam_init):
    bsz, s_len, _ = q.shape
    q = q.reshape(bsz, s_len, B_HEADS, 2, B_HEAD_DIM) * (B_HEAD_DIM ** -0.5)
    k = k.reshape(bsz, s_len, B_HEADS, 2, B_HEAD_DIM)
    v = v.reshape(bsz, s_len, B_HEADS, B_V_DIM)
    n_blocks = s_len // Q_BLOCK
    q_blocks = jnp.moveaxis(q.reshape(bsz, n_blocks, Q_BLOCK, B_HEADS, 2, B_HEAD_DIM), 1, 0)
    starts = jnp.arange(n_blocks, dtype=jnp.int32) * Q_BLOCK
    kpos = jnp.arange(s_len, dtype=jnp.int32)

    def block(args):
        q_blk, start = args
        sc = jnp.einsum('bqhmd,bkhmd->bmhqk', q_blk, k).astype(jnp.float32)
        qpos = start + jnp.arange(Q_BLOCK, dtype=jnp.int32)
        causal = kpos[None, :] <= qpos[:, None]
        sc = jnp.where(causal, sc, -jnp.inf)
        pr = jax.nn.softmax(sc, axis=-1)
        a = pr[:, 0] - lam * pr[:, 1]
        return jnp.einsum('bhqk,bkhe->bqhe', a.astype(v.dtype), v)

    o = lax.map(block, (q_blocks, starts))
    o = jnp.moveaxis(o, 0, 1).reshape(bsz, s_len, B_HEADS, B_V_DIM)
    o = rmsnorm(o, g_sub) * (1.0 - lam_init)
    return o.reshape(bsz, s_len, B_WIDTH)


def causal_dwconv(a, w, b):
    s_len = a.shape[1]
    ap = jnp.pad(a, ((0, 0), (CONV_W - 1, 0), (0, 0)))
    y = b
    for j in range(CONV_W):
        y = y + ap[:, j:j + s_len] * w[j]
    return y


def setup_inputs(seed: int = 0) -> dict:
    key = jax.random.key(seed)
    ks = jax.random.split(key, 32)
    f32 = jnp.float32
    nrm = lambda k, shape, scale: jax.random.normal(k, shape, f32) * scale
    gain = lambda k, shape: 1.0 + 0.02 * jax.random.normal(k, shape, f32)
    L = DEPTH
    return {
        "x": nrm(ks[0], (BATCH, SEQ, D_MODEL), 1.0),
        "p": nrm(ks[1], (DEPTH, BATCH, SEQ, PLE_DIM), 1.0),
        "g_mix": gain(ks[2], (L, D_MODEL)),
        "w_in": nrm(ks[3], (L, D_MODEL, N_IN), D_MODEL ** -0.5),
        "b_gate": nrm(ks[4], (L, 2 * D_MODEL), 0.02),
        "ln_v_g": gain(ks[5], (L, A_WIDTH)),
        "ln_v_b": nrm(ks[6], (L, A_WIDTH), 0.02),
        "w_s": nrm(ks[7], (L, A_GROUPS, CHUNK, CHUNK), CHUNK ** -0.5),
        "b_s": gain(ks[8], (L, A_GROUPS, CHUNK)),
        "lam_q1": nrm(ks[9], (L, B_HEAD_DIM), 0.1),
        "lam_k1": nrm(ks[10], (L, B_HEAD_DIM), 0.1),
        "lam_q2": nrm(ks[11], (L, B_HEAD_DIM), 0.1),
        "lam_k2": nrm(ks[12], (L, B_HEAD_DIM), 0.1),
        "g_sub": gain(ks[13], (L, B_V_DIM)),
        "w_pa": nrm(ks[14], (L, A_WIDTH, D_MODEL), A_WIDTH ** -0.5),
        "w_pb": nrm(ks[15], (L, B_WIDTH, D_MODEL), B_WIDTH ** -0.5),
        "w_o": nrm(ks[16], (L, D_MODEL, D_MODEL), D_MODEL ** -0.5),
        "g_ffn": gain(ks[17], (L, D_MODEL)),
        "w_up": nrm(ks[18], (L, D_MODEL, 2 * D_FF), D_MODEL ** -0.5),
        "conv_w": nrm(ks[19], (L, CONV_W, 2 * D_FF), CONV_W ** -0.5),
        "conv_b": nrm(ks[20], (L, 2 * D_FF), 0.02),
        "w_down": nrm(ks[21], (L, D_FF, D_MODEL), D_FF ** -0.5),
        "g_ple": gain(ks[22], (L, D_MODEL)),
        "w_pg": nrm(ks[23], (L, D_MODEL, D_MODEL), D_MODEL ** -0.5),
        "b_pg": nrm(ks[24], (L, D_MODEL), 0.02),
        "w_ple": nrm(ks[25], (L, PLE_DIM, D_MODEL), PLE_DIM ** -0.5),
        "g_final": gain(ks[26], (D_MODEL,)),
    }


def reference(x, p, g_mix, w_in, b_gate, ln_v_g, ln_v_b, w_s, b_s, lam_q1, lam_k1, lam_q2, lam_k2,
              g_sub, w_pa, w_pb, w_o, g_ffn, w_up, conv_w, conv_b, w_down, g_ple, w_pg, b_pg,
              w_ple, g_final):
    o_q = 2 * A_WIDTH
    o_k = o_q + B_QK_WIDTH
    o_v = o_k + B_QK_WIDTH
    o_g = o_v + B_WIDTH
    for i in range(DEPTH):
        lam_init = 0.8 - 0.6 * math.exp(-0.3 * i)
        h = rmsnorm(x, g_mix[i])
        z = h @ w_in[i]
        gates = jax.nn.sigmoid(z[..., o_g:] + b_gate[i])
        gate_a, gate_b = jnp.split(gates, 2, axis=-1)
        y_a = spatial_gating_mixer(z[..., :o_q], ln_v_g[i], ln_v_b[i], w_s[i], b_s[i])
        lam = (jnp.exp(jnp.sum(lam_q1[i].astype(jnp.float32) * lam_k1[i].astype(jnp.float32)))
               - jnp.exp(jnp.sum(lam_q2[i].astype(jnp.float32) * lam_k2[i].astype(jnp.float32)))
               + lam_init)
        y_b = diff_attention(z[..., o_q:o_k], z[..., o_k:o_v], z[..., o_v:o_g], lam, g_sub[i], lam_init)
        merged = gate_a * (y_a @ w_pa[i]) + gate_b * (y_b @ w_pb[i])
        x = x + merged @ w_o[i]
        h2 = rmsnorm(x, g_ffn[i])
        a = causal_dwconv(h2 @ w_up[i], conv_w[i], conv_b[i])
        a_g, a_v = jnp.split(a, 2, axis=-1)
        x = x + (gelu(a_g) * a_v) @ w_down[i]
        e = p[i] @ w_ple[i]
        pg = jax.nn.sigmoid(rmsnorm(x, g_ple[i]) @ w_pg[i] + b_pg[i])
        x = x + pg * e
    return rmsnorm(x, g_final)
```

```cpp
#include <hip/hip_runtime.h>
#include <hip/hip_cooperative_groups.h>
#include <cstdio>
#include <cstdint>
namespace cg = cooperative_groups;
namespace pg8 {
#define PG8_LAS __attribute__((address_space(3)))
typedef unsigned short bf16_t;
typedef short bf16x8 __attribute__((ext_vector_type(8)));
typedef float f32x4 __attribute__((ext_vector_type(4)));
typedef unsigned u32x4 __attribute__((ext_vector_type(4)));
constexpr int BM = 256, BK = 64, HALF = 128, HTB = HALF * BK * 2  , STAGE_BYTES = 8 * HTB, NXCD = 8, WGM = 8;

__host__ __device__ __forceinline__ int lds_byte(int r, int c) { const int st = (r >> 4) * 2 + (c >> 5), rr = r & 15, cc = c & 31, ob = rr * 64 + cc * 2; return st * 1024 + (ob ^ (((ob >> 9) & 1) << 5)); }
__host__ __device__ __forceinline__ void stage_rc(int b, int& R, int& C) { const int st = b / 1024, sb = b % 1024, swz = sb ^ (((sb >> 9) & 1) << 5); R = (st >> 1) * 16 + swz / 64; C = (st & 1) * 32 + (swz % 64) / 2; }
__host__ __device__ __forceinline__ int perm32(int rho) { const int n = rho >> 4, i = rho & 15; return 8 * (i >> 2) + 4 * n + (i & 3); }

struct Unit { int pm, pn; };
struct Gemm { const bf16_t* A; const bf16_t* Bt; int M, N, K; };

struct StaticOrder {
    int nM, nN, nwg, G, c;
    __host__ __device__ void init(int M, int N, int G_, int c_) { nM = M / BM; nN = N / BM; nwg = nM * nN; G = G_; c = c_; }
    __host__ __device__ bool next(int i, Unit& u) const {
        const long L = (long)i * G + c; if (L >= nwg) return false;
        int wgid = (int)L; { const int q = nwg / NXCD, r = nwg % NXCD, xcd = wgid % NXCD, off = wgid / NXCD; wgid = (xcd < r ? xcd * (q + 1) : r * (q + 1) + (xcd - r) * q) + off; }
        const int nig = WGM * nN, gid = wgid / nig, fm = gid * WGM, gsz = (nM - fm) < WGM ? (nM - fm) : WGM;
        u.pm = fm + ((wgid % nig) % gsz); u.pn = (wgid % nig) / gsz; return true;
    }
    __device__ __forceinline__ void a_ready(const Unit&) const {}
    __device__ __forceinline__ void done(const Unit&) const {}
};

typedef float cv_f32x2 __attribute__((ext_vector_type(2))); typedef __bf16 cv_bf16x2 __attribute__((ext_vector_type(2)));
__device__ __forceinline__ unsigned cvt_pk_bf16(float lo, float hi) { const cv_f32x2 v = {lo, hi}; const cv_bf16x2 b = __builtin_convertvector(v, cv_bf16x2); return __builtin_bit_cast(unsigned, b); }
typedef float f32x2 __attribute__((ext_vector_type(2)));
__device__ __forceinline__ f32x2 gelu_pk(f32x2 v) {
    const f32x2 av = __builtin_elementwise_abs(v), d = av * 0.2316418882f + 1.0f;
    f32x2 t; t.x = __builtin_amdgcn_rcpf(d.x); t.y = __builtin_amdgcn_rcpf(d.y);
    f32x2 q = t * 0.5307027145f + (-0.7265760135f); q = q * t + 0.7107068705f; q = q * t + (-0.142248368f); q = q * t + 0.127414796f; q = q * t;
    const f32x2 s = (v * v) * (-0.72134752044f);
    f32x2 e; e.x = __builtin_amdgcn_exp2f(s.x); e.y = __builtin_amdgcn_exp2f(s.y);
    const f32x2 m = v * (q * e), r = v - m;
    f32x2 o; o.x = v.x < 0.f ? m.x : r.x; o.y = v.y < 0.f ? m.y : r.y; return o;
}

template <int ACT  > struct EpiBf16 {
    static constexpr bool PERM = true, AFTER_DRAIN = false; static_assert(ACT == 0 || ACT == 1, "EpiBf16: ACT is 0 (none) or 1 (gelu_pk)");
    bf16_t* O; int ldc; const float* bias; int split_cols; size_t split_stride; float scale0;
    __device__ __forceinline__ void operator()(const f32x4 (&acc)[2][2][4][2], const Unit& u, int wr, int wc, int fr_, int fq_) const {
        int t_o = threadIdx.x; asm volatile("" : "+v"(t_o)); int fr = t_o & 15, fq = (t_o >> 4) & 3; (void)fr_; (void)fq_;

        const int row0 = u.pm * BM + wr * 64 + fr; int colt = u.pn * BM; bf16_t* base = O;
        float sc = 1.f; if (split_cols) { const int t = colt / split_cols; base += (size_t)t * split_stride; colt -= t * split_cols; if (t == 0) sc = scale0; }
        const int col0 = colt + wc * 32 + 8 * fq, bcol0 = u.pn * BM + wc * 32 + 8 * fq;
        f32x4 bv[2][2];
#pragma unroll
        for (int bj = 0; bj < 2; ++bj)
#pragma unroll
            for (int n = 0; n < 2; ++n) bv[bj][n] = bias ? *(const f32x4*)(bias + bcol0 + bj * HALF + 4 * n) : (f32x4){0.f, 0.f, 0.f, 0.f};
#pragma unroll
        for (int ai = 0; ai < 2; ++ai)
#pragma unroll
            for (int m = 0; m < 4; ++m) { bf16_t* rowp = base + (size_t)(row0 + ai * HALF + m * 16) * ldc + col0;
#pragma unroll
                for (int bj = 0; bj < 2; ++bj) { f32x4 v0 = acc[ai][bj][m][0] + bv[bj][0], v1 = acc[ai][bj][m][1] + bv[bj][1];
                    if (ACT == 1) { f32x2 a = gelu_pk((f32x2){v0[0], v0[1]}), b = gelu_pk((f32x2){v0[2], v0[3]}), c = gelu_pk((f32x2){v1[0], v1[1]}), d = gelu_pk((f32x2){v1[2], v1[3]});
                        v0 = (f32x4){a.x, a.y, b.x, b.y}; v1 = (f32x4){c.x, c.y, d.x, d.y}; }
                    v0 = v0 * sc; v1 = v1 * sc; u32x4 w; w.x = cvt_pk_bf16(v0[0], v0[1]); w.y = cvt_pk_bf16(v0[2], v0[3]); w.z = cvt_pk_bf16(v1[0], v1[1]); w.w = cvt_pk_bf16(v1[2], v1[3]);
                    *(u32x4*)(rowp + bj * HALF) = w; } }
    }
};
__device__ __forceinline__ float sigmoid_f(float x) { return __builtin_amdgcn_rcpf(1.0f + __builtin_amdgcn_exp2f(-1.4426950408889634f * x)); }
__device__ __forceinline__ float gelu_tanh_f(float x) { const float u = 0.7978845608028654f * (x + 0.044715f * x * x * x); return x * __builtin_amdgcn_rcpf(1.0f + __builtin_amdgcn_exp2f(-2.885390081777927f * u)); }
__device__ __forceinline__ float bf_lo(unsigned w) { return __builtin_bit_cast(float, w << 16); }
__device__ __forceinline__ float bf_hi(unsigned w) { return __builtin_bit_cast(float, w & 0xffff0000u); }
typedef unsigned u32x2 __attribute__((ext_vector_type(2)));

struct EpiIn {
    static constexpr bool PERM = true, AFTER_DRAIN = false;
    bf16_t* Z; size_t bufstride; const float* bgate; float qscale;
    template <int MODE> __device__ __forceinline__ void body(const f32x4 (&acc)[2][2][4][2], bf16_t* base, const float* bias, int row0, int col0) const {
        f32x4 bv[2][2];
#pragma unroll
        for (int bj = 0; bj < 2; ++bj)
#pragma unroll
            for (int n = 0; n < 2; ++n) bv[bj][n] = (MODE == 3) ? *(const f32x4*)(bias + col0 + bj * HALF + 4 * n) : (f32x4){0.f, 0.f, 0.f, 0.f};
#pragma unroll
        for (int ai = 0; ai < 2; ++ai)
#pragma unroll
            for (int m = 0; m < 4; ++m) { bf16_t* rowp = base + (size_t)(row0 + ai * HALF + m * 16) * 1024 + col0;
#pragma unroll
                for (int bj = 0; bj < 2; ++bj) { f32x4 v0 = acc[ai][bj][m][0], v1 = acc[ai][bj][m][1];
                    if (MODE == 1) {
#pragma unroll
                        for (int x = 0; x < 4; ++x) { v0[x] = gelu_tanh_f(v0[x]); v1[x] = gelu_tanh_f(v1[x]); } }
                    if (MODE == 2) { v0 = v0 * qscale; v1 = v1 * qscale; }
                    if (MODE == 3) { v0 = v0 + bv[bj][0]; v1 = v1 + bv[bj][1];
#pragma unroll
                        for (int x = 0; x < 4; ++x) { v0[x] = sigmoid_f(v0[x]); v1[x] = sigmoid_f(v1[x]); } }
                    u32x4 w; w.x = cvt_pk_bf16(v0[0], v0[1]); w.y = cvt_pk_bf16(v0[2], v0[3]); w.z = cvt_pk_bf16(v1[0], v1[1]); w.w = cvt_pk_bf16(v1[2], v1[3]);
                    *(u32x4*)(rowp + bj * HALF) = w; } }
    }
    __device__ __forceinline__ void operator()(const f32x4 (&acc)[2][2][4][2], const Unit& u, int wr, int wc, int fr_, int fq_) const {
        int t_o = threadIdx.x; asm volatile("" : "+v"(t_o)); int fr = t_o & 15, fq = (t_o >> 4) & 3; (void)fr_; (void)fq_;

        const int t = u.pn >> 2, colt = (u.pn & 3) * BM;
        bf16_t* base = Z + (size_t)t * bufstride;
        const int row0 = u.pm * BM + wr * 64 + fr, col0 = colt + wc * 32 + 8 * fq;
        if (t < 2) body<1>(acc, base, nullptr, row0, col0);
        else if (t == 2) body<2>(acc, base, nullptr, row0, col0);
        else if (t < 5) body<0>(acc, base, nullptr, row0, col0);
        else body<3>(acc, base, bgate + (t - 5) * 1024, row0, col0);
    }
};
struct EpiStore {
    static constexpr bool PERM = true, AFTER_DRAIN = false;
    bf16_t* O; int ldc;
    __device__ __forceinline__ void operator()(const f32x4 (&acc)[2][2][4][2], const Unit& u, int wr, int wc, int fr_, int fq_) const {
        int t_o = threadIdx.x; asm volatile("" : "+v"(t_o)); int fr = t_o & 15, fq = (t_o >> 4) & 3; (void)fr_; (void)fq_;

        const int row0 = u.pm * BM + wr * 64 + fr, col0 = u.pn * BM + wc * 32 + 8 * fq;
#pragma unroll
        for (int ai = 0; ai < 2; ++ai)
#pragma unroll
            for (int m = 0; m < 4; ++m) { bf16_t* rowp = O + (size_t)(row0 + ai * HALF + m * 16) * ldc + col0;
#pragma unroll
                for (int bj = 0; bj < 2; ++bj) { const f32x4 v0 = acc[ai][bj][m][0], v1 = acc[ai][bj][m][1];
                    u32x4 w; w.x = cvt_pk_bf16(v0[0], v0[1]); w.y = cvt_pk_bf16(v0[2], v0[3]); w.z = cvt_pk_bf16(v1[0], v1[1]); w.w = cvt_pk_bf16(v1[2], v1[3]);
                    *(u32x4*)(rowp + bj * HALF) = w; } }
    }
};
template <bool ADD> struct EpiGate {
    static constexpr bool PERM = true, AFTER_DRAIN = false;
    const bf16_t* G; bf16_t* MG;
    __device__ __forceinline__ void operator()(const f32x4 (&acc)[2][2][4][2], const Unit& u, int wr, int wc, int fr_, int fq_) const {
        int t_o = threadIdx.x; asm volatile("" : "+v"(t_o)); int fr = t_o & 15, fq = (t_o >> 4) & 3; (void)fr_; (void)fq_;

        const int row0 = u.pm * BM + wr * 64 + fr, col0 = u.pn * BM + wc * 32 + 8 * fq;
#pragma unroll
        for (int ai = 0; ai < 2; ++ai)
#pragma unroll
            for (int m = 0; m < 4; ++m) { const size_t off = (size_t)(row0 + ai * HALF + m * 16) * 1024 + col0;
#pragma unroll
                for (int bj = 0; bj < 2; ++bj) { const f32x4 v0 = acc[ai][bj][m][0], v1 = acc[ai][bj][m][1];
                    const u32x4 g = *(const u32x4*)(G + off + bj * HALF);
                    float r[8];
                    r[0] = bf_lo(g.x) * v0[0]; r[1] = bf_hi(g.x) * v0[1]; r[2] = bf_lo(g.y) * v0[2]; r[3] = bf_hi(g.y) * v0[3];
                    r[4] = bf_lo(g.z) * v1[0]; r[5] = bf_hi(g.z) * v1[1]; r[6] = bf_lo(g.w) * v1[2]; r[7] = bf_hi(g.w) * v1[3];
                    if (ADD) { const u32x4 o = *(const u32x4*)(MG + off + bj * HALF);
                        r[0] += bf_lo(o.x); r[1] += bf_hi(o.x); r[2] += bf_lo(o.y); r[3] += bf_hi(o.y); r[4] += bf_lo(o.z); r[5] += bf_hi(o.z); r[6] += bf_lo(o.w); r[7] += bf_hi(o.w); }
                    u32x4 w; w.x = cvt_pk_bf16(r[0], r[1]); w.y = cvt_pk_bf16(r[2], r[3]); w.z = cvt_pk_bf16(r[4], r[5]); w.w = cvt_pk_bf16(r[6], r[7]);
                    *(u32x4*)(MG + off + bj * HALF) = w; }
                asm volatile("" ::: "memory"); }
    }
};
template <bool PLE> struct EpiResid {
    static constexpr bool PERM = false, AFTER_DRAIN = false;
    const float* XI; float* XO; const float* bias; const bf16_t* E;
    __device__ __forceinline__ void operator()(const f32x4 (&acc)[2][2][4][2], const Unit& u, int wr, int wc, int fr_, int fq_) const {
        int t_o = threadIdx.x; asm volatile("" : "+v"(t_o)); int fr = t_o & 15, fq = (t_o >> 4) & 3; (void)fr_; (void)fq_;

        const int col0 = u.pn * BM + wc * 32 + 4 * fq;
#pragma unroll
        for (int ai = 0; ai < 2; ++ai)
#pragma unroll
            for (int m = 0; m < 4; ++m) { const size_t off = (size_t)(u.pm * BM + ai * HALF + wr * 64 + m * 16 + fr) * 1024 + col0;
#pragma unroll
                for (int bj = 0; bj < 2; ++bj)
#pragma unroll
                    for (int n = 0; n < 2; ++n) { const size_t o2 = off + bj * HALF + n * 16; const f32x4 xi = *(const f32x4*)(XI + o2); f32x4 a = acc[ai][bj][m][n];
                        if (PLE) { const f32x4 bv = *(const f32x4*)(bias + col0 + bj * HALF + n * 16); const u32x2 e = *(const u32x2*)(E + o2); a = a + bv;
                            a[0] = sigmoid_f(a[0]) * bf_lo(e.x); a[1] = sigmoid_f(a[1]) * bf_hi(e.x); a[2] = sigmoid_f(a[2]) * bf_lo(e.y); a[3] = sigmoid_f(a[3]) * bf_hi(e.y); }
                        *(f32x4*)(XO + o2) = xi + a; }
                asm volatile("" ::: "memory"); }
    }
};
constexpr int FFC = 2816, NTC = FFC / 128;
struct EpiConv {
    static constexpr bool PERM = true, AFTER_DRAIN = false;
    bf16_t* ACT; float* EDGE; const float* cw; const float* cb; PG8_LAS float* xb;
    __device__ __forceinline__ void operator()(f32x4 (&acc)[2][2][4][2], const Unit& u, int wr, int wc, int fr_, int fq_) const {
        int t_o = threadIdx.x; asm volatile("" : "+v"(t_o)); int fr = t_o & 15, fq = (t_o >> 4) & 3; (void)fr_; (void)fq_;

        const int lane = t_o & 63;
        const int jc0 = wc * 32 + 8 * fq;
        if (fr >= 14) {
#pragma unroll
            for (int ai = 0; ai < 2; ++ai)
#pragma unroll
                for (int bj = 0; bj < 2; ++bj)
#pragma unroll
                    for (int n = 0; n < 2; ++n) *(PG8_LAS f32x4*)(xb + (((ai * 2 + wr) * 2 + (fr - 14)) * 256 + bj * HALF + jc0 + 4 * n)) = acc[ai][bj][3][n];
        }
        float* eb = EDGE + (size_t)(u.pm * NTC + u.pn) * 4 * 256;
        if (wr == 0 && fr < 2) {
#pragma unroll
            for (int bj = 0; bj < 2; ++bj)
#pragma unroll
                for (int n = 0; n < 2; ++n) *(f32x4*)(eb + fr * 256 + bj * HALF + jc0 + 4 * n) = acc[0][bj][0][n];
        }
        if (wr == 1 && fr >= 14) {
#pragma unroll
            for (int bj = 0; bj < 2; ++bj)
#pragma unroll
                for (int n = 0; n < 2; ++n) *(f32x4*)(eb + (2 + fr - 14) * 256 + bj * HALF + jc0 + 4 * n) = acc[1][bj][3][n];
        }
        asm volatile("s_waitcnt lgkmcnt(0)" ::: "memory"); __builtin_amdgcn_s_barrier(); asm volatile("" ::: "memory");
        const int src1 = (lane & 48) | ((fr + 15) & 15), src2 = (lane & 48) | ((fr + 14) & 15);
#pragma unroll
        for (int bj = 0; bj < 2; ++bj)
#pragma unroll
            for (int n = 0; n < 2; ++n) {
                const int gc = bj * FFC + u.pn * 128 + jc0 + 4 * n;
                const f32x4 w0 = *(const f32x4*)(cw + gc), w1 = *(const f32x4*)(cw + 2 * FFC + gc), w2 = *(const f32x4*)(cw + 4 * FFC + gc), bb = *(const f32x4*)(cb + gc);
#pragma unroll
                for (int ai = 0; ai < 2; ++ai) {
                    const int grp = ai * 2 + wr;
                    f32x4 xp = (f32x4){0.f, 0.f, 0.f, 0.f};
                    if (grp > 0 && fr >= 14) xp = *(const PG8_LAS f32x4*)(xb + (((grp - 1) * 2 + (fr - 14)) * 256 + bj * HALF + jc0 + 4 * n));
#pragma unroll
                    for (int m = 3; m >= 0; --m) {
                        f32x4 cur = acc[ai][bj][m][n]; f32x4 prv = (m > 0) ? acc[ai][bj][m > 0 ? m - 1 : 0][n] : xp;
                        asm volatile("" : "+v"(cur), "+v"(prv));
                        f32x4 r;
#pragma unroll
                        for (int x = 0; x < 4; ++x) {
                            const float s1 = (fr == 15) ? prv[x] : cur[x], s2 = (fr >= 14) ? prv[x] : cur[x];
                            const float p1 = __builtin_bit_cast(float, __builtin_amdgcn_ds_bpermute(src1 << 2, __builtin_bit_cast(int, s1))), p2 = __builtin_bit_cast(float, __builtin_amdgcn_ds_bpermute(src2 << 2, __builtin_bit_cast(int, s2)));
                            r[x] = w0[x] * p2 + w1[x] * p1 + w2[x] * cur[x] + bb[x];
                        }
                        asm volatile("" : "+v"(r));
                        acc[ai][bj][m][n] = r;
                    }
                    __builtin_amdgcn_sched_barrier(0);
                }
                asm volatile("" ::: "memory");
            }
#pragma unroll
        for (int ai = 0; ai < 2; ++ai)
#pragma unroll
            for (int m = 0; m < 4; ++m) {
                const bool skip = (ai == 0 && wr == 0 && m == 0 && fr < 2);
                bf16_t* rowp = ACT + (size_t)(u.pm * BM + ai * HALF + wr * 64 + m * 16 + fr) * FFC + u.pn * 128 + jc0;
                const f32x4 g0 = acc[ai][0][m][0], g1 = acc[ai][0][m][1], v0 = acc[ai][1][m][0], v1 = acc[ai][1][m][1];
                float r[8];
#pragma unroll
                for (int x = 0; x < 4; ++x) { r[x] = gelu_tanh_f(g0[x]) * v0[x]; r[4 + x] = gelu_tanh_f(g1[x]) * v1[x]; }
                u32x4 w; w.x = cvt_pk_bf16(r[0], r[1]); w.y = cvt_pk_bf16(r[2], r[3]); w.z = cvt_pk_bf16(r[4], r[5]); w.w = cvt_pk_bf16(r[6], r[7]);
                if (!skip) *(u32x4*)rowp = w;
                asm volatile("" ::: "memory"); __builtin_amdgcn_sched_barrier(0);
            }
        asm volatile("s_waitcnt lgkmcnt(0)" ::: "memory"); __builtin_amdgcn_s_barrier(); asm volatile("" ::: "memory");
    }
};
template <class Epi, class Sched, bool ALIGN_EPI = false, bool SP2 = false>
__device__ __forceinline__ void gemm_phase(PG8_LAS unsigned char* lds, const Gemm g, const Sched& S, const Epi& E) {
    int tid_o = threadIdx.x; asm volatile("" : "+v"(tid_o));
    const int tid = tid_o, wid = __builtin_amdgcn_readfirstlane(tid >> 6), lane = tid & 63, wr = wid >> 2, wc = wid & 3, fr = lane & 15, fq = lane >> 4;
    int K_o = g.K; asm volatile("" : "+s"(K_o)); const int K = K_o, nt = K / BK;
    unsigned voffA[2], voffB[2];
#pragma unroll
    for (int i = 0; i < 2; ++i) { int R, C; stage_rc(tid * 16 + i * 8192, R, C); const int Rb = Epi::PERM ? ((R & ~31) + perm32(R & 31)) : R;
        voffA[i] = (unsigned)(R * K + C) * 2u; voffB[i] = (unsigned)(Rb * K + C) * 2u; }
    const size_t kstep = (size_t)(BK * 2);
    const size_t hstep = (size_t)HALF * K * 2;
    const size_t tstep = 2 * hstep;
    const unsigned ldsw = (unsigned)wid * 1024u;
    const int aoff = lds_byte(wr * 64 + fr, fq * 8), boff = lds_byte(wc * 32 + fr, fq * 8);
#define PG8_SA(b, h) (((b) * 2 + (h)) * HTB)
#define PG8_SB(b, h) ((4 + (b) * 2 + (h)) * HTB)
#define PG8_STAGE(bufoff, gbase, voff) do { _Pragma("unroll") for (int _i = 0; _i < 2; ++_i) \
        __builtin_amdgcn_global_load_lds((const unsigned*)((const char*)(gbase) + (voff)[_i]), (PG8_LAS unsigned*)(lds + (bufoff) + ldsw + _i * 8192), 16, 0, 0); } while (0)
#define PG8_LDA(dst, b, h) do { _Pragma("unroll") for (int m = 0; m < 4; ++m) _Pragma("unroll") for (int k = 0; k < 2; ++k) dst[m][k] = *(const PG8_LAS bf16x8*)(lds + PG8_SA(b, h) + aoff + m * 2048 + k * 1024); } while (0)
#define PG8_LDB(dst, b, h) do { _Pragma("unroll") for (int n = 0; n < 2; ++n) _Pragma("unroll") for (int k = 0; k < 2; ++k) dst[n][k] = *(const PG8_LAS bf16x8*)(lds + PG8_SB(b, h) + boff + n * 2048 + k * 1024); } while (0)
#define PG8_MMA(ai, bj, At, Bt) do { __builtin_amdgcn_s_setprio(1); _Pragma("unroll") for (int m = 0; m < 4; ++m) _Pragma("unroll") for (int n = 0; n < 2; ++n) _Pragma("unroll") for (int k = 0; k < 2; ++k) \
        acc[ai][bj][m][n] = __builtin_amdgcn_mfma_f32_16x16x32_bf16(Bt[n][k], At[m][k], acc[ai][bj][m][n], 0, 0, 0); __builtin_amdgcn_s_setprio(0); } while (0)
#define PG8_WAIT_V(n) asm volatile("s_waitcnt vmcnt(" #n ")" ::: "memory")
#define PG8_WAIT_L(n) asm volatile("s_waitcnt lgkmcnt(" #n ")" ::: "memory")
#define PG8_BAR __builtin_amdgcn_s_barrier()
#define PG8_SCHED __builtin_amdgcn_sched_barrier(0)
    Unit cur, nxt; int ui = 0;
    if (!S.next(0, cur)) return;
    f32x4 acc[2][2][4][2];
#pragma unroll
    for (int a = 0; a < 2; ++a)
#pragma unroll
        for (int b = 0; b < 2; ++b)
#pragma unroll
            for (int m = 0; m < 4; ++m)
#pragma unroll
                for (int n = 0; n < 2; ++n) acc[a][b][m][n] = (f32x4){0.f, 0.f, 0.f, 0.f};
    bf16x8 At[4][2], B0[2][2], B1[2][2];
    const char* cA = (const char*)g.A + (size_t)cur.pm * tstep; const char* cB = (const char*)g.Bt + (size_t)cur.pn * tstep;
    S.a_ready(cur);
    if constexpr (SP2) {
        PG8_STAGE(PG8_SB(0, 0), cB, voffB); PG8_STAGE(PG8_SB(0, 1), cB + hstep, voffB); PG8_STAGE(PG8_SA(0, 0), cA, voffA); PG8_STAGE(PG8_SA(0, 1), cA + hstep, voffA);
        if (wr == 1) PG8_BAR;
        PG8_WAIT_V(2); PG8_BAR;
        PG8_STAGE(PG8_SB(1, 0), cB + kstep, voffB); PG8_STAGE(PG8_SA(1, 0), cA + kstep, voffA); PG8_STAGE(PG8_SB(1, 1), cB + hstep + kstep, voffB);
        PG8_WAIT_V(6); PG8_BAR;
    } else {
        PG8_STAGE(PG8_SB(0, 0), cB, voffB); PG8_STAGE(PG8_SA(0, 0), cA, voffA); PG8_STAGE(PG8_SB(0, 1), cB + hstep, voffB); PG8_STAGE(PG8_SA(0, 1), cA + hstep, voffA);
        if (wr == 1) PG8_BAR;
        PG8_WAIT_V(4); PG8_BAR;
        PG8_STAGE(PG8_SB(1, 0), cB + kstep, voffB); PG8_STAGE(PG8_SA(1, 0), cA + kstep, voffA); PG8_STAGE(PG8_SB(1, 1), cB + hstep + kstep, voffB);
        PG8_WAIT_V(6); PG8_BAR;
    }
    for (;;) {
        const bool has_next = S.next(ui + 1, nxt);
        const char* nA = has_next ? (const char*)g.A + (size_t)nxt.pm * tstep : cA; const char* nB = has_next ? (const char*)g.Bt + (size_t)nxt.pn * tstep : cB;
        for (int t = 0; t < nt; t += 2) {
            const bool last = (t == nt - 2);
            const char* a1 = cA + (size_t)(t + 1) * kstep;
            const char* a2 = last ? nA : cA + (size_t)(t + 2) * kstep; const char* b2 = last ? nB : cB + (size_t)(t + 2) * kstep;
            const char* a3 = a2 + kstep; const char* b3 = b2 + kstep;
            if (last && has_next) S.a_ready(nxt);
            if constexpr (SP2) {
            PG8_LDB(B0, 0, 0); PG8_LDB(B1, 0, 1); PG8_SCHED; PG8_LDA(At, 0, 0); PG8_STAGE(PG8_SA(1, 1), a1 + hstep, voffA);
            PG8_WAIT_V(8); PG8_WAIT_L(0); PG8_BAR; PG8_MMA(0, 0, At, B0); PG8_MMA(0, 1, At, B1); PG8_BAR; PG8_SCHED;
            PG8_LDA(At, 0, 1); PG8_STAGE(PG8_SB(0, 0), b2, voffB); PG8_STAGE(PG8_SB(0, 1), b2 + hstep, voffB); PG8_STAGE(PG8_SA(0, 0), a2, voffA);
            PG8_WAIT_V(8); PG8_WAIT_L(0); PG8_BAR; PG8_MMA(1, 0, At, B0); PG8_MMA(1, 1, At, B1); PG8_BAR; PG8_SCHED;
            PG8_LDB(B0, 1, 0); PG8_LDB(B1, 1, 1); PG8_SCHED; PG8_LDA(At, 1, 0); PG8_STAGE(PG8_SA(0, 1), a2 + hstep, voffA);
            PG8_WAIT_V(8); PG8_WAIT_L(0); PG8_BAR; PG8_MMA(0, 0, At, B0); PG8_MMA(0, 1, At, B1); PG8_BAR; PG8_SCHED;
            PG8_LDA(At, 1, 1); PG8_STAGE(PG8_SB(1, 0), b3, voffB); PG8_STAGE(PG8_SB(1, 1), b3 + hstep, voffB); PG8_STAGE(PG8_SA(1, 0), a3, voffA);
            PG8_WAIT_V(8); PG8_WAIT_L(0); PG8_BAR; PG8_MMA(1, 0, At, B0); PG8_MMA(1, 1, At, B1); PG8_BAR; PG8_SCHED;
            } else {
            PG8_LDB(B0, 0, 0); PG8_SCHED; PG8_LDA(At, 0, 0); PG8_STAGE(PG8_SA(1, 1), a1 + hstep, voffA);
            PG8_WAIT_L(8); PG8_BAR; PG8_WAIT_L(0); PG8_MMA(0, 0, At, B0); PG8_BAR; PG8_SCHED;
            PG8_LDB(B1, 0, 1); PG8_STAGE(PG8_SB(0, 0), b2, voffB);
            PG8_BAR; PG8_WAIT_L(0); PG8_MMA(0, 1, At, B1); PG8_BAR;
            PG8_LDA(At, 0, 1); PG8_STAGE(PG8_SA(0, 0), a2, voffA);
            PG8_BAR; PG8_WAIT_L(0); PG8_MMA(1, 0, At, B0); PG8_BAR; PG8_SCHED;
            PG8_STAGE(PG8_SB(0, 1), b2 + hstep, voffB);
            PG8_WAIT_V(6); PG8_BAR; PG8_MMA(1, 1, At, B1); PG8_BAR;
            PG8_LDB(B0, 1, 0); PG8_SCHED; PG8_LDA(At, 1, 0); PG8_STAGE(PG8_SA(0, 1), a2 + hstep, voffA);
            PG8_WAIT_L(8); PG8_BAR; PG8_WAIT_L(0); PG8_MMA(0, 0, At, B0); PG8_BAR; PG8_SCHED;
            PG8_LDB(B1, 1, 1); PG8_STAGE(PG8_SB(1, 0), b3, voffB);
            PG8_BAR; PG8_WAIT_L(0); PG8_MMA(0, 1, At, B1); PG8_BAR;
            PG8_LDA(At, 1, 1); PG8_STAGE(PG8_SA(1, 0), a3, voffA);
            PG8_BAR; PG8_WAIT_L(0); PG8_MMA(1, 0, At, B0); PG8_BAR; PG8_SCHED;
            PG8_STAGE(PG8_SB(1, 1), b3 + hstep, voffB);
            PG8_WAIT_V(6); PG8_BAR; PG8_MMA(1, 1, At, B1); PG8_BAR;
            }
        }
        if constexpr (ALIGN_EPI) { if (wr == 0) PG8_BAR; }
        if constexpr (!Epi::AFTER_DRAIN) { E(acc, cur, wr, wc, fr, fq); S.done(cur); }
        if (!has_next) break;
#pragma unroll
        for (int a = 0; a < 2; ++a)
#pragma unroll
            for (int b = 0; b < 2; ++b)
#pragma unroll
                for (int m = 0; m < 4; ++m)
#pragma unroll
                    for (int n = 0; n < 2; ++n) acc[a][b][m][n] = (f32x4){0.f, 0.f, 0.f, 0.f};
        cur = nxt; cA = nA; cB = nB; ++ui;
        if constexpr (ALIGN_EPI) { if (wr == 1) PG8_BAR; }
    }
    PG8_WAIT_V(0);
    if constexpr (!ALIGN_EPI) { if (wr == 0) PG8_BAR; }
    PG8_BAR;
    if constexpr (Epi::AFTER_DRAIN) { E.fused(acc, cur, wr, wc, fr, fq, lds, wid, lane); S.done(cur); }
#undef PG8_SA
#undef PG8_SB
#undef PG8_STAGE
#undef PG8_LDA
#undef PG8_LDB
#undef PG8_MMA
#undef PG8_WAIT_V
#undef PG8_WAIT_L
#undef PG8_BAR
#undef PG8_SCHED
}
}
#include <hip/hip_bf16.h>
#include <cmath>
namespace attn_body {
using bf16=__hip_bfloat16;
using bf16x8=__attribute__((ext_vector_type(8)))short;
using s16x4=__attribute__((ext_vector_type(4)))short;
using f32x16=__attribute__((ext_vector_type(16)))float;
using u32x4=__attribute__((ext_vector_type(4)))unsigned;
constexpr int NHEAD=16,SEQ=4096,D=64,DM=NHEAD*D;
constexpr int NW=8,QBLK=32,QB=QBLK*NW,KVBLK=64,NQB=SEQ/QB;
constexpr int ATTN_PITCH=DM, ATTN_UNIT_ROWS=QB;
__device__ __forceinline__ int crow(int r,int hi){return (r&3)+8*(r>>2)+4*hi;}
#define SBAR() __builtin_amdgcn_sched_barrier(0)
__device__ __forceinline__ void cmask(f32x16&p0,f32x16&p1,int jb,int qrel,int hi){
  const float NEG=-INFINITY; int kb=64*jb+4*hi;
  #pragma unroll
  for(int r=0;r<16;++r){int kv=kb+(r&3)+8*(r>>2); if(kv>qrel)p0[r]=NEG; if(kv+32>qrel)p1[r]=NEG;}
}

constexpr int NSLOT=3, SLOTB=8192;
constexpr int LDS_K=0, LDS_V=NSLOT*SLOTB, LDS_WS=2*NSLOT*SLOTB, LDS_OST=LDS_WS+NW*64*4, LDS_BYTES=LDS_OST+NW*4096;
constexpr float C2=0.125f*1.4426950408889634f;
__device__ __forceinline__ void glds16(const void*gsrc,unsigned lds_dst){unsigned keep;
  asm volatile("s_mov_b32 %0, m0\n\ts_mov_b32 m0, %2\n\ts_nop 0\n\tglobal_load_lds_dwordx4 %1, off\n\ts_mov_b32 m0, %0":"=&s"(keep):"v"(gsrc),"s"(lds_dst):"memory");}
__device__ __forceinline__ float max3f(float a,float b,float c){float r;asm("v_max3_f32 %0, %1, %2, %3":"=v"(r):"v"(a),"v"(b),"v"(c));return r;}
__device__ __forceinline__ float max2f(float a,float b){float r;asm("v_max_f32_e32 %0, %1, %2":"=v"(r):"v"(a),"v"(b));return r;}
__device__ __forceinline__ float fadd_s(float a,float b){float r;asm("v_add_f32_e32 %0, %1, %2":"=v"(r):"v"(a),"v"(b));return r;}
__device__ __forceinline__ float fsub_s(float a,float b){float r;asm("v_sub_f32_e32 %0, %1, %2":"=v"(r):"v"(a),"v"(b));return r;}
typedef float f32x2_t __attribute__((ext_vector_type(2))); typedef __bf16 bf16x2_t __attribute__((ext_vector_type(2)));
__device__ __forceinline__ unsigned cvtpk_s(float lo,float hi){f32x2_t v={lo,hi};bf16x2_t b=__builtin_convertvector(v,bf16x2_t);return __builtin_bit_cast(unsigned,b);}
#define WAIT_BAR(N) asm volatile("s_waitcnt vmcnt(" #N ") lgkmcnt(0)\n\ts_barrier":::"memory")

__device__ __forceinline__ void qkt(f32x16&p0,f32x16&p1,const char*Kslot,const bf16x8*qr,const f32x16&negm,int r32,int hi){
  const char*kb=Kslot+hi*1024+r32*16;
  #pragma unroll
  for(int d0=0;d0<4;++d0){
    const bf16x8 b0=*reinterpret_cast<const bf16x8*>(kb+d0*2048);
    const bf16x8 b1=*reinterpret_cast<const bf16x8*>(kb+d0*2048+512);
    if(d0==0){p0=__builtin_amdgcn_mfma_f32_32x32x16_bf16(b0,qr[0],negm,0,0,0);p1=__builtin_amdgcn_mfma_f32_32x32x16_bf16(b1,qr[0],negm,0,0,0);}
    else{p0=__builtin_amdgcn_mfma_f32_32x32x16_bf16(b0,qr[d0],p0,0,0,0);p1=__builtin_amdgcn_mfma_f32_32x32x16_bf16(b1,qr[d0],p1,0,0,0);}}
}
typedef __attribute__((address_space(3))) const char* lds_cptr;
typedef short v4i16_t __attribute__((ext_vector_type(4)));
__device__ __forceinline__ void kload8(bf16x8*kf,lds_cptr kp){
  kf[0]=*(const __attribute__((address_space(3))) bf16x8*)(kp);      kf[1]=*(const __attribute__((address_space(3))) bf16x8*)(kp+512);
  kf[2]=*(const __attribute__((address_space(3))) bf16x8*)(kp+2048); kf[3]=*(const __attribute__((address_space(3))) bf16x8*)(kp+2560);
  kf[4]=*(const __attribute__((address_space(3))) bf16x8*)(kp+4096); kf[5]=*(const __attribute__((address_space(3))) bf16x8*)(kp+4608);
  kf[6]=*(const __attribute__((address_space(3))) bf16x8*)(kp+6144); kf[7]=*(const __attribute__((address_space(3))) bf16x8*)(kp+6656);
}
__device__ __forceinline__ void kload2(bf16x8*kf,lds_cptr kp,int j){ kf[2*j]=*(const __attribute__((address_space(3))) bf16x8*)(kp+j*2048); kf[2*j+1]=*(const __attribute__((address_space(3))) bf16x8*)(kp+j*2048+512); }
__device__ __forceinline__ s16x4 vtr(lds_cptr p){ return __builtin_bit_cast(s16x4,__builtin_amdgcn_ds_read_tr16_b64_v4i16((__attribute__((address_space(3))) v4i16_t*)p)); }
__device__ __forceinline__ float rowmax(const f32x16&p0,const f32x16&p1){
  float a=max3f(p0[0],p0[1],p1[0]),b=max3f(p0[2],p0[3],p1[1]);a=max3f(a,p1[2],p1[3]);
  #pragma unroll
  for(int r=4;r<16;r+=4){a=max3f(a,p0[r],p0[r+1]);b=max3f(b,p0[r+2],p0[r+3]);a=max3f(a,p1[r],p1[r+1]);b=max3f(b,p1[r+2],p1[r+3]);}
  const float m=max2f(a,b);
  auto rr=__builtin_amdgcn_permlane32_swap(__float_as_uint(m),__float_as_uint(m),false,false);
  return max2f(__uint_as_float(rr[0]),__uint_as_float(rr[1]));
}
__device__ __forceinline__ void pv(f32x16*o,int vb,bf16x8 pa0,bf16x8 pa1,bf16x8 pa2,bf16x8 pa3){
  #pragma unroll
  for(int d0=0;d0<2;++d0){s16x4 lo[4],hi[4];
    #pragma unroll
    for(int ks=0;ks<4;++ks){
      asm volatile("ds_read_b64_tr_b16 %0,%1 offset:%c2":"=&v"(lo[ks]):"v"(vb),"i"(d0*4096+ks*1024):"memory");
      asm volatile("ds_read_b64_tr_b16 %0,%1 offset:%c2":"=&v"(hi[ks]):"v"(vb),"i"(d0*4096+ks*1024+512):"memory");}
    asm volatile("s_waitcnt lgkmcnt(0)":::"memory");SBAR();
    #define PK(k) (bf16x8){lo[k][0],lo[k][1],lo[k][2],lo[k][3],hi[k][0],hi[k][1],hi[k][2],hi[k][3]}
    o[d0]=__builtin_amdgcn_mfma_f32_32x32x16_bf16(pa0,PK(0),o[d0],0,0,0);
    o[d0]=__builtin_amdgcn_mfma_f32_32x32x16_bf16(pa1,PK(1),o[d0],0,0,0);
    o[d0]=__builtin_amdgcn_mfma_f32_32x32x16_bf16(pa2,PK(2),o[d0],0,0,0);
    o[d0]=__builtin_amdgcn_mfma_f32_32x32x16_bf16(pa3,PK(3),o[d0],0,0,0);
    #undef PK
  }
}

#ifndef ATTN_STORE16
#define ATTN_STORE16(p,v) (*(u32x4*)(p)=(v))
#endif
template<int THRL> __device__ __forceinline__ void attn_unit(int b,int h,int hv,int ho,int qb,const bf16*Q,const bf16*__restrict__ K,const bf16*__restrict__ V,bf16*O,char*shm){
  int tid_o=threadIdx.x; asm volatile("":"+v"(tid_o)); const int tid=tid_o,lane=tid&63,r32=lane&31,hi=lane>>5; const int wid=__builtin_amdgcn_readfirstlane(tid>>6);
  const long rowbase=(long)b*SEQ; const int q0=qb*QB;
  const bf16*Qw=Q+(rowbase+q0+wid*QBLK)*DM+h*D;
  const bf16*Kh=K+rowbase*DM+h*D,*Vh=V+rowbase*DM+hv*D;
  const unsigned lds0=(unsigned)(uintptr_t)shm;
  float*wsf=(float*)(shm+LDS_WS)+wid*64;
  const bf16*ksrc=Kh+(long)lane*DM+wid*8;
  const bf16*vsrc=Vh+(long)(16*(wid&3)+(lane>>2))*DM+(wid>>2)*32+(lane&3)*8;
  const unsigned kdst=lds0+LDS_K+wid*1024, vdst=lds0+LDS_V+wid*1024;
  #define DMA_K(t,slot) glds16(ksrc+(long)(t)*KVBLK*DM,(unsigned)__builtin_amdgcn_readfirstlane(kdst+(slot)))
  #define DMA_V(t,slot) glds16(vsrc+(long)(t)*KVBLK*DM,(unsigned)__builtin_amdgcn_readfirstlane(vdst+(slot)))
  const int vb0=(int)(lds0+LDS_V)+((lane>>4)&1)*32+(lane&3)*8+(4*hi+((lane&15)>>2))*64;
  const char*Kbase=shm+LDS_K; bf16x8 kf[8];
  const lds_cptr shm3=(lds_cptr)shm; const lds_cptr kp0=shm3+LDS_K+hi*1024+r32*16; const lds_cptr vp0=shm3+LDS_V+((lane>>4)&1)*32+(lane&3)*8+(4*hi+((lane&15)>>2))*64;
  const int NT=(q0+QB)/KVBLK;
  DMA_K(0,0);DMA_V(0,0);DMA_K(1,SLOTB);
  bf16x8 qr[4];
  #pragma unroll
  for(int d0=0;d0<4;++d0)qr[d0]=*reinterpret_cast<const bf16x8*>(&Qw[(long)r32*DM+d0*16+hi*8]);
  float mhat=0.f,l_reg=0.f;f32x16 o[2];o[0]=f32x16{};o[1]=f32x16{};f32x16 negm=f32x16{};asm volatile("":"+v"(negm));
  const int qrel=wid*QBLK+r32;
  #define CMASK(P0,P1,t) do{int jb_=(t)-(NT-4); if(jb_>=0)cmask(P0,P1,jb_,qrel,hi);}while(0)
  bool resc=false;
  #define START(P0,P1) do{ const float rm=rowmax(P0,P1); resc=false; \
    { const float dl=rm; mhat=fadd_s(mhat,dl); \
      _Pragma("unroll") for(int r=0;r<16;++r){P0[r]=fsub_s(P0[r],dl);P1[r]=fsub_s(P1[r],dl);} \
      _Pragma("unroll") for(int r=0;r<16;++r)negm[r]=-mhat; asm volatile("":"+v"(negm)); } \
    _Pragma("unroll") for(int r=0;r<16;++r)P0[r]=__builtin_amdgcn_exp2f(P0[r]); }while(0)
  #define RESC() do{ if(resc){ asm volatile("s_waitcnt lgkmcnt(0)":::"memory"); \
      _Pragma("unroll") for(int d_=0;d_<2;++d_) _Pragma("unroll") for(int r=0;r<16;++r)o[d_][r]*=wsf[crow(r,hi)]; } }while(0)
  f32x16 pA0,pA1,pB0,pB1;
  int sl_prev=0,sl_cur=0,sl_next=SLOTB;
  #define ROT() do{sl_prev=sl_cur;sl_cur=sl_next;sl_next=(sl_next==(NSLOT-1)*SLOTB)?0:sl_next+SLOTB;}while(0)
  DMA_K(2,2*SLOTB);
  WAIT_BAR(3);
  qkt(pA0,pA1,Kbase,qr,negm,r32,hi);asm volatile("s_nop 15\n\ts_nop 7":"+v"(pA0),"+v"(pA1));CMASK(pA0,pA1,0);
  START(pA0,pA1);
  _Pragma("unroll") for(int r=0;r<16;++r)pA1[r]=__builtin_amdgcn_exp2f(pA1[r]);
  WAIT_BAR(0);
  DMA_K(3,0);DMA_V(1,SLOTB);
  ROT();
  kload8(kf,kp0+sl_cur);
  WAIT_BAR(2);
  s16x4 vlo[8],vhi[8]; u32x4 pw0,pw1,pw2,pw3;
  #define PKW(P,B) cvtpk_s(P[B],P[B+1])
  #define PAF(k) __builtin_bit_cast(bf16x8,pw##k)
  #define VFR(i) (bf16x8){vlo[i][0],vlo[i][1],vlo[i][2],vlo[i][3],vhi[i][0],vhi[i][1],vhi[i][2],vhi[i][3]}
  #define PIN(x) asm volatile("":"+v"(x))
  #define MX3(a,b,c) __builtin_fmaxf(__builtin_fmaxf((a),(b)),(c))
  #define GAPA(MF,A0,A1,A2,A3,W0,W1,PW) do{ MF; sacc+=A0; sacc+=A1; sacc+=A2; sacc+=A3; PIN(sacc); W0; W1; PIN(PW); SBAR(); }while(0)
  #define EX(v) __builtin_amdgcn_exp2f(v)
  #define GAPB(MF,X,B) do{ MF; X[B]=EX(X[B]); X[B+1]=EX(X[B+1]); X[B+2]=EX(X[B+2]); X[B+3]=EX(X[B+3]); PIN(X); SBAR(); }while(0)
  #define VRD(i) do{ vlo[i]=vtr(vp_+(((i)>>2)*4096+((i)&3)*1024)); vhi[i]=vtr(vp_+(((i)>>2)*4096+((i)&3)*1024+512)); }while(0)
  #define KRD(G,j) do{ if(G){ kload2(kf,kp0+sl_next,j); SBAR(); } }while(0)
  #define STEP(C0,C1,P0,P1,t,GK,GV,GL) do{ SBAR(); \
    const lds_cptr vp_=vp0+sl_prev; \
    VRD(0); SBAR(); float sacc=(P0[0]+P0[1]); \
    GAPA(C0=__builtin_amdgcn_mfma_f32_32x32x16_bf16(kf[0],qr[0],negm,0,0,0), P0[2],P0[3],P0[4],P0[5],     pw0[0]=PKW(P0,0), pw0[1]=PKW(P0,2), pw0); \
    VRD(4); SBAR(); GAPA(C1=__builtin_amdgcn_mfma_f32_32x32x16_bf16(kf[1],qr[0],negm,0,0,0), P0[6],P0[7],P0[8],P0[9],     pw0[2]=PKW(P0,4), pw0[3]=PKW(P0,6), pw0); \
    VRD(1); SBAR(); GAPA(C0=__builtin_amdgcn_mfma_f32_32x32x16_bf16(kf[2],qr[1],C0,0,0,0),   P0[10],P0[11],P0[12],P0[13], pw1[0]=PKW(P0,8), pw1[1]=PKW(P0,10), pw1); \
    VRD(5); SBAR(); GAPA(C1=__builtin_amdgcn_mfma_f32_32x32x16_bf16(kf[3],qr[1],C1,0,0,0),   P0[14],P0[15],P1[0],P1[1],   pw1[2]=PKW(P0,12),pw1[3]=PKW(P0,14), pw1); \
    VRD(2); SBAR(); GAPA(C0=__builtin_amdgcn_mfma_f32_32x32x16_bf16(kf[4],qr[2],C0,0,0,0),   P1[2],P1[3],P1[4],P1[5],     pw2[0]=PKW(P1,0), pw2[1]=PKW(P1,2), pw2); \
    VRD(6); SBAR(); GAPA(C1=__builtin_amdgcn_mfma_f32_32x32x16_bf16(kf[5],qr[2],C1,0,0,0),   P1[6],P1[7],P1[8],P1[9],     pw2[2]=PKW(P1,4), pw2[3]=PKW(P1,6), pw2); \
    VRD(3); SBAR(); GAPA(C0=__builtin_amdgcn_mfma_f32_32x32x16_bf16(kf[6],qr[3],C0,0,0,0),   P1[10],P1[11],P1[12],P1[13], pw3[0]=PKW(P1,8), pw3[1]=PKW(P1,10), pw3); \
    VRD(7); SBAR(); GAPA(C1=__builtin_amdgcn_mfma_f32_32x32x16_bf16(kf[7],qr[3],C1,0,0,0),   P1[14],P1[15],0.f,0.f,       pw3[2]=PKW(P1,12),pw3[3]=PKW(P1,14), pw3); \
    l_reg+=sacc; \
    if(GK){DMA_K((t)+3,sl_cur);} if(GV){DMA_V((t)+1,sl_next);} \
    CMASK(C0,C1,t); \
    { float a=MX3(C0[0],C0[1],C1[0]),b=MX3(C0[2],C0[3],C1[1]); a=MX3(a,C1[2],C1[3]); \
      _Pragma("unroll") for(int r=4;r<16;r+=4){a=MX3(a,C0[r],C0[r+1]);b=MX3(b,C0[r+2],C0[r+3]);a=MX3(a,C1[r],C1[r+1]);b=MX3(b,C1[r+2],C1[r+3]);} \
      float rm=__builtin_fmaxf(a,b); { auto rr=__builtin_amdgcn_permlane32_swap(__float_as_uint(rm),__float_as_uint(rm),false,false); rm=__builtin_fmaxf(__uint_as_float(rr[0]),__uint_as_float(rr[1])); } \
      resc=false; \
      if(__builtin_expect(__any(rm>(float)THRL),0)){ const float dl=__builtin_fmaxf(rm,0.f); mhat+=dl; \
        _Pragma("unroll") for(int r=0;r<16;++r){C0[r]-=dl;C1[r]-=dl;} \
        _Pragma("unroll") for(int r=0;r<16;++r)negm[r]=-mhat; asm volatile("":"+v"(negm)); \
        const float f=__builtin_amdgcn_exp2f(-dl); l_reg*=f; if(hi==0)wsf[r32]=f; resc=true; } } \
    SBAR(); \
    GAPB(o[0]=__builtin_amdgcn_mfma_f32_32x32x16_bf16(PAF(0),VFR(0),o[0],0,0,0), C0,0); \
    GAPB(o[1]=__builtin_amdgcn_mfma_f32_32x32x16_bf16(PAF(0),VFR(4),o[1],0,0,0), C0,4); \
    KRD(GL,0); GAPB(o[0]=__builtin_amdgcn_mfma_f32_32x32x16_bf16(PAF(1),VFR(1),o[0],0,0,0), C0,8); \
    KRD(GL,1); GAPB(o[1]=__builtin_amdgcn_mfma_f32_32x32x16_bf16(PAF(1),VFR(5),o[1],0,0,0), C0,12); \
    KRD(GL,2); GAPB(o[0]=__builtin_amdgcn_mfma_f32_32x32x16_bf16(PAF(2),VFR(2),o[0],0,0,0), C1,0); \
    KRD(GL,3); GAPB(o[1]=__builtin_amdgcn_mfma_f32_32x32x16_bf16(PAF(2),VFR(6),o[1],0,0,0), C1,4); \
    GAPB(o[0]=__builtin_amdgcn_mfma_f32_32x32x16_bf16(PAF(3),VFR(3),o[0],0,0,0), C1,8); \
    GAPB(o[1]=__builtin_amdgcn_mfma_f32_32x32x16_bf16(PAF(3),VFR(7),o[1],0,0,0), C1,12); \
    }while(0)
  int t=1;
  #undef CMASK
  #define CMASK(P0,P1,t) do{}while(0)
  for(;t+5<NT;t+=2){
    STEP(pB0,pB1,pA0,pA1,t,true,true,true);     WAIT_BAR(2); RESC(); ROT();
    STEP(pA0,pA1,pB0,pB1,t+1,true,true,true);   WAIT_BAR(2); RESC(); ROT();
  }
  #undef CMASK
  #define CMASK(P0,P1,t) do{int jb_=(t)-(NT-4); if(jb_>=0)cmask(P0,P1,jb_,qrel,hi);}while(0)
  #define ENDW(tt) do{ if((tt)+3<NT){WAIT_BAR(2);} else if((tt)+2<NT){WAIT_BAR(1);} else {WAIT_BAR(0);} }while(0)
  for(;t+1<NT;t+=2){
    STEP(pB0,pB1,pA0,pA1,t,(t+3<NT),(t+1<NT),(t+1<NT));       ENDW(t);   RESC(); ROT();
    STEP(pA0,pA1,pB0,pB1,t+1,(t+4<NT),(t+2<NT),(t+2<NT));     ENDW(t+1); RESC(); ROT();
  }
  STEP(pB0,pB1,pA0,pA1,NT-1,false,false,false); RESC();
  { float sacc=pB0[0]+pB0[1]; _Pragma("unroll") for(int r=2;r<16;++r)sacc+=pB0[r]; _Pragma("unroll") for(int r=0;r<16;++r)sacc+=pB1[r]; l_reg+=sacc;
    pw0=(u32x4){PKW(pB0,0),PKW(pB0,2),PKW(pB0,4),PKW(pB0,6)};pw1=(u32x4){PKW(pB0,8),PKW(pB0,10),PKW(pB0,12),PKW(pB0,14)};pw2=(u32x4){PKW(pB1,0),PKW(pB1,2),PKW(pB1,4),PKW(pB1,6)};pw3=(u32x4){PKW(pB1,8),PKW(pB1,10),PKW(pB1,12),PKW(pB1,14)};
    SBAR(); pv(o,vb0+sl_cur,PAF(0),PAF(1),PAF(2),PAF(3)); }
  #undef PKW
  #undef PAF
  #undef VFR
  #undef PIN
  #undef MX3
  #undef GAPA
  #undef GAPB
  #undef EX
  #undef VRD
  #undef KRD
  #undef STEP
  #undef ENDW
  {auto rr=__builtin_amdgcn_permlane32_swap(__float_as_uint(l_reg),__float_as_uint(l_reg),false,false);l_reg=__uint_as_float(rr[0])+__uint_as_float(rr[1]);}
  if(hi==0)wsf[32+r32]=l_reg;asm volatile("s_waitcnt lgkmcnt(0)":::"memory");
  float rli[16];
  #pragma unroll
  for(int r=0;r<16;++r)rli[r]=__builtin_amdgcn_rcpf(wsf[32+crow(r,hi)]);
  bf16*Ow=O+(rowbase+q0+wid*QBLK)*DM+ho*D;
  { bf16*stg=(bf16*)(shm+LDS_OST)+wid*2048;
    #pragma unroll
    for(int r=0;r<16;++r){const int orow=crow(r,hi);
      #pragma unroll
      for(int d0=0;d0<2;++d0)stg[orow*64+d0*32+r32]=__float2bfloat16(o[d0][r]*rli[r]);}
    asm volatile("s_waitcnt lgkmcnt(0)":::"memory");
    #pragma unroll
    for(int i=0;i<4;++i){const int row=i*8+(lane>>3),ch=lane&7; const u32x4 v=*(const u32x4*)(stg+row*64+ch*8); ATTN_STORE16(Ow+(long)row*DM+ch*8,v);} }
  asm volatile("s_waitcnt lgkmcnt(0)\n\ts_barrier":::"memory");
  #undef DMA_K
  #undef DMA_V
  #undef CMASK
  #undef START
  #undef RESC
  #undef ROT
}
constexpr int ATTN_LDS_BYTES=LDS_BYTES;
#undef SBAR
#undef WAIT_BAR
}
#define LAS __attribute__((address_space(3)))
typedef unsigned short bf16;
typedef unsigned v4u __attribute__((ext_vector_type(4)));
typedef unsigned v2u __attribute__((ext_vector_type(2)));
typedef float f32x4 __attribute__((ext_vector_type(4)));
typedef short bf16x8 __attribute__((ext_vector_type(8)));
#define LDS_WAIT() asm volatile("s_waitcnt lgkmcnt(0)" ::: "memory")

constexpr int NWAVES = 8, NTHREADS = 512;
constexpr int DM = 1024, BATCH = 16, SEQ = 4096, DEPTH = 4, M = BATCH * SEQ, MH = M / 2, NIN = 7168, DFF = 2816, NUP = 2 * DFF, PLE = 256;
constexpr float EPS = 1e-6f;
constexpr size_t MiB = 1u << 20;
constexpr size_t WS_W = 2 * MiB, W_LAYER = 40 * MiB;
constexpr size_t WO_IN = 0, WO_UP = 14 * MiB, WO_DOWN = 25 * MiB, WO_PA = 31 * MiB, WO_PB = 33 * MiB, WO_O = 35 * MiB, WO_PG = 37 * MiB, WO_PLE = 39 * MiB, WO_S = 39 * MiB + 512 * 1024;
constexpr size_t WS_H = 162 * MiB;
constexpr size_t WS_Z = 290 * MiB, ZS = (size_t)MH * DM;
constexpr size_t WS_O1 = 738 * MiB, WS_O2 = 802 * MiB;
constexpr size_t WS_ACT = 290 * MiB, WS_E = 642 * MiB, WS_PBF = 770 * MiB, WS_EDGE = 802 * MiB;
constexpr size_t WS_END = 866 * MiB;
constexpr int LDS_BYTES = 147456, XB_OFF = 131072 + 1024;

__device__ __forceinline__ unsigned f2bf(float f) { unsigned u = __builtin_bit_cast(unsigned, f); return (u + 0x7fffu + ((u >> 16) & 1u)) >> 16; }
__device__ __forceinline__ unsigned pk2(float lo, float hi) { return f2bf(lo) | (f2bf(hi) << 16); }
__device__ __forceinline__ float blo(unsigned w) { return __builtin_bit_cast(float, w << 16); }
__device__ __forceinline__ float bhi(unsigned w) { return __builtin_bit_cast(float, w & 0xffff0000u); }
__device__ __forceinline__ float bperm(float v, int srclane) { return __builtin_bit_cast(float, __builtin_amdgcn_ds_bpermute(srclane << 2, __builtin_bit_cast(int, v))); }
__device__ __forceinline__ float wave_sum(float v, int lane) {
#pragma unroll
    for (int o = 1; o < 64; o <<= 1) v += bperm(v, lane ^ o);
    return v;
}
__device__ __forceinline__ int up_row_map(int n) { return n < DFF ? (n >> 7) * 256 + (n & 127) : ((n - DFF) >> 7) * 256 + 128 + ((n - DFF) & 127); }
template <bool UPMAP> __device__ __forceinline__ void transpose_item(const float* W, int K, int N, bf16* WT, LAS float* scr, int item, int lane) {
    const int nblk = N / 32, kb = item / nblk, nb = item % nblk, k0 = 64 * kb, n0 = 32 * nb;
#pragma unroll 8
    for (int i = 0; i < 32; ++i) { const int kk = 2 * i + (lane >> 5); scr[kk * 33 + (lane & 31)] = W[(size_t)(k0 + kk) * N + n0 + (lane & 31)]; }
    LDS_WAIT(); asm volatile("" ::: "memory");
    const int c = lane & 7;
#pragma unroll
    for (int j = 0; j < 4; ++j) { const int n = (lane >> 3) + 8 * j; const LAS float* s = scr + (8 * c) * 33 + n;
        v4u o; o.x = pk2(s[0 * 33], s[1 * 33]); o.y = pk2(s[2 * 33], s[3 * 33]); o.z = pk2(s[4 * 33], s[5 * 33]); o.w = pk2(s[6 * 33], s[7 * 33]);
        const int dr = UPMAP ? up_row_map(n0 + n) : (n0 + n);
        *(v4u*)(WT + (size_t)dr * K + k0 + 8 * c) = o; }
    LDS_WAIT(); asm volatile("" ::: "memory");
}
template <bool OUTF32> __device__ __forceinline__ void rms_row(const float* xrow, const float* g, void* orow, int lane) {
    const f32x4* xr = (const f32x4*)xrow + lane;
    f32x4 v[4]; float s = 0.f;
#pragma unroll
    for (int j = 0; j < 4; ++j) { v[j] = xr[64 * j]; s += (v[j].x * v[j].x + v[j].y * v[j].y) + (v[j].z * v[j].z + v[j].w * v[j].w); }
    const float rstd = 1.0f / sqrtf(wave_sum(s, lane) * (1.f / DM) + EPS);
#pragma unroll
    for (int j = 0; j < 4; ++j) { const f32x4 gg = ((const f32x4*)g)[lane + 64 * j]; const f32x4 o = v[j] * rstd * gg;
        if (OUTF32) ((f32x4*)orow)[lane + 64 * j] = o;
        else ((unsigned long long*)orow)[lane + 64 * j] = (unsigned long long)pk2(o.x, o.y) | ((unsigned long long)pk2(o.z, o.w) << 32); }
}
__device__ __forceinline__ void sgu_unit(LAS unsigned char* lds, bf16* U, const bf16* V, const bf16* Wsb, const float* bs, const float* lng, const float* lnb, size_t row0, int tid, int lane, int wave) {
    LAS float* st = (LAS float*)lds;
    LAS unsigned char* vt = lds + 1024;
    for (int i = 0; i < 16; ++i) { const int r = wave * 16 + i; const bf16* vr = V + (row0 + r) * DM;
        const v4u a = ((const v4u*)vr)[lane], b = ((const v4u*)vr)[64 + lane];
        float f[16];
        f[0] = blo(a.x); f[1] = bhi(a.x); f[2] = blo(a.y); f[3] = bhi(a.y); f[4] = blo(a.z); f[5] = bhi(a.z); f[6] = blo(a.w); f[7] = bhi(a.w);
        f[8] = blo(b.x); f[9] = bhi(b.x); f[10] = blo(b.y); f[11] = bhi(b.y); f[12] = blo(b.z); f[13] = bhi(b.z); f[14] = blo(b.w); f[15] = bhi(b.w);
        float s = 0.f;
#pragma unroll
        for (int j = 0; j < 16; ++j) s += f[j];
        const float mean = wave_sum(s, lane) * (1.f / DM); float q = 0.f;
#pragma unroll
        for (int j = 0; j < 16; ++j) { const float d = f[j] - mean; q += d * d; }
        const float rstd = 1.0f / sqrtf(wave_sum(q, lane) * (1.f / DM) + EPS);
        if (lane == 0) { st[2 * r] = mean; st[2 * r + 1] = rstd; } }
    __syncthreads();
    const int cg8 = tid & 15, rp = tid >> 4, fr = lane & 15, fq = lane >> 4;
    const int ksmax = (wave * 16 + 15) >> 5;
#pragma unroll 1
    for (int g = 0; g < 8; ++g) {
        { float gam[8], bet[8];
#pragma unroll
          for (int j = 0; j < 8; ++j) { gam[j] = lng[g * 128 + 8 * cg8 + j]; bet[j] = lnb[g * 128 + 8 * cg8 + j]; }
          float nv[4][8];
#pragma unroll
          for (int rr = 0; rr < 4; ++rr) { const int r = 4 * rp + rr; const v4u raw = *(const v4u*)(V + (row0 + r) * DM + g * 128 + 8 * cg8);
              const float mean = st[2 * r], rstd = st[2 * r + 1];
              nv[rr][0] = (blo(raw.x) - mean) * rstd * gam[0] + bet[0]; nv[rr][1] = (bhi(raw.x) - mean) * rstd * gam[1] + bet[1];
              nv[rr][2] = (blo(raw.y) - mean) * rstd * gam[2] + bet[2]; nv[rr][3] = (bhi(raw.y) - mean) * rstd * gam[3] + bet[3];
              nv[rr][4] = (blo(raw.z) - mean) * rstd * gam[4] + bet[4]; nv[rr][5] = (bhi(raw.z) - mean) * rstd * gam[5] + bet[5];
              nv[rr][6] = (blo(raw.w) - mean) * rstd * gam[6] + bet[6]; nv[rr][7] = (bhi(raw.w) - mean) * rstd * gam[7] + bet[7]; }
#pragma unroll
          for (int j = 0; j < 8; ++j) { v2u w; w.x = pk2(nv[0][j], nv[1][j]); w.y = pk2(nv[2][j], nv[3][j]); *(LAS v2u*)(vt + (8 * cg8 + j) * 272 + rp * 8) = w; } }
        __syncthreads();
        const bf16* wrow = Wsb + (size_t)g * 16384 + (16 * wave + fr) * 128 + fq * 8;
        bf16x8 bw[4];
#pragma unroll
        for (int ks = 0; ks < 4; ++ks) bw[ks] = *(const bf16x8*)(wrow + ks * 32);
        f32x4 acc[8];
#pragma unroll
        for (int cb = 0; cb < 8; ++cb) acc[cb] = (f32x4){0.f, 0.f, 0.f, 0.f};
#pragma unroll
        for (int ks = 0; ks < 4; ++ks) if (ks <= ksmax) {
#pragma unroll
            for (int cb = 0; cb < 8; ++cb) { const bf16x8 av = *(const LAS bf16x8*)(vt + (16 * cb + fr) * 272 + (ks * 32 + fq * 8) * 2);
                acc[cb] = __builtin_amdgcn_mfma_f32_16x16x32_bf16(av, bw[ks], acc[cb], 0, 0, 0); } }
        const int t = 16 * wave + fr; const float bias = bs[g * 128 + t];
#pragma unroll
        for (int cb = 0; cb < 8; ++cb) { bf16* up = U + (row0 + t) * DM + g * 128 + 16 * cb + 4 * fq; const v2u uu = *(const v2u*)up;
            v2u w; w.x = pk2(blo(uu.x) * (acc[cb][0] + bias), bhi(uu.x) * (acc[cb][1] + bias)); w.y = pk2(blo(uu.y) * (acc[cb][2] + bias), bhi(uu.y) * (acc[cb][3] + bias));
            *(v2u*)up = w; }
        __syncthreads();
    }
}

struct Args { const float* in[27]; float* out; unsigned char* ws; };

#define PH() \
    const Args* ap; { auto kp_ = __builtin_amdgcn_kernarg_segment_ptr(); asm volatile("" : "+s"(kp_)); ap = (const Args*)kp_; } \
    int tid_o = threadIdx.x, bx_o = blockIdx.x, G_o = gridDim.x; asm volatile("" : "+v"(tid_o)); asm volatile("" : "+s"(bx_o), "+s"(G_o)); \
    const int tid = tid_o, bx = bx_o, G = G_o, lane = tid & 63, wave = __builtin_amdgcn_readfirstlane(tid >> 6); \
    const int gw = bx * NWAVES + wave, NGW = G * NWAVES; const size_t gt = (size_t)bx * NTHREADS + tid, NGT = (size_t)G * NTHREADS; \
    unsigned char* const ws = ap->ws; float* const X = ap->out; bf16* const H = (bf16*)(ws + WS_H); bf16* const Z = (bf16*)(ws + WS_Z); \
    bf16 *const ZU = Z, *const ZV = Z + ZS, *const ZQ = Z + 2 * ZS, *const ZK = Z + 3 * ZS, *const ZVA = Z + 4 * ZS, *const ZGA = Z + 5 * ZS, *const ZGB = Z + 6 * ZS; \
    bf16 *const O1 = (bf16*)(ws + WS_O1), *const O2 = (bf16*)(ws + WS_O2), *const ACT = (bf16*)(ws + WS_ACT), *const EB = (bf16*)(ws + WS_E), *const PBF = (bf16*)(ws + WS_PBF); \
    float* const EDGE = (float*)(ws + WS_EDGE); unsigned char* const wl = ws + WS_W + (size_t)l * W_LAYER; \
    (void)lane; (void)gw; (void)NGW; (void)gt; (void)NGT; (void)X; (void)H; (void)ZU; (void)ZV; (void)ZQ; (void)ZK; (void)ZVA; (void)ZGA; (void)ZGB; (void)O1; (void)O2; (void)ACT; (void)EB; (void)PBF; (void)EDGE; (void)wl

__device__ __forceinline__ void ctr_grid_sync(unsigned* ctr, unsigned target) {
    asm volatile("s_waitcnt vmcnt(0) lgkmcnt(0)" ::: "memory");
    __syncthreads();
    if (threadIdx.x == 0) {
        __builtin_amdgcn_fence(__ATOMIC_RELEASE, "agent");
        asm volatile("s_waitcnt vmcnt(0)" ::: "memory");
        __hip_atomic_fetch_add(ctr, 1u, __ATOMIC_RELAXED, __HIP_MEMORY_SCOPE_AGENT);
        while (__hip_atomic_load(ctr, __ATOMIC_RELAXED, __HIP_MEMORY_SCOPE_AGENT) < target) __builtin_amdgcn_s_sleep(2);
    }
    __syncthreads();
    __builtin_amdgcn_fence(__ATOMIC_ACQUIRE, "agent");
    asm volatile("s_waitcnt vmcnt(0)" ::: "memory");
}
#define GRID_SYNC() do { unsigned G_s = gridDim.x; asm volatile("" : "+s"(G_s)); ++nsync; const Args* ap_s; { auto kp_ = __builtin_amdgcn_kernarg_segment_ptr(); asm volatile("" : "+s"(kp_)); ap_s = (const Args*)kp_; } ctr_grid_sync((unsigned*)ap_s->ws, nsync * G_s); } while (0)
__global__ void __launch_bounds__(NTHREADS, 2) fwd_kernel(Args a_unused) {
    extern __shared__ __attribute__((aligned(16))) unsigned char lds[];
    cg::grid_group grid = cg::this_grid();
    LAS unsigned char* ldsl = (LAS unsigned char*)lds;
    unsigned nsync = 0;
    grid.sync();

    {
        const int l = 0; PH();
        LAS float* scr = (LAS float*)(ldsl + wave * 16384);
        constexpr int I_IN = (DM / 64) * (NIN / 32), I_SQ = (DM / 64) * (DM / 32), I_UP = (DM / 64) * (NUP / 32), I_DN = (DFF / 64) * (DM / 32), I_PLE = (PLE / 64) * (DM / 32);
        constexpr int I_LAYER = I_IN + 4 * I_SQ + I_UP + I_DN + I_PLE;
        for (int it = gw; it < DEPTH * I_LAYER; it += NGW) {
            const int ll = it / I_LAYER; int r = it % I_LAYER; unsigned char* wll = ws + WS_W + (size_t)ll * W_LAYER;
            if (r < I_IN) { transpose_item<false>(ap->in[3] + (size_t)ll * DM * NIN, DM, NIN, (bf16*)(wll + WO_IN), scr, r, lane); continue; } r -= I_IN;
            if (r < I_SQ) { transpose_item<false>(ap->in[14] + (size_t)ll * DM * DM, DM, DM, (bf16*)(wll + WO_PA), scr, r, lane); continue; } r -= I_SQ;
            if (r < I_SQ) { transpose_item<false>(ap->in[15] + (size_t)ll * DM * DM, DM, DM, (bf16*)(wll + WO_PB), scr, r, lane); continue; } r -= I_SQ;
            if (r < I_SQ) { transpose_item<false>(ap->in[16] + (size_t)ll * DM * DM, DM, DM, (bf16*)(wll + WO_O), scr, r, lane); continue; } r -= I_SQ;
            if (r < I_SQ) { transpose_item<false>(ap->in[23] + (size_t)ll * DM * DM, DM, DM, (bf16*)(wll + WO_PG), scr, r, lane); continue; } r -= I_SQ;
            if (r < I_UP) { transpose_item<true>(ap->in[18] + (size_t)ll * DM * NUP, DM, NUP, (bf16*)(wll + WO_UP), scr, r, lane); continue; } r -= I_UP;
            if (r < I_DN) { transpose_item<false>(ap->in[21] + (size_t)ll * DFF * DM, DFF, DM, (bf16*)(wll + WO_DOWN), scr, r, lane); continue; } r -= I_DN;
            transpose_item<false>(ap->in[25] + (size_t)ll * PLE * DM, PLE, DM, (bf16*)(wll + WO_PLE), scr, r, lane);
        }
        { const float* wsrc = ap->in[7];
          for (size_t i = gt; i < (size_t)DEPTH * 8 * 128 * 128; i += NGT) { const int ll = (int)(i >> 17), rem = (int)(i & 131071), t = (rem >> 7) & 127, sc = rem & 127;
              const float w = wsrc[i]; ((bf16*)(ws + WS_W + (size_t)ll * W_LAYER + WO_S))[rem] = (bf16)f2bf(sc <= t ? w : 0.f); } }
        { const float* xin = ap->in[0]; const float* g0 = ap->in[2];
          for (int m = gw; m < M; m += NGW) rms_row<false>(xin + (size_t)m * DM, g0, H + (size_t)m * DM, lane); }
    }
    GRID_SYNC();

#ifndef DBG_STOP
#define DBG_STOP 0
#endif
#define DBG_DUMP_BF16(buf) do { PH(); for (size_t i = gt; i < (size_t)M * DM; i += NGT) X[i] = blo((unsigned)(buf)[i % ((size_t)MH * DM)]); return; } while (0)
#define DBG_DUMP3(b0, b1, b2) do { PH(); for (size_t i = gt; i < (size_t)M * DM; i += NGT) { const size_t k = i % ((size_t)MH * DM); X[i] = blo((unsigned)(b0)[k]) + blo((unsigned)(b1)[k]) + blo((unsigned)(b2)[k]); } return; } while (0)
#define DBG_ZERO_UPPER() do { PH(); for (size_t i = gt; i < (size_t)MH * DM; i += NGT) X[(size_t)MH * DM + i] = 0.f; return; } while (0)
#pragma unroll 1
    for (int l = 0; l < DEPTH; ++l) {
#pragma unroll 1
        for (int hf = 0; hf < 2; ++hf) {
            { PH(); pg8::Gemm g{H + (size_t)hf * MH * DM, (const bf16*)(wl + WO_IN), MH, NIN, DM}; pg8::StaticOrder S; S.init(MH, NIN, G, bx);
              pg8::EpiIn E{Z, ZS, ap->in[4] + (size_t)l * 2 * DM, 0.125f * 1.4426950408889634f};
              pg8::gemm_phase<pg8::EpiIn, pg8::StaticOrder, true, true>(ldsl, g, S, E); }
            GRID_SYNC();
            if (DBG_STOP == 2) DBG_DUMP3(ZU, ZQ, ZGA);
            if (DBG_STOP == 12) DBG_DUMP3(ZV, ZK, ZGB);
            if (DBG_STOP == 22) DBG_DUMP3(ZVA, ZVA, ZVA);
            if (DBG_STOP == 1) DBG_DUMP3(H, H, H);
            if (DBG_STOP == 32) DBG_DUMP3(ZGA, ZGA, ZGA);
            if (DBG_STOP == 42) DBG_DUMP3(ZU, ZU, ZU);
            if (DBG_STOP == 52) DBG_DUMP3(ZQ, ZQ, ZQ);
            { PH();
              for (int i = bx; i < 4096; i += G) { const int combo = i & 255, qb = 15 - (i >> 8), b = combo & 7, r = combo >> 3, h = r >> 2, mp = (r >> 1) & 1, e = r & 1;
                  attn_body::attn_unit<8>(b, 2 * h + mp, 2 * h + e, 2 * h + e, qb, (const attn_body::bf16*)ZQ, (const attn_body::bf16*)ZK, (const attn_body::bf16*)ZVA, (attn_body::bf16*)(mp ? O2 : O1), (char*)lds); } }
            __syncthreads();
            { PH();
              const float* bs = ap->in[8] + (size_t)l * 1024; const float* lng = ap->in[5] + (size_t)l * DM; const float* lnb = ap->in[6] + (size_t)l * DM;
              for (int i = bx; i < MH / 128; i += G) sgu_unit(ldsl, ZU, ZV, (const bf16*)(wl + WO_S), bs, lng, lnb, (size_t)i * 128, tid, lane, wave); }
            GRID_SYNC();
            if (DBG_STOP == 3) DBG_DUMP3(O1, O2, ZU);
            if (DBG_STOP == 13) DBG_DUMP3(O1, O2, O1);
            if (DBG_STOP == 23) DBG_DUMP3(ZU, ZU, ZU);
            { PH();
              const float lam_init = 0.8f - 0.6f * expf(-0.3f * (float)l);
              const float s1 = wave_sum(ap->in[9][l * 64 + lane] * ap->in[10][l * 64 + lane], lane), s2 = wave_sum(ap->in[11][l * 64 + lane] * ap->in[12][l * 64 + lane], lane);
              const float lam = expf(s1) - expf(s2) + lam_init;
              float gs[16];
              { const float* gsub = ap->in[13] + l * 128 + 16 * (lane & 7);
#pragma unroll
                for (int j = 0; j < 16; ++j) gs[j] = gsub[j] * (1.0f - lam_init); }
#pragma unroll 1
              for (int r = gw; r < MH; r += NGW) {
                  const v4u a0 = *(const v4u*)(O1 + (size_t)r * DM + 16 * lane), a1 = *(const v4u*)(O1 + (size_t)r * DM + 16 * lane + 8);
                  const v4u b0 = *(const v4u*)(O2 + (size_t)r * DM + 16 * lane), b1 = *(const v4u*)(O2 + (size_t)r * DM + 16 * lane + 8);
                  float d[16];
                  d[0] = blo(a0.x) - lam * blo(b0.x); d[1] = bhi(a0.x) - lam * bhi(b0.x); d[2] = blo(a0.y) - lam * blo(b0.y); d[3] = bhi(a0.y) - lam * bhi(b0.y);
                  d[4] = blo(a0.z) - lam * blo(b0.z); d[5] = bhi(a0.z) - lam * bhi(b0.z); d[6] = blo(a0.w) - lam * blo(b0.w); d[7] = bhi(a0.w) - lam * bhi(b0.w);
                  d[8] = blo(a1.x) - lam * blo(b1.x); d[9] = bhi(a1.x) - lam * bhi(b1.x); d[10] = blo(a1.y) - lam * blo(b1.y); d[11] = bhi(a1.y) - lam * bhi(b1.y);
                  d[12] = blo(a1.z) - lam * blo(b1.z); d[13] = bhi(a1.z) - lam * bhi(b1.z); d[14] = blo(a1.w) - lam * blo(b1.w); d[15] = bhi(a1.w) - lam * bhi(b1.w);
                  float ss = 0.f;
#pragma unroll
                  for (int j = 0; j < 16; ++j) ss += d[j] * d[j];
                  ss += bperm(ss, lane ^ 1); ss += bperm(ss, lane ^ 2); ss += bperm(ss, lane ^ 4);
                  const float rs = 1.0f / sqrtf(ss * (1.f / 128.f) + EPS);
                  v4u w0, w1;
                  w0.x = pk2(d[0] * rs * gs[0], d[1] * rs * gs[1]); w0.y = pk2(d[2] * rs * gs[2], d[3] * rs * gs[3]); w0.z = pk2(d[4] * rs * gs[4], d[5] * rs * gs[5]); w0.w = pk2(d[6] * rs * gs[6], d[7] * rs * gs[7]);
                  w1.x = pk2(d[8] * rs * gs[8], d[9] * rs * gs[9]); w1.y = pk2(d[10] * rs * gs[10], d[11] * rs * gs[11]); w1.z = pk2(d[12] * rs * gs[12], d[13] * rs * gs[13]); w1.w = pk2(d[14] * rs * gs[14], d[15] * rs * gs[15]);
                  *(v4u*)(ZQ + (size_t)r * DM + 16 * lane) = w0; *(v4u*)(ZQ + (size_t)r * DM + 16 * lane + 8) = w1; } }
            GRID_SYNC();
            if (DBG_STOP == 4) DBG_DUMP3(ZQ, ZQ, ZQ);
            { PH(); pg8::StaticOrder S; S.init(MH, DM, G, bx);
              pg8::Gemm g{ZU, (const bf16*)(wl + WO_PA), MH, DM, DM}; pg8::EpiGate<false> E{ZGA, ZK}; pg8::gemm_phase<pg8::EpiGate<false>, pg8::StaticOrder, true, true>(ldsl, g, S, E); }
            { PH(); pg8::StaticOrder S; S.init(MH, DM, G, bx);
              pg8::Gemm g{ZQ, (const bf16*)(wl + WO_PB), MH, DM, DM}; pg8::EpiGate<true> E{ZGB, ZK}; pg8::gemm_phase<pg8::EpiGate<true>, pg8::StaticOrder, true, true>(ldsl, g, S, E); }
            GRID_SYNC();
            if (DBG_STOP == 5) DBG_DUMP3(ZK, ZK, ZK);
            { PH(); pg8::Gemm g{ZK, (const bf16*)(wl + WO_O), MH, DM, DM}; pg8::StaticOrder S; S.init(MH, DM, G, bx);
              pg8::EpiResid<false> E{(l == 0 ? ap->in[0] : X) + (size_t)hf * MH * DM, X + (size_t)hf * MH * DM, nullptr, nullptr};
              pg8::gemm_phase<pg8::EpiResid<false>, pg8::StaticOrder, true, true>(ldsl, g, S, E); }
            GRID_SYNC();
            if (DBG_STOP == 6) DBG_ZERO_UPPER();
        }
        { PH(); const float* gf = ap->in[17] + (size_t)l * DM;
          for (int m = gw; m < M; m += NGW) rms_row<false>(X + (size_t)m * DM, gf, H + (size_t)m * DM, lane);
          const float* pl = ap->in[1] + (size_t)l * M * PLE;
          for (size_t i = gt; i < (size_t)M * PLE / 8; i += NGT) { const f32x4 v0 = ((const f32x4*)pl)[2 * i], v1 = ((const f32x4*)pl)[2 * i + 1];
              v4u w; w.x = pk2(v0.x, v0.y); w.y = pk2(v0.z, v0.w); w.z = pk2(v1.x, v1.y); w.w = pk2(v1.z, v1.w); ((v4u*)PBF)[i] = w; } }
        GRID_SYNC();
        { PH(); pg8::Gemm g{PBF, (const bf16*)(wl + WO_PLE), M, DM, PLE}; pg8::StaticOrder S; S.init(M, DM, G, bx);
          pg8::EpiStore E{EB, DM}; pg8::gemm_phase<pg8::EpiStore, pg8::StaticOrder, true, true>(ldsl, g, S, E); }
        { PH(); pg8::Gemm g{H, (const bf16*)(wl + WO_UP), M, NUP, DM}; pg8::StaticOrder S; S.init(M, NUP, G, bx);
          pg8::EpiConv E{ACT, EDGE, ap->in[19] + (size_t)l * 3 * NUP, ap->in[20] + (size_t)l * NUP, (LAS float*)(ldsl + XB_OFF)};
          pg8::gemm_phase<pg8::EpiConv, pg8::StaticOrder, true, true>(ldsl, g, S, E); }
        GRID_SYNC();
        { PH(); const float* cw = ap->in[19] + (size_t)l * 3 * NUP; const float* cb = ap->in[20] + (size_t)l * NUP;
          for (size_t i = gt; i < (size_t)(M / 256) * pg8::NTC * 2 * 128; i += NGT) {
              const int c = (int)(i & 127), row = (int)((i >> 7) & 1), tile = (int)(i >> 8), pn = tile % pg8::NTC, pm = tile / pg8::NTC;
              const bool first = (pm % (SEQ / 256)) == 0; const int gcol = pn * 128 + c;
              const float* e1 = EDGE + (size_t)tile * 1024; const float* e0 = EDGE + (size_t)(first ? tile : tile - pg8::NTC) * 1024;
              float av[2];
#pragma unroll
              for (int q = 0; q < 2; ++q) { const int jc = q * 128 + c, col = q * DFF + gcol;
                  const float pm2 = first ? 0.f : e0[2 * 256 + jc], pm1 = first ? 0.f : e0[3 * 256 + jc], r0 = e1[jc], r1 = e1[256 + jc];
                  const float w0 = cw[col], w1 = cw[NUP + col], w2 = cw[2 * NUP + col], bb = cb[col];
                  av[q] = row == 0 ? (w0 * pm2 + w1 * pm1 + w2 * r0 + bb) : (w0 * pm1 + w1 * r0 + w2 * r1 + bb); }
              ACT[(size_t)(pm * 256 + row) * DFF + gcol] = (bf16)f2bf(pg8::gelu_tanh_f(av[0]) * av[1]); } }
        GRID_SYNC();
        { PH(); pg8::Gemm g{ACT, (const bf16*)(wl + WO_DOWN), M, DM, DFF}; pg8::StaticOrder S; S.init(M, DM, G, bx);
          pg8::EpiResid<false> E{X, X, nullptr, nullptr}; pg8::gemm_phase<pg8::EpiResid<false>, pg8::StaticOrder, true, true>(ldsl, g, S, E); }
        GRID_SYNC();
        { PH(); const float* gp = ap->in[22] + (size_t)l * DM; for (int m = gw; m < M; m += NGW) rms_row<false>(X + (size_t)m * DM, gp, H + (size_t)m * DM, lane); }
        GRID_SYNC();
        { PH(); pg8::Gemm g{H, (const bf16*)(wl + WO_PG), M, DM, DM}; pg8::StaticOrder S; S.init(M, DM, G, bx);
          pg8::EpiResid<true> E{X, X, ap->in[24] + (size_t)l * DM, EB}; pg8::gemm_phase<pg8::EpiResid<true>, pg8::StaticOrder, true, true>(ldsl, g, S, E); }
        GRID_SYNC();
        if (l + 1 < DEPTH) { { PH(); const float* gm = ap->in[2] + (size_t)(l + 1) * DM; for (int m = gw; m < M; m += NGW) rms_row<false>(X + (size_t)m * DM, gm, H + (size_t)m * DM, lane); } GRID_SYNC(); }
        else { PH(); const float* gfin = ap->in[26]; for (int m = gw; m < M; m += NGW) rms_row<true>(X + (size_t)m * DM, gfin, X + (size_t)m * DM, lane); }
    }
}

extern "C" void kernel_launch(void* const* d_in, const int* in_sizes, int n_in, void* d_out, int out_size, void* d_ws, size_t ws_size, hipStream_t stream) {
    static int grid = 0;
    if (grid == 0) {
        if (n_in != 27 || out_size != M * DM || ws_size < WS_END) { fprintf(stderr, "kernel_launch: unexpected shapes (n_in %d out %d ws %zu)\n", n_in, out_size, ws_size); grid = -1; return; }
        int dev = 0, cus = 0, per_cu = 0;
        if (hipGetDevice(&dev) != hipSuccess || hipDeviceGetAttribute(&cus, hipDeviceAttributeMultiprocessorCount, dev) != hipSuccess) { grid = -1; return; }
        if (hipFuncSetAttribute((const void*)fwd_kernel, hipFuncAttributeMaxDynamicSharedMemorySize, LDS_BYTES) != hipSuccess) { fprintf(stderr, "kernel_launch: hipFuncSetAttribute failed\n"); grid = -1; return; }
        if (hipOccupancyMaxActiveBlocksPerMultiprocessor(&per_cu, (const void*)fwd_kernel, NTHREADS, LDS_BYTES) != hipSuccess || per_cu < 1) { fprintf(stderr, "kernel_launch: occupancy query gives %d\n", per_cu); per_cu = 1; }
        (void)hipGetLastError();
        grid = cus * per_cu;
    }
    if (grid < 0) return;
    if (hipMemsetAsync(d_ws, 0, 256, stream) != hipSuccess) { fprintf(stderr, "kernel_launch: memset failed\n"); return; }
    Args a{};
    for (int i = 0; i < 27; ++i) a.in[i] = (const float*)d_in[i];
    a.out = (float*)d_out; a.ws = (unsigned char*)d_ws;
    void* args[] = {&a};
    hipError_t e = hipLaunchCooperativeKernel((const void*)fwd_kernel, dim3(grid), dim3(NTHREADS), args, LDS_BYTES, stream);
    if (e != hipSuccess) fprintf(stderr, "kernel_launch: cooperative launch failed: %s (grid %d)\n", hipGetErrorString(e), grid);
}
```

```cpp
#include <hip/hip_runtime.h>
#include <hip/hip_cooperative_groups.h>
#include <cstdio>
#include <cstdint>
namespace cg = cooperative_groups;
namespace pg8 {
#define PG8_LAS __attribute__((address_space(3)))
typedef unsigned short bf16_t;
typedef short bf16x8 __attribute__((ext_vector_type(8)));
typedef float f32x4 __attribute__((ext_vector_type(4)));
typedef unsigned u32x4 __attribute__((ext_vector_type(4)));
constexpr int BM = 256, BK = 64, HALF = 128, HTB = HALF * BK * 2  , STAGE_BYTES = 8 * HTB, NXCD = 8, WGM = 8;

__host__ __device__ __forceinline__ int lds_byte(int r, int c) { const int st = (r >> 4) * 2 + (c >> 5), rr = r & 15, cc = c & 31, ob = rr * 64 + cc * 2; return st * 1024 + (ob ^ (((ob >> 9) & 1) << 5)); }
__host__ __device__ __forceinline__ void stage_rc(int b, int& R, int& C) { const int st = b / 1024, sb = b % 1024, swz = sb ^ (((sb >> 9) & 1) << 5); R = (st >> 1) * 16 + swz / 64; C = (st & 1) * 32 + (swz % 64) / 2; }
__host__ __device__ __forceinline__ int perm32(int rho) { const int n = rho >> 4, i = rho & 15; return 8 * (i >> 2) + 4 * n + (i & 3); }

struct Unit { int pm, pn; };
struct Gemm { const bf16_t* A; const bf16_t* Bt; int M, N, K; };

struct StaticOrder {
    int nM, nN, nwg, G, c;
    __host__ __device__ void init(int M, int N, int G_, int c_) { nM = M / BM; nN = N / BM; nwg = nM * nN; G = G_; c = c_; }
    __host__ __device__ bool next(int i, Unit& u) const {
        const long L = (long)i * G + c; if (L >= nwg) return false;
        int wgid = (int)L; { const int q = nwg / NXCD, r = nwg % NXCD, xcd = wgid % NXCD, off = wgid / NXCD; wgid = (xcd < r ? xcd * (q + 1) : r * (q + 1) + (xcd - r) * q) + off; }
        const int nig = WGM * nN, gid = wgid / nig, fm = gid * WGM, gsz = (nM - fm) < WGM ? (nM - fm) : WGM;
        u.pm = fm + ((wgid % nig) % gsz); u.pn = (wgid % nig) / gsz; return true;
    }
    __device__ __forceinline__ void a_ready(const Unit&) const {}
    __device__ __forceinline__ void done(const Unit&) const {}
};

typedef float cv_f32x2 __attribute__((ext_vector_type(2))); typedef __bf16 cv_bf16x2 __attribute__((ext_vector_type(2)));
__device__ __forceinline__ unsigned cvt_pk_bf16(float lo, float hi) { const cv_f32x2 v = {lo, hi}; const cv_bf16x2 b = __builtin_convertvector(v, cv_bf16x2); return __builtin_bit_cast(unsigned, b); }
typedef float f32x2 __attribute__((ext_vector_type(2)));
__device__ __forceinline__ f32x2 gelu_pk(f32x2 v) {
    const f32x2 av = __builtin_elementwise_abs(v), d = av * 0.2316418882f + 1.0f;
    f32x2 t; t.x = __builtin_amdgcn_rcpf(d.x); t.y = __builtin_amdgcn_rcpf(d.y);
    f32x2 q = t * 0.5307027145f + (-0.7265760135f); q = q * t + 0.7107068705f; q = q * t + (-0.142248368f); q = q * t + 0.127414796f; q = q * t;
    const f32x2 s = (v * v) * (-0.72134752044f);
    f32x2 e; e.x = __builtin_amdgcn_exp2f(s.x); e.y = __builtin_amdgcn_exp2f(s.y);
    const f32x2 m = v * (q * e), r = v - m;
    f32x2 o; o.x = v.x < 0.f ? m.x : r.x; o.y = v.y < 0.f ? m.y : r.y; return o;
}

template <int ACT  > struct EpiBf16 {
    static constexpr bool PERM = true, AFTER_DRAIN = false; static_assert(ACT == 0 || ACT == 1, "EpiBf16: ACT is 0 (none) or 1 (gelu_pk)");
    bf16_t* O; int ldc; const float* bias; int split_cols; size_t split_stride; float scale0;
    __device__ __forceinline__ void operator()(const f32x4 (&acc)[2][2][4][2], const Unit& u, int wr, int wc, int fr_, int fq_) const {
        int t_o = threadIdx.x; asm volatile("" : "+v"(t_o)); int fr = t_o & 15, fq = (t_o >> 4) & 3; (void)fr_; (void)fq_;

        const int row0 = u.pm * BM + wr * 64 + fr; int colt = u.pn * BM; bf16_t* base = O;
        float sc = 1.f; if (split_cols) { const int t = colt / split_cols; base += (size_t)t * split_stride; colt -= t * split_cols; if (t == 0) sc = scale0; }
        const int col0 = colt + wc * 32 + 8 * fq, bcol0 = u.pn * BM + wc * 32 + 8 * fq;
        f32x4 bv[2][2];
#pragma unroll
        for (int bj = 0; bj < 2; ++bj)
#pragma unroll
            for (int n = 0; n < 2; ++n) bv[bj][n] = bias ? *(const f32x4*)(bias + bcol0 + bj * HALF + 4 * n) : (f32x4){0.f, 0.f, 0.f, 0.f};
#pragma unroll
        for (int ai = 0; ai < 2; ++ai)
#pragma unroll
            for (int m = 0; m < 4; ++m) { bf16_t* rowp = base + (size_t)(row0 + ai * HALF + m * 16) * ldc + col0;
#pragma unroll
                for (int bj = 0; bj < 2; ++bj) { f32x4 v0 = acc[ai][bj][m][0] + bv[bj][0], v1 = acc[ai][bj][m][1] + bv[bj][1];
                    if (ACT == 1) { f32x2 a = gelu_pk((f32x2){v0[0], v0[1]}), b = gelu_pk((f32x2){v0[2], v0[3]}), c = gelu_pk((f32x2){v1[0], v1[1]}), d = gelu_pk((f32x2){v1[2], v1[3]});
                        v0 = (f32x4){a.x, a.y, b.x, b.y}; v1 = (f32x4){c.x, c.y, d.x, d.y}; }
                    v0 = v0 * sc; v1 = v1 * sc; u32x4 w; w.x = cvt_pk_bf16(v0[0], v0[1]); w.y = cvt_pk_bf16(v0[2], v0[3]); w.z = cvt_pk_bf16(v1[0], v1[1]); w.w = cvt_pk_bf16(v1[2], v1[3]);
                    *(u32x4*)(rowp + bj * HALF) = w; } }
    }
};
__device__ __forceinline__ float sigmoid_f(float x) { return __builtin_amdgcn_rcpf(1.0f + __builtin_amdgcn_exp2f(-1.4426950408889634f * x)); }
__device__ __forceinline__ float gelu_tanh_f(float x) { const float u = 0.7978845608028654f * (x + 0.044715f * x * x * x); return x * __builtin_amdgcn_rcpf(1.0f + __builtin_amdgcn_exp2f(-2.885390081777927f * u)); }
__device__ __forceinline__ float bf_lo(unsigned w) { return __builtin_bit_cast(float, w << 16); }
__device__ __forceinline__ float bf_hi(unsigned w) { return __builtin_bit_cast(float, w & 0xffff0000u); }
typedef unsigned u32x2 __attribute__((ext_vector_type(2)));
typedef _Float16 h16x2 __attribute__((ext_vector_type(2)));
__device__ __forceinline__ float h_lo(unsigned w) { return (float)__builtin_bit_cast(h16x2, w)[0]; }
__device__ __forceinline__ float h_hi(unsigned w) { return (float)__builtin_bit_cast(h16x2, w)[1]; }
__device__ __forceinline__ unsigned cvt_pk_f16(float lo, float hi) { const h16x2 v = {(_Float16)lo, (_Float16)hi}; return __builtin_bit_cast(unsigned, v); }

__device__ __forceinline__ float rstd_row(const float* SSI, int row) { const f32x4* p = (const f32x4*)(SSI + (size_t)row * 16); const f32x4 a = p[0], b = p[1], c = p[2], d = p[3];
    const float s = ((a[0] + a[1]) + (a[2] + a[3])) + ((b[0] + b[1]) + (b[2] + b[3])) + ((c[0] + c[1]) + (c[2] + c[3])) + ((d[0] + d[1]) + (d[2] + d[3])); return __builtin_amdgcn_rsqf(s * (1.f / 1024.f) + 1e-6f); }
struct EpiIn {
    static constexpr bool PERM = true, AFTER_DRAIN = false;
    bf16_t* Z; size_t bufstride; const float* bgate; float qscale; const float* SSI; float* VST = nullptr;
    template <int MODE> __device__ __forceinline__ void body(const f32x4 (&acc)[2][2][4][2], bf16_t* base, const float* bias, int row0, int col0, int lane = 0, int slot = 0) const {
        f32x4 bv[2][2];
#pragma unroll
        for (int bj = 0; bj < 2; ++bj)
#pragma unroll
            for (int n = 0; n < 2; ++n) bv[bj][n] = (MODE == 3) ? *(const f32x4*)(bias + col0 + bj * HALF + 4 * n) : (f32x4){0.f, 0.f, 0.f, 0.f};
#pragma unroll
        for (int ai = 0; ai < 2; ++ai)
#pragma unroll
            for (int m = 0; m < 4; ++m) { bf16_t* rowp = base + (size_t)(row0 + ai * HALF + m * 16) * 1024 + col0;
                const float rs = rstd_row(SSI, row0 + ai * HALF + m * 16); float ps = 0.f, pq = 0.f;
#pragma unroll
                for (int bj = 0; bj < 2; ++bj) { f32x4 v0 = acc[ai][bj][m][0] * rs, v1 = acc[ai][bj][m][1] * rs;
                    if (MODE == 1 || MODE == 4) {
#pragma unroll
                        for (int x = 0; x < 4; ++x) { v0[x] = gelu_tanh_f(v0[x]); v1[x] = gelu_tanh_f(v1[x]); } }
                    if (MODE == 4) { ps += ((v0[0] + v0[1]) + (v0[2] + v0[3])) + ((v1[0] + v1[1]) + (v1[2] + v1[3]));
                        pq += ((v0[0] * v0[0] + v0[1] * v0[1]) + (v0[2] * v0[2] + v0[3] * v0[3])) + ((v1[0] * v1[0] + v1[1] * v1[1]) + (v1[2] * v1[2] + v1[3] * v1[3])); }
                    if (MODE == 2) { v0 = v0 * qscale; v1 = v1 * qscale; }
                    if (MODE == 3) { v0 = v0 + bv[bj][0]; v1 = v1 + bv[bj][1];
#pragma unroll
                        for (int x = 0; x < 4; ++x) { v0[x] = sigmoid_f(v0[x]); v1[x] = sigmoid_f(v1[x]); } }
                    u32x4 w; w.x = cvt_pk_bf16(v0[0], v0[1]); w.y = cvt_pk_bf16(v0[2], v0[3]); w.z = cvt_pk_bf16(v1[0], v1[1]); w.w = cvt_pk_bf16(v1[2], v1[3]);
                    *(u32x4*)(rowp + bj * HALF) = w; }
                if (MODE == 4) {
                    ps += __builtin_bit_cast(float, __builtin_amdgcn_ds_bpermute((lane ^ 16) << 2, __builtin_bit_cast(int, ps))); pq += __builtin_bit_cast(float, __builtin_amdgcn_ds_bpermute((lane ^ 16) << 2, __builtin_bit_cast(int, pq)));
                    ps += __builtin_bit_cast(float, __builtin_amdgcn_ds_bpermute((lane ^ 32) << 2, __builtin_bit_cast(int, ps))); pq += __builtin_bit_cast(float, __builtin_amdgcn_ds_bpermute((lane ^ 32) << 2, __builtin_bit_cast(int, pq)));
                    if ((lane >> 4) == 0) { float* vp = VST + (size_t)(row0 + ai * HALF + m * 16) * 32 + slot * 2; vp[0] = ps; vp[1] = pq; } }
                asm volatile("" ::: "memory"); }
    }
    __device__ __forceinline__ void operator()(const f32x4 (&acc)[2][2][4][2], const Unit& u, int wr, int wc, int fr_, int fq_) const {
        int t_o = threadIdx.x; asm volatile("" : "+v"(t_o)); int fr = t_o & 15, fq = (t_o >> 4) & 3; (void)fr_; (void)fq_;

        const int t = u.pn >> 2, colt = (u.pn & 3) * BM;
        bf16_t* base = Z + (size_t)t * bufstride;
        const int row0 = u.pm * BM + wr * 64 + fr, col0 = colt + wc * 32 + 8 * fq;
        if (t == 0) body<1>(acc, base, nullptr, row0, col0);
        else if (t == 1) body<4>(acc, base, nullptr, row0, col0, t_o & 63, (u.pn & 3) * 4 + wc);
        else if (t == 2) body<2>(acc, base, nullptr, row0, col0);
        else if (t < 5) body<0>(acc, base, nullptr, row0, col0);
        else body<3>(acc, base, bgate + (t - 5) * 1024, row0, col0);
    }
};
struct EpiNull {
    static constexpr bool PERM = true, AFTER_DRAIN = false;
    __device__ __forceinline__ void operator()(const f32x4 (&acc)[2][2][4][2], const Unit& u, int wr, int wc, int fr_, int fq_) const {
#pragma unroll
        for (int ai = 0; ai < 2; ++ai)
#pragma unroll
            for (int bj = 0; bj < 2; ++bj)
#pragma unroll
                for (int m = 0; m < 4; ++m)
#pragma unroll
                    for (int n = 0; n < 2; ++n) asm volatile("" :: "v"(acc[ai][bj][m][n]));
    }
};
struct EpiStore {
    static constexpr bool PERM = true, AFTER_DRAIN = false;
    bf16_t* O; int ldc;
    __device__ __forceinline__ void operator()(const f32x4 (&acc)[2][2][4][2], const Unit& u, int wr, int wc, int fr_, int fq_) const {
        int t_o = threadIdx.x; asm volatile("" : "+v"(t_o)); int fr = t_o & 15, fq = (t_o >> 4) & 3; (void)fr_; (void)fq_;

        const int row0 = u.pm * BM + wr * 64 + fr, col0 = u.pn * BM + wc * 32 + 8 * fq;
#pragma unroll
        for (int ai = 0; ai < 2; ++ai)
#pragma unroll
            for (int m = 0; m < 4; ++m) { bf16_t* rowp = O + (size_t)(row0 + ai * HALF + m * 16) * ldc + col0;
#pragma unroll
                for (int bj = 0; bj < 2; ++bj) { const f32x4 v0 = acc[ai][bj][m][0], v1 = acc[ai][bj][m][1];
                    u32x4 w; w.x = cvt_pk_bf16(v0[0], v0[1]); w.y = cvt_pk_bf16(v0[2], v0[3]); w.z = cvt_pk_bf16(v1[0], v1[1]); w.w = cvt_pk_bf16(v1[2], v1[3]);
                    *(u32x4*)(rowp + bj * HALF) = w; } }
    }
};
template <bool ADD> struct EpiGate {
    static constexpr bool PERM = true, AFTER_DRAIN = false;
    const bf16_t* G; bf16_t* MG;
    __device__ __forceinline__ void operator()(const f32x4 (&acc)[2][2][4][2], const Unit& u, int wr, int wc, int fr_, int fq_) const {
        int t_o = threadIdx.x; asm volatile("" : "+v"(t_o)); int fr = t_o & 15, fq = (t_o >> 4) & 3; (void)fr_; (void)fq_;

        const int row0 = u.pm * BM + wr * 64 + fr, col0 = u.pn * BM + wc * 32 + 8 * fq;
#pragma unroll
        for (int ai = 0; ai < 2; ++ai)
#pragma unroll
            for (int m = 0; m < 4; ++m) { const size_t off = (size_t)(row0 + ai * HALF + m * 16) * 1024 + col0;
#pragma unroll
                for (int bj = 0; bj < 2; ++bj) { const f32x4 v0 = acc[ai][bj][m][0], v1 = acc[ai][bj][m][1];
                    const u32x4 g = *(const u32x4*)(G + off + bj * HALF);
                    float r[8];
                    r[0] = bf_lo(g.x) * v0[0]; r[1] = bf_hi(g.x) * v0[1]; r[2] = bf_lo(g.y) * v0[2]; r[3] = bf_hi(g.y) * v0[3];
                    r[4] = bf_lo(g.z) * v1[0]; r[5] = bf_hi(g.z) * v1[1]; r[6] = bf_lo(g.w) * v1[2]; r[7] = bf_hi(g.w) * v1[3];
                    if (ADD) { const u32x4 o = *(const u32x4*)(MG + off + bj * HALF);
                        r[0] += bf_lo(o.x); r[1] += bf_hi(o.x); r[2] += bf_lo(o.y); r[3] += bf_hi(o.y); r[4] += bf_lo(o.z); r[5] += bf_hi(o.z); r[6] += bf_lo(o.w); r[7] += bf_hi(o.w); }
                    u32x4 w; w.x = cvt_pk_bf16(r[0], r[1]); w.y = cvt_pk_bf16(r[2], r[3]); w.z = cvt_pk_bf16(r[4], r[5]); w.w = cvt_pk_bf16(r[6], r[7]);
                    *(u32x4*)(MG + off + bj * HALF) = w; }
                asm volatile("" ::: "memory"); }
    }
};
template <bool PLE> struct EpiResid {
    static constexpr bool PERM = false, AFTER_DRAIN = false;
    const bf16_t* XIB; bf16_t* XBO; const float* bias; const bf16_t* E;
    float* SSO; const float* SSI;
    float ascale = 1.f;
    __device__ __forceinline__ void operator()(const f32x4 (&acc)[2][2][4][2], const Unit& u, int wr, int wc, int fr_, int fq_) const {
        int t_o = threadIdx.x; asm volatile("" : "+v"(t_o)); int fr = t_o & 15, fq = (t_o >> 4) & 3; (void)fr_; (void)fq_;
        const int lane = t_o & 63;
        const int col0 = u.pn * BM + wc * 32 + 4 * fq;
        constexpr int MG = PLE ? 2 : 4;
#pragma unroll
        for (int ai = 0; ai < 2; ++ai)
#pragma unroll
        for (int m0 = 0; m0 < 4; m0 += MG) {
            u32x2 xi[4][2][2]; u32x2 ev[4][2][2]; float rs[4];
#pragma unroll
            for (int m = m0; m < m0 + MG; ++m) { const int row = u.pm * BM + ai * HALF + wr * 64 + m * 16 + fr; const size_t off = (size_t)row * 1024 + col0;
                rs[m] = 1.f; if (PLE) rs[m] = rstd_row(SSI, row);
#pragma unroll
                for (int bj = 0; bj < 2; ++bj)
#pragma unroll
                    for (int n = 0; n < 2; ++n) { const size_t o2 = off + bj * HALF + n * 16; xi[m][bj][n] = *(const u32x2*)(XIB + o2); if (PLE) ev[m][bj][n] = *(const u32x2*)(E + o2); } }
#pragma unroll
            for (int m = m0; m < m0 + MG; ++m) { const int row = u.pm * BM + ai * HALF + wr * 64 + m * 16 + fr; const size_t off = (size_t)row * 1024 + col0;
                float q = 0.f;
#pragma unroll
                for (int bj = 0; bj < 2; ++bj)
#pragma unroll
                    for (int n = 0; n < 2; ++n) { const size_t o2 = off + bj * HALF + n * 16; f32x4 a = acc[ai][bj][m][n];
                        if (PLE) { const f32x4 bv = *(const f32x4*)(bias + col0 + bj * HALF + n * 16); const u32x2 e = ev[m][bj][n]; a = a * rs[m] + bv;
                            a[0] = sigmoid_f(a[0]) * bf_lo(e.x); a[1] = sigmoid_f(a[1]) * bf_hi(e.x); a[2] = sigmoid_f(a[2]) * bf_lo(e.y); a[3] = sigmoid_f(a[3]) * bf_hi(e.y); }
                        const u32x2 xo = xi[m][bj][n];
                        const f32x4 xn = (f32x4){h_lo(xo.x), h_hi(xo.x), h_lo(xo.y), h_hi(xo.y)} + a * ascale;
                        u32x2 w; w.x = cvt_pk_f16(xn[0], xn[1]); w.y = cvt_pk_f16(xn[2], xn[3]); *(u32x2*)(XBO + o2) = w;
                        q += (xn[0] * xn[0] + xn[1] * xn[1]) + (xn[2] * xn[2] + xn[3] * xn[3]); }
                q += __builtin_bit_cast(float, __builtin_amdgcn_ds_bpermute((lane ^ 16) << 2, __builtin_bit_cast(int, q)));
                q += __builtin_bit_cast(float, __builtin_amdgcn_ds_bpermute((lane ^ 32) << 2, __builtin_bit_cast(int, q)));
                if (fq == 0) SSO[(size_t)row * 16 + u.pn * 4 + wc] = q; }
            asm volatile("" ::: "memory"); }
    }
};
constexpr int FFC = 2816, NTC = FFC / 128;
struct EpiConv {
    static constexpr bool PERM = true, AFTER_DRAIN = false;
    bf16_t* ACT; float* EDGE; const float* cw; const float* cb; PG8_LAS float* xb; const float* SSI;
    __device__ __forceinline__ void operator()(f32x4 (&acc)[2][2][4][2], const Unit& u, int wr, int wc, int fr_, int fq_) const {
        int t_o = threadIdx.x; asm volatile("" : "+v"(t_o)); int fr = t_o & 15, fq = (t_o >> 4) & 3; (void)fr_; (void)fq_;

        const int lane = t_o & 63;
        const int jc0 = wc * 32 + 8 * fq;
        { PG8_LAS float* rtab = xb + 2048; const int tt = t_o & 511;
          if (tt < 256) rtab[tt] = rstd_row(SSI, u.pm * BM + tt);
          asm volatile("s_waitcnt lgkmcnt(0)" ::: "memory"); __builtin_amdgcn_s_barrier(); asm volatile("" ::: "memory");
#pragma unroll
          for (int ai = 0; ai < 2; ++ai)
#pragma unroll
            for (int m = 0; m < 4; ++m) { const float rs = rtab[ai * HALF + wr * 64 + m * 16 + fr];
#pragma unroll
                for (int bj = 0; bj < 2; ++bj)
#pragma unroll
                    for (int n = 0; n < 2; ++n) acc[ai][bj][m][n] = acc[ai][bj][m][n] * rs; } }
        if (fr >= 14) {
#pragma unroll
            for (int ai = 0; ai < 2; ++ai)
#pragma unroll
                for (int bj = 0; bj < 2; ++bj)
#pragma unroll
                    for (int n = 0; n < 2; ++n) *(PG8_LAS f32x4*)(xb + (((ai * 2 + wr) * 2 + (fr - 14)) * 256 + bj * HALF + jc0 + 4 * n)) = acc[ai][bj][3][n];
        }
        float* eb = EDGE + (size_t)(u.pm * NTC + u.pn) * 4 * 256;
        if (wr == 0 && fr < 2) {
#pragma unroll
            for (int bj = 0; bj < 2; ++bj)
#pragma unroll
                for (int n = 0; n < 2; ++n) *(f32x4*)(eb + fr * 256 + bj * HALF + jc0 + 4 * n) = acc[0][bj][0][n];
        }
        if (wr == 1 && fr >= 14) {
#pragma unroll
            for (int bj = 0; bj < 2; ++bj)
#pragma unroll
                for (int n = 0; n < 2; ++n) *(f32x4*)(eb + (2 + fr - 14) * 256 + bj * HALF + jc0 + 4 * n) = acc[1][bj][3][n];
        }
        asm volatile("s_waitcnt lgkmcnt(0)" ::: "memory"); __builtin_amdgcn_s_barrier(); asm volatile("" ::: "memory");
        const int src1 = (lane & 48) | ((fr + 15) & 15), src2 = (lane & 48) | ((fr + 14) & 15);
#pragma unroll
        for (int bj = 0; bj < 2; ++bj)
#pragma unroll
            for (int n = 0; n < 2; ++n) {
                const int gc = bj * FFC + u.pn * 128 + jc0 + 4 * n;
                const f32x4 w0 = *(const f32x4*)(cw + gc), w1 = *(const f32x4*)(cw + 2 * FFC + gc), w2 = *(const f32x4*)(cw + 4 * FFC + gc), bb = *(const f32x4*)(cb + gc);
#pragma unroll
                for (int ai = 0; ai < 2; ++ai) {
                    const int grp = ai * 2 + wr;
                    f32x4 xp = (f32x4){0.f, 0.f, 0.f, 0.f};
                    if (grp > 0 && fr >= 14) xp = *(const PG8_LAS f32x4*)(xb + (((grp - 1) * 2 + (fr - 14)) * 256 + bj * HALF + jc0 + 4 * n));
#pragma unroll
                    for (int m = 3; m >= 0; --m) {
                        f32x4 cur = acc[ai][bj][m][n]; f32x4 prv = (m > 0) ? acc[ai][bj][m > 0 ? m - 1 : 0][n] : xp;
                        asm volatile("" : "+v"(cur), "+v"(prv));
                        f32x4 r;
#pragma unroll
                        for (int x = 0; x < 4; ++x) {
                            const float s1 = (fr == 15) ? prv[x] : cur[x], s2 = (fr >= 14) ? prv[x] : cur[x];
                            const float p1 = __builtin_bit_cast(float, __builtin_amdgcn_ds_bpermute(src1 << 2, __builtin_bit_cast(int, s1))), p2 = __builtin_bit_cast(float, __builtin_amdgcn_ds_bpermute(src2 << 2, __builtin_bit_cast(int, s2)));
                            r[x] = w0[x] * p2 + w1[x] * p1 + w2[x] * cur[x] + bb[x];
                        }
                        asm volatile("" : "+v"(r));
                        acc[ai][bj][m][n] = r;
                    }
                    __builtin_amdgcn_sched_barrier(0);
                }
                asm volatile("" ::: "memory");
            }
#pragma unroll
        for (int ai = 0; ai < 2; ++ai)
#pragma unroll
            for (int m = 0; m < 4; ++m) {
                const bool skip = (ai == 0 && wr == 0 && m == 0 && fr < 2);
                bf16_t* rowp = ACT + (size_t)(u.pm * BM + ai * HALF + wr * 64 + m * 16 + fr) * FFC + u.pn * 128 + jc0;
                const f32x4 g0 = acc[ai][0][m][0], g1 = acc[ai][0][m][1], v0 = acc[ai][1][m][0], v1 = acc[ai][1][m][1];
                float r[8];
#pragma unroll
                for (int x = 0; x < 4; ++x) { r[x] = gelu_tanh_f(g0[x]) * v0[x]; r[4 + x] = gelu_tanh_f(g1[x]) * v1[x]; }
                u32x4 w; w.x = cvt_pk_bf16(r[0], r[1]); w.y = cvt_pk_bf16(r[2], r[3]); w.z = cvt_pk_bf16(r[4], r[5]); w.w = cvt_pk_bf16(r[6], r[7]);
                if (!skip) *(u32x4*)rowp = w;
                asm volatile("" ::: "memory"); __builtin_amdgcn_sched_barrier(0);
            }
        asm volatile("s_waitcnt lgkmcnt(0)" ::: "memory"); __builtin_amdgcn_s_barrier(); asm volatile("" ::: "memory");
    }
};
typedef _Float16 f16x8 __attribute__((ext_vector_type(8)));
template <class Epi, class Sched, bool ALIGN_EPI = false, bool SP2 = false, bool F16 = false>
__device__ __forceinline__ void gemm_phase(PG8_LAS unsigned char* lds, const Gemm g, const Sched& S, const Epi& E) {
    int tid_o = threadIdx.x; asm volatile("" : "+v"(tid_o));
    const int tid = tid_o, wid = __builtin_amdgcn_readfirstlane(tid >> 6), lane = tid & 63, wr = wid >> 2, wc = wid & 3, fr = lane & 15, fq = lane >> 4;
    int K_o = g.K; asm volatile("" : "+s"(K_o)); const int K = K_o, nt = K / BK;
    unsigned voffA[2], voffB[2];
#pragma unroll
    for (int i = 0; i < 2; ++i) { int R, C; stage_rc(tid * 16 + i * 8192, R, C); const int Rb = Epi::PERM ? ((R & ~31) + perm32(R & 31)) : R;
        voffA[i] = (unsigned)(R * K + C) * 2u; voffB[i] = (unsigned)(Rb * K + C) * 2u; }
    const size_t kstep = (size_t)(BK * 2);
    const size_t hstep = (size_t)HALF * K * 2;
    const size_t tstep = 2 * hstep;
    const unsigned ldsw = (unsigned)wid * 1024u;
    const int aoff = lds_byte(wr * 64 + fr, fq * 8), boff = lds_byte(wc * 32 + fr, fq * 8);
#define PG8_SA(b, h) (((b) * 2 + (h)) * HTB)
#define PG8_SB(b, h) ((4 + (b) * 2 + (h)) * HTB)
#define PG8_STAGE(bufoff, gbase, voff) do { _Pragma("unroll") for (int _i = 0; _i < 2; ++_i) \
        __builtin_amdgcn_global_load_lds((const unsigned*)((const char*)(gbase) + (voff)[_i]), (PG8_LAS unsigned*)(lds + (bufoff) + ldsw + _i * 8192), 16, 0, 0); } while (0)
#define PG8_LDA(dst, b, h) do { _Pragma("unroll") for (int m = 0; m < 4; ++m) _Pragma("unroll") for (int k = 0; k < 2; ++k) dst[m][k] = *(const PG8_LAS bf16x8*)(lds + PG8_SA(b, h) + aoff + m * 2048 + k * 1024); } while (0)
#define PG8_LDB(dst, b, h) do { _Pragma("unroll") for (int n = 0; n < 2; ++n) _Pragma("unroll") for (int k = 0; k < 2; ++k) dst[n][k] = *(const PG8_LAS bf16x8*)(lds + PG8_SB(b, h) + boff + n * 2048 + k * 1024); } while (0)
#define PG8_MMA(ai, bj, At, Bt) do { __builtin_amdgcn_s_setprio(1); _Pragma("unroll") for (int m = 0; m < 4; ++m) _Pragma("unroll") for (int n = 0; n < 2; ++n) _Pragma("unroll") for (int k = 0; k < 2; ++k) \
        { if constexpr (F16) acc[ai][bj][m][n] = __builtin_amdgcn_mfma_f32_16x16x32_f16(__builtin_bit_cast(f16x8, Bt[n][k]), __builtin_bit_cast(f16x8, At[m][k]), acc[ai][bj][m][n], 0, 0, 0); \
          else acc[ai][bj][m][n] = __builtin_amdgcn_mfma_f32_16x16x32_bf16(Bt[n][k], At[m][k], acc[ai][bj][m][n], 0, 0, 0); } __builtin_amdgcn_s_setprio(0); } while (0)
#define PG8_WAIT_V(n) asm volatile("s_waitcnt vmcnt(" #n ")" ::: "memory")
#define PG8_WAIT_L(n) asm volatile("s_waitcnt lgkmcnt(" #n ")" ::: "memory")
#define PG8_BAR __builtin_amdgcn_s_barrier()
#define PG8_SCHED __builtin_amdgcn_sched_barrier(0)
    Unit cur, nxt; int ui = 0;
    if (!S.next(0, cur)) return;
    f32x4 acc[2][2][4][2];
#pragma unroll
    for (int a = 0; a < 2; ++a)
#pragma unroll
        for (int b = 0; b < 2; ++b)
#pragma unroll
            for (int m = 0; m < 4; ++m)
#pragma unroll
                for (int n = 0; n < 2; ++n) acc[a][b][m][n] = (f32x4){0.f, 0.f, 0.f, 0.f};
    bf16x8 At[4][2], B0[2][2], B1[2][2];
    const char* cA = (const char*)g.A + (size_t)cur.pm * tstep; const char* cB = (const char*)g.Bt + (size_t)cur.pn * tstep;
    S.a_ready(cur);
    if constexpr (SP2) {
        PG8_STAGE(PG8_SB(0, 0), cB, voffB); PG8_STAGE(PG8_SB(0, 1), cB + hstep, voffB); PG8_STAGE(PG8_SA(0, 0), cA, voffA); PG8_STAGE(PG8_SA(0, 1), cA + hstep, voffA);
        if (wr == 1) PG8_BAR;
        PG8_WAIT_V(2); PG8_BAR;
        PG8_STAGE(PG8_SB(1, 0), cB + kstep, voffB); PG8_STAGE(PG8_SA(1, 0), cA + kstep, voffA); PG8_STAGE(PG8_SB(1, 1), cB + hstep + kstep, voffB);
        PG8_WAIT_V(6); PG8_BAR;
    } else {
        PG8_STAGE(PG8_SB(0, 0), cB, voffB); PG8_STAGE(PG8_SA(0, 0), cA, voffA); PG8_STAGE(PG8_SB(0, 1), cB + hstep, voffB); PG8_STAGE(PG8_SA(0, 1), cA + hstep, voffA);
        if (wr == 1) PG8_BAR;
        PG8_WAIT_V(4); PG8_BAR;
        PG8_STAGE(PG8_SB(1, 0), cB + kstep, voffB); PG8_STAGE(PG8_SA(1, 0), cA + kstep, voffA); PG8_STAGE(PG8_SB(1, 1), cB + hstep + kstep, voffB);
        PG8_WAIT_V(6); PG8_BAR;
    }
    for (;;) {
        const bool has_next = S.next(ui + 1, nxt);
        const char* nA = has_next ? (const char*)g.A + (size_t)nxt.pm * tstep : cA; const char* nB = has_next ? (const char*)g.Bt + (size_t)nxt.pn * tstep : cB;
        for (int t = 0; t < nt; t += 2) {
            const bool last = (t == nt - 2);
            const char* a1 = cA + (size_t)(t + 1) * kstep;
            const char* a2 = last ? nA : cA + (size_t)(t + 2) * kstep; const char* b2 = last ? nB : cB + (size_t)(t + 2) * kstep;
            const char* a3 = a2 + kstep; const char* b3 = b2 + kstep;
            if (last && has_next) S.a_ready(nxt);
            if constexpr (SP2) {
            PG8_LDB(B0, 0, 0); PG8_LDB(B1, 0, 1); PG8_SCHED; PG8_LDA(At, 0, 0); PG8_STAGE(PG8_SA(1, 1), a1 + hstep, voffA);
            PG8_WAIT_V(8); PG8_WAIT_L(0); PG8_BAR; PG8_MMA(0, 0, At, B0); PG8_MMA(0, 1, At, B1); PG8_BAR; PG8_SCHED;
            PG8_LDA(At, 0, 1); PG8_STAGE(PG8_SB(0, 0), b2, voffB); PG8_STAGE(PG8_SB(0, 1), b2 + hstep, voffB); PG8_STAGE(PG8_SA(0, 0), a2, voffA);
            PG8_WAIT_V(8); PG8_WAIT_L(0); PG8_BAR; PG8_MMA(1, 0, At, B0); PG8_MMA(1, 1, At, B1); PG8_BAR; PG8_SCHED;
            PG8_LDB(B0, 1, 0); PG8_LDB(B1, 1, 1); PG8_SCHED; PG8_LDA(At, 1, 0); PG8_STAGE(PG8_SA(0, 1), a2 + hstep, voffA);
            PG8_WAIT_V(8); PG8_WAIT_L(0); PG8_BAR; PG8_MMA(0, 0, At, B0); PG8_MMA(0, 1, At, B1); PG8_BAR; PG8_SCHED;
            PG8_LDA(At, 1, 1); PG8_STAGE(PG8_SB(1, 0), b3, voffB); PG8_STAGE(PG8_SB(1, 1), b3 + hstep, voffB); PG8_STAGE(PG8_SA(1, 0), a3, voffA);
            PG8_WAIT_V(8); PG8_WAIT_L(0); PG8_BAR; PG8_MMA(1, 0, At, B0); PG8_MMA(1, 1, At, B1); PG8_BAR; PG8_SCHED;
            } else {
            PG8_LDB(B0, 0, 0); PG8_SCHED; PG8_LDA(At, 0, 0); PG8_STAGE(PG8_SA(1, 1), a1 + hstep, voffA);
            PG8_WAIT_L(8); PG8_BAR; PG8_WAIT_L(0); PG8_MMA(0, 0, At, B0); PG8_BAR; PG8_SCHED;
            PG8_LDB(B1, 0, 1); PG8_STAGE(PG8_SB(0, 0), b2, voffB);
            PG8_BAR; PG8_WAIT_L(0); PG8_MMA(0, 1, At, B1); PG8_BAR;
            PG8_LDA(At, 0, 1); PG8_STAGE(PG8_SA(0, 0), a2, voffA);
            PG8_BAR; PG8_WAIT_L(0); PG8_MMA(1, 0, At, B0); PG8_BAR; PG8_SCHED;
            PG8_STAGE(PG8_SB(0, 1), b2 + hstep, voffB);
            PG8_WAIT_V(6); PG8_BAR; PG8_MMA(1, 1, At, B1); PG8_BAR;
            PG8_LDB(B0, 1, 0); PG8_SCHED; PG8_LDA(At, 1, 0); PG8_STAGE(PG8_SA(0, 1), a2 + hstep, voffA);
            PG8_WAIT_L(8); PG8_BAR; PG8_WAIT_L(0); PG8_MMA(0, 0, At, B0); PG8_BAR; PG8_SCHED;
            PG8_LDB(B1, 1, 1); PG8_STAGE(PG8_SB(1, 0), b3, voffB);
            PG8_BAR; PG8_WAIT_L(0); PG8_MMA(0, 1, At, B1); PG8_BAR;
            PG8_LDA(At, 1, 1); PG8_STAGE(PG8_SA(1, 0), a3, voffA);
            PG8_BAR; PG8_WAIT_L(0); PG8_MMA(1, 0, At, B0); PG8_BAR; PG8_SCHED;
            PG8_STAGE(PG8_SB(1, 1), b3 + hstep, voffB);
            PG8_WAIT_V(6); PG8_BAR; PG8_MMA(1, 1, At, B1); PG8_BAR;
            }
        }
        if constexpr (ALIGN_EPI) { if (wr == 0) PG8_BAR; }
        if constexpr (!Epi::AFTER_DRAIN) { E(acc, cur, wr, wc, fr, fq); S.done(cur); }
        if (!has_next) break;
#pragma unroll
        for (int a = 0; a < 2; ++a)
#pragma unroll
            for (int b = 0; b < 2; ++b)
#pragma unroll
                for (int m = 0; m < 4; ++m)
#pragma unroll
                    for (int n = 0; n < 2; ++n) acc[a][b][m][n] = (f32x4){0.f, 0.f, 0.f, 0.f};
        cur = nxt; cA = nA; cB = nB; ++ui;
        if constexpr (ALIGN_EPI) { if (wr == 1) PG8_BAR; }
    }
    PG8_WAIT_V(0);
    if constexpr (!ALIGN_EPI) { if (wr == 0) PG8_BAR; }
    PG8_BAR;
    if constexpr (Epi::AFTER_DRAIN) { E.fused(acc, cur, wr, wc, fr, fq, lds, wid, lane); S.done(cur); }
#undef PG8_SA
#undef PG8_SB
#undef PG8_STAGE
#undef PG8_LDA
#undef PG8_LDB
#undef PG8_MMA
#undef PG8_WAIT_V
#undef PG8_WAIT_L
#undef PG8_BAR
#undef PG8_SCHED
}
}
#include <hip/hip_bf16.h>
#include <cmath>
namespace attn_body {
using bf16=__hip_bfloat16;
using bf16x8=__attribute__((ext_vector_type(8)))short;
using s16x4=__attribute__((ext_vector_type(4)))short;
using f32x16=__attribute__((ext_vector_type(16)))float;
using u32x4=__attribute__((ext_vector_type(4)))unsigned;
constexpr int NHEAD=16,SEQ=4096,D=64,DM=NHEAD*D;
constexpr int NW=8,QBLK=32,QB=QBLK*NW,KVBLK=64,NQB=SEQ/QB;
constexpr int ATTN_PITCH=DM, ATTN_UNIT_ROWS=QB;
__device__ __forceinline__ int crow(int r,int hi){return (r&3)+8*(r>>2)+4*hi;}
#define SBAR() __builtin_amdgcn_sched_barrier(0)
__device__ __forceinline__ void cmask(f32x16&p0,f32x16&p1,int jb,int qrel,int hi){
  const float NEG=-INFINITY; int kb=64*jb+4*hi;
  #pragma unroll
  for(int r=0;r<16;++r){int kv=kb+(r&3)+8*(r>>2); if(kv>qrel)p0[r]=NEG; if(kv+32>qrel)p1[r]=NEG;}
}

constexpr int NSLOT=3, SLOTB=8192, VSLOTB=2*SLOTB;
constexpr int LDS_K=0, LDS_V=NSLOT*SLOTB, LDS_WS=LDS_V+NSLOT*VSLOTB, LDS_OST=LDS_WS+NW*64*4, LDS_BYTES=LDS_OST+NW*4096;
constexpr float C2=0.125f*1.4426950408889634f;
__device__ __forceinline__ void glds16(const void*gsrc,unsigned lds_dst){unsigned keep;
  asm volatile("s_mov_b32 %0, m0\n\ts_mov_b32 m0, %2\n\ts_nop 0\n\tglobal_load_lds_dwordx4 %1, off\n\ts_mov_b32 m0, %0":"=&s"(keep):"v"(gsrc),"s"(lds_dst):"memory");}
__device__ __forceinline__ float max3f(float a,float b,float c){float r;asm("v_max3_f32 %0, %1, %2, %3":"=v"(r):"v"(a),"v"(b),"v"(c));return r;}
__device__ __forceinline__ float max2f(float a,float b){float r;asm("v_max_f32_e32 %0, %1, %2":"=v"(r):"v"(a),"v"(b));return r;}
__device__ __forceinline__ float fadd_s(float a,float b){float r;asm("v_add_f32_e32 %0, %1, %2":"=v"(r):"v"(a),"v"(b));return r;}
__device__ __forceinline__ float fsub_s(float a,float b){float r;asm("v_sub_f32_e32 %0, %1, %2":"=v"(r):"v"(a),"v"(b));return r;}
typedef float f32x2_t __attribute__((ext_vector_type(2))); typedef __bf16 bf16x2_t __attribute__((ext_vector_type(2)));
__device__ __forceinline__ unsigned cvtpk_s(float lo,float hi){f32x2_t v={lo,hi};bf16x2_t b=__builtin_convertvector(v,bf16x2_t);return __builtin_bit_cast(unsigned,b);}
#define WAIT_BAR(N) asm volatile("s_waitcnt vmcnt(" #N ") lgkmcnt(0)\n\ts_barrier":::"memory")

__device__ __forceinline__ void qkt(f32x16&p0,f32x16&p1,const char*Kslot,const bf16x8*qr,const f32x16&negm,int r32,int hi){
  const char*kb=Kslot+hi*1024+r32*16;
  #pragma unroll
  for(int d0=0;d0<4;++d0){
    const bf16x8 b0=*reinterpret_cast<const bf16x8*>(kb+d0*2048);
    const bf16x8 b1=*reinterpret_cast<const bf16x8*>(kb+d0*2048+512);
    if(d0==0){p0=__builtin_amdgcn_mfma_f32_32x32x16_bf16(b0,qr[0],negm,0,0,0);p1=__builtin_amdgcn_mfma_f32_32x32x16_bf16(b1,qr[0],negm,0,0,0);}
    else{p0=__builtin_amdgcn_mfma_f32_32x32x16_bf16(b0,qr[d0],p0,0,0,0);p1=__builtin_amdgcn_mfma_f32_32x32x16_bf16(b1,qr[d0],p1,0,0,0);}}
}
typedef __attribute__((address_space(3))) const char* lds_cptr;
typedef short v4i16_t __attribute__((ext_vector_type(4)));
__device__ __forceinline__ void kload8(bf16x8*kf,lds_cptr kp){
  kf[0]=*(const __attribute__((address_space(3))) bf16x8*)(kp);      kf[1]=*(const __attribute__((address_space(3))) bf16x8*)(kp+512);
  kf[2]=*(const __attribute__((address_space(3))) bf16x8*)(kp+2048); kf[3]=*(const __attribute__((address_space(3))) bf16x8*)(kp+2560);
  kf[4]=*(const __attribute__((address_space(3))) bf16x8*)(kp+4096); kf[5]=*(const __attribute__((address_space(3))) bf16x8*)(kp+4608);
  kf[6]=*(const __attribute__((address_space(3))) bf16x8*)(kp+6144); kf[7]=*(const __attribute__((address_space(3))) bf16x8*)(kp+6656);
}
__device__ __forceinline__ void kload2(bf16x8*kf,lds_cptr kp,int j){ kf[2*j]=*(const __attribute__((address_space(3))) bf16x8*)(kp+j*2048); kf[2*j+1]=*(const __attribute__((address_space(3))) bf16x8*)(kp+j*2048+512); }
__device__ __forceinline__ s16x4 vtr(lds_cptr p){ return __builtin_bit_cast(s16x4,__builtin_amdgcn_ds_read_tr16_b64_v4i16((__attribute__((address_space(3))) v4i16_t*)p)); }
__device__ __forceinline__ float rowmax(const f32x16&p0,const f32x16&p1){
  float a=max3f(p0[0],p0[1],p1[0]),b=max3f(p0[2],p0[3],p1[1]);a=max3f(a,p1[2],p1[3]);
  #pragma unroll
  for(int r=4;r<16;r+=4){a=max3f(a,p0[r],p0[r+1]);b=max3f(b,p0[r+2],p0[r+3]);a=max3f(a,p1[r],p1[r+1]);b=max3f(b,p1[r+2],p1[r+3]);}
  const float m=max2f(a,b);
  auto rr=__builtin_amdgcn_permlane32_swap(__float_as_uint(m),__float_as_uint(m),false,false);
  return max2f(__uint_as_float(rr[0]),__uint_as_float(rr[1]));
}
__device__ __forceinline__ void pv(f32x16*o,int vb,bf16x8 pa0,bf16x8 pa1,bf16x8 pa2,bf16x8 pa3){
  #pragma unroll
  for(int d0=0;d0<4;++d0){s16x4 lo[4],hi[4];
    #pragma unroll
    for(int ks=0;ks<4;++ks){
      asm volatile("ds_read_b64_tr_b16 %0,%1 offset:%c2":"=&v"(lo[ks]):"v"(vb),"i"(d0*4096+ks*1024):"memory");
      asm volatile("ds_read_b64_tr_b16 %0,%1 offset:%c2":"=&v"(hi[ks]):"v"(vb),"i"(d0*4096+ks*1024+512):"memory");}
    asm volatile("s_waitcnt lgkmcnt(0)":::"memory");SBAR();
    #define PK(k) (bf16x8){lo[k][0],lo[k][1],lo[k][2],lo[k][3],hi[k][0],hi[k][1],hi[k][2],hi[k][3]}
    o[d0]=__builtin_amdgcn_mfma_f32_32x32x16_bf16(pa0,PK(0),o[d0],0,0,0);
    o[d0]=__builtin_amdgcn_mfma_f32_32x32x16_bf16(pa1,PK(1),o[d0],0,0,0);
    o[d0]=__builtin_amdgcn_mfma_f32_32x32x16_bf16(pa2,PK(2),o[d0],0,0,0);
    o[d0]=__builtin_amdgcn_mfma_f32_32x32x16_bf16(pa3,PK(3),o[d0],0,0,0);
    #undef PK
  }
}

#ifndef ATTN_STORE16
#define ATTN_STORE16(p,v) (*(u32x4*)(p)=(v))
#endif
template<int THRL,bool COMB> __device__ __forceinline__ void attn_unit(int b,int h,int hv,int qb,const bf16*Q,const bf16*__restrict__ K,const bf16*__restrict__ V,bf16*O,bf16*YB,float lam,float oscale,const float*gsub,char*shm){
  int tid_o=threadIdx.x; asm volatile("":"+v"(tid_o)); const int tid=tid_o,lane=tid&63,r32=lane&31,hi=lane>>5; const int wid=__builtin_amdgcn_readfirstlane(tid>>6);
  const long rowbase=(long)b*SEQ; const int q0=qb*QB;
  const bf16*Qw=Q+(rowbase+q0+wid*QBLK)*DM+h*D;
  const bf16*Kh=K+rowbase*DM+h*D,*Vh=V+rowbase*DM+hv*2*D;
  const unsigned lds0=(unsigned)(uintptr_t)shm;
  float*wsf=(float*)(shm+LDS_WS)+wid*64;
  const bf16*ksrc=Kh+(long)lane*DM+wid*8;
  const bf16*vsrc=Vh+(long)(16*(wid&3)+(lane>>2))*DM+(wid>>2)*32+(lane&3)*8;
  const unsigned kdst=lds0+LDS_K+wid*1024, vdst=lds0+LDS_V+wid*1024;
  #define DMA_K(t,slot) glds16(ksrc+(long)(t)*KVBLK*DM,(unsigned)__builtin_amdgcn_readfirstlane(kdst+(slot)))
  #define DMA_V(t,slot) do{ glds16(vsrc+(long)(t)*KVBLK*DM,(unsigned)__builtin_amdgcn_readfirstlane(vdst+2*(slot))); glds16(vsrc+64+(long)(t)*KVBLK*DM,(unsigned)__builtin_amdgcn_readfirstlane(vdst+2*(slot)+8192)); }while(0)
  const int vb0=(int)(lds0+LDS_V)+((lane>>4)&1)*32+(lane&3)*8+(4*hi+((lane&15)>>2))*64;
  const char*Kbase=shm+LDS_K; bf16x8 kf[8];
  const lds_cptr shm3=(lds_cptr)shm; const lds_cptr kp0=shm3+LDS_K+hi*1024+r32*16; const lds_cptr vp0=shm3+LDS_V+((lane>>4)&1)*32+(lane&3)*8+(4*hi+((lane&15)>>2))*64;
  const int NT=(q0+QB)/KVBLK;
  DMA_K(0,0);DMA_V(0,0);DMA_K(1,SLOTB);
  bf16x8 qr[4];
  #pragma unroll
  for(int d0=0;d0<4;++d0)qr[d0]=*reinterpret_cast<const bf16x8*>(&Qw[(long)r32*DM+d0*16+hi*8]);
  float mhat=0.f,l_reg=0.f;f32x16 o[4];o[0]=f32x16{};o[1]=f32x16{};o[2]=f32x16{};o[3]=f32x16{};f32x16 negm=f32x16{};asm volatile("":"+v"(negm));
  const int qrel=wid*QBLK+r32;
  #define CMASK(P0,P1,t) do{int jb_=(t)-(NT-4); if(jb_>=0)cmask(P0,P1,jb_,qrel,hi);}while(0)
  bool resc=false;
  #define START(P0,P1) do{ const float rm=rowmax(P0,P1); resc=false; \
    { const float dl=rm; mhat=fadd_s(mhat,dl); \
      _Pragma("unroll") for(int r=0;r<16;++r){P0[r]=fsub_s(P0[r],dl);P1[r]=fsub_s(P1[r],dl);} \
      _Pragma("unroll") for(int r=0;r<16;++r)negm[r]=-mhat; asm volatile("":"+v"(negm)); } \
    _Pragma("unroll") for(int r=0;r<16;++r)P0[r]=__builtin_amdgcn_exp2f(P0[r]); }while(0)
  #define RESC() do{ if(resc){ asm volatile("s_waitcnt lgkmcnt(0)":::"memory"); \
      _Pragma("unroll") for(int d_=0;d_<4;++d_) _Pragma("unroll") for(int r=0;r<16;++r)o[d_][r]*=wsf[crow(r,hi)]; } }while(0)
  f32x16 pA0,pA1,pB0,pB1;
  int sl_prev=0,sl_cur=0,sl_next=SLOTB;
  #define ROT() do{sl_prev=sl_cur;sl_cur=sl_next;sl_next=(sl_next==(NSLOT-1)*SLOTB)?0:sl_next+SLOTB;}while(0)
  DMA_K(2,2*SLOTB);
  WAIT_BAR(3);
  qkt(pA0,pA1,Kbase,qr,negm,r32,hi);asm volatile("s_nop 15\n\ts_nop 7":"+v"(pA0),"+v"(pA1));CMASK(pA0,pA1,0);
  START(pA0,pA1);
  _Pragma("unroll") for(int r=0;r<16;++r)pA1[r]=__builtin_amdgcn_exp2f(pA1[r]);
  WAIT_BAR(0);
  DMA_K(3,0);DMA_V(1,SLOTB);
  ROT();
  kload8(kf,kp0+sl_cur);
  WAIT_BAR(3);
  s16x4 vlo[8],vhi[8]; u32x4 pw0,pw1,pw2,pw3;
  #define PKW(P,B) cvtpk_s(P[B],P[B+1])
  #define PAF(k) __builtin_bit_cast(bf16x8,pw##k)
  #define VFR(i) (bf16x8){vlo[i][0],vlo[i][1],vlo[i][2],vlo[i][3],vhi[i][0],vhi[i][1],vhi[i][2],vhi[i][3]}
  #define PIN(x) asm volatile("":"+v"(x))
  #define MX3(a,b,c) __builtin_fmaxf(__builtin_fmaxf((a),(b)),(c))
  #define GAPA(MF,A0,A1,A2,A3,W0,W1,PW) do{ MF; sacc+=A0; sacc+=A1; sacc+=A2; sacc+=A3; PIN(sacc); W0; W1; PIN(PW); SBAR(); }while(0)
  #define EX(v) __builtin_amdgcn_exp2f(v)
  #define GAPB(MF,X,B) do{ MF; X[B]=EX(X[B]); X[B+1]=EX(X[B+1]); X[B+2]=EX(X[B+2]); X[B+3]=EX(X[B+3]); PIN(X); SBAR(); }while(0)
  #define GAPH(MF,X,B) do{ MF; X[B]=EX(X[B]); X[B+1]=EX(X[B+1]); PIN(X); SBAR(); }while(0)
  #define VRD(i) do{ vlo[i]=vtr(vp_+(((i)>>2)*4096+((i)&3)*1024)); vhi[i]=vtr(vp_+(((i)>>2)*4096+((i)&3)*1024+512)); }while(0)
  #define VRD2(i) do{ vlo[i]=vtr(vp_+(8192+((i)>>2)*4096+((i)&3)*1024)); vhi[i]=vtr(vp_+(8192+((i)>>2)*4096+((i)&3)*1024+512)); }while(0)
  #define KRD(G,j) do{ if(G){ kload2(kf,kp0+sl_next,j); SBAR(); } }while(0)
  #define STEP(C0,C1,P0,P1,t,GK,GV,GL) do{ SBAR(); \
    const lds_cptr vp_=vp0+2*sl_prev; \
    float sacc=(P0[0]+P0[1]); \
    GAPA(C0=__builtin_amdgcn_mfma_f32_32x32x16_bf16(kf[0],qr[0],negm,0,0,0), P0[2],P0[3],P0[4],P0[5],     pw0[0]=PKW(P0,0), pw0[1]=PKW(P0,2), pw0); \
    GAPA(C1=__builtin_amdgcn_mfma_f32_32x32x16_bf16(kf[1],qr[0],negm,0,0,0), P0[6],P0[7],P0[8],P0[9],     pw0[2]=PKW(P0,4), pw0[3]=PKW(P0,6), pw0); \
    GAPA(C0=__builtin_amdgcn_mfma_f32_32x32x16_bf16(kf[2],qr[1],C0,0,0,0),   P0[10],P0[11],P0[12],P0[13], pw1[0]=PKW(P0,8), pw1[1]=PKW(P0,10), pw1); \
    GAPA(C1=__builtin_amdgcn_mfma_f32_32x32x16_bf16(kf[3],qr[1],C1,0,0,0),   P0[14],P0[15],P1[0],P1[1],   pw1[2]=PKW(P0,12),pw1[3]=PKW(P0,14), pw1); \
    GAPA(C0=__builtin_amdgcn_mfma_f32_32x32x16_bf16(kf[4],qr[2],C0,0,0,0),   P1[2],P1[3],P1[4],P1[5],     pw2[0]=PKW(P1,0), pw2[1]=PKW(P1,2), pw2); \
    GAPA(C1=__builtin_amdgcn_mfma_f32_32x32x16_bf16(kf[5],qr[2],C1,0,0,0),   P1[6],P1[7],P1[8],P1[9],     pw2[2]=PKW(P1,4), pw2[3]=PKW(P1,6), pw2); \
    GAPA(C0=__builtin_amdgcn_mfma_f32_32x32x16_bf16(kf[6],qr[3],C0,0,0,0),   P1[10],P1[11],P1[12],P1[13], pw3[0]=PKW(P1,8), pw3[1]=PKW(P1,10), pw3); \
    GAPA(C1=__builtin_amdgcn_mfma_f32_32x32x16_bf16(kf[7],qr[3],C1,0,0,0),   P1[14],P1[15],0.f,0.f,       pw3[2]=PKW(P1,12),pw3[3]=PKW(P1,14), pw3); \
    l_reg+=sacc; \
    VRD(0);VRD(4);VRD(1);VRD(5);VRD(2);VRD(6);VRD(3);VRD(7); SBAR();   \
    if(GK){DMA_K((t)+3,sl_cur);} if(GV){DMA_V((t)+1,sl_next);} \
    CMASK(C0,C1,t); \
    { float a=MX3(C0[0],C0[1],C1[0]),b=MX3(C0[2],C0[3],C1[1]); a=MX3(a,C1[2],C1[3]); \
      _Pragma("unroll") for(int r=4;r<16;r+=4){a=MX3(a,C0[r],C0[r+1]);b=MX3(b,C0[r+2],C0[r+3]);a=MX3(a,C1[r],C1[r+1]);b=MX3(b,C1[r+2],C1[r+3]);} \
      float rm=__builtin_fmaxf(a,b); { auto rr=__builtin_amdgcn_permlane32_swap(__float_as_uint(rm),__float_as_uint(rm),false,false); rm=__builtin_fmaxf(__uint_as_float(rr[0]),__uint_as_float(rr[1])); } \
      resc=false; \
      if(__builtin_expect(__any(rm>(float)THRL),0)){ const float dl=__builtin_fmaxf(rm,0.f); mhat+=dl; \
        _Pragma("unroll") for(int r=0;r<16;++r){C0[r]-=dl;C1[r]-=dl;} \
        _Pragma("unroll") for(int r=0;r<16;++r)negm[r]=-mhat; asm volatile("":"+v"(negm)); \
        const float f=__builtin_amdgcn_exp2f(-dl); l_reg*=f; if(hi==0)wsf[r32]=f; resc=true; } } \
    SBAR(); \
    GAPH(o[0]=__builtin_amdgcn_mfma_f32_32x32x16_bf16(PAF(0),VFR(0),o[0],0,0,0), C0,0); VRD2(0); \
    GAPH(o[1]=__builtin_amdgcn_mfma_f32_32x32x16_bf16(PAF(0),VFR(4),o[1],0,0,0), C0,4); VRD2(4); \
    KRD(GL,0); GAPH(o[0]=__builtin_amdgcn_mfma_f32_32x32x16_bf16(PAF(1),VFR(1),o[0],0,0,0), C0,8); VRD2(1); \
    KRD(GL,1); GAPH(o[1]=__builtin_amdgcn_mfma_f32_32x32x16_bf16(PAF(1),VFR(5),o[1],0,0,0), C0,12); VRD2(5); \
    KRD(GL,2); GAPH(o[0]=__builtin_amdgcn_mfma_f32_32x32x16_bf16(PAF(2),VFR(2),o[0],0,0,0), C1,0); VRD2(2); \
    KRD(GL,3); GAPH(o[1]=__builtin_amdgcn_mfma_f32_32x32x16_bf16(PAF(2),VFR(6),o[1],0,0,0), C1,4); VRD2(6); \
    GAPH(o[0]=__builtin_amdgcn_mfma_f32_32x32x16_bf16(PAF(3),VFR(3),o[0],0,0,0), C1,8); VRD2(3); \
    GAPH(o[1]=__builtin_amdgcn_mfma_f32_32x32x16_bf16(PAF(3),VFR(7),o[1],0,0,0), C1,12); VRD2(7); SBAR(); \
      \
    GAPH(o[2]=__builtin_amdgcn_mfma_f32_32x32x16_bf16(PAF(0),VFR(0),o[2],0,0,0), C0,2); \
    GAPH(o[3]=__builtin_amdgcn_mfma_f32_32x32x16_bf16(PAF(0),VFR(4),o[3],0,0,0), C0,6); \
    GAPH(o[2]=__builtin_amdgcn_mfma_f32_32x32x16_bf16(PAF(1),VFR(1),o[2],0,0,0), C0,10); \
    GAPH(o[3]=__builtin_amdgcn_mfma_f32_32x32x16_bf16(PAF(1),VFR(5),o[3],0,0,0), C0,14); \
    GAPH(o[2]=__builtin_amdgcn_mfma_f32_32x32x16_bf16(PAF(2),VFR(2),o[2],0,0,0), C1,2); \
    GAPH(o[3]=__builtin_amdgcn_mfma_f32_32x32x16_bf16(PAF(2),VFR(6),o[3],0,0,0), C1,6); \
    GAPH(o[2]=__builtin_amdgcn_mfma_f32_32x32x16_bf16(PAF(3),VFR(3),o[2],0,0,0), C1,10); \
    GAPH(o[3]=__builtin_amdgcn_mfma_f32_32x32x16_bf16(PAF(3),VFR(7),o[3],0,0,0), C1,14); \
    }while(0)
  int t=1;
  #undef CMASK
  #define CMASK(P0,P1,t) do{}while(0)
  for(;t+5<NT;t+=2){
    STEP(pB0,pB1,pA0,pA1,t,true,true,true);     WAIT_BAR(3); RESC(); ROT();
    STEP(pA0,pA1,pB0,pB1,t+1,true,true,true);   WAIT_BAR(3); RESC(); ROT();
  }
  #undef CMASK
  #define CMASK(P0,P1,t) do{int jb_=(t)-(NT-4); if(jb_>=0)cmask(P0,P1,jb_,qrel,hi);}while(0)
  #define ENDW(tt) do{ if((tt)+3<NT){WAIT_BAR(3);} else if((tt)+2<NT){WAIT_BAR(2);} else {WAIT_BAR(0);} }while(0)
  for(;t+1<NT;t+=2){
    STEP(pB0,pB1,pA0,pA1,t,(t+3<NT),(t+1<NT),(t+1<NT));       ENDW(t);   RESC(); ROT();
    STEP(pA0,pA1,pB0,pB1,t+1,(t+4<NT),(t+2<NT),(t+2<NT));     ENDW(t+1); RESC(); ROT();
  }
  STEP(pB0,pB1,pA0,pA1,NT-1,false,false,false); RESC();
  { float sacc=pB0[0]+pB0[1]; _Pragma("unroll") for(int r=2;r<16;++r)sacc+=pB0[r]; _Pragma("unroll") for(int r=0;r<16;++r)sacc+=pB1[r]; l_reg+=sacc;
    pw0=(u32x4){PKW(pB0,0),PKW(pB0,2),PKW(pB0,4),PKW(pB0,6)};pw1=(u32x4){PKW(pB0,8),PKW(pB0,10),PKW(pB0,12),PKW(pB0,14)};pw2=(u32x4){PKW(pB1,0),PKW(pB1,2),PKW(pB1,4),PKW(pB1,6)};pw3=(u32x4){PKW(pB1,8),PKW(pB1,10),PKW(pB1,12),PKW(pB1,14)};
    SBAR(); pv(o,vb0+2*sl_cur,PAF(0),PAF(1),PAF(2),PAF(3)); }
  #undef PKW
  #undef PAF
  #undef VFR
  #undef PIN
  #undef MX3
  #undef GAPA
  #undef GAPB
  #undef GAPH
  #undef EX
  #undef VRD
  #undef VRD2
  #undef KRD
  #undef STEP
  #undef ENDW
  {auto rr=__builtin_amdgcn_permlane32_swap(__float_as_uint(l_reg),__float_as_uint(l_reg),false,false);l_reg=__uint_as_float(rr[0])+__uint_as_float(rr[1]);}
  if(hi==0)wsf[32+r32]=l_reg;asm volatile("s_waitcnt lgkmcnt(0)":::"memory");
  float rli[16];
  #pragma unroll
  for(int r=0;r<16;++r)rli[r]=__builtin_amdgcn_rcpf(wsf[32+crow(r,hi)]);
  bf16*Ow=O+(rowbase+q0+wid*QBLK)*DM+hv*2*D;
  { bf16*stg=(bf16*)(shm+LDS_OST)+wid*2048;
    if constexpr(!COMB){
    #pragma unroll
    for(int hh=0;hh<2;++hh){
      #pragma unroll
      for(int r=0;r<16;++r){const int orow=crow(r,hi);
        #pragma unroll
        for(int d0=0;d0<2;++d0)stg[orow*64+d0*32+r32]=__float2bfloat16(o[2*hh+d0][r]*rli[r]);}
      asm volatile("s_waitcnt lgkmcnt(0)":::"memory");
      #pragma unroll
      for(int i=0;i<4;++i){const int row=i*8+(lane>>3),ch=lane&7; const u32x4 v=*(const u32x4*)(stg+row*64+ch*8); ATTN_STORE16(Ow+(long)row*DM+hh*64+ch*8,v);}
      asm volatile("s_waitcnt lgkmcnt(0)":::"memory"); }
    } else {
    float dv[2][4][8];
    #pragma unroll
    for(int hh=0;hh<2;++hh){
      #pragma unroll
      for(int r=0;r<16;++r){const int orow=crow(r,hi);
        #pragma unroll
        for(int d0=0;d0<2;++d0)stg[orow*64+d0*32+r32]=__float2bfloat16(o[2*hh+d0][r]*rli[r]);}
      asm volatile("s_waitcnt lgkmcnt(0)":::"memory");
      #pragma unroll
      for(int i=0;i<4;++i){const int row=i*8+(lane>>3),ch=lane&7; const u32x4 v2=*(const u32x4*)(stg+row*64+ch*8); const u32x4 v1=*(const u32x4*)(Ow+(long)row*DM+hh*64+ch*8);
        #define BL(w) __builtin_bit_cast(float,(w)<<16)
        #define BH(w) __builtin_bit_cast(float,(w)&0xffff0000u)
        dv[hh][i][0]=BL(v1[0])-lam*BL(v2[0]); dv[hh][i][1]=BH(v1[0])-lam*BH(v2[0]); dv[hh][i][2]=BL(v1[1])-lam*BL(v2[1]); dv[hh][i][3]=BH(v1[1])-lam*BH(v2[1]);
        dv[hh][i][4]=BL(v1[2])-lam*BL(v2[2]); dv[hh][i][5]=BH(v1[2])-lam*BH(v2[2]); dv[hh][i][6]=BL(v1[3])-lam*BL(v2[3]); dv[hh][i][7]=BH(v1[3])-lam*BH(v2[3]);
        #undef BL
        #undef BH
      }
      asm volatile("s_waitcnt lgkmcnt(0)":::"memory"); }
    bf16*Yw=YB+(rowbase+q0+wid*QBLK)*DM+hv*2*D;
    #pragma unroll
    for(int i=0;i<4;++i){const int row=i*8+(lane>>3),ch=lane&7; float ss=0.f;
      #pragma unroll
      for(int hh=0;hh<2;++hh){
        #pragma unroll
        for(int j=0;j<8;++j)ss+=dv[hh][i][j]*dv[hh][i][j];}
      ss+=__builtin_bit_cast(float,__builtin_amdgcn_ds_bpermute((lane^1)<<2,__builtin_bit_cast(int,ss)));
      ss+=__builtin_bit_cast(float,__builtin_amdgcn_ds_bpermute((lane^2)<<2,__builtin_bit_cast(int,ss)));
      ss+=__builtin_bit_cast(float,__builtin_amdgcn_ds_bpermute((lane^4)<<2,__builtin_bit_cast(int,ss)));
      const float rs=oscale/sqrtf(ss*(1.f/128.f)+1e-6f);
      #pragma unroll
      for(int hh=0;hh<2;++hh){const float*gp=gsub+hh*64+ch*8; float y[8];
        #pragma unroll
        for(int j=0;j<8;++j)y[j]=dv[hh][i][j]*rs*gp[j];
        u32x4 w; w[0]=cvtpk_s(y[0],y[1]); w[1]=cvtpk_s(y[2],y[3]); w[2]=cvtpk_s(y[4],y[5]); w[3]=cvtpk_s(y[6],y[7]);
        ATTN_STORE16(Yw+(long)row*DM+hh*64+ch*8,w);} }
    }
  }
  asm volatile("s_waitcnt lgkmcnt(0)\n\ts_barrier":::"memory");
  #undef DMA_K
  #undef DMA_V
  #undef CMASK
  #undef START
  #undef RESC
  #undef ROT
}
constexpr int ATTN_LDS_BYTES=LDS_BYTES;
#undef SBAR
#undef WAIT_BAR
}
#define LAS __attribute__((address_space(3)))
typedef unsigned short bf16;
typedef unsigned v4u __attribute__((ext_vector_type(4)));
typedef unsigned v2u __attribute__((ext_vector_type(2)));
typedef float f32x4 __attribute__((ext_vector_type(4)));
typedef short bf16x8 __attribute__((ext_vector_type(8)));
#define LDS_WAIT() asm volatile("s_waitcnt lgkmcnt(0)" ::: "memory")

constexpr int NWAVES = 8, NTHREADS = 512;
constexpr int DM = 1024, BATCH = 16, SEQ = 4096, DEPTH = 4, M = BATCH * SEQ, MH = M / 2, NIN = 7168, DFF = 2816, NUP = 2 * DFF, PLE = 256;
constexpr float EPS = 1e-6f;
constexpr size_t MiB = 1u << 20;
constexpr size_t WS_W = 2 * MiB, W_LAYER = 40 * MiB;
constexpr size_t WO_IN = 0, WO_UP = 14 * MiB, WO_DOWN = 25 * MiB, WO_PA = 31 * MiB, WO_PB = 33 * MiB, WO_O = 35 * MiB, WO_PG = 37 * MiB, WO_PLE = 39 * MiB, WO_S = 39 * MiB + 512 * 1024;
constexpr size_t WS_H = 162 * MiB;
constexpr size_t WS_Z = 290 * MiB, ZS = (size_t)MH * DM;
constexpr size_t WS_O1 = 738 * MiB, WS_O2 = 802 * MiB;
constexpr size_t WS_ACT = 290 * MiB, WS_XBB = 642 * MiB, WS_EDGE = 802 * MiB, WS_E = 290 * MiB;
constexpr size_t WS_SS = 866 * MiB, SSS = (size_t)M * 16, WS_PBF = 920 * MiB;
constexpr size_t WS_VST = 952 * MiB;
constexpr size_t WS_END = 956 * MiB;
constexpr int LDS_BYTES = 147456, XB_OFF = 131072 + 1024;

__device__ __forceinline__ unsigned f2bf(float f) { unsigned u = __builtin_bit_cast(unsigned, f); return (u + 0x7fffu + ((u >> 16) & 1u)) >> 16; }
__device__ __forceinline__ unsigned pk2(float lo, float hi) { return f2bf(lo) | (f2bf(hi) << 16); }
__device__ __forceinline__ unsigned pkh2(float lo, float hi) { return pg8::cvt_pk_f16(lo, hi); }
__device__ __forceinline__ float blo(unsigned w) { return __builtin_bit_cast(float, w << 16); }
__device__ __forceinline__ float bhi(unsigned w) { return __builtin_bit_cast(float, w & 0xffff0000u); }
__device__ __forceinline__ float bperm(float v, int srclane) { return __builtin_bit_cast(float, __builtin_amdgcn_ds_bpermute(srclane << 2, __builtin_bit_cast(int, v))); }
__device__ __forceinline__ float wave_sum(float v, int lane) {
#pragma unroll
    for (int o = 1; o < 64; o <<= 1) v += bperm(v, lane ^ o);
    return v;
}
__device__ __forceinline__ int up_row_map(int n) { return n < DFF ? (n >> 7) * 256 + (n & 127) : ((n - DFF) >> 7) * 256 + 128 + ((n - DFF) & 127); }
template <bool UPMAP, bool F16OUT = false> __device__ __forceinline__ void transpose_item(const float* W, int K, int N, bf16* WT, LAS float* scr, int item, int lane, const float* gk = nullptr) {
    const int nblk = N / 32, kb = item / nblk, nb = item % nblk, k0 = 64 * kb, n0 = 32 * nb;
#pragma unroll 8
    for (int i = 0; i < 32; ++i) { const int kk = 2 * i + (lane >> 5); float w = W[(size_t)(k0 + kk) * N + n0 + (lane & 31)]; if (gk) w *= gk[k0 + kk]; scr[kk * 33 + (lane & 31)] = w; }
    LDS_WAIT(); asm volatile("" ::: "memory");
    const int c = lane & 7;
#pragma unroll
    for (int j = 0; j < 4; ++j) { const int n = (lane >> 3) + 8 * j; const LAS float* s = scr + (8 * c) * 33 + n;
        v4u o; if (F16OUT) {
#define W8(v) __builtin_bit_cast(float, f2bf(v) << 16)
            o.x = pkh2(W8(s[0 * 33]), W8(s[1 * 33])); o.y = pkh2(W8(s[2 * 33]), W8(s[3 * 33])); o.z = pkh2(W8(s[4 * 33]), W8(s[5 * 33])); o.w = pkh2(W8(s[6 * 33]), W8(s[7 * 33]));
#undef W8
        }
        else { o.x = pk2(s[0 * 33], s[1 * 33]); o.y = pk2(s[2 * 33], s[3 * 33]); o.z = pk2(s[4 * 33], s[5 * 33]); o.w = pk2(s[6 * 33], s[7 * 33]); }
        const int dr = UPMAP ? up_row_map(n0 + n) : (n0 + n);
        *(v4u*)(WT + (size_t)dr * K + k0 + 8 * c) = o; }
    LDS_WAIT(); asm volatile("" ::: "memory");
}
template <bool OUTF32> __device__ __forceinline__ void rms_row(const float* xrow, const float* g, void* orow, int lane) {
    const f32x4* xr = (const f32x4*)xrow + lane;
    f32x4 v[4]; float s = 0.f;
#pragma unroll
    for (int j = 0; j < 4; ++j) { v[j] = xr[64 * j]; s += (v[j].x * v[j].x + v[j].y * v[j].y) + (v[j].z * v[j].z + v[j].w * v[j].w); }
    const float rstd = 1.0f / sqrtf(wave_sum(s, lane) * (1.f / DM) + EPS);
#pragma unroll
    for (int j = 0; j < 4; ++j) { const f32x4 gg = ((const f32x4*)g)[lane + 64 * j]; const f32x4 o = v[j] * rstd * gg;
        if (OUTF32) ((f32x4*)orow)[lane + 64 * j] = o;
        else ((unsigned long long*)orow)[lane + 64 * j] = (unsigned long long)pk2(o.x, o.y) | ((unsigned long long)pk2(o.z, o.w) << 32); }
}
__device__ __forceinline__ void sgu_unit(LAS unsigned char* lds, bf16* U, bf16* UO, const bf16* V, const float* VST, const bf16* Wsb, const float* bs, const float* lng, const float* lnb, size_t row0, int tid, int lane, int wave) {
    LAS float* st = (LAS float*)lds;
    LAS unsigned char* vt0 = lds + 1024;
    constexpr int VTB = 128 * 272;
    { const int r = tid >> 2, q = tid & 3; const f32x4* vp = (const f32x4*)(VST + (row0 + r) * 32 + q * 8);
      const f32x4 a = vp[0], c = vp[1];
      float sm = (a[0] + a[2]) + (c[0] + c[2]), sq = (a[1] + a[3]) + (c[1] + c[3]);
      sm += bperm(sm, lane ^ 1); sq += bperm(sq, lane ^ 1); sm += bperm(sm, lane ^ 2); sq += bperm(sq, lane ^ 2);
      const float mean = sm * (1.f / DM); float var = sq * (1.f / DM) - mean * mean; var = var > 0.f ? var : 0.f;
      if (q == 0) { st[2 * r] = mean; st[2 * r + 1] = 1.0f / sqrtf(var + EPS); } }
    __syncthreads();
    const int cg8 = tid & 15, rp = tid >> 4, fr = lane & 15, fq = lane >> 4;
    const int ksmax = (wave * 16 + 15) >> 5;
    const int t = 16 * wave + fr;
    float mu[4], rsd[4];
#pragma unroll
    for (int rr = 0; rr < 4; ++rr) { mu[rr] = st[2 * (4 * rp + rr)]; rsd[rr] = st[2 * (4 * rp + rr) + 1]; }
    v4u vraw[4]; bf16x8 bw[4]; v2u uraw[8]; f32x4 gm[2], bt[2]; float bias;
#define SGU_LOAD(g) do { \
        _Pragma("unroll") for (int rr = 0; rr < 4; ++rr) vraw[rr] = *(const v4u*)(V + (row0 + 4 * rp + rr) * DM + (g) * 128 + 8 * cg8); \
        gm[0] = *(const f32x4*)(lng + (g) * 128 + 8 * cg8); gm[1] = *(const f32x4*)(lng + (g) * 128 + 8 * cg8 + 4); bt[0] = *(const f32x4*)(lnb + (g) * 128 + 8 * cg8); bt[1] = *(const f32x4*)(lnb + (g) * 128 + 8 * cg8 + 4); \
        _Pragma("unroll") for (int ks = 0; ks < 4; ++ks) bw[ks] = *(const bf16x8*)(Wsb + (size_t)(g) * 16384 + (16 * wave + fr) * 128 + fq * 8 + ks * 32); \
        _Pragma("unroll") for (int cb = 0; cb < 8; ++cb) uraw[cb] = *(const v2u*)(U + (row0 + t) * DM + (g) * 128 + 16 * cb + 4 * fq); \
        bias = bs[(g) * 128 + t]; } while (0)
    SGU_LOAD(0);
#pragma unroll 1
    for (int g = 0; g < 8; ++g) {
        LAS unsigned char* vt = vt0 + (g & 1) * VTB;
        { float nv[4][8];
#pragma unroll
          for (int rr = 0; rr < 4; ++rr) { const v4u raw = vraw[rr]; const float mean = mu[rr], rstd = rsd[rr];
              nv[rr][0] = (blo(raw.x) - mean) * rstd * gm[0][0] + bt[0][0]; nv[rr][1] = (bhi(raw.x) - mean) * rstd * gm[0][1] + bt[0][1];
              nv[rr][2] = (blo(raw.y) - mean) * rstd * gm[0][2] + bt[0][2]; nv[rr][3] = (bhi(raw.y) - mean) * rstd * gm[0][3] + bt[0][3];
              nv[rr][4] = (blo(raw.z) - mean) * rstd * gm[1][0] + bt[1][0]; nv[rr][5] = (bhi(raw.z) - mean) * rstd * gm[1][1] + bt[1][1];
              nv[rr][6] = (blo(raw.w) - mean) * rstd * gm[1][2] + bt[1][2]; nv[rr][7] = (bhi(raw.w) - mean) * rstd * gm[1][3] + bt[1][3]; }
#pragma unroll
          for (int j = 0; j < 8; ++j) { v2u w; w.x = pk2(nv[0][j], nv[1][j]); w.y = pk2(nv[2][j], nv[3][j]); *(LAS v2u*)(vt + (8 * cg8 + j) * 272 + rp * 8) = w; } }
        bf16x8 bwc[4]; v2u uc[8]; const float biasc = bias;
#pragma unroll
        for (int ks = 0; ks < 4; ++ks) bwc[ks] = bw[ks];
#pragma unroll
        for (int cb = 0; cb < 8; ++cb) uc[cb] = uraw[cb];
        __syncthreads();
        if (g < 7) SGU_LOAD(g + 1);
        f32x4 acc[8];
#pragma unroll
        for (int cb = 0; cb < 8; ++cb) acc[cb] = (f32x4){0.f, 0.f, 0.f, 0.f};
#pragma unroll
        for (int ks = 0; ks < 4; ++ks) if (ks <= ksmax) {
#pragma unroll
            for (int cb = 0; cb < 8; ++cb) { const bf16x8 av = *(const LAS bf16x8*)(vt + (16 * cb + fr) * 272 + (ks * 32 + fq * 8) * 2);
                acc[cb] = __builtin_amdgcn_mfma_f32_16x16x32_bf16(av, bwc[ks], acc[cb], 0, 0, 0); } }
#pragma unroll
        for (int cb = 0; cb < 8; ++cb) { bf16* up = UO + (row0 + t) * DM + g * 128 + 16 * cb + 4 * fq; const v2u uu = uc[cb];
            v2u w; w.x = pk2(blo(uu.x) * (acc[cb][0] + biasc), bhi(uu.x) * (acc[cb][1] + biasc)); w.y = pk2(blo(uu.y) * (acc[cb][2] + biasc), bhi(uu.y) * (acc[cb][3] + biasc));
            *(v2u*)up = w; }
    }
#undef SGU_LOAD
    __syncthreads();
}

struct Args { const float* in[27]; float* out; unsigned char* ws; };

#define PH() \
    const Args* ap; { auto kp_ = __builtin_amdgcn_kernarg_segment_ptr(); asm volatile("" : "+s"(kp_)); ap = (const Args*)kp_; } \
    int tid_o = threadIdx.x, bx_o = blockIdx.x, G_o = gridDim.x; asm volatile("" : "+v"(tid_o)); asm volatile("" : "+s"(bx_o), "+s"(G_o)); \
    const int tid = tid_o, bx = bx_o, G = G_o, lane = tid & 63, wave = __builtin_amdgcn_readfirstlane(tid >> 6); \
    const int gw = bx * NWAVES + wave, NGW = G * NWAVES; const size_t gt = (size_t)bx * NTHREADS + tid, NGT = (size_t)G * NTHREADS; \
    unsigned char* const ws = ap->ws; float* const X = ap->out; bf16* const H = (bf16*)(ws + WS_H); bf16* const Z = (bf16*)(ws + WS_Z); \
    bf16 *const ZU = Z, *const ZV = Z + ZS, *const ZQ = Z + 2 * ZS, *const ZK = Z + 3 * ZS, *const ZVA = Z + 4 * ZS, *const ZGA = Z + 5 * ZS, *const ZGB = Z + 6 * ZS; \
    bf16 *const O1 = (bf16*)(ws + WS_O1), *const O2 = (bf16*)(ws + WS_O2), *const ACT = (bf16*)(ws + WS_ACT), *const EB = (bf16*)(ws + WS_E), *const PBF = (bf16*)(ws + WS_PBF); \
    float* const EDGE = (float*)(ws + WS_EDGE); unsigned char* const wl = ws + WS_W + (size_t)l * W_LAYER; bf16* const XBB = (bf16*)(ws + WS_XBB); float* const SS = (float*)(ws + WS_SS); (void)XBB; (void)SS; \
    (void)lane; (void)gw; (void)NGW; (void)gt; (void)NGT; (void)X; (void)H; (void)ZU; (void)ZV; (void)ZQ; (void)ZK; (void)ZVA; (void)ZGA; (void)ZGB; (void)O1; (void)O2; (void)ACT; (void)EB; (void)PBF; (void)EDGE; (void)wl

#define RLX_AGENT __ATOMIC_RELAXED, __HIP_MEMORY_SCOPE_AGENT
#define XB_TMO      128
#define XB_XCNT(j)  (256  + 64 * (j))
#define XB_XSUB(j)  (1280 + 64 * (j))
#define XB_XGEN(j)  (2304 + 64 * (j))
#define XB_TOP      3328
#define XB_TOPGEN   3392
#define XCD_BAR_WORDS 3456
#define XB_SPIN_CAP (1u << 18)

__device__ __forceinline__ unsigned xb_ld(unsigned* p)              { return __hip_atomic_load(p, __ATOMIC_RELAXED, __HIP_MEMORY_SCOPE_AGENT); }
__device__ __forceinline__ unsigned xb_add(unsigned* p, unsigned v) { return __hip_atomic_fetch_add(p, v, __ATOMIC_RELAXED, __HIP_MEMORY_SCOPE_AGENT); }
__device__ __forceinline__ unsigned xb_xcc_id() { return (unsigned)__builtin_amdgcn_s_getreg((3 << 11) | 20) & 0xFu; }
#define XB_SPIN(cond, bar) do { unsigned _sp = 0; while (cond) { __builtin_amdgcn_s_sleep(1); \
    if ((++_sp & 255u) == 0u) { if (xb_ld(&(bar)[XB_TMO])) break; if (_sp > XB_SPIN_CAP) { atomicAdd(&(bar)[XB_TMO], 1u); break; } } } } while (0)

__device__ __forceinline__ void xcd_barrier_complete(unsigned* bar, unsigned x, unsigned& nloc, unsigned& nx) {
    const unsigned G = gridDim.x * gridDim.y * gridDim.z;
    unsigned sum, cnt, mine, sp = 0u;
    for (;;) {
        sum = 0u; cnt = 0u; mine = 0u;
#pragma unroll
        for (unsigned j = 0; j < 16; ++j) { const unsigned c = xb_ld(&bar[XB_XCNT(j)]); sum += c; cnt += (c > 0u) ? 1u : 0u; mine = (j == x) ? c : mine; }
        if (sum == G) break;
        __builtin_amdgcn_s_sleep(1);
        if ((++sp & 255u) == 0u) { if (xb_ld(&bar[XB_TMO])) break; if (sp > XB_SPIN_CAP) { atomicAdd(&bar[XB_TMO], 1u); break; } }
    }
    nloc = mine > 0u ? mine : 1u; nx = cnt > 0u ? cnt : 1u;
}

__device__ __forceinline__ void xcd_barrier(unsigned* const bar_, volatile LAS unsigned* const st_) {
    struct { unsigned* bar; unsigned x; volatile LAS unsigned* st; } b; b.bar = bar_; b.x = xb_xcc_id(); b.st = st_;
    asm volatile("s_waitcnt vmcnt(0)" ::: "memory");
    __syncthreads();
    if (threadIdx.x == 0) {
        unsigned* bar = b.bar;
        __builtin_amdgcn_s_waitcnt(0);
        unsigned nloc = b.st[0], nx = b.st[1];
        if (nloc == 0u) { xcd_barrier_complete(bar, b.x, nloc, nx); b.st[0] = nloc; b.st[1] = nx; }
        const unsigned old = xb_add(&bar[XB_XSUB(b.x)], 1u);
        const unsigned gen = old / nloc;
        if (old + 1u == (gen + 1u) * nloc) {
            __builtin_amdgcn_fence(__ATOMIC_RELEASE, "agent");
            asm volatile("s_waitcnt vmcnt(0)" ::: "memory");
            const unsigned og = xb_add(&bar[XB_TOP], 1u);
            const unsigned tg = og / nx;
            if (og + 1u == (tg + 1u) * nx) xb_add(&bar[XB_TOPGEN], 1u);
            else XB_SPIN(xb_ld(&bar[XB_TOPGEN]) == tg, bar);
            __builtin_amdgcn_fence(__ATOMIC_ACQUIRE, "agent");
            xb_add(&bar[XB_XGEN(b.x)], 1u);
            asm volatile("s_waitcnt vmcnt(0)" ::: "memory");
        } else {
            XB_SPIN(xb_ld(&bar[XB_XGEN(b.x)]) == gen, bar);
            __builtin_amdgcn_fence(__ATOMIC_ACQUIRE, "agent");
            asm volatile("s_waitcnt vmcnt(0)" ::: "memory");
        }
    }
    __syncthreads();
}

__device__ __forceinline__ void ctr_grid_sync(unsigned* ctr, unsigned target) {
    asm volatile("s_waitcnt vmcnt(0) lgkmcnt(0)" ::: "memory");
    __syncthreads();
    if (threadIdx.x == 0) {
        __builtin_amdgcn_fence(__ATOMIC_RELEASE, "agent");
        asm volatile("s_waitcnt vmcnt(0)" ::: "memory");
        __hip_atomic_fetch_add(ctr, 1u, __ATOMIC_RELAXED, __HIP_MEMORY_SCOPE_AGENT);
        while (__hip_atomic_load(ctr, __ATOMIC_RELAXED, __HIP_MEMORY_SCOPE_AGENT) < target) __builtin_amdgcn_s_sleep(2);
    }
    __syncthreads();
    __builtin_amdgcn_fence(__ATOMIC_ACQUIRE, "agent");
    asm volatile("s_waitcnt vmcnt(0)" ::: "memory");
}
#define GRID_SYNC1() do { const Args* ap_s; { auto kp_ = __builtin_amdgcn_kernarg_segment_ptr(); asm volatile("" : "+s"(kp_)); ap_s = (const Args*)kp_; } xcd_barrier((unsigned*)(ap_s->ws + 4096), (volatile LAS unsigned*)(ldsl + LDS_BYTES - 16)); } while (0)
#ifndef DBG_REP_SYNC
#define DBG_REP_SYNC 0
#endif
#define GRID_SYNC() do { GRID_SYNC1(); if (DBG_REP_SYNC) GRID_SYNC1(); } while (0)
#ifndef DBG_REP_ATTN
#define DBG_REP_ATTN 0
#endif
#ifndef DBG_REP_IN
#define DBG_REP_IN 0
#endif
#ifndef DBG_REP_UP
#define DBG_REP_UP 0
#endif
#ifndef DBG_REP_PRO
#define DBG_REP_PRO 0
#endif
#ifndef DBG_REP_COMB
#define DBG_REP_COMB 0
#endif
#ifndef DBG_REP_P4
#define DBG_REP_P4 0
#endif
#ifndef DBG_REP_RES
#define DBG_REP_RES 0
#endif
#ifndef DBG_REP_SGU
#define DBG_REP_SGU 0
#endif
#ifndef DBG_REP_INNULL
#define DBG_REP_INNULL 0
#endif
#ifndef DBG_TIME
#define DBG_TIME 0
#endif
#ifndef SELA
#define SELA 0x4
#endif
#ifndef SELB
#define SELB 0x2
#endif
#define TSTAMP(id) do { if (DBG_TIME && blockIdx.x == 0 && threadIdx.x == 0) { const Args* ap_t; { auto kp_ = __builtin_amdgcn_kernarg_segment_ptr(); asm volatile("" : "+s"(kp_)); ap_t = (const Args*)kp_; } \
    unsigned long long* tb = (unsigned long long*)(ap_t->ws + 64); const unsigned long long t_ = __builtin_amdgcn_s_memrealtime(); tb[1 + (id)] += t_ - tb[0]; tb[0] = t_; } } while (0)
__global__ void __launch_bounds__(NTHREADS, 2) fwd_kernel(Args a_unused) {
    extern __shared__ __attribute__((aligned(16))) unsigned char lds[];
    cg::grid_group grid = cg::this_grid();
    LAS unsigned char* ldsl = (LAS unsigned char*)lds;
    if (threadIdx.x == 0) { ((volatile LAS unsigned*)(ldsl + LDS_BYTES - 16))[0] = 0u; ((volatile LAS unsigned*)(ldsl + LDS_BYTES - 16))[1] = 0u;
        const Args* ap_s; { auto kp_ = __builtin_amdgcn_kernarg_segment_ptr(); asm volatile("" : "+s"(kp_)); ap_s = (const Args*)kp_; } (void)xb_add(&((unsigned*)(ap_s->ws + 4096))[XB_XCNT(xb_xcc_id())], 1u); }
    __syncthreads();
    if (DBG_TIME && blockIdx.x == 0 && threadIdx.x == 0) { const Args* ap_t; { auto kp_ = __builtin_amdgcn_kernarg_segment_ptr(); asm volatile("" : "+s"(kp_)); ap_t = (const Args*)kp_; } ((unsigned long long*)(ap_t->ws + 64))[0] = __builtin_amdgcn_s_memrealtime(); }
    grid.sync();

    for (int rep_ = 0; rep_ < (DBG_REP_PRO ? 2 : 1); ++rep_)
    {
        const int l = 0; PH();
        LAS float* scr = (LAS float*)(ldsl + wave * 16384);
        constexpr int I_IN = (DM / 64) * (NIN / 32), I_SQ = (DM / 64) * (DM / 32), I_UP = (DM / 64) * (NUP / 32), I_DN = (DFF / 64) * (DM / 32), I_PLE = (PLE / 64) * (DM / 32);
        constexpr int I_LAYER = I_IN + 4 * I_SQ + I_UP + I_DN + I_PLE;
        for (int it = gw; it < DEPTH * I_LAYER; it += NGW) {
            const int ll = it / I_LAYER; int r = it % I_LAYER; unsigned char* wll = ws + WS_W + (size_t)ll * W_LAYER;
            if (r < I_IN) { transpose_item<false, true>(ap->in[3] + (size_t)ll * DM * NIN, DM, NIN, (bf16*)(wll + WO_IN), scr, r, lane, ap->in[2] + (size_t)ll * DM); continue; } r -= I_IN;
            if (r < I_SQ) { transpose_item<false>(ap->in[14] + (size_t)ll * DM * DM, DM, DM, (bf16*)(wll + WO_PA), scr, r, lane); continue; } r -= I_SQ;
            if (r < I_SQ) { transpose_item<false>(ap->in[15] + (size_t)ll * DM * DM, DM, DM, (bf16*)(wll + WO_PB), scr, r, lane); continue; } r -= I_SQ;
            if (r < I_SQ) { transpose_item<false>(ap->in[16] + (size_t)ll * DM * DM, DM, DM, (bf16*)(wll + WO_O), scr, r, lane); continue; } r -= I_SQ;
            if (r < I_SQ) { transpose_item<false, true>(ap->in[23] + (size_t)ll * DM * DM, DM, DM, (bf16*)(wll + WO_PG), scr, r, lane, ap->in[22] + (size_t)ll * DM); continue; } r -= I_SQ;
            if (r < I_UP) { transpose_item<true, true>(ap->in[18] + (size_t)ll * DM * NUP, DM, NUP, (bf16*)(wll + WO_UP), scr, r, lane, ap->in[17] + (size_t)ll * DM); continue; } r -= I_UP;
            if (r < I_DN) { transpose_item<false>(ap->in[21] + (size_t)ll * DFF * DM, DFF, DM, (bf16*)(wll + WO_DOWN), scr, r, lane); continue; } r -= I_DN;
            transpose_item<false>(ap->in[25] + (size_t)ll * PLE * DM, PLE, DM, (bf16*)(wll + WO_PLE), scr, r, lane);
        }
        { const float* wsrc = ap->in[7];
          for (size_t i = gt; i < (size_t)DEPTH * 8 * 128 * 128; i += NGT) { const int ll = (int)(i >> 17), rem = (int)(i & 131071), t = (rem >> 7) & 127, sc = rem & 127;
              const float w = wsrc[i]; ((bf16*)(ws + WS_W + (size_t)ll * W_LAYER + WO_S))[rem] = (bf16)f2bf(sc <= t ? w : 0.f); } }
        { const float* xin = ap->in[0];
          for (int m = gw; m < M; m += NGW) { const f32x4* xr = (const f32x4*)(xin + (size_t)m * DM) + lane; float sq = 0.f;
#pragma unroll
              for (int j = 0; j < 4; ++j) { const f32x4 v = xr[64 * j]; sq += (v.x * v.x + v.y * v.y) + (v.z * v.z + v.w * v.w);
                  ((unsigned long long*)(H + (size_t)m * DM))[lane + 64 * j] = (unsigned long long)pkh2(v.x, v.y) | ((unsigned long long)pkh2(v.z, v.w) << 32); }
              sq = wave_sum(sq, lane); if (lane < 16) SS[(size_t)m * 16 + lane] = lane == 0 ? sq : 0.f; } }
    }
    GRID_SYNC(); TSTAMP(0);

#ifndef DBG_STOP
#define DBG_STOP 0
#endif
#define DBG_DUMP_BF16(buf) do { PH(); for (size_t i = gt; i < (size_t)M * DM; i += NGT) X[i] = blo((unsigned)(buf)[i % ((size_t)MH * DM)]); return; } while (0)
#define DBG_DUMP3(b0, b1, b2) do { PH(); for (size_t i = gt; i < (size_t)M * DM; i += NGT) { const size_t k = i % ((size_t)MH * DM); X[i] = blo((unsigned)(b0)[k]) + blo((unsigned)(b1)[k]) + blo((unsigned)(b2)[k]); } return; } while (0)
#define DBG_ZERO_UPPER() do { PH(); for (size_t i = gt; i < (size_t)MH * DM; i += NGT) X[(size_t)MH * DM + i] = 0.f; return; } while (0)
#pragma unroll 1
    for (int l = 0; l < DEPTH; ++l) {
#pragma unroll 1
        for (int hf = 0; hf < 2; ++hf) {
            if (DBG_REP_INNULL) { PH(); pg8::Gemm g{H + (size_t)hf * MH * DM, (const bf16*)(wl + WO_IN), MH, NIN, DM}; pg8::StaticOrder S; S.init(MH, NIN, G, bx); pg8::EpiNull E; pg8::gemm_phase<pg8::EpiNull, pg8::StaticOrder, true, true, true>(ldsl, g, S, E); }
            for (int rep_ = 0; rep_ < (DBG_REP_IN ? 2 : 1); ++rep_)
            { PH(); pg8::Gemm g{H + (size_t)hf * MH * DM, (const bf16*)(wl + WO_IN), MH, NIN, DM}; pg8::StaticOrder S; S.init(MH, NIN, G, bx);
              pg8::EpiIn E{Z, ZS, ap->in[4] + (size_t)l * 2 * DM, 0.125f * 1.4426950408889634f, SS + (size_t)(3 * l) * SSS + (size_t)hf * MH * 16, (float*)(ws + WS_VST)};
              pg8::gemm_phase<pg8::EpiIn, pg8::StaticOrder, true, true, true>(ldsl, g, S, E); }
            GRID_SYNC(); TSTAMP(1);
            if (DBG_STOP == 2) DBG_DUMP3(ZU, ZQ, ZGA);
            if (DBG_STOP == 12) DBG_DUMP3(ZV, ZK, ZGB);
            if (DBG_STOP == 22) DBG_DUMP3(ZVA, ZVA, ZVA);
            if (DBG_STOP == 1) DBG_DUMP3(H, H, H);
            if (DBG_STOP == 32) DBG_DUMP3(ZGA, ZGA, ZGA);
            if (DBG_STOP == 42) DBG_DUMP3(ZU, ZU, ZU);
            if (DBG_STOP == 52) DBG_DUMP3(ZQ, ZQ, ZQ);
            { PH();
              int l_o = l; asm volatile("" : "+s"(l_o));
              const float lam_init = 0.8f - 0.6f * expf(-0.3f * (float)l_o);
              const float s1 = wave_sum(ap->in[9][l * 64 + lane] * ap->in[10][l * 64 + lane], lane), s2 = wave_sum(ap->in[11][l * 64 + lane] * ap->in[12][l * 64 + lane], lane);
              const float lam = __builtin_bit_cast(float, __builtin_amdgcn_readfirstlane(__builtin_bit_cast(int, expf(s1) - expf(s2) + lam_init)));
              const float oscale = __builtin_bit_cast(float, __builtin_amdgcn_readfirstlane(__builtin_bit_cast(int, 1.0f - lam_init)));
              const float* gsub = ap->in[13] + l * 128;
              for (int p = bx; p < 1024; p += G) {
                  const int combo = p & 255, qi = p >> 8, b = combo & 7, r = combo >> 3, h = r >> 2, sq = r & 3;
                  const int qb = qi == 0 ? 15 - sq : qi == 1 ? 8 + sq : qi == 2 ? 7 - sq : sq;
#pragma unroll 1
                  for (int mp = 0; mp < 2; ++mp)
                  if (mp == 0) attn_body::attn_unit<8, false>(b, 2 * h, h, qb, (const attn_body::bf16*)ZQ, (const attn_body::bf16*)ZK, (const attn_body::bf16*)ZVA, (attn_body::bf16*)O1, nullptr, 0.f, 0.f, nullptr, (char*)lds);
                  else attn_body::attn_unit<8, true>(b, 2 * h + 1, h, qb, (const attn_body::bf16*)ZQ, (const attn_body::bf16*)ZK, (const attn_body::bf16*)ZVA, (attn_body::bf16*)O1, (attn_body::bf16*)ZQ, lam, oscale, gsub, (char*)lds); } }
            __syncthreads();
            { PH();
              const float* bs = ap->in[8] + (size_t)l * 1024; const float* lng = ap->in[5] + (size_t)l * DM; const float* lnb = ap->in[6] + (size_t)l * DM;
              for (int i = bx; i < MH / 128; i += G) sgu_unit(ldsl, ZU, ZU, ZV, (const float*)(ws + WS_VST), (const bf16*)(wl + WO_S), bs, lng, lnb, (size_t)i * 128, tid, lane, wave); }
            GRID_SYNC(); TSTAMP(2);
            if (DBG_STOP == 3) DBG_DUMP3(O1, O2, ZU);
            if (DBG_STOP == 13) DBG_DUMP3(O1, O2, O1);
            if (DBG_STOP == 23) DBG_DUMP3(ZU, ZU, ZU);
            for (int rep_ = 0; rep_ < (DBG_REP_P4 ? 2 : 1); ++rep_) {
            { PH(); pg8::StaticOrder S; S.init(MH, DM, G, bx);
              pg8::Gemm g{ZU, (const bf16*)(wl + WO_PA), MH, DM, DM}; pg8::EpiGate<false> E{ZGA, ZK}; pg8::gemm_phase<pg8::EpiGate<false>, pg8::StaticOrder, true, true>(ldsl, g, S, E); }
            { PH(); pg8::StaticOrder S; S.init(MH, DM, G, bx);
              pg8::Gemm g{ZQ, (const bf16*)(wl + WO_PB), MH, DM, DM}; pg8::EpiGate<true> E{ZGB, ZK}; pg8::gemm_phase<pg8::EpiGate<true>, pg8::StaticOrder, true, true>(ldsl, g, S, E); }
            }
            GRID_SYNC(); TSTAMP(4);
            if (DBG_STOP == 5) DBG_DUMP3(ZK, ZK, ZK);
            { PH(); pg8::Gemm g{ZK, (const bf16*)(wl + WO_O), MH, DM, DM}; pg8::StaticOrder S; S.init(MH, DM, G, bx);
              pg8::EpiResid<false> E{H + (size_t)hf * MH * DM, H + (size_t)hf * MH * DM, nullptr, nullptr, SS + (size_t)(3 * l + 1) * SSS + (size_t)hf * MH * 16, nullptr};
              if (DBG_REP_RES) { pg8::EpiResid<false> E0 = E; E0.ascale = 0.f; pg8::gemm_phase<pg8::EpiResid<false>, pg8::StaticOrder, true, true>(ldsl, g, S, E0); }
              pg8::gemm_phase<pg8::EpiResid<false>, pg8::StaticOrder, true, true>(ldsl, g, S, E); }
            GRID_SYNC(); TSTAMP(5);
            if (DBG_STOP == 6) DBG_ZERO_UPPER();
        }
        for (int rep_ = 0; rep_ < (DBG_REP_UP ? 2 : 1); ++rep_)
        { PH(); pg8::Gemm g{H, (const bf16*)(wl + WO_UP), M, NUP, DM}; pg8::StaticOrder S; S.init(M, NUP, G, bx);
          pg8::EpiConv E{ACT, EDGE, ap->in[19] + (size_t)l * 3 * NUP, ap->in[20] + (size_t)l * NUP, (LAS float*)(ldsl + XB_OFF), SS + (size_t)(3 * l + 1) * SSS};
          pg8::gemm_phase<pg8::EpiConv, pg8::StaticOrder, true, true, true>(ldsl, g, S, E); }
        GRID_SYNC(); TSTAMP(7);
        { PH(); const float* cw = ap->in[19] + (size_t)l * 3 * NUP; const float* cb = ap->in[20] + (size_t)l * NUP;
          for (size_t i = gt; i < (size_t)(M / 256) * pg8::NTC * 2 * 32; i += NGT) {
              const int c = (int)(i & 31) * 4, row = (int)((i >> 5) & 1), tile = (int)(i >> 6), pn = tile % pg8::NTC, pm = tile / pg8::NTC;
              const bool first = (pm % (SEQ / 256)) == 0; const int gcol = pn * 128 + c;
              const float* e1 = EDGE + (size_t)tile * 1024; const float* e0 = EDGE + (size_t)(first ? tile : tile - pg8::NTC) * 1024;
              f32x4 av[2];
#pragma unroll
              for (int q = 0; q < 2; ++q) { const int jc = q * 128 + c, col = q * DFF + gcol;
                  const f32x4 z4 = (f32x4){0.f, 0.f, 0.f, 0.f};
                  const f32x4 pm2 = first ? z4 : *(const f32x4*)(e0 + 2 * 256 + jc), pm1 = first ? z4 : *(const f32x4*)(e0 + 3 * 256 + jc), r0 = *(const f32x4*)(e1 + jc), r1 = *(const f32x4*)(e1 + 256 + jc);
                  const f32x4 w0 = *(const f32x4*)(cw + col), w1 = *(const f32x4*)(cw + NUP + col), w2 = *(const f32x4*)(cw + 2 * NUP + col), bb = *(const f32x4*)(cb + col);
                  av[q] = row == 0 ? (w0 * pm2 + w1 * pm1 + w2 * r0 + bb) : (w0 * pm1 + w1 * r0 + w2 * r1 + bb); }
              v2u w; w.x = pk2(pg8::gelu_tanh_f(av[0][0]) * av[1][0], pg8::gelu_tanh_f(av[0][1]) * av[1][1]); w.y = pk2(pg8::gelu_tanh_f(av[0][2]) * av[1][2], pg8::gelu_tanh_f(av[0][3]) * av[1][3]);
              *(v2u*)(ACT + (size_t)(pm * 256 + row) * DFF + gcol) = w; }
          const float* pl = ap->in[1] + (size_t)l * M * PLE;
          for (size_t i = gt; i < (size_t)M * PLE / 8; i += NGT) { const f32x4 v0 = ((const f32x4*)pl)[2 * i], v1 = ((const f32x4*)pl)[2 * i + 1];
              v4u w; w.x = pk2(v0.x, v0.y); w.y = pk2(v0.z, v0.w); w.z = pk2(v1.x, v1.y); w.w = pk2(v1.z, v1.w); ((v4u*)PBF)[i] = w; } }
        GRID_SYNC(); TSTAMP(8);
        { PH(); pg8::Gemm g{ACT, (const bf16*)(wl + WO_DOWN), M, DM, DFF}; pg8::StaticOrder S; S.init(M, DM, G, bx);
          pg8::EpiResid<false> E{H, XBB, nullptr, nullptr, SS + (size_t)(3 * l + 2) * SSS, nullptr};
          if (DBG_REP_RES) { pg8::EpiResid<false> E0 = E; E0.ascale = 0.f; pg8::gemm_phase<pg8::EpiResid<false>, pg8::StaticOrder, true, true>(ldsl, g, S, E0); }
          pg8::gemm_phase<pg8::EpiResid<false>, pg8::StaticOrder, true, true>(ldsl, g, S, E); }
        GRID_SYNC(); TSTAMP(9);
        { PH(); pg8::Gemm g{PBF, (const bf16*)(wl + WO_PLE), M, DM, PLE}; pg8::StaticOrder S; S.init(M, DM, G, bx);
          pg8::EpiStore E{EB, DM}; pg8::gemm_phase<pg8::EpiStore, pg8::StaticOrder, true, true>(ldsl, g, S, E); }
        { PH(); pg8::Gemm g{XBB, (const bf16*)(wl + WO_PG), M, DM, DM}; pg8::StaticOrder S; S.init(M, DM, G, bx);
          pg8::EpiResid<true> E{XBB, H, ap->in[24] + (size_t)l * DM, EB, SS + (size_t)(3 * l + 3) * SSS, SS + (size_t)(3 * l + 2) * SSS};
          if (DBG_REP_RES) { pg8::EpiResid<true> E0 = E; E0.ascale = 0.f; E0.XBO = XBB; pg8::gemm_phase<pg8::EpiResid<true>, pg8::StaticOrder, true, true, true>(ldsl, g, S, E0); }
          pg8::gemm_phase<pg8::EpiResid<true>, pg8::StaticOrder, true, true, true>(ldsl, g, S, E); }
        GRID_SYNC(); TSTAMP(11);
        if (l + 1 == DEPTH) { PH(); const float* gfin = ap->in[26];
            for (int m = gw; m < M; m += NGW) { const bf16* xr = H + (size_t)m * DM + 16 * lane; const v4u a0 = *(const v4u*)xr, a1 = *(const v4u*)(xr + 8);
                float f[16]; f[0] = pg8::h_lo(a0.x); f[1] = pg8::h_hi(a0.x); f[2] = pg8::h_lo(a0.y); f[3] = pg8::h_hi(a0.y); f[4] = pg8::h_lo(a0.z); f[5] = pg8::h_hi(a0.z); f[6] = pg8::h_lo(a0.w); f[7] = pg8::h_hi(a0.w);
                f[8] = pg8::h_lo(a1.x); f[9] = pg8::h_hi(a1.x); f[10] = pg8::h_lo(a1.y); f[11] = pg8::h_hi(a1.y); f[12] = pg8::h_lo(a1.z); f[13] = pg8::h_hi(a1.z); f[14] = pg8::h_lo(a1.w); f[15] = pg8::h_hi(a1.w);
                float sq = 0.f;
#pragma unroll
                for (int j = 0; j < 16; ++j) sq += f[j] * f[j];
                const float rstd = 1.0f / sqrtf(wave_sum(sq, lane) * (1.f / DM) + EPS);
                float* orow = X + (size_t)m * DM + 16 * lane;
#pragma unroll
                for (int j = 0; j < 4; ++j) { const f32x4 gg = *(const f32x4*)(gfin + 16 * lane + 4 * j); *(f32x4*)(orow + 4 * j) = (f32x4){f[4 * j] * rstd * gg[0], f[4 * j + 1] * rstd * gg[1], f[4 * j + 2] * rstd * gg[2], f[4 * j + 3] * rstd * gg[3]}; } } }
        if (DBG_TIME && l + 1 == DEPTH) { GRID_SYNC(); TSTAMP(12); GRID_SYNC();
            PH(); const unsigned long long* tb = (const unsigned long long*)(ws + 64); unsigned long long sa = 0, sb = 0;
            for (int k = 0; k < 13; ++k) { const unsigned long long v = __hip_atomic_load(tb + 1 + k, __ATOMIC_RELAXED, __HIP_MEMORY_SCOPE_AGENT); if ((SELA >> k) & 1) sa += v; if ((SELB >> k) & 1) sb += v; }
            const float fb = (float)(sa + sb) * 0.00001f;
            for (size_t i = gt; i < (size_t)16384 * DM; i += NGT) X[i] = fb; }
    }
}

extern "C" void kernel_launch(void* const* d_in, const int* in_sizes, int n_in, void* d_out, int out_size, void* d_ws, size_t ws_size, hipStream_t stream) {
    static int grid = 0;
    if (grid == 0) {
        if (n_in != 27 || out_size != M * DM || ws_size < WS_END) { fprintf(stderr, "kernel_launch: unexpected shapes (n_in %d out %d ws %zu)\n", n_in, out_size, ws_size); grid = -1; return; }
        int dev = 0, cus = 0, per_cu = 0;
        if (hipGetDevice(&dev) != hipSuccess || hipDeviceGetAttribute(&cus, hipDeviceAttributeMultiprocessorCount, dev) != hipSuccess) { grid = -1; return; }
        if (hipFuncSetAttribute((const void*)fwd_kernel, hipFuncAttributeMaxDynamicSharedMemorySize, LDS_BYTES) != hipSuccess) { fprintf(stderr, "kernel_launch: hipFuncSetAttribute failed\n"); grid = -1; return; }
        if (hipOccupancyMaxActiveBlocksPerMultiprocessor(&per_cu, (const void*)fwd_kernel, NTHREADS, LDS_BYTES) != hipSuccess || per_cu < 1) { fprintf(stderr, "kernel_launch: occupancy query gives %d\n", per_cu); per_cu = 1; }
        (void)hipGetLastError();
        grid = cus * per_cu;
    }
    if (grid < 0) return;
    if (hipMemsetAsync(d_ws, 0, 32768, stream) != hipSuccess) { fprintf(stderr, "kernel_launch: memset failed\n"); return; }
    Args a{};
    for (int i = 0; i < 27; ++i) a.in[i] = (const float*)d_in[i];
    a.out = (float*)d_out; a.ws = (unsigned char*)d_ws;
    void* args[] = {&a};
    hipError_t e = hipLaunchCooperativeKernel((const void*)fwd_kernel, dim3(grid), dim3(NTHREADS), args, LDS_BYTES, stream);
    if (e != hipSuccess) fprintf(stderr, "kernel_launch: cooperative launch failed: %s (grid %d)\n", hipGetErrorString(e), grid);
}
```

```cpp
#include <hip/hip_runtime.h>
#include <hip/hip_cooperative_groups.h>
#include <cstdio>
#include <cstdint>
namespace cg = cooperative_groups;
namespace pg8 {
#define PG8_LAS __attribute__((address_space(3)))
typedef unsigned short bf16_t;
typedef short bf16x8 __attribute__((ext_vector_type(8)));
typedef float f32x4 __attribute__((ext_vector_type(4)));
typedef unsigned u32x4 __attribute__((ext_vector_type(4)));
constexpr int BM = 256, BK = 64, HALF = 128, HTB = HALF * BK * 2  , STAGE_BYTES = 8 * HTB, NXCD = 8, WGM = 8;

__host__ __device__ __forceinline__ int lds_byte(int r, int c) { const int st = (r >> 4) * 2 + (c >> 5), rr = r & 15, cc = c & 31, ob = rr * 64 + cc * 2; return st * 1024 + (ob ^ (((ob >> 9) & 1) << 5)); }
__host__ __device__ __forceinline__ void stage_rc(int b, int& R, int& C) { const int st = b / 1024, sb = b % 1024, swz = sb ^ (((sb >> 9) & 1) << 5); R = (st >> 1) * 16 + swz / 64; C = (st & 1) * 32 + (swz % 64) / 2; }
__host__ __device__ __forceinline__ int perm32(int rho) { const int n = rho >> 4, i = rho & 15; return 8 * (i >> 2) + 4 * n + (i & 3); }

struct Unit { int pm, pn; };
struct Gemm { const bf16_t* A; const bf16_t* Bt; int M, N, K; };

struct StaticOrder {
    int nM, nN, nwg, G, c;
    __host__ __device__ void init(int M, int N, int G_, int c_) { nM = M / BM; nN = N / BM; nwg = nM * nN; G = G_; c = c_; }
    __host__ __device__ bool next(int i, Unit& u) const {
        const long L = (long)i * G + c; if (L >= nwg) return false;
        int wgid = (int)L; { const int q = nwg / NXCD, r = nwg % NXCD, xcd = wgid % NXCD, off = wgid / NXCD; wgid = (xcd < r ? xcd * (q + 1) : r * (q + 1) + (xcd - r) * q) + off; }
        const int nig = WGM * nN, gid = wgid / nig, fm = gid * WGM, gsz = (nM - fm) < WGM ? (nM - fm) : WGM;
        u.pm = fm + ((wgid % nig) % gsz); u.pn = (wgid % nig) / gsz; return true;
    }
    __device__ __forceinline__ void a_ready(const Unit&) const {}
    __device__ __forceinline__ void done(const Unit&) const {}
};

typedef float cv_f32x2 __attribute__((ext_vector_type(2))); typedef __bf16 cv_bf16x2 __attribute__((ext_vector_type(2)));
__device__ __forceinline__ unsigned cvt_pk_bf16(float lo, float hi) { const cv_f32x2 v = {lo, hi}; const cv_bf16x2 b = __builtin_convertvector(v, cv_bf16x2); return __builtin_bit_cast(unsigned, b); }
typedef float f32x2 __attribute__((ext_vector_type(2)));
__device__ __forceinline__ f32x2 gelu_pk(f32x2 v) {
    const f32x2 av = __builtin_elementwise_abs(v), d = av * 0.2316418882f + 1.0f;
    f32x2 t; t.x = __builtin_amdgcn_rcpf(d.x); t.y = __builtin_amdgcn_rcpf(d.y);
    f32x2 q = t * 0.5307027145f + (-0.7265760135f); q = q * t + 0.7107068705f; q = q * t + (-0.142248368f); q = q * t + 0.127414796f; q = q * t;
    const f32x2 s = (v * v) * (-0.72134752044f);
    f32x2 e; e.x = __builtin_amdgcn_exp2f(s.x); e.y = __builtin_amdgcn_exp2f(s.y);
    const f32x2 m = v * (q * e), r = v - m;
    f32x2 o; o.x = v.x < 0.f ? m.x : r.x; o.y = v.y < 0.f ? m.y : r.y; return o;
}

template <int ACT  > struct EpiBf16 {
    static constexpr bool PERM = true, AFTER_DRAIN = false; static_assert(ACT == 0 || ACT == 1, "EpiBf16: ACT is 0 (none) or 1 (gelu_pk)");
    bf16_t* O; int ldc; const float* bias; int split_cols; size_t split_stride; float scale0;
    __device__ __forceinline__ void operator()(const f32x4 (&acc)[2][2][4][2], const Unit& u, int wr, int wc, int fr_, int fq_) const {
        int t_o = threadIdx.x; asm volatile("" : "+v"(t_o)); int fr = t_o & 15, fq = (t_o >> 4) & 3; (void)fr_; (void)fq_;

        const int row0 = u.pm * BM + wr * 64 + fr; int colt = u.pn * BM; bf16_t* base = O;
        float sc = 1.f; if (split_cols) { const int t = colt / split_cols; base += (size_t)t * split_stride; colt -= t * split_cols; if (t == 0) sc = scale0; }
        const int col0 = colt + wc * 32 + 8 * fq, bcol0 = u.pn * BM + wc * 32 + 8 * fq;
        f32x4 bv[2][2];
#pragma unroll
        for (int bj = 0; bj < 2; ++bj)
#pragma unroll
            for (int n = 0; n < 2; ++n) bv[bj][n] = bias ? *(const f32x4*)(bias + bcol0 + bj * HALF + 4 * n) : (f32x4){0.f, 0.f, 0.f, 0.f};
#pragma unroll
        for (int ai = 0; ai < 2; ++ai)
#pragma unroll
            for (int m = 0; m < 4; ++m) { bf16_t* rowp = base + (size_t)(row0 + ai * HALF + m * 16) * ldc + col0;
#pragma unroll
                for (int bj = 0; bj < 2; ++bj) { f32x4 v0 = acc[ai][bj][m][0] + bv[bj][0], v1 = acc[ai][bj][m][1] + bv[bj][1];
                    if (ACT == 1) { f32x2 a = gelu_pk((f32x2){v0[0], v0[1]}), b = gelu_pk((f32x2){v0[2], v0[3]}), c = gelu_pk((f32x2){v1[0], v1[1]}), d = gelu_pk((f32x2){v1[2], v1[3]});
                        v0 = (f32x4){a.x, a.y, b.x, b.y}; v1 = (f32x4){c.x, c.y, d.x, d.y}; }
                    v0 = v0 * sc; v1 = v1 * sc; u32x4 w; w.x = cvt_pk_bf16(v0[0], v0[1]); w.y = cvt_pk_bf16(v0[2], v0[3]); w.z = cvt_pk_bf16(v1[0], v1[1]); w.w = cvt_pk_bf16(v1[2], v1[3]);
                    *(u32x4*)(rowp + bj * HALF) = w; } }
    }
};
__device__ __forceinline__ float sigmoid_f(float x) { return __builtin_amdgcn_rcpf(1.0f + __builtin_amdgcn_exp2f(-1.4426950408889634f * x)); }
__device__ __forceinline__ float gelu_tanh_f(float x) { const float u = 0.7978845608028654f * (x + 0.044715f * x * x * x); return x * __builtin_amdgcn_rcpf(1.0f + __builtin_amdgcn_exp2f(-2.885390081777927f * u)); }
__device__ __forceinline__ float bf_lo(unsigned w) { return __builtin_bit_cast(float, w << 16); }
__device__ __forceinline__ float bf_hi(unsigned w) { return __builtin_bit_cast(float, w & 0xffff0000u); }
typedef unsigned u32x2 __attribute__((ext_vector_type(2)));
typedef _Float16 h16x2 __attribute__((ext_vector_type(2)));
__device__ __forceinline__ float h_lo(unsigned w) { return (float)__builtin_bit_cast(h16x2, w)[0]; }
__device__ __forceinline__ float h_hi(unsigned w) { return (float)__builtin_bit_cast(h16x2, w)[1]; }
__device__ __forceinline__ unsigned cvt_pk_f16(float lo, float hi) { const h16x2 v = {(_Float16)lo, (_Float16)hi}; return __builtin_bit_cast(unsigned, v); }

__device__ __forceinline__ float rstd_row(const float* SSI, int row) { const f32x4* p = (const f32x4*)(SSI + (size_t)row * 16); const f32x4 a = p[0], b = p[1], c = p[2], d = p[3];
    const float s = ((a[0] + a[1]) + (a[2] + a[3])) + ((b[0] + b[1]) + (b[2] + b[3])) + ((c[0] + c[1]) + (c[2] + c[3])) + ((d[0] + d[1]) + (d[2] + d[3])); return __builtin_amdgcn_rsqf(s * (1.f / 1024.f) + 1e-6f); }
struct EpiIn {
    static constexpr bool PERM = true, AFTER_DRAIN = false;
    bf16_t* Z; size_t bufstride; const float* bgate; float qscale; const float* SSI; float* VST = nullptr;
    template <int MODE> __device__ __forceinline__ void body(const f32x4 (&acc)[2][2][4][2], bf16_t* base, const float* bias, int row0, int col0, int lane = 0, int slot = 0) const {
        f32x4 bv[2][2];
#pragma unroll
        for (int bj = 0; bj < 2; ++bj)
#pragma unroll
            for (int n = 0; n < 2; ++n) bv[bj][n] = (MODE == 3) ? *(const f32x4*)(bias + col0 + bj * HALF + 4 * n) : (f32x4){0.f, 0.f, 0.f, 0.f};
#pragma unroll
        for (int ai = 0; ai < 2; ++ai)
#pragma unroll
            for (int m = 0; m < 4; ++m) { bf16_t* rowp = base + (size_t)(row0 + ai * HALF + m * 16) * 1024 + col0;
                const float rs = rstd_row(SSI, row0 + ai * HALF + m * 16); float ps = 0.f, pq = 0.f;
#pragma unroll
                for (int bj = 0; bj < 2; ++bj) { f32x4 v0 = acc[ai][bj][m][0] * rs, v1 = acc[ai][bj][m][1] * rs;
                    if (MODE == 1 || MODE == 4) {
#pragma unroll
                        for (int x = 0; x < 4; ++x) { v0[x] = gelu_tanh_f(v0[x]); v1[x] = gelu_tanh_f(v1[x]); } }
                    if (MODE == 4) { ps += ((v0[0] + v0[1]) + (v0[2] + v0[3])) + ((v1[0] + v1[1]) + (v1[2] + v1[3]));
                        pq += ((v0[0] * v0[0] + v0[1] * v0[1]) + (v0[2] * v0[2] + v0[3] * v0[3])) + ((v1[0] * v1[0] + v1[1] * v1[1]) + (v1[2] * v1[2] + v1[3] * v1[3])); }
                    if (MODE == 2) { v0 = v0 * qscale; v1 = v1 * qscale; }
                    if (MODE == 3) { v0 = v0 + bv[bj][0]; v1 = v1 + bv[bj][1];
#pragma unroll
                        for (int x = 0; x < 4; ++x) { v0[x] = sigmoid_f(v0[x]); v1[x] = sigmoid_f(v1[x]); } }
                    u32x4 w; w.x = cvt_pk_bf16(v0[0], v0[1]); w.y = cvt_pk_bf16(v0[2], v0[3]); w.z = cvt_pk_bf16(v1[0], v1[1]); w.w = cvt_pk_bf16(v1[2], v1[3]);
                    *(u32x4*)(rowp + bj * HALF) = w; }
                if (MODE == 4) {
                    ps += __builtin_bit_cast(float, __builtin_amdgcn_ds_bpermute((lane ^ 16) << 2, __builtin_bit_cast(int, ps))); pq += __builtin_bit_cast(float, __builtin_amdgcn_ds_bpermute((lane ^ 16) << 2, __builtin_bit_cast(int, pq)));
                    ps += __builtin_bit_cast(float, __builtin_amdgcn_ds_bpermute((lane ^ 32) << 2, __builtin_bit_cast(int, ps))); pq += __builtin_bit_cast(float, __builtin_amdgcn_ds_bpermute((lane ^ 32) << 2, __builtin_bit_cast(int, pq)));
                    if ((lane >> 4) == 0) { float* vp = VST + (size_t)(row0 + ai * HALF + m * 16) * 32 + slot * 2; vp[0] = ps; vp[1] = pq; } }
                asm volatile("" ::: "memory"); }
    }
    __device__ __forceinline__ void operator()(const f32x4 (&acc)[2][2][4][2], const Unit& u, int wr, int wc, int fr_, int fq_) const {
        int t_o = threadIdx.x; asm volatile("" : "+v"(t_o)); int fr = t_o & 15, fq = (t_o >> 4) & 3; (void)fr_; (void)fq_;

        const int t = u.pn >> 2, colt = (u.pn & 3) * BM;
        bf16_t* base = Z + (size_t)t * bufstride;
        const int row0 = u.pm * BM + wr * 64 + fr, col0 = colt + wc * 32 + 8 * fq;
        if (t == 0) body<1>(acc, base, nullptr, row0, col0);
        else if (t == 1) body<4>(acc, base, nullptr, row0, col0, t_o & 63, (u.pn & 3) * 4 + wc);
        else if (t == 2) body<2>(acc, base, nullptr, row0, col0);
        else if (t < 5) body<0>(acc, base, nullptr, row0, col0);
        else body<3>(acc, base, bgate + (t - 5) * 1024, row0, col0);
    }
};
struct EpiNull {
    static constexpr bool PERM = true, AFTER_DRAIN = false;
    __device__ __forceinline__ void operator()(const f32x4 (&acc)[2][2][4][2], const Unit& u, int wr, int wc, int fr_, int fq_) const {
#pragma unroll
        for (int ai = 0; ai < 2; ++ai)
#pragma unroll
            for (int bj = 0; bj < 2; ++bj)
#pragma unroll
                for (int m = 0; m < 4; ++m)
#pragma unroll
                    for (int n = 0; n < 2; ++n) asm volatile("" :: "v"(acc[ai][bj][m][n]));
    }
};
struct EpiStore {
    static constexpr bool PERM = true, AFTER_DRAIN = false;
    bf16_t* O; int ldc;
    __device__ __forceinline__ void operator()(const f32x4 (&acc)[2][2][4][2], const Unit& u, int wr, int wc, int fr_, int fq_) const {
        int t_o = threadIdx.x; asm volatile("" : "+v"(t_o)); int fr = t_o & 15, fq = (t_o >> 4) & 3; (void)fr_; (void)fq_;

        const int row0 = u.pm * BM + wr * 64 + fr, col0 = u.pn * BM + wc * 32 + 8 * fq;
#pragma unroll
        for (int ai = 0; ai < 2; ++ai)
#pragma unroll
            for (int m = 0; m < 4; ++m) { bf16_t* rowp = O + (size_t)(row0 + ai * HALF + m * 16) * ldc + col0;
#pragma unroll
                for (int bj = 0; bj < 2; ++bj) { const f32x4 v0 = acc[ai][bj][m][0], v1 = acc[ai][bj][m][1];
                    u32x4 w; w.x = cvt_pk_bf16(v0[0], v0[1]); w.y = cvt_pk_bf16(v0[2], v0[3]); w.z = cvt_pk_bf16(v1[0], v1[1]); w.w = cvt_pk_bf16(v1[2], v1[3]);
                    *(u32x4*)(rowp + bj * HALF) = w; } }
    }
};
template <bool ADD> struct EpiGate {
    static constexpr bool PERM = true, AFTER_DRAIN = false;
    const bf16_t* G; bf16_t* MG;
    __device__ __forceinline__ void operator()(const f32x4 (&acc)[2][2][4][2], const Unit& u, int wr, int wc, int fr_, int fq_) const {
        int t_o = threadIdx.x; asm volatile("" : "+v"(t_o)); int fr = t_o & 15, fq = (t_o >> 4) & 3; (void)fr_; (void)fq_;

        const int row0 = u.pm * BM + wr * 64 + fr, col0 = u.pn * BM + wc * 32 + 8 * fq;
#pragma unroll
        for (int ai = 0; ai < 2; ++ai)
#pragma unroll
            for (int m = 0; m < 4; ++m) { const size_t off = (size_t)(row0 + ai * HALF + m * 16) * 1024 + col0;
#pragma unroll
                for (int bj = 0; bj < 2; ++bj) { const f32x4 v0 = acc[ai][bj][m][0], v1 = acc[ai][bj][m][1];
                    const u32x4 g = *(const u32x4*)(G + off + bj * HALF);
                    float r[8];
                    r[0] = bf_lo(g.x) * v0[0]; r[1] = bf_hi(g.x) * v0[1]; r[2] = bf_lo(g.y) * v0[2]; r[3] = bf_hi(g.y) * v0[3];
                    r[4] = bf_lo(g.z) * v1[0]; r[5] = bf_hi(g.z) * v1[1]; r[6] = bf_lo(g.w) * v1[2]; r[7] = bf_hi(g.w) * v1[3];
                    if (ADD) { const u32x4 o = *(const u32x4*)(MG + off + bj * HALF);
                        r[0] += bf_lo(o.x); r[1] += bf_hi(o.x); r[2] += bf_lo(o.y); r[3] += bf_hi(o.y); r[4] += bf_lo(o.z); r[5] += bf_hi(o.z); r[6] += bf_lo(o.w); r[7] += bf_hi(o.w); }
                    u32x4 w; w.x = cvt_pk_bf16(r[0], r[1]); w.y = cvt_pk_bf16(r[2], r[3]); w.z = cvt_pk_bf16(r[4], r[5]); w.w = cvt_pk_bf16(r[6], r[7]);
                    *(u32x4*)(MG + off + bj * HALF) = w; }
                asm volatile("" ::: "memory"); }
    }
};
template <bool PLE> struct EpiResid {
    static constexpr bool PERM = false, AFTER_DRAIN = false;
    const bf16_t* XIB; bf16_t* XBO; const float* bias; const bf16_t* E;
    float* SSO; const float* SSI;
    float ascale = 1.f;
    __device__ __forceinline__ void operator()(const f32x4 (&acc)[2][2][4][2], const Unit& u, int wr, int wc, int fr_, int fq_) const {
        int t_o = threadIdx.x; asm volatile("" : "+v"(t_o)); int fr = t_o & 15, fq = (t_o >> 4) & 3; (void)fr_; (void)fq_;
        const int lane = t_o & 63;
        const int col0 = u.pn * BM + wc * 32 + 4 * fq;
        constexpr int MG = PLE ? 2 : 4;
#pragma unroll
        for (int ai = 0; ai < 2; ++ai)
#pragma unroll
        for (int m0 = 0; m0 < 4; m0 += MG) {
            u32x2 xi[4][2][2]; u32x2 ev[4][2][2]; float rs[4];
#pragma unroll
            for (int m = m0; m < m0 + MG; ++m) { const int row = u.pm * BM + ai * HALF + wr * 64 + m * 16 + fr; const size_t off = (size_t)row * 1024 + col0;
                rs[m] = 1.f; if (PLE) rs[m] = rstd_row(SSI, row);
#pragma unroll
                for (int bj = 0; bj < 2; ++bj)
#pragma unroll
                    for (int n = 0; n < 2; ++n) { const size_t o2 = off + bj * HALF + n * 16; xi[m][bj][n] = *(const u32x2*)(XIB + o2); if (PLE) ev[m][bj][n] = *(const u32x2*)(E + o2); } }
#pragma unroll
            for (int m = m0; m < m0 + MG; ++m) { const int row = u.pm * BM + ai * HALF + wr * 64 + m * 16 + fr; const size_t off = (size_t)row * 1024 + col0;
                float q = 0.f;
#pragma unroll
                for (int bj = 0; bj < 2; ++bj)
#pragma unroll
                    for (int n = 0; n < 2; ++n) { const size_t o2 = off + bj * HALF + n * 16; f32x4 a = acc[ai][bj][m][n];
                        if (PLE) { const f32x4 bv = *(const f32x4*)(bias + col0 + bj * HALF + n * 16); const u32x2 e = ev[m][bj][n]; a = a * rs[m] + bv;
                            a[0] = sigmoid_f(a[0]) * bf_lo(e.x); a[1] = sigmoid_f(a[1]) * bf_hi(e.x); a[2] = sigmoid_f(a[2]) * bf_lo(e.y); a[3] = sigmoid_f(a[3]) * bf_hi(e.y); }
                        const u32x2 xo = xi[m][bj][n];
                        const f32x4 xn = (f32x4){h_lo(xo.x), h_hi(xo.x), h_lo(xo.y), h_hi(xo.y)} + a * ascale;
                        u32x2 w; w.x = cvt_pk_f16(xn[0], xn[1]); w.y = cvt_pk_f16(xn[2], xn[3]); *(u32x2*)(XBO + o2) = w;
                        q += (xn[0] * xn[0] + xn[1] * xn[1]) + (xn[2] * xn[2] + xn[3] * xn[3]); }
                q += __builtin_bit_cast(float, __builtin_amdgcn_ds_bpermute((lane ^ 16) << 2, __builtin_bit_cast(int, q)));
                q += __builtin_bit_cast(float, __builtin_amdgcn_ds_bpermute((lane ^ 32) << 2, __builtin_bit_cast(int, q)));
                if (fq == 0) SSO[(size_t)row * 16 + u.pn * 4 + wc] = q; }
            asm volatile("" ::: "memory"); }
    }
};
constexpr int FFC = 2816, NTC = FFC / 128;
struct EpiConv {
    static constexpr bool PERM = true, AFTER_DRAIN = false;
    bf16_t* ACT; float* EDGE; const float* cw; const float* cb; PG8_LAS float* xb; const float* SSI;
    __device__ __forceinline__ void operator()(f32x4 (&acc)[2][2][4][2], const Unit& u, int wr, int wc, int fr_, int fq_) const {
        int t_o = threadIdx.x; asm volatile("" : "+v"(t_o)); int fr = t_o & 15, fq = (t_o >> 4) & 3; (void)fr_; (void)fq_;

        const int lane = t_o & 63;
        const int jc0 = wc * 32 + 8 * fq;
        { PG8_LAS float* rtab = xb + 2048; const int tt = t_o & 511;
          if (tt < 256) rtab[tt] = rstd_row(SSI, u.pm * BM + tt);
          asm volatile("s_waitcnt lgkmcnt(0)" ::: "memory"); __builtin_amdgcn_s_barrier(); asm volatile("" ::: "memory");
#pragma unroll
          for (int ai = 0; ai < 2; ++ai)
#pragma unroll
            for (int m = 0; m < 4; ++m) { const float rs = rtab[ai * HALF + wr * 64 + m * 16 + fr];
#pragma unroll
                for (int bj = 0; bj < 2; ++bj)
#pragma unroll
                    for (int n = 0; n < 2; ++n) acc[ai][bj][m][n] = acc[ai][bj][m][n] * rs; } }
        if (fr >= 14) {
#pragma unroll
            for (int ai = 0; ai < 2; ++ai)
#pragma unroll
                for (int bj = 0; bj < 2; ++bj)
#pragma unroll
                    for (int n = 0; n < 2; ++n) *(PG8_LAS f32x4*)(xb + (((ai * 2 + wr) * 2 + (fr - 14)) * 256 + bj * HALF + jc0 + 4 * n)) = acc[ai][bj][3][n];
        }
        float* eb = EDGE + (size_t)(u.pm * NTC + u.pn) * 4 * 256;
        if (wr == 0 && fr < 2) {
#pragma unroll
            for (int bj = 0; bj < 2; ++bj)
#pragma unroll
                for (int n = 0; n < 2; ++n) *(f32x4*)(eb + fr * 256 + bj * HALF + jc0 + 4 * n) = acc[0][bj][0][n];
        }
        if (wr == 1 && fr >= 14) {
#pragma unroll
            for (int bj = 0; bj < 2; ++bj)
#pragma unroll
                for (int n = 0; n < 2; ++n) *(f32x4*)(eb + (2 + fr - 14) * 256 + bj * HALF + jc0 + 4 * n) = acc[1][bj][3][n];
        }
        asm volatile("s_waitcnt lgkmcnt(0)" ::: "memory"); __builtin_amdgcn_s_barrier(); asm volatile("" ::: "memory");
        const int src1 = (lane & 48) | ((fr + 15) & 15), src2 = (lane & 48) | ((fr + 14) & 15);
#pragma unroll
        for (int bj = 0; bj < 2; ++bj)
#pragma unroll
            for (int n = 0; n < 2; ++n) {
                const int gc = bj * FFC + u.pn * 128 + jc0 + 4 * n;
                const f32x4 w0 = *(const f32x4*)(cw + gc), w1 = *(const f32x4*)(cw + 2 * FFC + gc), w2 = *(const f32x4*)(cw + 4 * FFC + gc), bb = *(const f32x4*)(cb + gc);
#pragma unroll
                for (int ai = 0; ai < 2; ++ai) {
                    const int grp = ai * 2 + wr;
                    f32x4 xp = (f32x4){0.f, 0.f, 0.f, 0.f};
                    if (grp > 0 && fr >= 14) xp = *(const PG8_LAS f32x4*)(xb + (((grp - 1) * 2 + (fr - 14)) * 256 + bj * HALF + jc0 + 4 * n));
#pragma unroll
                    for (int m = 3; m >= 0; --m) {
                        f32x4 cur = acc[ai][bj][m][n]; f32x4 prv = (m > 0) ? acc[ai][bj][m > 0 ? m - 1 : 0][n] : xp;
                        asm volatile("" : "+v"(cur), "+v"(prv));
                        f32x4 r;
#pragma unroll
                        for (int x = 0; x < 4; ++x) {
                            const float s1 = (fr == 15) ? prv[x] : cur[x], s2 = (fr >= 14) ? prv[x] : cur[x];
                            const float p1 = __builtin_bit_cast(float, __builtin_amdgcn_update_dpp(0, __builtin_bit_cast(int, s1), 0x121, 0xf, 0xf, false)), p2 = __builtin_bit_cast(float, __builtin_amdgcn_update_dpp(0, __builtin_bit_cast(int, s2), 0x122, 0xf, 0xf, false));
                            r[x] = w0[x] * p2 + w1[x] * p1 + w2[x] * cur[x] + bb[x];
                        }
                        asm volatile("" : "+v"(r));
                        acc[ai][bj][m][n] = r;
                    }
                    __builtin_amdgcn_sched_barrier(0);
                }
                asm volatile("" ::: "memory");
            }
#pragma unroll
        for (int ai = 0; ai < 2; ++ai)
#pragma unroll
            for (int m = 0; m < 4; ++m) {
                const bool skip = (ai == 0 && wr == 0 && m == 0 && fr < 2);
                bf16_t* rowp = ACT + (size_t)(u.pm * BM + ai * HALF + wr * 64 + m * 16 + fr) * FFC + u.pn * 128 + jc0;
                const f32x4 g0 = acc[ai][0][m][0], g1 = acc[ai][0][m][1], v0 = acc[ai][1][m][0], v1 = acc[ai][1][m][1];
                float r[8];
#pragma unroll
                for (int x = 0; x < 4; ++x) { r[x] = gelu_tanh_f(g0[x]) * v0[x]; r[4 + x] = gelu_tanh_f(g1[x]) * v1[x]; }
                u32x4 w; w.x = cvt_pk_bf16(r[0], r[1]); w.y = cvt_pk_bf16(r[2], r[3]); w.z = cvt_pk_bf16(r[4], r[5]); w.w = cvt_pk_bf16(r[6], r[7]);
                if (!skip) *(u32x4*)rowp = w;
                asm volatile("" ::: "memory"); __builtin_amdgcn_sched_barrier(0);
            }
        asm volatile("s_waitcnt lgkmcnt(0)" ::: "memory"); __builtin_amdgcn_s_barrier(); asm volatile("" ::: "memory");
    }
};
typedef _Float16 f16x8 __attribute__((ext_vector_type(8)));
template <class Epi, class Sched, bool ALIGN_EPI = false, bool SP2 = false, bool F16 = false>
__device__ __forceinline__ void gemm_phase(PG8_LAS unsigned char* lds, const Gemm g, const Sched& S, const Epi& E) {
    int tid_o = threadIdx.x; asm volatile("" : "+v"(tid_o));
    const int tid = tid_o, wid = __builtin_amdgcn_readfirstlane(tid >> 6), lane = tid & 63, wr = wid >> 2, wc = wid & 3, fr = lane & 15, fq = lane >> 4;
    int K_o = g.K; asm volatile("" : "+s"(K_o)); const int K = K_o, nt = K / BK;
    unsigned voffA[2], voffB[2];
#pragma unroll
    for (int i = 0; i < 2; ++i) { int R, C; stage_rc(tid * 16 + i * 8192, R, C); const int Rb = Epi::PERM ? ((R & ~31) + perm32(R & 31)) : R;
        voffA[i] = (unsigned)(R * K + C) * 2u; voffB[i] = (unsigned)(Rb * K + C) * 2u; }
    const size_t kstep = (size_t)(BK * 2);
    const size_t hstep = (size_t)HALF * K * 2;
    const size_t tstep = 2 * hstep;
    const unsigned ldsw = (unsigned)wid * 1024u;
    const int aoff = lds_byte(wr * 64 + fr, fq * 8), boff = lds_byte(wc * 32 + fr, fq * 8);
#define PG8_SA(b, h) (((b) * 2 + (h)) * HTB)
#define PG8_SB(b, h) ((4 + (b) * 2 + (h)) * HTB)
#define PG8_STAGE(bufoff, gbase, voff) do { _Pragma("unroll") for (int _i = 0; _i < 2; ++_i) \
        __builtin_amdgcn_global_load_lds((const unsigned*)((const char*)(gbase) + (voff)[_i]), (PG8_LAS unsigned*)(lds + (bufoff) + ldsw + _i * 8192), 16, 0, 0); } while (0)
#define PG8_LDA(dst, b, h) do { _Pragma("unroll") for (int m = 0; m < 4; ++m) _Pragma("unroll") for (int k = 0; k < 2; ++k) dst[m][k] = *(const PG8_LAS bf16x8*)(lds + PG8_SA(b, h) + aoff + m * 2048 + k * 1024); } while (0)
#define PG8_LDB(dst, b, h) do { _Pragma("unroll") for (int n = 0; n < 2; ++n) _Pragma("unroll") for (int k = 0; k < 2; ++k) dst[n][k] = *(const PG8_LAS bf16x8*)(lds + PG8_SB(b, h) + boff + n * 2048 + k * 1024); } while (0)
#define PG8_MMA(ai, bj, At, Bt) do { __builtin_amdgcn_s_setprio(1); _Pragma("unroll") for (int m = 0; m < 4; ++m) _Pragma("unroll") for (int n = 0; n < 2; ++n) _Pragma("unroll") for (int k = 0; k < 2; ++k) \
        { if constexpr (F16) acc[ai][bj][m][n] = __builtin_amdgcn_mfma_f32_16x16x32_f16(__builtin_bit_cast(f16x8, Bt[n][k]), __builtin_bit_cast(f16x8, At[m][k]), acc[ai][bj][m][n], 0, 0, 0); \
          else acc[ai][bj][m][n] = __builtin_amdgcn_mfma_f32_16x16x32_bf16(Bt[n][k], At[m][k], acc[ai][bj][m][n], 0, 0, 0); } __builtin_amdgcn_s_setprio(0); } while (0)
#define PG8_WAIT_V(n) asm volatile("s_waitcnt vmcnt(" #n ")" ::: "memory")
#define PG8_WAIT_L(n) asm volatile("s_waitcnt lgkmcnt(" #n ")" ::: "memory")
#define PG8_BAR __builtin_amdgcn_s_barrier()
#define PG8_SCHED __builtin_amdgcn_sched_barrier(0)
    Unit cur, nxt; int ui = 0;
    if (!S.next(0, cur)) return;
    f32x4 acc[2][2][4][2];
#pragma unroll
    for (int a = 0; a < 2; ++a)
#pragma unroll
        for (int b = 0; b < 2; ++b)
#pragma unroll
            for (int m = 0; m < 4; ++m)
#pragma unroll
                for (int n = 0; n < 2; ++n) acc[a][b][m][n] = (f32x4){0.f, 0.f, 0.f, 0.f};
    bf16x8 At[4][2], B0[2][2], B1[2][2];
    const char* cA = (const char*)g.A + (size_t)cur.pm * tstep; const char* cB = (const char*)g.Bt + (size_t)cur.pn * tstep;
    S.a_ready(cur);
    if constexpr (SP2) {
        PG8_STAGE(PG8_SB(0, 0), cB, voffB); PG8_STAGE(PG8_SB(0, 1), cB + hstep, voffB); PG8_STAGE(PG8_SA(0, 0), cA, voffA); PG8_STAGE(PG8_SA(0, 1), cA + hstep, voffA);
        if (wr == 1) PG8_BAR;
        PG8_WAIT_V(2); PG8_BAR;
        PG8_STAGE(PG8_SB(1, 0), cB + kstep, voffB); PG8_STAGE(PG8_SA(1, 0), cA + kstep, voffA); PG8_STAGE(PG8_SB(1, 1), cB + hstep + kstep, voffB);
        PG8_WAIT_V(6); PG8_BAR;
    } else {
        PG8_STAGE(PG8_SB(0, 0), cB, voffB); PG8_STAGE(PG8_SA(0, 0), cA, voffA); PG8_STAGE(PG8_SB(0, 1), cB + hstep, voffB); PG8_STAGE(PG8_SA(0, 1), cA + hstep, voffA);
        if (wr == 1) PG8_BAR;
        PG8_WAIT_V(4); PG8_BAR;
        PG8_STAGE(PG8_SB(1, 0), cB + kstep, voffB); PG8_STAGE(PG8_SA(1, 0), cA + kstep, voffA); PG8_STAGE(PG8_SB(1, 1), cB + hstep + kstep, voffB);
        PG8_WAIT_V(6); PG8_BAR;
    }
    for (;;) {
        const bool has_next = S.next(ui + 1, nxt);
        const char* nA = has_next ? (const char*)g.A + (size_t)nxt.pm * tstep : cA; const char* nB = has_next ? (const char*)g.Bt + (size_t)nxt.pn * tstep : cB;
        for (int t = 0; t < nt; t += 2) {
            const bool last = (t == nt - 2);
            const char* a1 = cA + (size_t)(t + 1) * kstep;
            const char* a2 = last ? nA : cA + (size_t)(t + 2) * kstep; const char* b2 = last ? nB : cB + (size_t)(t + 2) * kstep;
            const char* a3 = a2 + kstep; const char* b3 = b2 + kstep;
            if (last && has_next) S.a_ready(nxt);
            if constexpr (SP2) {
            PG8_LDB(B0, 0, 0); PG8_LDB(B1, 0, 1); PG8_SCHED; PG8_LDA(At, 0, 0); PG8_STAGE(PG8_SA(1, 1), a1 + hstep, voffA);
            PG8_WAIT_V(8); PG8_WAIT_L(0); PG8_BAR; PG8_MMA(0, 0, At, B0); PG8_MMA(0, 1, At, B1); PG8_BAR; PG8_SCHED;
            PG8_LDA(At, 0, 1); PG8_STAGE(PG8_SB(0, 0), b2, voffB); PG8_STAGE(PG8_SB(0, 1), b2 + hstep, voffB); PG8_STAGE(PG8_SA(0, 0), a2, voffA);
            PG8_WAIT_V(8); PG8_WAIT_L(0); PG8_BAR; PG8_MMA(1, 0, At, B0); PG8_MMA(1, 1, At, B1); PG8_BAR; PG8_SCHED;
            PG8_LDB(B0, 1, 0); PG8_LDB(B1, 1, 1); PG8_SCHED; PG8_LDA(At, 1, 0); PG8_STAGE(PG8_SA(0, 1), a2 + hstep, voffA);
            PG8_WAIT_V(8); PG8_WAIT_L(0); PG8_BAR; PG8_MMA(0, 0, At, B0); PG8_MMA(0, 1, At, B1); PG8_BAR; PG8_SCHED;
            PG8_LDA(At, 1, 1); PG8_STAGE(PG8_SB(1, 0), b3, voffB); PG8_STAGE(PG8_SB(1, 1), b3 + hstep, voffB); PG8_STAGE(PG8_SA(1, 0), a3, voffA);
            PG8_WAIT_V(8); PG8_WAIT_L(0); PG8_BAR; PG8_MMA(1, 0, At, B0); PG8_MMA(1, 1, At, B1); PG8_BAR; PG8_SCHED;
            } else {
            PG8_LDB(B0, 0, 0); PG8_SCHED; PG8_LDA(At, 0, 0); PG8_STAGE(PG8_SA(1, 1), a1 + hstep, voffA);
            PG8_WAIT_L(8); PG8_BAR; PG8_WAIT_L(0); PG8_MMA(0, 0, At, B0); PG8_BAR; PG8_SCHED;
            PG8_LDB(B1, 0, 1); PG8_STAGE(PG8_SB(0, 0), b2, voffB);
            PG8_BAR; PG8_WAIT_L(0); PG8_MMA(0, 1, At, B1); PG8_BAR;
            PG8_LDA(At, 0, 1); PG8_STAGE(PG8_SA(0, 0), a2, voffA);
            PG8_BAR; PG8_WAIT_L(0); PG8_MMA(1, 0, At, B0); PG8_BAR; PG8_SCHED;
            PG8_STAGE(PG8_SB(0, 1), b2 + hstep, voffB);
            PG8_WAIT_V(6); PG8_BAR; PG8_MMA(1, 1, At, B1); PG8_BAR;
            PG8_LDB(B0, 1, 0); PG8_SCHED; PG8_LDA(At, 1, 0); PG8_STAGE(PG8_SA(0, 1), a2 + hstep, voffA);
            PG8_WAIT_L(8); PG8_BAR; PG8_WAIT_L(0); PG8_MMA(0, 0, At, B0); PG8_BAR; PG8_SCHED;
            PG8_LDB(B1, 1, 1); PG8_STAGE(PG8_SB(1, 0), b3, voffB);
            PG8_BAR; PG8_WAIT_L(0); PG8_MMA(0, 1, At, B1); PG8_BAR;
            PG8_LDA(At, 1, 1); PG8_STAGE(PG8_SA(1, 0), a3, voffA);
            PG8_BAR; PG8_WAIT_L(0); PG8_MMA(1, 0, At, B0); PG8_BAR; PG8_SCHED;
            PG8_STAGE(PG8_SB(1, 1), b3 + hstep, voffB);
            PG8_WAIT_V(6); PG8_BAR; PG8_MMA(1, 1, At, B1); PG8_BAR;
            }
        }
        if constexpr (ALIGN_EPI) { if (wr == 0) PG8_BAR; }
        if constexpr (!Epi::AFTER_DRAIN) { E(acc, cur, wr, wc, fr, fq); S.done(cur); }
        if (!has_next) break;
#pragma unroll
        for (int a = 0; a < 2; ++a)
#pragma unroll
            for (int b = 0; b < 2; ++b)
#pragma unroll
                for (int m = 0; m < 4; ++m)
#pragma unroll
                    for (int n = 0; n < 2; ++n) acc[a][b][m][n] = (f32x4){0.f, 0.f, 0.f, 0.f};
        cur = nxt; cA = nA; cB = nB; ++ui;
        if constexpr (ALIGN_EPI) { if (wr == 1) PG8_BAR; }
    }
    PG8_WAIT_V(0);
    if constexpr (!ALIGN_EPI) { if (wr == 0) PG8_BAR; }
    PG8_BAR;
    if constexpr (Epi::AFTER_DRAIN) { E.fused(acc, cur, wr, wc, fr, fq, lds, wid, lane); S.done(cur); }
#undef PG8_SA
#undef PG8_SB
#undef PG8_STAGE
#undef PG8_LDA
#undef PG8_LDB
#undef PG8_MMA
#undef PG8_WAIT_V
#undef PG8_WAIT_L
#undef PG8_BAR
#undef PG8_SCHED
}
}
#include <hip/hip_bf16.h>
#include <cmath>
namespace attn_body {
using bf16=__hip_bfloat16;
using bf16x8=__attribute__((ext_vector_type(8)))short;
using s16x4=__attribute__((ext_vector_type(4)))short;
using f32x16=__attribute__((ext_vector_type(16)))float;
using u32x4=__attribute__((ext_vector_type(4)))unsigned;
constexpr int NHEAD=16,SEQ=4096,D=64,DM=NHEAD*D;
constexpr int NW=8,QBLK=32,QB=QBLK*NW,KVBLK=64,NQB=SEQ/QB;
constexpr int ATTN_PITCH=DM, ATTN_UNIT_ROWS=QB;
__device__ __forceinline__ int crow(int r,int hi){return (r&3)+8*(r>>2)+4*hi;}
#define SBAR() __builtin_amdgcn_sched_barrier(0)
__device__ __forceinline__ void cmask(f32x16&p0,f32x16&p1,int jb,int qrel,int hi){
  const float NEG=-INFINITY; int kb=64*jb+4*hi;
  #pragma unroll
  for(int r=0;r<16;++r){int kv=kb+(r&3)+8*(r>>2); if(kv>qrel)p0[r]=NEG; if(kv+32>qrel)p1[r]=NEG;}
}

constexpr int NSLOT=3, SLOTB=8192, VSLOTB=2*SLOTB;
constexpr int LDS_K=0, LDS_V=NSLOT*SLOTB, LDS_WS=LDS_V+NSLOT*VSLOTB, LDS_OST=LDS_WS+NW*64*4, LDS_BYTES=LDS_OST+NW*4096;
constexpr float C2=0.125f*1.4426950408889634f;
__device__ __forceinline__ void glds16(const void*gsrc,unsigned lds_dst){unsigned keep;
  asm volatile("s_mov_b32 %0, m0\n\ts_mov_b32 m0, %2\n\ts_nop 0\n\tglobal_load_lds_dwordx4 %1, off\n\ts_mov_b32 m0, %0":"=&s"(keep):"v"(gsrc),"s"(lds_dst):"memory");}
__device__ __forceinline__ float max3f(float a,float b,float c){float r;asm("v_max3_f32 %0, %1, %2, %3":"=v"(r):"v"(a),"v"(b),"v"(c));return r;}
__device__ __forceinline__ float max2f(float a,float b){float r;asm("v_max_f32_e32 %0, %1, %2":"=v"(r):"v"(a),"v"(b));return r;}
__device__ __forceinline__ float fadd_s(float a,float b){float r;asm("v_add_f32_e32 %0, %1, %2":"=v"(r):"v"(a),"v"(b));return r;}
__device__ __forceinline__ float fsub_s(float a,float b){float r;asm("v_sub_f32_e32 %0, %1, %2":"=v"(r):"v"(a),"v"(b));return r;}
typedef float f32x2_t __attribute__((ext_vector_type(2))); typedef __bf16 bf16x2_t __attribute__((ext_vector_type(2)));
__device__ __forceinline__ unsigned cvtpk_s(float lo,float hi){f32x2_t v={lo,hi};bf16x2_t b=__builtin_convertvector(v,bf16x2_t);return __builtin_bit_cast(unsigned,b);}
#define WAIT_BAR(N) asm volatile("s_waitcnt vmcnt(" #N ") lgkmcnt(0)\n\ts_barrier":::"memory")

__device__ __forceinline__ void qkt(f32x16&p0,f32x16&p1,const char*Kslot,const bf16x8*qr,const f32x16&negm,int r32,int hi){
  const char*kb=Kslot+hi*1024+r32*16;
  #pragma unroll
  for(int d0=0;d0<4;++d0){
    const bf16x8 b0=*reinterpret_cast<const bf16x8*>(kb+d0*2048);
    const bf16x8 b1=*reinterpret_cast<const bf16x8*>(kb+d0*2048+512);
    if(d0==0){p0=__builtin_amdgcn_mfma_f32_32x32x16_bf16(b0,qr[0],negm,0,0,0);p1=__builtin_amdgcn_mfma_f32_32x32x16_bf16(b1,qr[0],negm,0,0,0);}
    else{p0=__builtin_amdgcn_mfma_f32_32x32x16_bf16(b0,qr[d0],p0,0,0,0);p1=__builtin_amdgcn_mfma_f32_32x32x16_bf16(b1,qr[d0],p1,0,0,0);}}
}
typedef __attribute__((address_space(3))) const char* lds_cptr;
typedef short v4i16_t __attribute__((ext_vector_type(4)));
__device__ __forceinline__ void kload8(bf16x8*kf,lds_cptr kp){
  kf[0]=*(const __attribute__((address_space(3))) bf16x8*)(kp);      kf[1]=*(const __attribute__((address_space(3))) bf16x8*)(kp+512);
  kf[2]=*(const __attribute__((address_space(3))) bf16x8*)(kp+2048); kf[3]=*(const __attribute__((address_space(3))) bf16x8*)(kp+2560);
  kf[4]=*(const __attribute__((address_space(3))) bf16x8*)(kp+4096); kf[5]=*(const __attribute__((address_space(3))) bf16x8*)(kp+4608);
  kf[6]=*(const __attribute__((address_space(3))) bf16x8*)(kp+6144); kf[7]=*(const __attribute__((address_space(3))) bf16x8*)(kp+6656);
}
__device__ __forceinline__ void kload2(bf16x8*kf,lds_cptr kp,int j){ kf[2*j]=*(const __attribute__((address_space(3))) bf16x8*)(kp+j*2048); kf[2*j+1]=*(const __attribute__((address_space(3))) bf16x8*)(kp+j*2048+512); }
__device__ __forceinline__ s16x4 vtr(lds_cptr p){ return __builtin_bit_cast(s16x4,__builtin_amdgcn_ds_read_tr16_b64_v4i16((__attribute__((address_space(3))) v4i16_t*)p)); }
__device__ __forceinline__ float rowmax(const f32x16&p0,const f32x16&p1){
  float a=max3f(p0[0],p0[1],p1[0]),b=max3f(p0[2],p0[3],p1[1]);a=max3f(a,p1[2],p1[3]);
  #pragma unroll
  for(int r=4;r<16;r+=4){a=max3f(a,p0[r],p0[r+1]);b=max3f(b,p0[r+2],p0[r+3]);a=max3f(a,p1[r],p1[r+1]);b=max3f(b,p1[r+2],p1[r+3]);}
  const float m=max2f(a,b);
  auto rr=__builtin_amdgcn_permlane32_swap(__float_as_uint(m),__float_as_uint(m),false,false);
  return max2f(__uint_as_float(rr[0]),__uint_as_float(rr[1]));
}
__device__ __forceinline__ void pv(f32x16*o,int vb,bf16x8 pa0,bf16x8 pa1,bf16x8 pa2,bf16x8 pa3){
  #pragma unroll
  for(int d0=0;d0<4;++d0){s16x4 lo[4],hi[4];
    #pragma unroll
    for(int ks=0;ks<4;++ks){
      asm volatile("ds_read_b64_tr_b16 %0,%1 offset:%c2":"=&v"(lo[ks]):"v"(vb),"i"(d0*4096+ks*1024):"memory");
      asm volatile("ds_read_b64_tr_b16 %0,%1 offset:%c2":"=&v"(hi[ks]):"v"(vb),"i"(d0*4096+ks*1024+512):"memory");}
    asm volatile("s_waitcnt lgkmcnt(0)":::"memory");SBAR();
    #define PK(k) (bf16x8){lo[k][0],lo[k][1],lo[k][2],lo[k][3],hi[k][0],hi[k][1],hi[k][2],hi[k][3]}
    o[d0]=__builtin_amdgcn_mfma_f32_32x32x16_bf16(pa0,PK(0),o[d0],0,0,0);
    o[d0]=__builtin_amdgcn_mfma_f32_32x32x16_bf16(pa1,PK(1),o[d0],0,0,0);
    o[d0]=__builtin_amdgcn_mfma_f32_32x32x16_bf16(pa2,PK(2),o[d0],0,0,0);
    o[d0]=__builtin_amdgcn_mfma_f32_32x32x16_bf16(pa3,PK(3),o[d0],0,0,0);
    #undef PK
  }
}

#ifndef ATTN_STORE16
#define ATTN_STORE16(p,v) (*(u32x4*)(p)=(v))
#endif
template<int THRL,bool COMB> __device__ __forceinline__ void attn_unit(int b,int h,int hv,int qb,const bf16*Q,const bf16*__restrict__ K,const bf16*__restrict__ V,bf16*O,bf16*YB,float lam,float oscale,const float*gsub,char*shm){
  int tid_o=threadIdx.x; asm volatile("":"+v"(tid_o)); const int tid=tid_o,lane=tid&63,r32=lane&31,hi=lane>>5; const int wid=__builtin_amdgcn_readfirstlane(tid>>6);
  const long rowbase=(long)b*SEQ; const int q0=qb*QB;
  const bf16*Qw=Q+(rowbase+q0+wid*QBLK)*DM+h*D;
  const bf16*Kh=K+rowbase*DM+h*D,*Vh=V+rowbase*DM+hv*2*D;
  const unsigned lds0=(unsigned)(uintptr_t)shm;
  float*wsf=(float*)(shm+LDS_WS)+wid*64;
  const bf16*ksrc=Kh+(long)lane*DM+wid*8;
  const bf16*vsrc=Vh+(long)(16*(wid&3)+(lane>>2))*DM+(wid>>2)*32+(lane&3)*8;
  const unsigned kdst=lds0+LDS_K+wid*1024, vdst=lds0+LDS_V+wid*1024;
  #define DMA_K(t,slot) glds16(ksrc+(long)(t)*KVBLK*DM,(unsigned)__builtin_amdgcn_readfirstlane(kdst+(slot)))
  #define DMA_V(t,slot) do{ glds16(vsrc+(long)(t)*KVBLK*DM,(unsigned)__builtin_amdgcn_readfirstlane(vdst+2*(slot))); glds16(vsrc+64+(long)(t)*KVBLK*DM,(unsigned)__builtin_amdgcn_readfirstlane(vdst+2*(slot)+8192)); }while(0)
  const int vb0=(int)(lds0+LDS_V)+((lane>>4)&1)*32+(lane&3)*8+(4*hi+((lane&15)>>2))*64;
  const char*Kbase=shm+LDS_K; bf16x8 kf[8];
  const lds_cptr shm3=(lds_cptr)shm; const lds_cptr kp0=shm3+LDS_K+hi*1024+r32*16; const lds_cptr vp0=shm3+LDS_V+((lane>>4)&1)*32+(lane&3)*8+(4*hi+((lane&15)>>2))*64;
  const int NT=(q0+QB)/KVBLK;
  DMA_K(0,0);DMA_V(0,0);DMA_K(1,SLOTB);
  bf16x8 qr[4];
  #pragma unroll
  for(int d0=0;d0<4;++d0)qr[d0]=*reinterpret_cast<const bf16x8*>(&Qw[(long)r32*DM+d0*16+hi*8]);
  float mhat=0.f,l_reg=0.f;f32x16 o[4];o[0]=f32x16{};o[1]=f32x16{};o[2]=f32x16{};o[3]=f32x16{};f32x16 negm=f32x16{};asm volatile("":"+v"(negm));
  const int qrel=wid*QBLK+r32;
  #define CMASK(P0,P1,t) do{int jb_=(t)-(NT-4); if(jb_>=0)cmask(P0,P1,jb_,qrel,hi);}while(0)
  bool resc=false;
  #define START(P0,P1) do{ const float rm=rowmax(P0,P1); resc=false; \
    { const float dl=rm; mhat=fadd_s(mhat,dl); \
      _Pragma("unroll") for(int r=0;r<16;++r){P0[r]=fsub_s(P0[r],dl);P1[r]=fsub_s(P1[r],dl);} \
      _Pragma("unroll") for(int r=0;r<16;++r)negm[r]=-mhat; asm volatile("":"+v"(negm)); } \
    _Pragma("unroll") for(int r=0;r<16;++r)P0[r]=__builtin_amdgcn_exp2f(P0[r]); }while(0)
  #define RESC() do{ if(resc){ asm volatile("s_waitcnt lgkmcnt(0)":::"memory"); \
      _Pragma("unroll") for(int d_=0;d_<4;++d_) _Pragma("unroll") for(int r=0;r<16;++r)o[d_][r]*=wsf[crow(r,hi)]; } }while(0)
  f32x16 pA0,pA1,pB0,pB1;
  int sl_prev=0,sl_cur=0,sl_next=SLOTB;
  #define ROT() do{sl_prev=sl_cur;sl_cur=sl_next;sl_next=(sl_next==(NSLOT-1)*SLOTB)?0:sl_next+SLOTB;}while(0)
  DMA_K(2,2*SLOTB);
  WAIT_BAR(3);
  qkt(pA0,pA1,Kbase,qr,negm,r32,hi);asm volatile("s_nop 15\n\ts_nop 7":"+v"(pA0),"+v"(pA1));CMASK(pA0,pA1,0);
  START(pA0,pA1);
  _Pragma("unroll") for(int r=0;r<16;++r)pA1[r]=__builtin_amdgcn_exp2f(pA1[r]);
  WAIT_BAR(0);
  DMA_K(3,0);DMA_V(1,SLOTB);
  ROT();
  kload8(kf,kp0+sl_cur);
  WAIT_BAR(3);
  s16x4 vlo[8],vhi[8]; u32x4 pw0,pw1,pw2,pw3;
  #define PKW(P,B) cvtpk_s(P[B],P[B+1])
  #define PAF(k) __builtin_bit_cast(bf16x8,pw##k)
  #define VFR(i) (bf16x8){vlo[i][0],vlo[i][1],vlo[i][2],vlo[i][3],vhi[i][0],vhi[i][1],vhi[i][2],vhi[i][3]}
  #define PIN(x) asm volatile("":"+v"(x))
  #define MX3(a,b,c) __builtin_fmaxf(__builtin_fmaxf((a),(b)),(c))
  #define GAPA(MF,A0,A1,A2,A3,W0,W1,PW) do{ MF; sacc+=A0; sacc+=A1; sacc+=A2; sacc+=A3; PIN(sacc); W0; W1; PIN(PW); SBAR(); }while(0)
  #define EX(v) __builtin_amdgcn_exp2f(v)
  #define GAPB(MF,X,B) do{ MF; X[B]=EX(X[B]); X[B+1]=EX(X[B+1]); X[B+2]=EX(X[B+2]); X[B+3]=EX(X[B+3]); PIN(X); SBAR(); }while(0)
  #define GAPH(MF,X,B) do{ MF; X[B]=EX(X[B]); X[B+1]=EX(X[B+1]); PIN(X); SBAR(); }while(0)
  #define VRD(i) do{ vlo[i]=vtr(vp_+(((i)>>2)*4096+((i)&3)*1024)); vhi[i]=vtr(vp_+(((i)>>2)*4096+((i)&3)*1024+512)); }while(0)
  #define VRD2(i) do{ vlo[i]=vtr(vp_+(8192+((i)>>2)*4096+((i)&3)*1024)); vhi[i]=vtr(vp_+(8192+((i)>>2)*4096+((i)&3)*1024+512)); }while(0)
  #define KRD(G,j) do{ if(G){ kload2(kf,kp0+sl_next,j); SBAR(); } }while(0)
  #define STEP(C0,C1,P0,P1,t,GK,GV,GL) do{ SBAR(); \
    const lds_cptr vp_=vp0+2*sl_prev; \
    float sacc=(P0[0]+P0[1]); \
    GAPA(C0=__builtin_amdgcn_mfma_f32_32x32x16_bf16(kf[0],qr[0],negm,0,0,0), P0[2],P0[3],P0[4],P0[5],     pw0[0]=PKW(P0,0), pw0[1]=PKW(P0,2), pw0); \
    GAPA(C1=__builtin_amdgcn_mfma_f32_32x32x16_bf16(kf[1],qr[0],negm,0,0,0), P0[6],P0[7],P0[8],P0[9],     pw0[2]=PKW(P0,4), pw0[3]=PKW(P0,6), pw0); \
    GAPA(C0=__builtin_amdgcn_mfma_f32_32x32x16_bf16(kf[2],qr[1],C0,0,0,0),   P0[10],P0[11],P0[12],P0[13], pw1[0]=PKW(P0,8), pw1[1]=PKW(P0,10), pw1); \
    GAPA(C1=__builtin_amdgcn_mfma_f32_32x32x16_bf16(kf[3],qr[1],C1,0,0,0),   P0[14],P0[15],P1[0],P1[1],   pw1[2]=PKW(P0,12),pw1[3]=PKW(P0,14), pw1); \
    GAPA(C0=__builtin_amdgcn_mfma_f32_32x32x16_bf16(kf[4],qr[2],C0,0,0,0),   P1[2],P1[3],P1[4],P1[5],     pw2[0]=PKW(P1,0), pw2[1]=PKW(P1,2), pw2); \
    GAPA(C1=__builtin_amdgcn_mfma_f32_32x32x16_bf16(kf[5],qr[2],C1,0,0,0),   P1[6],P1[7],P1[8],P1[9],     pw2[2]=PKW(P1,4), pw2[3]=PKW(P1,6), pw2); \
    GAPA(C0=__builtin_amdgcn_mfma_f32_32x32x16_bf16(kf[6],qr[3],C0,0,0,0),   P1[10],P1[11],P1[12],P1[13], pw3[0]=PKW(P1,8), pw3[1]=PKW(P1,10), pw3); \
    GAPA(C1=__builtin_amdgcn_mfma_f32_32x32x16_bf16(kf[7],qr[3],C1,0,0,0),   P1[14],P1[15],0.f,0.f,       pw3[2]=PKW(P1,12),pw3[3]=PKW(P1,14), pw3); \
    l_reg+=sacc; \
    VRD(0);VRD(4);VRD(1);VRD(5);VRD(2);VRD(6);VRD(3);VRD(7); SBAR();   \
    if(GK){DMA_K((t)+3,sl_cur);} if(GV){DMA_V((t)+1,sl_next);} \
    CMASK(C0,C1,t); \
    { float a=MX3(C0[0],C0[1],C1[0]),b=MX3(C0[2],C0[3],C1[1]); a=MX3(a,C1[2],C1[3]); \
      _Pragma("unroll") for(int r=4;r<16;r+=4){a=MX3(a,C0[r],C0[r+1]);b=MX3(b,C0[r+2],C0[r+3]);a=MX3(a,C1[r],C1[r+1]);b=MX3(b,C1[r+2],C1[r+3]);} \
      float rm=__builtin_fmaxf(a,b); { auto rr=__builtin_amdgcn_permlane32_swap(__float_as_uint(rm),__float_as_uint(rm),false,false); rm=__builtin_fmaxf(__uint_as_float(rr[0]),__uint_as_float(rr[1])); } \
      resc=false; \
      if(__builtin_expect(__any(rm>(float)THRL),0)){ const float dl=__builtin_fmaxf(rm,0.f); mhat+=dl; \
        _Pragma("unroll") for(int r=0;r<16;++r){C0[r]-=dl;C1[r]-=dl;} \
        _Pragma("unroll") for(int r=0;r<16;++r)negm[r]=-mhat; asm volatile("":"+v"(negm)); \
        const float f=__builtin_amdgcn_exp2f(-dl); l_reg*=f; if(hi==0)wsf[r32]=f; resc=true; } } \
    SBAR(); \
    GAPH(o[0]=__builtin_amdgcn_mfma_f32_32x32x16_bf16(PAF(0),VFR(0),o[0],0,0,0), C0,0); VRD2(0); \
    GAPH(o[1]=__builtin_amdgcn_mfma_f32_32x32x16_bf16(PAF(0),VFR(4),o[1],0,0,0), C0,4); VRD2(4); \
    KRD(GL,0); GAPH(o[0]=__builtin_amdgcn_mfma_f32_32x32x16_bf16(PAF(1),VFR(1),o[0],0,0,0), C0,8); VRD2(1); \
    KRD(GL,1); GAPH(o[1]=__builtin_amdgcn_mfma_f32_32x32x16_bf16(PAF(1),VFR(5),o[1],0,0,0), C0,12); VRD2(5); \
    KRD(GL,2); GAPH(o[0]=__builtin_amdgcn_mfma_f32_32x32x16_bf16(PAF(2),VFR(2),o[0],0,0,0), C1,0); VRD2(2); \
    KRD(GL,3); GAPH(o[1]=__builtin_amdgcn_mfma_f32_32x32x16_bf16(PAF(2),VFR(6),o[1],0,0,0), C1,4); VRD2(6); \
    GAPH(o[0]=__builtin_amdgcn_mfma_f32_32x32x16_bf16(PAF(3),VFR(3),o[0],0,0,0), C1,8); VRD2(3); \
    GAPH(o[1]=__builtin_amdgcn_mfma_f32_32x32x16_bf16(PAF(3),VFR(7),o[1],0,0,0), C1,12); VRD2(7); SBAR(); \
      \
    GAPH(o[2]=__builtin_amdgcn_mfma_f32_32x32x16_bf16(PAF(0),VFR(0),o[2],0,0,0), C0,2); \
    GAPH(o[3]=__builtin_amdgcn_mfma_f32_32x32x16_bf16(PAF(0),VFR(4),o[3],0,0,0), C0,6); \
    GAPH(o[2]=__builtin_amdgcn_mfma_f32_32x32x16_bf16(PAF(1),VFR(1),o[2],0,0,0), C0,10); \
    GAPH(o[3]=__builtin_amdgcn_mfma_f32_32x32x16_bf16(PAF(1),VFR(5),o[3],0,0,0), C0,14); \
    GAPH(o[2]=__builtin_amdgcn_mfma_f32_32x32x16_bf16(PAF(2),VFR(2),o[2],0,0,0), C1,2); \
    GAPH(o[3]=__builtin_amdgcn_mfma_f32_32x32x16_bf16(PAF(2),VFR(6),o[3],0,0,0), C1,6); \
    GAPH(o[2]=__builtin_amdgcn_mfma_f32_32x32x16_bf16(PAF(3),VFR(3),o[2],0,0,0), C1,10); \
    GAPH(o[3]=__builtin_amdgcn_mfma_f32_32x32x16_bf16(PAF(3),VFR(7),o[3],0,0,0), C1,14); \
    }while(0)
  int t=1;
  #undef CMASK
  #define CMASK(P0,P1,t) do{}while(0)
  for(;t+5<NT;t+=2){
    STEP(pB0,pB1,pA0,pA1,t,true,true,true);     WAIT_BAR(3); RESC(); ROT();
    STEP(pA0,pA1,pB0,pB1,t+1,true,true,true);   WAIT_BAR(3); RESC(); ROT();
  }
  #undef CMASK
  #define CMASK(P0,P1,t) do{int jb_=(t)-(NT-4); if(jb_>=0)cmask(P0,P1,jb_,qrel,hi);}while(0)
  #define ENDW(tt) do{ if((tt)+3<NT){WAIT_BAR(3);} else if((tt)+2<NT){WAIT_BAR(2);} else {WAIT_BAR(0);} }while(0)
  for(;t+1<NT;t+=2){
    STEP(pB0,pB1,pA0,pA1,t,(t+3<NT),(t+1<NT),(t+1<NT));       ENDW(t);   RESC(); ROT();
    STEP(pA0,pA1,pB0,pB1,t+1,(t+4<NT),(t+2<NT),(t+2<NT));     ENDW(t+1); RESC(); ROT();
  }
  STEP(pB0,pB1,pA0,pA1,NT-1,false,false,false); RESC();
  { float sacc=pB0[0]+pB0[1]; _Pragma("unroll") for(int r=2;r<16;++r)sacc+=pB0[r]; _Pragma("unroll") for(int r=0;r<16;++r)sacc+=pB1[r]; l_reg+=sacc;
    pw0=(u32x4){PKW(pB0,0),PKW(pB0,2),PKW(pB0,4),PKW(pB0,6)};pw1=(u32x4){PKW(pB0,8),PKW(pB0,10),PKW(pB0,12),PKW(pB0,14)};pw2=(u32x4){PKW(pB1,0),PKW(pB1,2),PKW(pB1,4),PKW(pB1,6)};pw3=(u32x4){PKW(pB1,8),PKW(pB1,10),PKW(pB1,12),PKW(pB1,14)};
    SBAR(); pv(o,vb0+2*sl_cur,PAF(0),PAF(1),PAF(2),PAF(3)); }
  #undef PKW
  #undef PAF
  #undef VFR
  #undef PIN
  #undef MX3
  #undef GAPA
  #undef GAPB
  #undef GAPH
  #undef EX
  #undef VRD
  #undef VRD2
  #undef KRD
  #undef STEP
  #undef ENDW
  {auto rr=__builtin_amdgcn_permlane32_swap(__float_as_uint(l_reg),__float_as_uint(l_reg),false,false);l_reg=__uint_as_float(rr[0])+__uint_as_float(rr[1]);}
  if(hi==0)wsf[32+r32]=l_reg;asm volatile("s_waitcnt lgkmcnt(0)":::"memory");
  float rli[16];
  #pragma unroll
  for(int r=0;r<16;++r)rli[r]=__builtin_amdgcn_rcpf(wsf[32+crow(r,hi)]);
  bf16*Ow=O+(rowbase+q0+wid*QBLK)*DM+hv*2*D;
  { bf16*stg=(bf16*)(shm+LDS_OST)+wid*2048;
    if constexpr(!COMB){
    #pragma unroll
    for(int hh=0;hh<2;++hh){
      #pragma unroll
      for(int r=0;r<16;++r){const int orow=crow(r,hi);
        #pragma unroll
        for(int d0=0;d0<2;++d0)stg[orow*64+d0*32+r32]=__float2bfloat16(o[2*hh+d0][r]*rli[r]);}
      asm volatile("s_waitcnt lgkmcnt(0)":::"memory");
      #pragma unroll
      for(int i=0;i<4;++i){const int row=i*8+(lane>>3),ch=lane&7; const u32x4 v=*(const u32x4*)(stg+row*64+ch*8); ATTN_STORE16(Ow+(long)row*DM+hh*64+ch*8,v);}
      asm volatile("s_waitcnt lgkmcnt(0)":::"memory"); }
    } else {
    float dv[2][4][8];
    #pragma unroll
    for(int hh=0;hh<2;++hh){
      #pragma unroll
      for(int r=0;r<16;++r){const int orow=crow(r,hi);
        #pragma unroll
        for(int d0=0;d0<2;++d0)stg[orow*64+d0*32+r32]=__float2bfloat16(o[2*hh+d0][r]*rli[r]);}
      asm volatile("s_waitcnt lgkmcnt(0)":::"memory");
      #pragma unroll
      for(int i=0;i<4;++i){const int row=i*8+(lane>>3),ch=lane&7; const u32x4 v2=*(const u32x4*)(stg+row*64+ch*8); const u32x4 v1=*(const u32x4*)(Ow+(long)row*DM+hh*64+ch*8);
        #define BL(w) __builtin_bit_cast(float,(w)<<16)
        #define BH(w) __builtin_bit_cast(float,(w)&0xffff0000u)
        dv[hh][i][0]=BL(v1[0])-lam*BL(v2[0]); dv[hh][i][1]=BH(v1[0])-lam*BH(v2[0]); dv[hh][i][2]=BL(v1[1])-lam*BL(v2[1]); dv[hh][i][3]=BH(v1[1])-lam*BH(v2[1]);
        dv[hh][i][4]=BL(v1[2])-lam*BL(v2[2]); dv[hh][i][5]=BH(v1[2])-lam*BH(v2[2]); dv[hh][i][6]=BL(v1[3])-lam*BL(v2[3]); dv[hh][i][7]=BH(v1[3])-lam*BH(v2[3]);
        #undef BL
        #undef BH
      }
      asm volatile("s_waitcnt lgkmcnt(0)":::"memory"); }
    bf16*Yw=YB+(rowbase+q0+wid*QBLK)*DM+hv*2*D;
    #pragma unroll
    for(int i=0;i<4;++i){const int row=i*8+(lane>>3),ch=lane&7; float ss=0.f;
      #pragma unroll
      for(int hh=0;hh<2;++hh){
        #pragma unroll
        for(int j=0;j<8;++j)ss+=dv[hh][i][j]*dv[hh][i][j];}
      ss+=__builtin_bit_cast(float,__builtin_amdgcn_ds_bpermute((lane^1)<<2,__builtin_bit_cast(int,ss)));
      ss+=__builtin_bit_cast(float,__builtin_amdgcn_ds_bpermute((lane^2)<<2,__builtin_bit_cast(int,ss)));
      ss+=__builtin_bit_cast(float,__builtin_amdgcn_ds_bpermute((lane^4)<<2,__builtin_bit_cast(int,ss)));
      const float rs=oscale/sqrtf(ss*(1.f/128.f)+1e-6f);
      #pragma unroll
      for(int hh=0;hh<2;++hh){const float*gp=gsub+hh*64+ch*8; float y[8];
        #pragma unroll
        for(int j=0;j<8;++j)y[j]=dv[hh][i][j]*rs*gp[j];
        u32x4 w; w[0]=cvtpk_s(y[0],y[1]); w[1]=cvtpk_s(y[2],y[3]); w[2]=cvtpk_s(y[4],y[5]); w[3]=cvtpk_s(y[6],y[7]);
        ATTN_STORE16(Yw+(long)row*DM+hh*64+ch*8,w);} }
    }
  }
  asm volatile("s_waitcnt lgkmcnt(0)\n\ts_barrier":::"memory");
  #undef DMA_K
  #undef DMA_V
  #undef CMASK
  #undef START
  #undef RESC
  #undef ROT
}
constexpr int ATTN_LDS_BYTES=LDS_BYTES;
#undef SBAR
#undef WAIT_BAR
}
#define LAS __attribute__((address_space(3)))
typedef unsigned short bf16;
typedef unsigned v4u __attribute__((ext_vector_type(4)));
typedef unsigned v2u __attribute__((ext_vector_type(2)));
typedef float f32x4 __attribute__((ext_vector_type(4)));
typedef short bf16x8 __attribute__((ext_vector_type(8)));
#define LDS_WAIT() asm volatile("s_waitcnt lgkmcnt(0)" ::: "memory")

constexpr int NWAVES = 8, NTHREADS = 512;
constexpr int DM = 1024, BATCH = 16, SEQ = 4096, DEPTH = 4, M = BATCH * SEQ, MH = M / 2, NIN = 7168, DFF = 2816, NUP = 2 * DFF, PLE = 256;
constexpr float EPS = 1e-6f;
constexpr size_t MiB = 1u << 20;
constexpr size_t WS_W = 2 * MiB, W_LAYER = 40 * MiB;
constexpr size_t WO_IN = 0, WO_UP = 14 * MiB, WO_DOWN = 25 * MiB, WO_PA = 31 * MiB, WO_PB = 33 * MiB, WO_O = 35 * MiB, WO_PG = 37 * MiB, WO_PLE = 39 * MiB, WO_S = 39 * MiB + 512 * 1024;
constexpr size_t WS_H = 162 * MiB;
constexpr size_t WS_Z = 290 * MiB, ZS = (size_t)MH * DM;
constexpr size_t WS_O1 = 738 * MiB, WS_O2 = 802 * MiB;
constexpr size_t WS_ACT = 290 * MiB, WS_XBB = 642 * MiB, WS_EDGE = 802 * MiB, WS_E = 290 * MiB;
constexpr size_t WS_SS = 866 * MiB, SSS = (size_t)M * 16, WS_PBF = 920 * MiB;
constexpr size_t WS_VST = 952 * MiB;
constexpr size_t WS_END = 956 * MiB;
constexpr int LDS_BYTES = 147456, XB_OFF = 131072 + 1024;

__device__ __forceinline__ unsigned f2bf(float f) { unsigned u = __builtin_bit_cast(unsigned, f); return (u + 0x7fffu + ((u >> 16) & 1u)) >> 16; }
__device__ __forceinline__ unsigned pk2(float lo, float hi) { return f2bf(lo) | (f2bf(hi) << 16); }
__device__ __forceinline__ unsigned pkh2(float lo, float hi) { return pg8::cvt_pk_f16(lo, hi); }
__device__ __forceinline__ float blo(unsigned w) { return __builtin_bit_cast(float, w << 16); }
__device__ __forceinline__ float bhi(unsigned w) { return __builtin_bit_cast(float, w & 0xffff0000u); }
__device__ __forceinline__ float bperm(float v, int srclane) { return __builtin_bit_cast(float, __builtin_amdgcn_ds_bpermute(srclane << 2, __builtin_bit_cast(int, v))); }
__device__ __forceinline__ float wave_sum(float v, int lane) {
#pragma unroll
    for (int o = 1; o < 64; o <<= 1) v += bperm(v, lane ^ o);
    return v;
}
__device__ __forceinline__ int up_row_map(int n) { return n < DFF ? (n >> 7) * 256 + (n & 127) : ((n - DFF) >> 7) * 256 + 128 + ((n - DFF) & 127); }
template <bool UPMAP, bool F16OUT = false> __device__ __forceinline__ void transpose_item(const float* W, int K, int N, bf16* WT, LAS float* scr, int item, int lane, const float* gk = nullptr) {
    const int nblk = N / 32, kb = item / nblk, nb = item % nblk, k0 = 64 * kb, n0 = 32 * nb;
#pragma unroll 8
    for (int i = 0; i < 32; ++i) { const int kk = 2 * i + (lane >> 5); float w = W[(size_t)(k0 + kk) * N + n0 + (lane & 31)]; if (gk) w *= gk[k0 + kk]; scr[kk * 33 + (lane & 31)] = w; }
    LDS_WAIT(); asm volatile("" ::: "memory");
    const int c = lane & 7;
#pragma unroll
    for (int j = 0; j < 4; ++j) { const int n = (lane >> 3) + 8 * j; const LAS float* s = scr + (8 * c) * 33 + n;
        v4u o; if (F16OUT) {
#define W8(v) __builtin_bit_cast(float, f2bf(v) << 16)
            o.x = pkh2(W8(s[0 * 33]), W8(s[1 * 33])); o.y = pkh2(W8(s[2 * 33]), W8(s[3 * 33])); o.z = pkh2(W8(s[4 * 33]), W8(s[5 * 33])); o.w = pkh2(W8(s[6 * 33]), W8(s[7 * 33]));
#undef W8
        }
        else { o.x = pk2(s[0 * 33], s[1 * 33]); o.y = pk2(s[2 * 33], s[3 * 33]); o.z = pk2(s[4 * 33], s[5 * 33]); o.w = pk2(s[6 * 33], s[7 * 33]); }
        const int dr = UPMAP ? up_row_map(n0 + n) : (n0 + n);
        *(v4u*)(WT + (size_t)dr * K + k0 + 8 * c) = o; }
    LDS_WAIT(); asm volatile("" ::: "memory");
}
template <bool OUTF32> __device__ __forceinline__ void rms_row(const float* xrow, const float* g, void* orow, int lane) {
    const f32x4* xr = (const f32x4*)xrow + lane;
    f32x4 v[4]; float s = 0.f;
#pragma unroll
    for (int j = 0; j < 4; ++j) { v[j] = xr[64 * j]; s += (v[j].x * v[j].x + v[j].y * v[j].y) + (v[j].z * v[j].z + v[j].w * v[j].w); }
    const float rstd = 1.0f / sqrtf(wave_sum(s, lane) * (1.f / DM) + EPS);
#pragma unroll
    for (int j = 0; j < 4; ++j) { const f32x4 gg = ((const f32x4*)g)[lane + 64 * j]; const f32x4 o = v[j] * rstd * gg;
        if (OUTF32) ((f32x4*)orow)[lane + 64 * j] = o;
        else ((unsigned long long*)orow)[lane + 64 * j] = (unsigned long long)pk2(o.x, o.y) | ((unsigned long long)pk2(o.z, o.w) << 32); }
}
__device__ __forceinline__ void sgu_unit(LAS unsigned char* lds, bf16* U, bf16* UO, const bf16* V, const float* VST, const bf16* Wsb, const float* bs, const float* lng, const float* lnb, size_t row0, int tid, int lane, int wave) {
    LAS float* st = (LAS float*)lds;
    LAS unsigned char* vt0 = lds + 1024;
    constexpr int VTB = 128 * 272;
    { const int r = tid >> 2, q = tid & 3; const f32x4* vp = (const f32x4*)(VST + (row0 + r) * 32 + q * 8);
      const f32x4 a = vp[0], c = vp[1];
      float sm = (a[0] + a[2]) + (c[0] + c[2]), sq = (a[1] + a[3]) + (c[1] + c[3]);
      sm += bperm(sm, lane ^ 1); sq += bperm(sq, lane ^ 1); sm += bperm(sm, lane ^ 2); sq += bperm(sq, lane ^ 2);
      const float mean = sm * (1.f / DM); float var = sq * (1.f / DM) - mean * mean; var = var > 0.f ? var : 0.f;
      if (q == 0) { st[2 * r] = mean; st[2 * r + 1] = 1.0f / sqrtf(var + EPS); } }
    __syncthreads();
    const int cg8 = tid & 15, rp = tid >> 4, fr = lane & 15, fq = lane >> 4;
    const int ksmax = (wave * 16 + 15) >> 5;
    const int t = 16 * wave + fr;
    float mu[4], rsd[4];
#pragma unroll
    for (int rr = 0; rr < 4; ++rr) { mu[rr] = st[2 * (4 * rp + rr)]; rsd[rr] = st[2 * (4 * rp + rr) + 1]; }
    v4u vraw[4]; bf16x8 bw[4]; v2u uraw[8]; f32x4 gm[2], bt[2]; float bias;
#define SGU_LOAD(g) do { \
        _Pragma("unroll") for (int rr = 0; rr < 4; ++rr) vraw[rr] = *(const v4u*)(V + (row0 + 4 * rp + rr) * DM + (g) * 128 + 8 * cg8); \
        gm[0] = *(const f32x4*)(lng + (g) * 128 + 8 * cg8); gm[1] = *(const f32x4*)(lng + (g) * 128 + 8 * cg8 + 4); bt[0] = *(const f32x4*)(lnb + (g) * 128 + 8 * cg8); bt[1] = *(const f32x4*)(lnb + (g) * 128 + 8 * cg8 + 4); \
        _Pragma("unroll") for (int ks = 0; ks < 4; ++ks) bw[ks] = *(const bf16x8*)(Wsb + (size_t)(g) * 16384 + (16 * wave + fr) * 128 + fq * 8 + ks * 32); \
        _Pragma("unroll") for (int cb = 0; cb < 8; ++cb) uraw[cb] = *(const v2u*)(U + (row0 + t) * DM + (g) * 128 + 16 * cb + 4 * fq); \
        bias = bs[(g) * 128 + t]; } while (0)
    SGU_LOAD(0);
#pragma unroll 1
    for (int g = 0; g < 8; ++g) {
        LAS unsigned char* vt = vt0 + (g & 1) * VTB;
        { float nv[4][8];
#pragma unroll
          for (int rr = 0; rr < 4; ++rr) { const v4u raw = vraw[rr]; const float mean = mu[rr], rstd = rsd[rr];
              nv[rr][0] = (blo(raw.x) - mean) * rstd * gm[0][0] + bt[0][0]; nv[rr][1] = (bhi(raw.x) - mean) * rstd * gm[0][1] + bt[0][1];
              nv[rr][2] = (blo(raw.y) - mean) * rstd * gm[0][2] + bt[0][2]; nv[rr][3] = (bhi(raw.y) - mean) * rstd * gm[0][3] + bt[0][3];
              nv[rr][4] = (blo(raw.z) - mean) * rstd * gm[1][0] + bt[1][0]; nv[rr][5] = (bhi(raw.z) - mean) * rstd * gm[1][1] + bt[1][1];
              nv[rr][6] = (blo(raw.w) - mean) * rstd * gm[1][2] + bt[1][2]; nv[rr][7] = (bhi(raw.w) - mean) * rstd * gm[1][3] + bt[1][3]; }
#pragma unroll
          for (int j = 0; j < 8; ++j) { v2u w; w.x = pk2(nv[0][j], nv[1][j]); w.y = pk2(nv[2][j], nv[3][j]); *(LAS v2u*)(vt + (8 * cg8 + j) * 272 + rp * 8) = w; } }
        bf16x8 bwc[4]; v2u uc[8]; const float biasc = bias;
#pragma unroll
        for (int ks = 0; ks < 4; ++ks) bwc[ks] = bw[ks];
#pragma unroll
        for (int cb = 0; cb < 8; ++cb) uc[cb] = uraw[cb];
        __syncthreads();
        if (g < 7) SGU_LOAD(g + 1);
        f32x4 acc[8];
#pragma unroll
        for (int cb = 0; cb < 8; ++cb) acc[cb] = (f32x4){0.f, 0.f, 0.f, 0.f};
#pragma unroll
        for (int ks = 0; ks < 4; ++ks) if (ks <= ksmax) {
#pragma unroll
            for (int cb = 0; cb < 8; ++cb) { const bf16x8 av = *(const LAS bf16x8*)(vt + (16 * cb + fr) * 272 + (ks * 32 + fq * 8) * 2);
                acc[cb] = __builtin_amdgcn_mfma_f32_16x16x32_bf16(av, bwc[ks], acc[cb], 0, 0, 0); } }
#pragma unroll
        for (int cb = 0; cb < 8; ++cb) { bf16* up = UO + (row0 + t) * DM + g * 128 + 16 * cb + 4 * fq; const v2u uu = uc[cb];
            v2u w; w.x = pk2(blo(uu.x) * (acc[cb][0] + biasc), bhi(uu.x) * (acc[cb][1] + biasc)); w.y = pk2(blo(uu.y) * (acc[cb][2] + biasc), bhi(uu.y) * (acc[cb][3] + biasc));
            *(v2u*)up = w; }
    }
#undef SGU_LOAD
    __syncthreads();
}

struct Args { const float* in[27]; float* out; unsigned char* ws; };

#define PH() \
    const Args* ap; { auto kp_ = __builtin_amdgcn_kernarg_segment_ptr(); asm volatile("" : "+s"(kp_)); ap = (const Args*)kp_; } \
    int tid_o = threadIdx.x, bx_o = blockIdx.x, G_o = gridDim.x; asm volatile("" : "+v"(tid_o)); asm volatile("" : "+s"(bx_o), "+s"(G_o)); \
    const int tid = tid_o, bx = bx_o, G = G_o, lane = tid & 63, wave = __builtin_amdgcn_readfirstlane(tid >> 6); \
    const int gw = bx * NWAVES + wave, NGW = G * NWAVES; const size_t gt = (size_t)bx * NTHREADS + tid, NGT = (size_t)G * NTHREADS; \
    unsigned char* const ws = ap->ws; float* const X = ap->out; bf16* const H = (bf16*)(ws + WS_H); bf16* const Z = (bf16*)(ws + WS_Z); \
    bf16 *const ZU = Z, *const ZV = Z + ZS, *const ZQ = Z + 2 * ZS, *const ZK = Z + 3 * ZS, *const ZVA = Z + 4 * ZS, *const ZGA = Z + 5 * ZS, *const ZGB = Z + 6 * ZS; \
    bf16 *const O1 = (bf16*)(ws + WS_O1), *const O2 = (bf16*)(ws + WS_O2), *const ACT = (bf16*)(ws + WS_ACT), *const EB = (bf16*)(ws + WS_E), *const PBF = (bf16*)(ws + WS_PBF); \
    float* const EDGE = (float*)(ws + WS_EDGE); unsigned char* const wl = ws + WS_W + (size_t)l * W_LAYER; bf16* const XBB = (bf16*)(ws + WS_XBB); float* const SS = (float*)(ws + WS_SS); (void)XBB; (void)SS; \
    (void)lane; (void)gw; (void)NGW; (void)gt; (void)NGT; (void)X; (void)H; (void)ZU; (void)ZV; (void)ZQ; (void)ZK; (void)ZVA; (void)ZGA; (void)ZGB; (void)O1; (void)O2; (void)ACT; (void)EB; (void)PBF; (void)EDGE; (void)wl

#define RLX_AGENT __ATOMIC_RELAXED, __HIP_MEMORY_SCOPE_AGENT
#define XB_TMO      128
#define XB_XCNT(j)  (256  + 64 * (j))
#define XB_XSUB(j)  (1280 + 64 * (j))
#define XB_XGEN(j)  (2304 + 64 * (j))
#define XB_TOP      3328
#define XB_TOPGEN   3392
#define XCD_BAR_WORDS 3456
#define XB_SPIN_CAP (1u << 18)

__device__ __forceinline__ unsigned xb_ld(unsigned* p)              { return __hip_atomic_load(p, __ATOMIC_RELAXED, __HIP_MEMORY_SCOPE_AGENT); }
__device__ __forceinline__ unsigned xb_add(unsigned* p, unsigned v) { return __hip_atomic_fetch_add(p, v, __ATOMIC_RELAXED, __HIP_MEMORY_SCOPE_AGENT); }
__device__ __forceinline__ unsigned xb_xcc_id() { return (unsigned)__builtin_amdgcn_s_getreg((3 << 11) | 20) & 0xFu; }
#define XB_SPIN(cond, bar) do { unsigned _sp = 0; while (cond) { __builtin_amdgcn_s_sleep(1); \
    if ((++_sp & 255u) == 0u) { if (xb_ld(&(bar)[XB_TMO])) break; if (_sp > XB_SPIN_CAP) { atomicAdd(&(bar)[XB_TMO], 1u); break; } } } } while (0)

__device__ __forceinline__ void xcd_barrier_complete(unsigned* bar, unsigned x, unsigned& nloc, unsigned& nx) {
    const unsigned G = gridDim.x * gridDim.y * gridDim.z;
    unsigned sum, cnt, mine, sp = 0u;
    for (;;) {
        sum = 0u; cnt = 0u; mine = 0u;
#pragma unroll
        for (unsigned j = 0; j < 16; ++j) { const unsigned c = xb_ld(&bar[XB_XCNT(j)]); sum += c; cnt += (c > 0u) ? 1u : 0u; mine = (j == x) ? c : mine; }
        if (sum == G) break;
        __builtin_amdgcn_s_sleep(1);
        if ((++sp & 255u) == 0u) { if (xb_ld(&bar[XB_TMO])) break; if (sp > XB_SPIN_CAP) { atomicAdd(&bar[XB_TMO], 1u); break; } }
    }
    nloc = mine > 0u ? mine : 1u; nx = cnt > 0u ? cnt : 1u;
}

__device__ __forceinline__ void xcd_barrier(unsigned* const bar_, volatile LAS unsigned* const st_) {
    struct { unsigned* bar; unsigned x; volatile LAS unsigned* st; } b; b.bar = bar_; b.x = xb_xcc_id(); b.st = st_;
    asm volatile("s_waitcnt vmcnt(0)" ::: "memory");
    __syncthreads();
    if (threadIdx.x == 0) {
        unsigned* bar = b.bar;
        __builtin_amdgcn_s_waitcnt(0);
        unsigned nloc = b.st[0], nx = b.st[1];
        if (nloc == 0u) { xcd_barrier_complete(bar, b.x, nloc, nx); b.st[0] = nloc; b.st[1] = nx; }
        const unsigned old = xb_add(&bar[XB_XSUB(b.x)], 1u);
        const unsigned gen = old / nloc;
        if (old + 1u == (gen + 1u) * nloc) {
            __builtin_amdgcn_fence(__ATOMIC_RELEASE, "agent");
            asm volatile("s_waitcnt vmcnt(0)" ::: "memory");
            const unsigned og = xb_add(&bar[XB_TOP], 1u);
            const unsigned tg = og / nx;
            if (og + 1u == (tg + 1u) * nx) xb_add(&bar[XB_TOPGEN], 1u);
            else XB_SPIN(xb_ld(&bar[XB_TOPGEN]) == tg, bar);
            __builtin_amdgcn_fence(__ATOMIC_ACQUIRE, "agent");
            xb_add(&bar[XB_XGEN(b.x)], 1u);
            asm volatile("s_waitcnt vmcnt(0)" ::: "memory");
        } else {
            XB_SPIN(xb_ld(&bar[XB_XGEN(b.x)]) == gen, bar);
            __builtin_amdgcn_fence(__ATOMIC_ACQUIRE, "agent");
            asm volatile("s_waitcnt vmcnt(0)" ::: "memory");
        }
    }
    __syncthreads();
}

__device__ __forceinline__ void ctr_grid_sync(unsigned* ctr, unsigned target) {
    asm volatile("s_waitcnt vmcnt(0) lgkmcnt(0)" ::: "memory");
    __syncthreads();
    if (threadIdx.x == 0) {
        __builtin_amdgcn_fence(__ATOMIC_RELEASE, "agent");
        asm volatile("s_waitcnt vmcnt(0)" ::: "memory");
        __hip_atomic_fetch_add(ctr, 1u, __ATOMIC_RELAXED, __HIP_MEMORY_SCOPE_AGENT);
        while (__hip_atomic_load(ctr, __ATOMIC_RELAXED, __HIP_MEMORY_SCOPE_AGENT) < target) __builtin_amdgcn_s_sleep(2);
    }
    __syncthreads();
    __builtin_amdgcn_fence(__ATOMIC_ACQUIRE, "agent");
    asm volatile("s_waitcnt vmcnt(0)" ::: "memory");
}
#define GRID_SYNC1() do { const Args* ap_s; { auto kp_ = __builtin_amdgcn_kernarg_segment_ptr(); asm volatile("" : "+s"(kp_)); ap_s = (const Args*)kp_; } xcd_barrier((unsigned*)(ap_s->ws + 4096), (volatile LAS unsigned*)(ldsl + LDS_BYTES - 16)); } while (0)
#ifndef DBG_REP_SYNC
#define DBG_REP_SYNC 0
#endif
#define GRID_SYNC() do { GRID_SYNC1(); if (DBG_REP_SYNC) GRID_SYNC1(); } while (0)
#ifndef DBG_REP_ATTN
#define DBG_REP_ATTN 0
#endif
#ifndef DBG_REP_IN
#define DBG_REP_IN 0
#endif
#ifndef DBG_REP_UP
#define DBG_REP_UP 0
#endif
#ifndef DBG_REP_PRO
#define DBG_REP_PRO 0
#endif
#ifndef DBG_REP_COMB
#define DBG_REP_COMB 0
#endif
#ifndef DBG_REP_P4
#define DBG_REP_P4 0
#endif
#ifndef DBG_REP_RES
#define DBG_REP_RES 0
#endif
#ifndef DBG_REP_SGU
#define DBG_REP_SGU 0
#endif
#ifndef DBG_REP_INNULL
#define DBG_REP_INNULL 0
#endif
#ifndef DBG_TIME
#define DBG_TIME 0
#endif
#ifndef SELA
#define SELA 0x4
#endif
#ifndef SELB
#define SELB 0x2
#endif
#define TSTAMP(id) do { if (DBG_TIME && blockIdx.x == 0 && threadIdx.x == 0) { const Args* ap_t; { auto kp_ = __builtin_amdgcn_kernarg_segment_ptr(); asm volatile("" : "+s"(kp_)); ap_t = (const Args*)kp_; } \
    unsigned long long* tb = (unsigned long long*)(ap_t->ws + 64); const unsigned long long t_ = __builtin_amdgcn_s_memrealtime(); tb[1 + (id)] += t_ - tb[0]; tb[0] = t_; } } while (0)
__global__ void __launch_bounds__(NTHREADS, 2) fwd_kernel(Args a_unused) {
    extern __shared__ __attribute__((aligned(16))) unsigned char lds[];
    cg::grid_group grid = cg::this_grid();
    LAS unsigned char* ldsl = (LAS unsigned char*)lds;
    if (threadIdx.x == 0) { ((volatile LAS unsigned*)(ldsl + LDS_BYTES - 16))[0] = 0u; ((volatile LAS unsigned*)(ldsl + LDS_BYTES - 16))[1] = 0u;
        const Args* ap_s; { auto kp_ = __builtin_amdgcn_kernarg_segment_ptr(); asm volatile("" : "+s"(kp_)); ap_s = (const Args*)kp_; } (void)xb_add(&((unsigned*)(ap_s->ws + 4096))[XB_XCNT(xb_xcc_id())], 1u); }
    __syncthreads();
    if (DBG_TIME && blockIdx.x == 0 && threadIdx.x == 0) { const Args* ap_t; { auto kp_ = __builtin_amdgcn_kernarg_segment_ptr(); asm volatile("" : "+s"(kp_)); ap_t = (const Args*)kp_; } ((unsigned long long*)(ap_t->ws + 64))[0] = __builtin_amdgcn_s_memrealtime(); }
    grid.sync();

    for (int rep_ = 0; rep_ < (DBG_REP_PRO ? 2 : 1); ++rep_)
    {
        const int l = 0; PH();
        LAS float* scr = (LAS float*)(ldsl + wave * 16384);
        constexpr int I_IN = (DM / 64) * (NIN / 32), I_SQ = (DM / 64) * (DM / 32), I_UP = (DM / 64) * (NUP / 32), I_DN = (DFF / 64) * (DM / 32), I_PLE = (PLE / 64) * (DM / 32);
        constexpr int I_LAYER = I_IN + 4 * I_SQ + I_UP + I_DN + I_PLE;
        for (int it = gw; it < DEPTH * I_LAYER; it += NGW) {
            const int ll = it / I_LAYER; int r = it % I_LAYER; unsigned char* wll = ws + WS_W + (size_t)ll * W_LAYER;
            if (r < I_IN) { transpose_item<false, true>(ap->in[3] + (size_t)ll * DM * NIN, DM, NIN, (bf16*)(wll + WO_IN), scr, r, lane, ap->in[2] + (size_t)ll * DM); continue; } r -= I_IN;
            if (r < I_SQ) { transpose_item<false>(ap->in[14] + (size_t)ll * DM * DM, DM, DM, (bf16*)(wll + WO_PA), scr, r, lane); continue; } r -= I_SQ;
            if (r < I_SQ) { transpose_item<false>(ap->in[15] + (size_t)ll * DM * DM, DM, DM, (bf16*)(wll + WO_PB), scr, r, lane); continue; } r -= I_SQ;
            if (r < I_SQ) { transpose_item<false>(ap->in[16] + (size_t)ll * DM * DM, DM, DM, (bf16*)(wll + WO_O), scr, r, lane); continue; } r -= I_SQ;
            if (r < I_SQ) { transpose_item<false, true>(ap->in[23] + (size_t)ll * DM * DM, DM, DM, (bf16*)(wll + WO_PG), scr, r, lane, ap->in[22] + (size_t)ll * DM); continue; } r -= I_SQ;
            if (r < I_UP) { transpose_item<true, true>(ap->in[18] + (size_t)ll * DM * NUP, DM, NUP, (bf16*)(wll + WO_UP), scr, r, lane, ap->in[17] + (size_t)ll * DM); continue; } r -= I_UP;
            if (r < I_DN) { transpose_item<false>(ap->in[21] + (size_t)ll * DFF * DM, DFF, DM, (bf16*)(wll + WO_DOWN), scr, r, lane); continue; } r -= I_DN;
            transpose_item<false>(ap->in[25] + (size_t)ll * PLE * DM, PLE, DM, (bf16*)(wll + WO_PLE), scr, r, lane);
        }
        { const float* wsrc = ap->in[7];
          for (size_t i = gt; i < (size_t)DEPTH * 8 * 128 * 128; i += NGT) { const int ll = (int)(i >> 17), rem = (int)(i & 131071), t = (rem >> 7) & 127, sc = rem & 127;
              const float w = wsrc[i]; ((bf16*)(ws + WS_W + (size_t)ll * W_LAYER + WO_S))[rem] = (bf16)f2bf(sc <= t ? w : 0.f); } }
        { const float* xin = ap->in[0];
          for (int m = gw; m < M; m += NGW) { const f32x4* xr = (const f32x4*)(xin + (size_t)m * DM) + lane; float sq = 0.f;
#pragma unroll
              for (int j = 0; j < 4; ++j) { const f32x4 v = xr[64 * j]; sq += (v.x * v.x + v.y * v.y) + (v.z * v.z + v.w * v.w);
                  ((unsigned long long*)(H + (size_t)m * DM))[lane + 64 * j] = (unsigned long long)pkh2(v.x, v.y) | ((unsigned long long)pkh2(v.z, v.w) << 32); }
              sq = wave_sum(sq, lane); if (lane < 16) SS[(size_t)m * 16 + lane] = lane == 0 ? sq : 0.f; } }
    }
    GRID_SYNC(); TSTAMP(0);

#ifndef DBG_STOP
#define DBG_STOP 0
#endif
#define DBG_DUMP_BF16(buf) do { PH(); for (size_t i = gt; i < (size_t)M * DM; i += NGT) X[i] = blo((unsigned)(buf)[i % ((size_t)MH * DM)]); return; } while (0)
#define DBG_DUMP3(b0, b1, b2) do { PH(); for (size_t i = gt; i < (size_t)M * DM; i += NGT) { const size_t k = i % ((size_t)MH * DM); X[i] = blo((unsigned)(b0)[k]) + blo((unsigned)(b1)[k]) + blo((unsigned)(b2)[k]); } return; } while (0)
#define DBG_ZERO_UPPER() do { PH(); for (size_t i = gt; i < (size_t)MH * DM; i += NGT) X[(size_t)MH * DM + i] = 0.f; return; } while (0)
#pragma unroll 1
    for (int l = 0; l < DEPTH; ++l) {
#pragma unroll 1
        for (int hf = 0; hf < 2; ++hf) {
            if (DBG_REP_INNULL) { PH(); pg8::Gemm g{H + (size_t)hf * MH * DM, (const bf16*)(wl + WO_IN), MH, NIN, DM}; pg8::StaticOrder S; S.init(MH, NIN, G, bx); pg8::EpiNull E; pg8::gemm_phase<pg8::EpiNull, pg8::StaticOrder, true, true, true>(ldsl, g, S, E); }
            for (int rep_ = 0; rep_ < (DBG_REP_IN ? 2 : 1); ++rep_)
            { PH(); pg8::Gemm g{H + (size_t)hf * MH * DM, (const bf16*)(wl + WO_IN), MH, NIN, DM}; pg8::StaticOrder S; S.init(MH, NIN, G, bx);
              pg8::EpiIn E{Z, ZS, ap->in[4] + (size_t)l * 2 * DM, 0.125f * 1.4426950408889634f, SS + (size_t)(3 * l) * SSS + (size_t)hf * MH * 16, (float*)(ws + WS_VST)};
              pg8::gemm_phase<pg8::EpiIn, pg8::StaticOrder, true, true, true>(ldsl, g, S, E); }
            GRID_SYNC(); TSTAMP(1);
            if (DBG_STOP == 2) DBG_DUMP3(ZU, ZQ, ZGA);
            if (DBG_STOP == 12) DBG_DUMP3(ZV, ZK, ZGB);
            if (DBG_STOP == 22) DBG_DUMP3(ZVA, ZVA, ZVA);
            if (DBG_STOP == 1) DBG_DUMP3(H, H, H);
            if (DBG_STOP == 32) DBG_DUMP3(ZGA, ZGA, ZGA);
            if (DBG_STOP == 42) DBG_DUMP3(ZU, ZU, ZU);
            if (DBG_STOP == 52) DBG_DUMP3(ZQ, ZQ, ZQ);
            { PH();
              int l_o = l; asm volatile("" : "+s"(l_o));
              const float lam_init = 0.8f - 0.6f * expf(-0.3f * (float)l_o);
              const float s1 = wave_sum(ap->in[9][l * 64 + lane] * ap->in[10][l * 64 + lane], lane), s2 = wave_sum(ap->in[11][l * 64 + lane] * ap->in[12][l * 64 + lane], lane);
              const float lam = __builtin_bit_cast(float, __builtin_amdgcn_readfirstlane(__builtin_bit_cast(int, expf(s1) - expf(s2) + lam_init)));
              const float oscale = __builtin_bit_cast(float, __builtin_amdgcn_readfirstlane(__builtin_bit_cast(int, 1.0f - lam_init)));
              const float* gsub = ap->in[13] + l * 128;
              for (int p = bx; p < 1024; p += G) {
                  const int combo = p & 255, qi = p >> 8, b = combo & 7, r = combo >> 3, h = r >> 2, sq = r & 3;
                  const int qb = qi == 0 ? 15 - sq : qi == 1 ? 8 + sq : qi == 2 ? 7 - sq : sq;
#pragma unroll 1
                  for (int mp = 0; mp < 2; ++mp)
                  if (mp == 0) attn_body::attn_unit<8, false>(b, 2 * h, h, qb, (const attn_body::bf16*)ZQ, (const attn_body::bf16*)ZK, (const attn_body::bf16*)ZVA, (attn_body::bf16*)O1, nullptr, 0.f, 0.f, nullptr, (char*)lds);
                  else attn_body::attn_unit<8, true>(b, 2 * h + 1, h, qb, (const attn_body::bf16*)ZQ, (const attn_body::bf16*)ZK, (const attn_body::bf16*)ZVA, (attn_body::bf16*)O1, (attn_body::bf16*)ZQ, lam, oscale, gsub, (char*)lds); } }
            __syncthreads();
            { PH();
              const float* bs = ap->in[8] + (size_t)l * 1024; const float* lng = ap->in[5] + (size_t)l * DM; const float* lnb = ap->in[6] + (size_t)l * DM;
              for (int i = bx; i < MH / 128; i += G) sgu_unit(ldsl, ZU, ZU, ZV, (const float*)(ws + WS_VST), (const bf16*)(wl + WO_S), bs, lng, lnb, (size_t)i * 128, tid, lane, wave); }
            GRID_SYNC(); TSTAMP(2);
            if (DBG_STOP == 3) DBG_DUMP3(O1, O2, ZU);
            if (DBG_STOP == 13) DBG_DUMP3(O1, O2, O1);
            if (DBG_STOP == 23) DBG_DUMP3(ZU, ZU, ZU);
            for (int rep_ = 0; rep_ < (DBG_REP_P4 ? 2 : 1); ++rep_) {
            { PH(); pg8::StaticOrder S; S.init(MH, DM, G, bx);
              pg8::Gemm g{ZU, (const bf16*)(wl + WO_PA), MH, DM, DM}; pg8::EpiGate<false> E{ZGA, ZK}; pg8::gemm_phase<pg8::EpiGate<false>, pg8::StaticOrder, true, true>(ldsl, g, S, E); }
            { PH(); pg8::StaticOrder S; S.init(MH, DM, G, bx);
              pg8::Gemm g{ZQ, (const bf16*)(wl + WO_PB), MH, DM, DM}; pg8::EpiGate<true> E{ZGB, ZK}; pg8::gemm_phase<pg8::EpiGate<true>, pg8::StaticOrder, true, true>(ldsl, g, S, E); }
            }
            GRID_SYNC(); TSTAMP(4);
            if (DBG_STOP == 5) DBG_DUMP3(ZK, ZK, ZK);
            { PH(); pg8::Gemm g{ZK, (const bf16*)(wl + WO_O), MH, DM, DM}; pg8::StaticOrder S; S.init(MH, DM, G, bx);
              pg8::EpiResid<false> E{H + (size_t)hf * MH * DM, H + (size_t)hf * MH * DM, nullptr, nullptr, SS + (size_t)(3 * l + 1) * SSS + (size_t)hf * MH * 16, nullptr};
              if (DBG_REP_RES) { pg8::EpiResid<false> E0 = E; E0.ascale = 0.f; pg8::gemm_phase<pg8::EpiResid<false>, pg8::StaticOrder, true, true>(ldsl, g, S, E0); }
              pg8::gemm_phase<pg8::EpiResid<false>, pg8::StaticOrder, true, true>(ldsl, g, S, E); }
            GRID_SYNC(); TSTAMP(5);
            if (DBG_STOP == 6) DBG_ZERO_UPPER();
        }
        for (int rep_ = 0; rep_ < (DBG_REP_UP ? 2 : 1); ++rep_)
        { PH(); pg8::Gemm g{H, (const bf16*)(wl + WO_UP), M, NUP, DM}; pg8::StaticOrder S; S.init(M, NUP, G, bx);
          pg8::EpiConv E{ACT, EDGE, ap->in[19] + (size_t)l * 3 * NUP, ap->in[20] + (size_t)l * NUP, (LAS float*)(ldsl + XB_OFF), SS + (size_t)(3 * l + 1) * SSS};
          pg8::gemm_phase<pg8::EpiConv, pg8::StaticOrder, true, true, true>(ldsl, g, S, E); }
        GRID_SYNC(); TSTAMP(7);
        { PH(); const float* cw = ap->in[19] + (size_t)l * 3 * NUP; const float* cb = ap->in[20] + (size_t)l * NUP;
          for (size_t i = gt; i < (size_t)(M / 256) * pg8::NTC * 2 * 32; i += NGT) {
              const int c = (int)(i & 31) * 4, row = (int)((i >> 5) & 1), tile = (int)(i >> 6), pn = tile % pg8::NTC, pm = tile / pg8::NTC;
              const bool first = (pm % (SEQ / 256)) == 0; const int gcol = pn * 128 + c;
              const float* e1 = EDGE + (size_t)tile * 1024; const float* e0 = EDGE + (size_t)(first ? tile : tile - pg8::NTC) * 1024;
              f32x4 av[2];
#pragma unroll
              for (int q = 0; q < 2; ++q) { const int jc = q * 128 + c, col = q * DFF + gcol;
                  const f32x4 z4 = (f32x4){0.f, 0.f, 0.f, 0.f};
                  const f32x4 pm2 = first ? z4 : *(const f32x4*)(e0 + 2 * 256 + jc), pm1 = first ? z4 : *(const f32x4*)(e0 + 3 * 256 + jc), r0 = *(const f32x4*)(e1 + jc), r1 = *(const f32x4*)(e1 + 256 + jc);
                  const f32x4 w0 = *(const f32x4*)(cw + col), w1 = *(const f32x4*)(cw + NUP + col), w2 = *(const f32x4*)(cw + 2 * NUP + col), bb = *(const f32x4*)(cb + col);
                  av[q] = row == 0 ? (w0 * pm2 + w1 * pm1 + w2 * r0 + bb) : (w0 * pm1 + w1 * r0 + w2 * r1 + bb); }
              v2u w; w.x = pk2(pg8::gelu_tanh_f(av[0][0]) * av[1][0], pg8::gelu_tanh_f(av[0][1]) * av[1][1]); w.y = pk2(pg8::gelu_tanh_f(av[0][2]) * av[1][2], pg8::gelu_tanh_f(av[0][3]) * av[1][3]);
              *(v2u*)(ACT + (size_t)(pm * 256 + row) * DFF + gcol) = w; }
          const float* pl = ap->in[1] + (size_t)l * M * PLE;
          for (size_t i = gt; i < (size_t)M * PLE / 8; i += NGT) { const f32x4 v0 = ((const f32x4*)pl)[2 * i], v1 = ((const f32x4*)pl)[2 * i + 1];
              v4u w; w.x = pk2(v0.x, v0.y); w.y = pk2(v0.z, v0.w); w.z = pk2(v1.x, v1.y); w.w = pk2(v1.z, v1.w); ((v4u*)PBF)[i] = w; } }
        GRID_SYNC(); TSTAMP(8);
        { PH(); pg8::Gemm g{ACT, (const bf16*)(wl + WO_DOWN), M, DM, DFF}; pg8::StaticOrder S; S.init(M, DM, G, bx);
          pg8::EpiResid<false> E{H, XBB, nullptr, nullptr, SS + (size_t)(3 * l + 2) * SSS, nullptr};
          if (DBG_REP_RES) { pg8::EpiResid<false> E0 = E; E0.ascale = 0.f; pg8::gemm_phase<pg8::EpiResid<false>, pg8::StaticOrder, true, true>(ldsl, g, S, E0); }
          pg8::gemm_phase<pg8::EpiResid<false>, pg8::StaticOrder, true, true>(ldsl, g, S, E); }
        GRID_SYNC(); TSTAMP(9);
        { PH(); pg8::Gemm g{PBF, (const bf16*)(wl + WO_PLE), M, DM, PLE}; pg8::StaticOrder S; S.init(M, DM, G, bx);
          pg8::EpiStore E{EB, DM}; pg8::gemm_phase<pg8::EpiStore, pg8::StaticOrder, true, true>(ldsl, g, S, E); }
        { PH(); pg8::Gemm g{XBB, (const bf16*)(wl + WO_PG), M, DM, DM}; pg8::StaticOrder S; S.init(M, DM, G, bx);
          pg8::EpiResid<true> E{XBB, H, ap->in[24] + (size_t)l * DM, EB, SS + (size_t)(3 * l + 3) * SSS, SS + (size_t)(3 * l + 2) * SSS};
          if (DBG_REP_RES) { pg8::EpiResid<true> E0 = E; E0.ascale = 0.f; E0.XBO = XBB; pg8::gemm_phase<pg8::EpiResid<true>, pg8::StaticOrder, true, true, true>(ldsl, g, S, E0); }
          pg8::gemm_phase<pg8::EpiResid<true>, pg8::StaticOrder, true, true, true>(ldsl, g, S, E); }
        GRID_SYNC(); TSTAMP(11);
        if (l + 1 == DEPTH) { PH(); const float* gfin = ap->in[26];
            for (int m = gw; m < M; m += NGW) { const bf16* xr = H + (size_t)m * DM + 16 * lane; const v4u a0 = *(const v4u*)xr, a1 = *(const v4u*)(xr + 8);
                float f[16]; f[0] = pg8::h_lo(a0.x); f[1] = pg8::h_hi(a0.x); f[2] = pg8::h_lo(a0.y); f[3] = pg8::h_hi(a0.y); f[4] = pg8::h_lo(a0.z); f[5] = pg8::h_hi(a0.z); f[6] = pg8::h_lo(a0.w); f[7] = pg8::h_hi(a0.w);
                f[8] = pg8::h_lo(a1.x); f[9] = pg8::h_hi(a1.x); f[10] = pg8::h_lo(a1.y); f[11] = pg8::h_hi(a1.y); f[12] = pg8::h_lo(a1.z); f[13] = pg8::h_hi(a1.z); f[14] = pg8::h_lo(a1.w); f[15] = pg8::h_hi(a1.w);
                float sq = 0.f;
#pragma unroll
                for (int j = 0; j < 16; ++j) sq += f[j] * f[j];
                const float rstd = 1.0f / sqrtf(wave_sum(sq, lane) * (1.f / DM) + EPS);
                float* orow = X + (size_t)m * DM + 16 * lane;
#pragma unroll
                for (int j = 0; j < 4; ++j) { const f32x4 gg = *(const f32x4*)(gfin + 16 * lane + 4 * j); *(f32x4*)(orow + 4 * j) = (f32x4){f[4 * j] * rstd * gg[0], f[4 * j + 1] * rstd * gg[1], f[4 * j + 2] * rstd * gg[2], f[4 * j + 3] * rstd * gg[3]}; } } }
        if (DBG_TIME && l + 1 == DEPTH) { GRID_SYNC(); TSTAMP(12); GRID_SYNC();
            PH(); const unsigned long long* tb = (const unsigned long long*)(ws + 64); unsigned long long sa = 0, sb = 0;
            for (int k = 0; k < 13; ++k) { const unsigned long long v = __hip_atomic_load(tb + 1 + k, __ATOMIC_RELAXED, __HIP_MEMORY_SCOPE_AGENT); if ((SELA >> k) & 1) sa += v; if ((SELB >> k) & 1) sb += v; }
            const float fb = (float)(sa + sb) * 0.00001f;
            for (size_t i = gt; i < (size_t)16384 * DM; i += NGT) X[i] = fb; }
    }
}

extern "C" void kernel_launch(void* const* d_in, const int* in_sizes, int n_in, void* d_out, int out_size, void* d_ws, size_t ws_size, hipStream_t stream) {
    static int grid = 0;
    if (grid == 0) {
        if (n_in != 27 || out_size != M * DM || ws_size < WS_END) { fprintf(stderr, "kernel_launch: unexpected shapes (n_in %d out %d ws %zu)\n", n_in, out_size, ws_size); grid = -1; return; }
        int dev = 0, cus = 0, per_cu = 0;
        if (hipGetDevice(&dev) != hipSuccess || hipDeviceGetAttribute(&cus, hipDeviceAttributeMultiprocessorCount, dev) != hipSuccess) { grid = -1; return; }
        if (hipFuncSetAttribute((const void*)fwd_kernel, hipFuncAttributeMaxDynamicSharedMemorySize, LDS_BYTES) != hipSuccess) { fprintf(stderr, "kernel_launch: hipFuncSetAttribute failed\n"); grid = -1; return; }
        if (hipOccupancyMaxActiveBlocksPerMultiprocessor(&per_cu, (const void*)fwd_kernel, NTHREADS, LDS_BYTES) != hipSuccess || per_cu < 1) { fprintf(stderr, "kernel_launch: occupancy query gives %d\n", per_cu); per_cu = 1; }
        (void)hipGetLastError();
        grid = cus * per_cu;
    }
    if (grid < 0) return;
    if (hipMemsetAsync(d_ws, 0, 32768, stream) != hipSuccess) { fprintf(stderr, "kernel_launch: memset failed\n"); return; }
    Args a{};
    for (int i = 0; i < 27; ++i) a.in[i] = (const float*)d_in[i];
    a.out = (float*)d_out; a.ws = (unsigned char*)d_ws;
    void* args[] = {&a};
    hipError_t e = hipLaunchCooperativeKernel((const void*)fwd_kernel, dim3(grid), dim3(NTHREADS), args, LDS_BYTES, stream);
    if (e != hipSuccess) fprintf(stderr, "kernel_launch: cooperative launch failed: %s (grid %d)\n", hipGetErrorString(e), grid);
}
```

```cpp
#include <hip/hip_runtime.h>
#include <hip/hip_cooperative_groups.h>
#include <cstdio>
#include <cstdint>
namespace cg = cooperative_groups;
namespace pg8 {
#define PG8_LAS __attribute__((address_space(3)))
typedef unsigned short bf16_t;
typedef short bf16x8 __attribute__((ext_vector_type(8)));
typedef float f32x4 __attribute__((ext_vector_type(4)));
typedef unsigned u32x4 __attribute__((ext_vector_type(4)));
constexpr int BM = 256, BK = 64, HALF = 128, HTB = HALF * BK * 2  , STAGE_BYTES = 8 * HTB, NXCD = 8, WGM = 8;

__host__ __device__ __forceinline__ int lds_byte(int r, int c) { const int st = (r >> 4) * 2 + (c >> 5), rr = r & 15, cc = c & 31, ob = rr * 64 + cc * 2; return st * 1024 + (ob ^ (((ob >> 9) & 1) << 5)); }
__host__ __device__ __forceinline__ void stage_rc(int b, int& R, int& C) { const int st = b / 1024, sb = b % 1024, swz = sb ^ (((sb >> 9) & 1) << 5); R = (st >> 1) * 16 + swz / 64; C = (st & 1) * 32 + (swz % 64) / 2; }
__host__ __device__ __forceinline__ int perm32(int rho) { const int n = rho >> 4, i = rho & 15; return 8 * (i >> 2) + 4 * n + (i & 3); }

struct Unit { int pm, pn; };
struct Gemm { const bf16_t* A; const bf16_t* Bt; int M, N, K; };

struct StaticOrder {
    int nM, nN, nwg, G, c;
    __host__ __device__ void init(int M, int N, int G_, int c_) { nM = M / BM; nN = N / BM; nwg = nM * nN; G = G_; c = c_; }
    __host__ __device__ bool next(int i, Unit& u) const {
        const long L = (long)i * G + c; if (L >= nwg) return false;
        int wgid = (int)L; { const int q = nwg / NXCD, r = nwg % NXCD, xcd = wgid % NXCD, off = wgid / NXCD; wgid = (xcd < r ? xcd * (q + 1) : r * (q + 1) + (xcd - r) * q) + off; }
        const int nig = WGM * nN, gid = wgid / nig, fm = gid * WGM, gsz = (nM - fm) < WGM ? (nM - fm) : WGM;
        u.pm = fm + ((wgid % nig) % gsz); u.pn = (wgid % nig) / gsz; return true;
    }
    __device__ __forceinline__ void a_ready(const Unit&) const {}
    __device__ __forceinline__ void done(const Unit&) const {}
};

typedef float cv_f32x2 __attribute__((ext_vector_type(2))); typedef __bf16 cv_bf16x2 __attribute__((ext_vector_type(2)));
__device__ __forceinline__ unsigned cvt_pk_bf16(float lo, float hi) { const cv_f32x2 v = {lo, hi}; const cv_bf16x2 b = __builtin_convertvector(v, cv_bf16x2); return __builtin_bit_cast(unsigned, b); }
typedef float f32x2 __attribute__((ext_vector_type(2)));
__device__ __forceinline__ f32x2 gelu_pk(f32x2 v) {
    const f32x2 av = __builtin_elementwise_abs(v), d = av * 0.2316418882f + 1.0f;
    f32x2 t; t.x = __builtin_amdgcn_rcpf(d.x); t.y = __builtin_amdgcn_rcpf(d.y);
    f32x2 q = t * 0.5307027145f + (-0.7265760135f); q = q * t + 0.7107068705f; q = q * t + (-0.142248368f); q = q * t + 0.127414796f; q = q * t;
    const f32x2 s = (v * v) * (-0.72134752044f);
    f32x2 e; e.x = __builtin_amdgcn_exp2f(s.x); e.y = __builtin_amdgcn_exp2f(s.y);
    const f32x2 m = v * (q * e), r = v - m;
    f32x2 o; o.x = v.x < 0.f ? m.x : r.x; o.y = v.y < 0.f ? m.y : r.y; return o;
}

template <int ACT  > struct EpiBf16 {
    static constexpr bool PERM = true, AFTER_DRAIN = false; static_assert(ACT == 0 || ACT == 1, "EpiBf16: ACT is 0 (none) or 1 (gelu_pk)");
    bf16_t* O; int ldc; const float* bias; int split_cols; size_t split_stride; float scale0;
    __device__ __forceinline__ void operator()(const f32x4 (&acc)[2][2][4][2], const Unit& u, int wr, int wc, int fr_, int fq_) const {
        int t_o = threadIdx.x; asm volatile("" : "+v"(t_o)); int fr = t_o & 15, fq = (t_o >> 4) & 3; (void)fr_; (void)fq_;

        const int row0 = u.pm * BM + wr * 64 + fr; int colt = u.pn * BM; bf16_t* base = O;
        float sc = 1.f; if (split_cols) { const int t = colt / split_cols; base += (size_t)t * split_stride; colt -= t * split_cols; if (t == 0) sc = scale0; }
        const int col0 = colt + wc * 32 + 8 * fq, bcol0 = u.pn * BM + wc * 32 + 8 * fq;
        f32x4 bv[2][2];
#pragma unroll
        for (int bj = 0; bj < 2; ++bj)
#pragma unroll
            for (int n = 0; n < 2; ++n) bv[bj][n] = bias ? *(const f32x4*)(bias + bcol0 + bj * HALF + 4 * n) : (f32x4){0.f, 0.f, 0.f, 0.f};
#pragma unroll
        for (int ai = 0; ai < 2; ++ai)
#pragma unroll
            for (int m = 0; m < 4; ++m) { bf16_t* rowp = base + (size_t)(row0 + ai * HALF + m * 16) * ldc + col0;
#pragma unroll
                for (int bj = 0; bj < 2; ++bj) { f32x4 v0 = acc[ai][bj][m][0] + bv[bj][0], v1 = acc[ai][bj][m][1] + bv[bj][1];
                    if (ACT == 1) { f32x2 a = gelu_pk((f32x2){v0[0], v0[1]}), b = gelu_pk((f32x2){v0[2], v0[3]}), c = gelu_pk((f32x2){v1[0], v1[1]}), d = gelu_pk((f32x2){v1[2], v1[3]});
                        v0 = (f32x4){a.x, a.y, b.x, b.y}; v1 = (f32x4){c.x, c.y, d.x, d.y}; }
                    v0 = v0 * sc; v1 = v1 * sc; u32x4 w; w.x = cvt_pk_bf16(v0[0], v0[1]); w.y = cvt_pk_bf16(v0[2], v0[3]); w.z = cvt_pk_bf16(v1[0], v1[1]); w.w = cvt_pk_bf16(v1[2], v1[3]);
                    *(u32x4*)(rowp + bj * HALF) = w; } }
    }
};
__device__ __forceinline__ float sigmoid_f(float x) { return __builtin_amdgcn_rcpf(1.0f + __builtin_amdgcn_exp2f(-1.4426950408889634f * x)); }
__device__ __forceinline__ float gelu_tanh_f(float x) { const float p = __builtin_fmaf(x * x, -0.10294324f, -2.3022082f); return x * __builtin_amdgcn_rcpf(1.0f + __builtin_amdgcn_exp2f(x * p)); }
__device__ __forceinline__ float bf_lo(unsigned w) { return __builtin_bit_cast(float, w << 16); }
__device__ __forceinline__ float bf_hi(unsigned w) { return __builtin_bit_cast(float, w & 0xffff0000u); }
typedef unsigned u32x2 __attribute__((ext_vector_type(2)));
typedef _Float16 h16x2 __attribute__((ext_vector_type(2)));
__device__ __forceinline__ float h_lo(unsigned w) { return (float)__builtin_bit_cast(h16x2, w)[0]; }
__device__ __forceinline__ float h_hi(unsigned w) { return (float)__builtin_bit_cast(h16x2, w)[1]; }
__device__ __forceinline__ unsigned cvt_pk_f16(float lo, float hi) { const h16x2 v = {(_Float16)lo, (_Float16)hi}; return __builtin_bit_cast(unsigned, v); }

__device__ __forceinline__ float rstd_row(const float* SSI, int row) { const f32x4* p = (const f32x4*)(SSI + (size_t)row * 16); const f32x4 a = p[0], b = p[1], c = p[2], d = p[3];
    const float s = ((a[0] + a[1]) + (a[2] + a[3])) + ((b[0] + b[1]) + (b[2] + b[3])) + ((c[0] + c[1]) + (c[2] + c[3])) + ((d[0] + d[1]) + (d[2] + d[3])); return __builtin_amdgcn_rsqf(s * (1.f / 1024.f) + 1e-6f); }
struct EpiIn {
    static constexpr bool PERM = true, AFTER_DRAIN = false;
    bf16_t* Z; size_t bufstride; const float* bgate; float qscale; const float* SSI; float* VST = nullptr;
    template <int MODE> __device__ __forceinline__ void body(const f32x4 (&acc)[2][2][4][2], bf16_t* base, const float* bias, int row0, int col0, int lane = 0, int slot = 0) const {
        f32x4 bv[2][2];
#pragma unroll
        for (int bj = 0; bj < 2; ++bj)
#pragma unroll
            for (int n = 0; n < 2; ++n) bv[bj][n] = (MODE == 3) ? *(const f32x4*)(bias + col0 + bj * HALF + 4 * n) : (f32x4){0.f, 0.f, 0.f, 0.f};
#pragma unroll
        for (int ai = 0; ai < 2; ++ai)
#pragma unroll
            for (int m = 0; m < 4; ++m) { bf16_t* rowp = base + (size_t)(row0 + ai * HALF + m * 16) * 1024 + col0;
                const float rs = rstd_row(SSI, row0 + ai * HALF + m * 16); float ps = 0.f, pq = 0.f;
#pragma unroll
                for (int bj = 0; bj < 2; ++bj) { f32x4 v0 = acc[ai][bj][m][0] * rs, v1 = acc[ai][bj][m][1] * rs;
                    if (MODE == 1 || MODE == 4) {
#pragma unroll
                        for (int x = 0; x < 4; ++x) { v0[x] = gelu_tanh_f(v0[x]); v1[x] = gelu_tanh_f(v1[x]); } }
                    if (MODE == 4) { ps += ((v0[0] + v0[1]) + (v0[2] + v0[3])) + ((v1[0] + v1[1]) + (v1[2] + v1[3]));
                        pq += ((v0[0] * v0[0] + v0[1] * v0[1]) + (v0[2] * v0[2] + v0[3] * v0[3])) + ((v1[0] * v1[0] + v1[1] * v1[1]) + (v1[2] * v1[2] + v1[3] * v1[3])); }
                    if (MODE == 2) { v0 = v0 * qscale; v1 = v1 * qscale; }
                    if (MODE == 3) { v0 = v0 + bv[bj][0]; v1 = v1 + bv[bj][1];
#pragma unroll
                        for (int x = 0; x < 4; ++x) { v0[x] = sigmoid_f(v0[x]); v1[x] = sigmoid_f(v1[x]); } }
                    u32x4 w; w.x = cvt_pk_bf16(v0[0], v0[1]); w.y = cvt_pk_bf16(v0[2], v0[3]); w.z = cvt_pk_bf16(v1[0], v1[1]); w.w = cvt_pk_bf16(v1[2], v1[3]);
                    *(u32x4*)(rowp + bj * HALF) = w; }
                if (MODE == 4) {
                    ps += __builtin_bit_cast(float, __builtin_amdgcn_ds_bpermute((lane ^ 16) << 2, __builtin_bit_cast(int, ps))); pq += __builtin_bit_cast(float, __builtin_amdgcn_ds_bpermute((lane ^ 16) << 2, __builtin_bit_cast(int, pq)));
                    ps += __builtin_bit_cast(float, __builtin_amdgcn_ds_bpermute((lane ^ 32) << 2, __builtin_bit_cast(int, ps))); pq += __builtin_bit_cast(float, __builtin_amdgcn_ds_bpermute((lane ^ 32) << 2, __builtin_bit_cast(int, pq)));
                    if ((lane >> 4) == 0) { float* vp = VST + (size_t)(row0 + ai * HALF + m * 16) * 32 + slot * 2; vp[0] = ps; vp[1] = pq; } }
                asm volatile("" ::: "memory"); }
    }
    __device__ __forceinline__ void operator()(const f32x4 (&acc)[2][2][4][2], const Unit& u, int wr, int wc, int fr_, int fq_) const {
        int t_o = threadIdx.x; asm volatile("" : "+v"(t_o)); int fr = t_o & 15, fq = (t_o >> 4) & 3; (void)fr_; (void)fq_;

        const int t = u.pn >> 2, colt = (u.pn & 3) * BM;
        bf16_t* base = Z + (size_t)t * bufstride;
        const int row0 = u.pm * BM + wr * 64 + fr, col0 = colt + wc * 32 + 8 * fq;
        if (t == 0) body<1>(acc, base, nullptr, row0, col0);
        else if (t == 1) body<4>(acc, base, nullptr, row0, col0, t_o & 63, (u.pn & 3) * 4 + wc);
        else if (t == 2) body<2>(acc, base, nullptr, row0, col0);
        else if (t < 5) body<0>(acc, base, nullptr, row0, col0);
        else body<3>(acc, base, bgate + (t - 5) * 1024, row0, col0);
    }
};
struct EpiNull {
    static constexpr bool PERM = true, AFTER_DRAIN = false;
    __device__ __forceinline__ void operator()(const f32x4 (&acc)[2][2][4][2], const Unit& u, int wr, int wc, int fr_, int fq_) const {
#pragma unroll
        for (int ai = 0; ai < 2; ++ai)
#pragma unroll
            for (int bj = 0; bj < 2; ++bj)
#pragma unroll
                for (int m = 0; m < 4; ++m)
#pragma unroll
                    for (int n = 0; n < 2; ++n) asm volatile("" :: "v"(acc[ai][bj][m][n]));
    }
};
struct EpiStore {
    static constexpr bool PERM = true, AFTER_DRAIN = false;
    bf16_t* O; int ldc;
    __device__ __forceinline__ void operator()(const f32x4 (&acc)[2][2][4][2], const Unit& u, int wr, int wc, int fr_, int fq_) const {
        int t_o = threadIdx.x; asm volatile("" : "+v"(t_o)); int fr = t_o & 15, fq = (t_o >> 4) & 3; (void)fr_; (void)fq_;

        const int row0 = u.pm * BM + wr * 64 + fr, col0 = u.pn * BM + wc * 32 + 8 * fq;
#pragma unroll
        for (int ai = 0; ai < 2; ++ai)
#pragma unroll
            for (int m = 0; m < 4; ++m) { bf16_t* rowp = O + (size_t)(row0 + ai * HALF + m * 16) * ldc + col0;
#pragma unroll
                for (int bj = 0; bj < 2; ++bj) { const f32x4 v0 = acc[ai][bj][m][0], v1 = acc[ai][bj][m][1];
                    u32x4 w; w.x = cvt_pk_bf16(v0[0], v0[1]); w.y = cvt_pk_bf16(v0[2], v0[3]); w.z = cvt_pk_bf16(v1[0], v1[1]); w.w = cvt_pk_bf16(v1[2], v1[3]);
                    *(u32x4*)(rowp + bj * HALF) = w; } }
    }
};
template <bool ADD> struct EpiGate {
    static constexpr bool PERM = true, AFTER_DRAIN = false;
    const bf16_t* G; bf16_t* MG;
    __device__ __forceinline__ void operator()(const f32x4 (&acc)[2][2][4][2], const Unit& u, int wr, int wc, int fr_, int fq_) const {
        int t_o = threadIdx.x; asm volatile("" : "+v"(t_o)); int fr = t_o & 15, fq = (t_o >> 4) & 3; (void)fr_; (void)fq_;

        const int row0 = u.pm * BM + wr * 64 + fr, col0 = u.pn * BM + wc * 32 + 8 * fq;
#pragma unroll
        for (int ai = 0; ai < 2; ++ai)
#pragma unroll
            for (int m = 0; m < 4; ++m) { const size_t off = (size_t)(row0 + ai * HALF + m * 16) * 1024 + col0;
#pragma unroll
                for (int bj = 0; bj < 2; ++bj) { const f32x4 v0 = acc[ai][bj][m][0], v1 = acc[ai][bj][m][1];
                    const u32x4 g = *(const u32x4*)(G + off + bj * HALF);
                    float r[8];
                    r[0] = bf_lo(g.x) * v0[0]; r[1] = bf_hi(g.x) * v0[1]; r[2] = bf_lo(g.y) * v0[2]; r[3] = bf_hi(g.y) * v0[3];
                    r[4] = bf_lo(g.z) * v1[0]; r[5] = bf_hi(g.z) * v1[1]; r[6] = bf_lo(g.w) * v1[2]; r[7] = bf_hi(g.w) * v1[3];
                    if (ADD) { const u32x4 o = *(const u32x4*)(MG + off + bj * HALF);
                        r[0] += bf_lo(o.x); r[1] += bf_hi(o.x); r[2] += bf_lo(o.y); r[3] += bf_hi(o.y); r[4] += bf_lo(o.z); r[5] += bf_hi(o.z); r[6] += bf_lo(o.w); r[7] += bf_hi(o.w); }
                    u32x4 w; w.x = cvt_pk_bf16(r[0], r[1]); w.y = cvt_pk_bf16(r[2], r[3]); w.z = cvt_pk_bf16(r[4], r[5]); w.w = cvt_pk_bf16(r[6], r[7]);
                    *(u32x4*)(MG + off + bj * HALF) = w; }
                asm volatile("" ::: "memory"); }
    }
};
template <bool PLE> struct EpiResid {
    static constexpr bool PERM = false, AFTER_DRAIN = false;
    const bf16_t* XIB; bf16_t* XBO; const float* bias; const bf16_t* E;
    float* SSO; const float* SSI;
    float ascale = 1.f;
    __device__ __forceinline__ void operator()(const f32x4 (&acc)[2][2][4][2], const Unit& u, int wr, int wc, int fr_, int fq_) const {
        int t_o = threadIdx.x; asm volatile("" : "+v"(t_o)); int fr = t_o & 15, fq = (t_o >> 4) & 3; (void)fr_; (void)fq_;
        const int lane = t_o & 63;
        const int col0 = u.pn * BM + wc * 32 + 4 * fq;
        constexpr int MG = PLE ? 2 : 4;
#pragma unroll
        for (int ai = 0; ai < 2; ++ai)
#pragma unroll
        for (int m0 = 0; m0 < 4; m0 += MG) {
            u32x2 xi[4][2][2]; u32x2 ev[4][2][2]; float rs[4];
#pragma unroll
            for (int m = m0; m < m0 + MG; ++m) { const int row = u.pm * BM + ai * HALF + wr * 64 + m * 16 + fr; const size_t off = (size_t)row * 1024 + col0;
                rs[m] = 1.f; if (PLE) rs[m] = rstd_row(SSI, row);
#pragma unroll
                for (int bj = 0; bj < 2; ++bj)
#pragma unroll
                    for (int n = 0; n < 2; ++n) { const size_t o2 = off + bj * HALF + n * 16; xi[m][bj][n] = *(const u32x2*)(XIB + o2); if (PLE) ev[m][bj][n] = *(const u32x2*)(E + o2); } }
#pragma unroll
            for (int m = m0; m < m0 + MG; ++m) { const int row = u.pm * BM + ai * HALF + wr * 64 + m * 16 + fr; const size_t off = (size_t)row * 1024 + col0;
                float q = 0.f;
#pragma unroll
                for (int bj = 0; bj < 2; ++bj)
#pragma unroll
                    for (int n = 0; n < 2; ++n) { const size_t o2 = off + bj * HALF + n * 16; f32x4 a = acc[ai][bj][m][n];
                        if (PLE) { const f32x4 bv = *(const f32x4*)(bias + col0 + bj * HALF + n * 16); const u32x2 e = ev[m][bj][n]; a = a * rs[m] + bv;
                            a[0] = sigmoid_f(a[0]) * bf_lo(e.x); a[1] = sigmoid_f(a[1]) * bf_hi(e.x); a[2] = sigmoid_f(a[2]) * bf_lo(e.y); a[3] = sigmoid_f(a[3]) * bf_hi(e.y); }
                        const u32x2 xo = xi[m][bj][n];
                        const f32x4 xn = (f32x4){h_lo(xo.x), h_hi(xo.x), h_lo(xo.y), h_hi(xo.y)} + a * ascale;
                        u32x2 w; w.x = cvt_pk_f16(xn[0], xn[1]); w.y = cvt_pk_f16(xn[2], xn[3]); *(u32x2*)(XBO + o2) = w;
                        q += (xn[0] * xn[0] + xn[1] * xn[1]) + (xn[2] * xn[2] + xn[3] * xn[3]); }
                q += __builtin_bit_cast(float, __builtin_amdgcn_ds_bpermute((lane ^ 16) << 2, __builtin_bit_cast(int, q)));
                q += __builtin_bit_cast(float, __builtin_amdgcn_ds_bpermute((lane ^ 32) << 2, __builtin_bit_cast(int, q)));
                if (fq == 0) SSO[(size_t)row * 16 + u.pn * 4 + wc] = q; }
            asm volatile("" ::: "memory"); }
    }
};
constexpr int FFC = 2816, NTC = FFC / 128;
struct EpiConv {
    static constexpr bool PERM = true, AFTER_DRAIN = false;
    bf16_t* ACT; float* EDGE; const float* cw; const float* cb; PG8_LAS float* xb; const float* SSI;
    __device__ __forceinline__ void operator()(f32x4 (&acc)[2][2][4][2], const Unit& u, int wr, int wc, int fr_, int fq_) const {
        int t_o = threadIdx.x; asm volatile("" : "+v"(t_o)); int fr = t_o & 15, fq = (t_o >> 4) & 3; (void)fr_; (void)fq_;

        const int lane = t_o & 63;
        const int jc0 = wc * 32 + 8 * fq;
        { PG8_LAS float* rtab = xb + 2048; const int tt = t_o & 511;
          if (tt < 256) rtab[tt] = rstd_row(SSI, u.pm * BM + tt);
          asm volatile("s_waitcnt lgkmcnt(0)" ::: "memory"); __builtin_amdgcn_s_barrier(); asm volatile("" ::: "memory");
#pragma unroll
          for (int ai = 0; ai < 2; ++ai)
#pragma unroll
            for (int m = 0; m < 4; ++m) { const float rs = rtab[ai * HALF + wr * 64 + m * 16 + fr];
#pragma unroll
                for (int bj = 0; bj < 2; ++bj)
#pragma unroll
                    for (int n = 0; n < 2; ++n) acc[ai][bj][m][n] = acc[ai][bj][m][n] * rs; } }
        if (fr >= 14) {
#pragma unroll
            for (int ai = 0; ai < 2; ++ai)
#pragma unroll
                for (int bj = 0; bj < 2; ++bj)
#pragma unroll
                    for (int n = 0; n < 2; ++n) *(PG8_LAS f32x4*)(xb + (((ai * 2 + wr) * 2 + (fr - 14)) * 256 + bj * HALF + jc0 + 4 * n)) = acc[ai][bj][3][n];
        }
        float* eb = EDGE + (size_t)(u.pm * NTC + u.pn) * 4 * 256;
        if (wr == 0 && fr < 2) {
#pragma unroll
            for (int bj = 0; bj < 2; ++bj)
#pragma unroll
                for (int n = 0; n < 2; ++n) *(f32x4*)(eb + fr * 256 + bj * HALF + jc0 + 4 * n) = acc[0][bj][0][n];
        }
        if (wr == 1 && fr >= 14) {
#pragma unroll
            for (int bj = 0; bj < 2; ++bj)
#pragma unroll
                for (int n = 0; n < 2; ++n) *(f32x4*)(eb + (2 + fr - 14) * 256 + bj * HALF + jc0 + 4 * n) = acc[1][bj][3][n];
        }
        asm volatile("s_waitcnt lgkmcnt(0)" ::: "memory"); __builtin_amdgcn_s_barrier(); asm volatile("" ::: "memory");
        const int src1 = (lane & 48) | ((fr + 15) & 15), src2 = (lane & 48) | ((fr + 14) & 15);
#pragma unroll
        for (int bj = 0; bj < 2; ++bj)
#pragma unroll
            for (int n = 0; n < 2; ++n) {
                const int gc = bj * FFC + u.pn * 128 + jc0 + 4 * n;
                const f32x4 w0 = *(const f32x4*)(cw + gc), w1 = *(const f32x4*)(cw + 2 * FFC + gc), w2 = *(const f32x4*)(cw + 4 * FFC + gc), bb = *(const f32x4*)(cb + gc);
#pragma unroll
                for (int ai = 0; ai < 2; ++ai) {
                    const int grp = ai * 2 + wr;
                    f32x4 xp = (f32x4){0.f, 0.f, 0.f, 0.f};
                    if (grp > 0 && fr >= 14) xp = *(const PG8_LAS f32x4*)(xb + (((grp - 1) * 2 + (fr - 14)) * 256 + bj * HALF + jc0 + 4 * n));
#pragma unroll
                    for (int m = 3; m >= 0; --m) {
                        f32x4 cur = acc[ai][bj][m][n]; f32x4 prv = (m > 0) ? acc[ai][bj][m > 0 ? m - 1 : 0][n] : xp;
                        asm volatile("" : "+v"(cur), "+v"(prv));
                        f32x4 r;
#pragma unroll
                        for (int x = 0; x < 4; ++x) {
                            const float s1 = (fr == 15) ? prv[x] : cur[x], s2 = (fr >= 14) ? prv[x] : cur[x];
                            const float p1 = __builtin_bit_cast(float, __builtin_amdgcn_update_dpp(0, __builtin_bit_cast(int, s1), 0x121, 0xf, 0xf, false)), p2 = __builtin_bit_cast(float, __builtin_amdgcn_update_dpp(0, __builtin_bit_cast(int, s2), 0x122, 0xf, 0xf, false));
                            r[x] = w0[x] * p2 + w1[x] * p1 + w2[x] * cur[x] + bb[x];
                        }
                        asm volatile("" : "+v"(r));
                        acc[ai][bj][m][n] = r;
                    }
                    __builtin_amdgcn_sched_barrier(0);
                }
                asm volatile("" ::: "memory");
            }
#pragma unroll
        for (int ai = 0; ai < 2; ++ai)
#pragma unroll
            for (int m = 0; m < 4; ++m) {
                const bool skip = (ai == 0 && wr == 0 && m == 0 && fr < 2);
                bf16_t* rowp = ACT + (size_t)(u.pm * BM + ai * HALF + wr * 64 + m * 16 + fr) * FFC + u.pn * 128 + jc0;
                const f32x4 g0 = acc[ai][0][m][0], g1 = acc[ai][0][m][1], v0 = acc[ai][1][m][0], v1 = acc[ai][1][m][1];
                float r[8];
#pragma unroll
                for (int x = 0; x < 4; ++x) { r[x] = gelu_tanh_f(g0[x]) * v0[x]; r[4 + x] = gelu_tanh_f(g1[x]) * v1[x]; }
                u32x4 w; w.x = cvt_pk_bf16(r[0], r[1]); w.y = cvt_pk_bf16(r[2], r[3]); w.z = cvt_pk_bf16(r[4], r[5]); w.w = cvt_pk_bf16(r[6], r[7]);
                if (!skip) *(u32x4*)rowp = w;
                asm volatile("" ::: "memory"); __builtin_amdgcn_sched_barrier(0);
            }
        asm volatile("s_waitcnt lgkmcnt(0)" ::: "memory"); __builtin_amdgcn_s_barrier(); asm volatile("" ::: "memory");
    }
};
typedef _Float16 f16x8 __attribute__((ext_vector_type(8)));
template <class Epi, class Sched, bool ALIGN_EPI = false, bool SP2 = false, bool F16 = false>
__device__ __forceinline__ void gemm_phase(PG8_LAS unsigned char* lds, const Gemm g, const Sched& S, const Epi& E) {
    int tid_o = threadIdx.x; asm volatile("" : "+v"(tid_o));
    const int tid = tid_o, wid = __builtin_amdgcn_readfirstlane(tid >> 6), lane = tid & 63, wr = wid >> 2, wc = wid & 3, fr = lane & 15, fq = lane >> 4;
    int K_o = g.K; asm volatile("" : "+s"(K_o)); const int K = K_o, nt = K / BK;
    unsigned voffA[2], voffB[2];
#pragma unroll
    for (int i = 0; i < 2; ++i) { int R, C; stage_rc(tid * 16 + i * 8192, R, C); const int Rb = Epi::PERM ? ((R & ~31) + perm32(R & 31)) : R;
        voffA[i] = (unsigned)(R * K + C) * 2u; voffB[i] = (unsigned)(Rb * K + C) * 2u; }
    const size_t kstep = (size_t)(BK * 2);
    const size_t hstep = (size_t)HALF * K * 2;
    const size_t tstep = 2 * hstep;
    const unsigned ldsw = (unsigned)wid * 1024u;
    const int aoff = lds_byte(wr * 64 + fr, fq * 8), boff = lds_byte(wc * 32 + fr, fq * 8);
#define PG8_SA(b, h) (((b) * 2 + (h)) * HTB)
#define PG8_SB(b, h) ((4 + (b) * 2 + (h)) * HTB)
#define PG8_STAGE(bufoff, gbase, voff) do { _Pragma("unroll") for (int _i = 0; _i < 2; ++_i) \
        __builtin_amdgcn_global_load_lds((const unsigned*)((const char*)(gbase) + (voff)[_i]), (PG8_LAS unsigned*)(lds + (bufoff) + ldsw + _i * 8192), 16, 0, 0); } while (0)
#define PG8_LDA(dst, b, h) do { _Pragma("unroll") for (int m = 0; m < 4; ++m) _Pragma("unroll") for (int k = 0; k < 2; ++k) dst[m][k] = *(const PG8_LAS bf16x8*)(lds + PG8_SA(b, h) + aoff + m * 2048 + k * 1024); } while (0)
#define PG8_LDB(dst, b, h) do { _Pragma("unroll") for (int n = 0; n < 2; ++n) _Pragma("unroll") for (int k = 0; k < 2; ++k) dst[n][k] = *(const PG8_LAS bf16x8*)(lds + PG8_SB(b, h) + boff + n * 2048 + k * 1024); } while (0)
#define PG8_MMA(ai, bj, At, Bt) do { __builtin_amdgcn_s_setprio(1); _Pragma("unroll") for (int m = 0; m < 4; ++m) _Pragma("unroll") for (int n = 0; n < 2; ++n) _Pragma("unroll") for (int k = 0; k < 2; ++k) \
        { if constexpr (F16) acc[ai][bj][m][n] = __builtin_amdgcn_mfma_f32_16x16x32_f16(__builtin_bit_cast(f16x8, Bt[n][k]), __builtin_bit_cast(f16x8, At[m][k]), acc[ai][bj][m][n], 0, 0, 0); \
          else acc[ai][bj][m][n] = __builtin_amdgcn_mfma_f32_16x16x32_bf16(Bt[n][k], At[m][k], acc[ai][bj][m][n], 0, 0, 0); } __builtin_amdgcn_s_setprio(0); } while (0)
#define PG8_WAIT_V(n) asm volatile("s_waitcnt vmcnt(" #n ")" ::: "memory")
#define PG8_WAIT_L(n) asm volatile("s_waitcnt lgkmcnt(" #n ")" ::: "memory")
#define PG8_BAR __builtin_amdgcn_s_barrier()
#define PG8_SCHED __builtin_amdgcn_sched_barrier(0)
    Unit cur, nxt; int ui = 0;
    if (!S.next(0, cur)) return;
    f32x4 acc[2][2][4][2];
#pragma unroll
    for (int a = 0; a < 2; ++a)
#pragma unroll
        for (int b = 0; b < 2; ++b)
#pragma unroll
            for (int m = 0; m < 4; ++m)
#pragma unroll
                for (int n = 0; n < 2; ++n) acc[a][b][m][n] = (f32x4){0.f, 0.f, 0.f, 0.f};
    bf16x8 At[4][2], B0[2][2], B1[2][2];
    const char* cA = (const char*)g.A + (size_t)cur.pm * tstep; const char* cB = (const char*)g.Bt + (size_t)cur.pn * tstep;
    S.a_ready(cur);
    if constexpr (SP2) {
        PG8_STAGE(PG8_SB(0, 0), cB, voffB); PG8_STAGE(PG8_SB(0, 1), cB + hstep, voffB); PG8_STAGE(PG8_SA(0, 0), cA, voffA); PG8_STAGE(PG8_SA(0, 1), cA + hstep, voffA);
        if (wr == 1) PG8_BAR;
        PG8_WAIT_V(2); PG8_BAR;
        PG8_STAGE(PG8_SB(1, 0), cB + kstep, voffB); PG8_STAGE(PG8_SA(1, 0), cA + kstep, voffA); PG8_STAGE(PG8_SB(1, 1), cB + hstep + kstep, voffB);
        PG8_WAIT_V(6); PG8_BAR;
    } else {
        PG8_STAGE(PG8_SB(0, 0), cB, voffB); PG8_STAGE(PG8_SA(0, 0), cA, voffA); PG8_STAGE(PG8_SB(0, 1), cB + hstep, voffB); PG8_STAGE(PG8_SA(0, 1), cA + hstep, voffA);
        if (wr == 1) PG8_BAR;
        PG8_WAIT_V(4); PG8_BAR;
        PG8_STAGE(PG8_SB(1, 0), cB + kstep, voffB); PG8_STAGE(PG8_SA(1, 0), cA + kstep, voffA); PG8_STAGE(PG8_SB(1, 1), cB + hstep + kstep, voffB);
        PG8_WAIT_V(6); PG8_BAR;
    }
    for (;;) {
        const bool has_next = S.next(ui + 1, nxt);
        const char* nA = has_next ? (const char*)g.A + (size_t)nxt.pm * tstep : cA; const char* nB = has_next ? (const char*)g.Bt + (size_t)nxt.pn * tstep : cB;
        for (int t = 0; t < nt; t += 2) {
            const bool last = (t == nt - 2);
            const char* a1 = cA + (size_t)(t + 1) * kstep;
            const char* a2 = last ? nA : cA + (size_t)(t + 2) * kstep; const char* b2 = last ? nB : cB + (size_t)(t + 2) * kstep;
            const char* a3 = a2 + kstep; const char* b3 = b2 + kstep;
            if (last && has_next) S.a_ready(nxt);
            if constexpr (SP2) {
            PG8_LDB(B0, 0, 0); PG8_LDB(B1, 0, 1); PG8_SCHED; PG8_LDA(At, 0, 0); PG8_STAGE(PG8_SA(1, 1), a1 + hstep, voffA);
            PG8_WAIT_V(8); PG8_WAIT_L(0); PG8_BAR; PG8_MMA(0, 0, At, B0); PG8_MMA(0, 1, At, B1); PG8_BAR; PG8_SCHED;
            PG8_LDA(At, 0, 1); PG8_STAGE(PG8_SB(0, 0), b2, voffB); PG8_STAGE(PG8_SB(0, 1), b2 + hstep, voffB); PG8_STAGE(PG8_SA(0, 0), a2, voffA);
            PG8_WAIT_V(8); PG8_WAIT_L(0); PG8_BAR; PG8_MMA(1, 0, At, B0); PG8_MMA(1, 1, At, B1); PG8_BAR; PG8_SCHED;
            PG8_LDB(B0, 1, 0); PG8_LDB(B1, 1, 1); PG8_SCHED; PG8_LDA(At, 1, 0); PG8_STAGE(PG8_SA(0, 1), a2 + hstep, voffA);
            PG8_WAIT_V(8); PG8_WAIT_L(0); PG8_BAR; PG8_MMA(0, 0, At, B0); PG8_MMA(0, 1, At, B1); PG8_BAR; PG8_SCHED;
            PG8_LDA(At, 1, 1); PG8_STAGE(PG8_SB(1, 0), b3, voffB); PG8_STAGE(PG8_SB(1, 1), b3 + hstep, voffB); PG8_STAGE(PG8_SA(1, 0), a3, voffA);
            PG8_WAIT_V(8); PG8_WAIT_L(0); PG8_BAR; PG8_MMA(1, 0, At, B0); PG8_MMA(1, 1, At, B1); PG8_BAR; PG8_SCHED;
            } else {
            PG8_LDB(B0, 0, 0); PG8_SCHED; PG8_LDA(At, 0, 0); PG8_STAGE(PG8_SA(1, 1), a1 + hstep, voffA);
            PG8_WAIT_L(8); PG8_BAR; PG8_WAIT_L(0); PG8_MMA(0, 0, At, B0); PG8_BAR; PG8_SCHED;
            PG8_LDB(B1, 0, 1); PG8_STAGE(PG8_SB(0, 0), b2, voffB);
            PG8_BAR; PG8_WAIT_L(0); PG8_MMA(0, 1, At, B1); PG8_BAR;
            PG8_LDA(At, 0, 1); PG8_STAGE(PG8_SA(0, 0), a2, voffA);
            PG8_BAR; PG8_WAIT_L(0); PG8_MMA(1, 0, At, B0); PG8_BAR; PG8_SCHED;
            PG8_STAGE(PG8_SB(0, 1), b2 + hstep, voffB);
            PG8_WAIT_V(6); PG8_BAR; PG8_MMA(1, 1, At, B1); PG8_BAR;
            PG8_LDB(B0, 1, 0); PG8_SCHED; PG8_LDA(At, 1, 0); PG8_STAGE(PG8_SA(0, 1), a2 + hstep, voffA);
            PG8_WAIT_L(8); PG8_BAR; PG8_WAIT_L(0); PG8_MMA(0, 0, At, B0); PG8_BAR; PG8_SCHED;
            PG8_LDB(B1, 1, 1); PG8_STAGE(PG8_SB(1, 0), b3, voffB);
            PG8_BAR; PG8_WAIT_L(0); PG8_MMA(0, 1, At, B1); PG8_BAR;
            PG8_LDA(At, 1, 1); PG8_STAGE(PG8_SA(1, 0), a3, voffA);
            PG8_BAR; PG8_WAIT_L(0); PG8_MMA(1, 0, At, B0); PG8_BAR; PG8_SCHED;
            PG8_STAGE(PG8_SB(1, 1), b3 + hstep, voffB);
            PG8_WAIT_V(6); PG8_BAR; PG8_MMA(1, 1, At, B1); PG8_BAR;
            }
        }
        if constexpr (ALIGN_EPI) { if (wr == 0) PG8_BAR; }
        if constexpr (!Epi::AFTER_DRAIN) { E(acc, cur, wr, wc, fr, fq); S.done(cur); }
        if (!has_next) break;
#pragma unroll
        for (int a = 0; a < 2; ++a)
#pragma unroll
            for (int b = 0; b < 2; ++b)
#pragma unroll
                for (int m = 0; m < 4; ++m)
#pragma unroll
                    for (int n = 0; n < 2; ++n) acc[a][b][m][n] = (f32x4){0.f, 0.f, 0.f, 0.f};
        cur = nxt; cA = nA; cB = nB; ++ui;
        if constexpr (ALIGN_EPI) { if (wr == 1) PG8_BAR; }
    }
    PG8_WAIT_V(0);
    if constexpr (!ALIGN_EPI) { if (wr == 0) PG8_BAR; }
    PG8_BAR;
    if constexpr (Epi::AFTER_DRAIN) { E.fused(acc, cur, wr, wc, fr, fq, lds, wid, lane); S.done(cur); }
#undef PG8_SA
#undef PG8_SB
#undef PG8_STAGE
#undef PG8_LDA
#undef PG8_LDB
#undef PG8_MMA
#undef PG8_WAIT_V
#undef PG8_WAIT_L
#undef PG8_BAR
#undef PG8_SCHED
}
}
#include <hip/hip_bf16.h>
#include <cmath>
namespace attn_body {
using bf16=__hip_bfloat16;
using bf16x8=__attribute__((ext_vector_type(8)))short;
using s16x4=__attribute__((ext_vector_type(4)))short;
using f32x16=__attribute__((ext_vector_type(16)))float;
using u32x4=__attribute__((ext_vector_type(4)))unsigned;
constexpr int NHEAD=16,SEQ=4096,D=64,DM=NHEAD*D;
constexpr int NW=8,QBLK=32,QB=QBLK*NW,KVBLK=64,NQB=SEQ/QB;
constexpr int ATTN_PITCH=DM, ATTN_UNIT_ROWS=QB;
__device__ __forceinline__ int crow(int r,int hi){return (r&3)+8*(r>>2)+4*hi;}
#define SBAR() __builtin_amdgcn_sched_barrier(0)
__device__ __forceinline__ void cmask(f32x16&p0,f32x16&p1,int jb,int qrel,int hi){
  const float NEG=-INFINITY; int kb=64*jb+4*hi;
  #pragma unroll
  for(int r=0;r<16;++r){int kv=kb+(r&3)+8*(r>>2); if(kv>qrel)p0[r]=NEG; if(kv+32>qrel)p1[r]=NEG;}
}

constexpr int NSLOT=3, SLOTB=8192, VSLOTB=2*SLOTB;
constexpr int LDS_K=0, LDS_V=NSLOT*SLOTB, LDS_WS=LDS_V+NSLOT*VSLOTB, LDS_OST=LDS_WS+NW*64*4, LDS_BYTES=LDS_OST+NW*4096;
constexpr float C2=0.125f*1.4426950408889634f;
__device__ __forceinline__ void glds16(const void*gsrc,unsigned lds_dst){unsigned keep;
  asm volatile("s_mov_b32 %0, m0\n\ts_mov_b32 m0, %2\n\ts_nop 0\n\tglobal_load_lds_dwordx4 %1, off\n\ts_mov_b32 m0, %0":"=&s"(keep):"v"(gsrc),"s"(lds_dst):"memory");}
__device__ __forceinline__ void glds16s(const void*sbase,unsigned voff,unsigned lds_dst){unsigned keep;
  asm volatile("s_mov_b32 %0, m0\n\ts_mov_b32 m0, %3\n\ts_nop 0\n\tglobal_load_lds_dwordx4 %1, %2\n\ts_mov_b32 m0, %0":"=&s"(keep):"v"(voff),"s"(sbase),"s"(lds_dst):"memory");}
__device__ __forceinline__ float max3f(float a,float b,float c){float r;asm("v_max3_f32 %0, %1, %2, %3":"=v"(r):"v"(a),"v"(b),"v"(c));return r;}
__device__ __forceinline__ float max2f(float a,float b){float r;asm("v_max_f32_e32 %0, %1, %2":"=v"(r):"v"(a),"v"(b));return r;}
__device__ __forceinline__ float fadd_s(float a,float b){float r;asm("v_add_f32_e32 %0, %1, %2":"=v"(r):"v"(a),"v"(b));return r;}
__device__ __forceinline__ float fsub_s(float a,float b){float r;asm("v_sub_f32_e32 %0, %1, %2":"=v"(r):"v"(a),"v"(b));return r;}
typedef float f32x2_t __attribute__((ext_vector_type(2))); typedef __bf16 bf16x2_t __attribute__((ext_vector_type(2)));
__device__ __forceinline__ unsigned cvtpk_s(float lo,float hi){f32x2_t v={lo,hi};bf16x2_t b=__builtin_convertvector(v,bf16x2_t);return __builtin_bit_cast(unsigned,b);}
#define WAIT_BAR(N) asm volatile("s_waitcnt vmcnt(" #N ") lgkmcnt(0)\n\ts_barrier":::"memory")

__device__ __forceinline__ void qkt(f32x16&p0,f32x16&p1,const char*Kslot,const bf16x8*qr,const f32x16&negm,int r32,int hi){
  const char*kb=Kslot+hi*1024+r32*16;
  #pragma unroll
  for(int d0=0;d0<4;++d0){
    const bf16x8 b0=*reinterpret_cast<const bf16x8*>(kb+d0*2048);
    const bf16x8 b1=*reinterpret_cast<const bf16x8*>(kb+d0*2048+512);
    if(d0==0){p0=__builtin_amdgcn_mfma_f32_32x32x16_bf16(b0,qr[0],negm,0,0,0);p1=__builtin_amdgcn_mfma_f32_32x32x16_bf16(b1,qr[0],negm,0,0,0);}
    else{p0=__builtin_amdgcn_mfma_f32_32x32x16_bf16(b0,qr[d0],p0,0,0,0);p1=__builtin_amdgcn_mfma_f32_32x32x16_bf16(b1,qr[d0],p1,0,0,0);}}
}
typedef __attribute__((address_space(3))) const char* lds_cptr;
typedef short v4i16_t __attribute__((ext_vector_type(4)));
__device__ __forceinline__ void kload8(bf16x8*kf,lds_cptr kp){
  kf[0]=*(const __attribute__((address_space(3))) bf16x8*)(kp);      kf[1]=*(const __attribute__((address_space(3))) bf16x8*)(kp+512);
  kf[2]=*(const __attribute__((address_space(3))) bf16x8*)(kp+2048); kf[3]=*(const __attribute__((address_space(3))) bf16x8*)(kp+2560);
  kf[4]=*(const __attribute__((address_space(3))) bf16x8*)(kp+4096); kf[5]=*(const __attribute__((address_space(3))) bf16x8*)(kp+4608);
  kf[6]=*(const __attribute__((address_space(3))) bf16x8*)(kp+6144); kf[7]=*(const __attribute__((address_space(3))) bf16x8*)(kp+6656);
}
__device__ __forceinline__ void kload2(bf16x8*kf,lds_cptr kp,int j){ kf[2*j]=*(const __attribute__((address_space(3))) bf16x8*)(kp+j*2048); kf[2*j+1]=*(const __attribute__((address_space(3))) bf16x8*)(kp+j*2048+512); }
__device__ __forceinline__ s16x4 vtr(lds_cptr p){ return __builtin_bit_cast(s16x4,__builtin_amdgcn_ds_read_tr16_b64_v4i16((__attribute__((address_space(3))) v4i16_t*)p)); }
__device__ __forceinline__ float rowmax(const f32x16&p0,const f32x16&p1){
  float a=max3f(p0[0],p0[1],p1[0]),b=max3f(p0[2],p0[3],p1[1]);a=max3f(a,p1[2],p1[3]);
  #pragma unroll
  for(int r=4;r<16;r+=4){a=max3f(a,p0[r],p0[r+1]);b=max3f(b,p0[r+2],p0[r+3]);a=max3f(a,p1[r],p1[r+1]);b=max3f(b,p1[r+2],p1[r+3]);}
  const float m=max2f(a,b);
  auto rr=__builtin_amdgcn_permlane32_swap(__float_as_uint(m),__float_as_uint(m),false,false);
  return max2f(__uint_as_float(rr[0]),__uint_as_float(rr[1]));
}
__device__ __forceinline__ void pv(f32x16*o,int vb,bf16x8 pa0,bf16x8 pa1,bf16x8 pa2,bf16x8 pa3){
  #pragma unroll
  for(int d0=0;d0<4;++d0){s16x4 lo[4],hi[4];
    #pragma unroll
    for(int ks=0;ks<4;++ks){
      asm volatile("ds_read_b64_tr_b16 %0,%1 offset:%c2":"=&v"(lo[ks]):"v"(vb),"i"(d0*4096+ks*1024):"memory");
      asm volatile("ds_read_b64_tr_b16 %0,%1 offset:%c2":"=&v"(hi[ks]):"v"(vb),"i"(d0*4096+ks*1024+512):"memory");}
    asm volatile("s_waitcnt lgkmcnt(0)":::"memory");SBAR();
    #define PK(k) (bf16x8){lo[k][0],lo[k][1],lo[k][2],lo[k][3],hi[k][0],hi[k][1],hi[k][2],hi[k][3]}
    o[d0]=__builtin_amdgcn_mfma_f32_32x32x16_bf16(pa0,PK(0),o[d0],0,0,0);
    o[d0]=__builtin_amdgcn_mfma_f32_32x32x16_bf16(pa1,PK(1),o[d0],0,0,0);
    o[d0]=__builtin_amdgcn_mfma_f32_32x32x16_bf16(pa2,PK(2),o[d0],0,0,0);
    o[d0]=__builtin_amdgcn_mfma_f32_32x32x16_bf16(pa3,PK(3),o[d0],0,0,0);
    #undef PK
  }
}

#ifndef ATTN_STORE16
#define ATTN_STORE16(p,v) (*(u32x4*)(p)=(v))
#endif
template<int THRL,bool COMB> __device__ __forceinline__ void attn_unit(int b,int h,int hv,int qb,const bf16*Q,const bf16*__restrict__ K,const bf16*__restrict__ V,bf16*O,bf16*YB,float lam,float oscale,const float*gsub,char*shm){
  int tid_o=threadIdx.x; asm volatile("":"+v"(tid_o)); const int tid=tid_o,lane=tid&63,r32=lane&31,hi=lane>>5; const int wid=__builtin_amdgcn_readfirstlane(tid>>6);
  const long rowbase=(long)b*SEQ; const int q0=qb*QB;
  const bf16*Qw=Q+(rowbase+q0+wid*QBLK)*DM+h*D;
  const bf16*Kh=K+rowbase*DM+h*D,*Vh=V+rowbase*DM+hv*2*D;
  const unsigned lds0=(unsigned)(uintptr_t)shm;
  float*wsf=(float*)(shm+LDS_WS)+wid*64;
  const unsigned koff=(unsigned)(lane*DM+wid*8)*2u;
  const unsigned voff=(unsigned)((16*(wid&3)+(lane>>2))*DM+(wid>>2)*32+(lane&3)*8)*2u;
  const unsigned kdst=lds0+LDS_K+wid*1024, vdst=lds0+LDS_V+wid*1024;
  #define DMA_K(t,slot) glds16s(Kh+(long)(t)*KVBLK*DM,koff,(unsigned)__builtin_amdgcn_readfirstlane(kdst+(slot)))
  #define DMA_V(t,slot) do{ glds16s(Vh+(long)(t)*KVBLK*DM,voff,(unsigned)__builtin_amdgcn_readfirstlane(vdst+2*(slot))); glds16s(Vh+64+(long)(t)*KVBLK*DM,voff,(unsigned)__builtin_amdgcn_readfirstlane(vdst+2*(slot)+8192)); }while(0)
  const char*Kbase=shm+LDS_K; bf16x8 kf[8];
  const lds_cptr shm3=(lds_cptr)shm; const lds_cptr kp0=shm3+LDS_K+hi*1024+r32*16; const lds_cptr vp0=shm3+LDS_V+((lane>>4)&1)*32+(lane&3)*8+(4*hi+((lane&15)>>2))*64;
  const int NT=(q0+QB)/KVBLK;
  DMA_K(0,0);DMA_V(0,0);DMA_K(1,SLOTB);
  bf16x8 qr[4];
  #pragma unroll
  for(int d0=0;d0<4;++d0)qr[d0]=*reinterpret_cast<const bf16x8*>(&Qw[(long)r32*DM+d0*16+hi*8]);
  float mhat=0.f,l_reg=0.f;f32x16 o[4];o[0]=f32x16{};o[1]=f32x16{};o[2]=f32x16{};o[3]=f32x16{};f32x16 negm=f32x16{};asm volatile("":"+v"(negm));
  const int qrel=wid*QBLK+r32;
  #define CMASK(P0,P1,t) do{int jb_=(t)-(NT-4); if(jb_>=0)cmask(P0,P1,jb_,qrel,hi);}while(0)
  bool resc=false;
  #define START(P0,P1) do{ const float rm=rowmax(P0,P1); resc=false; \
    { const float dl=rm; mhat=fadd_s(mhat,dl); \
      _Pragma("unroll") for(int r=0;r<16;++r){P0[r]=fsub_s(P0[r],dl);P1[r]=fsub_s(P1[r],dl);} \
      _Pragma("unroll") for(int r=0;r<16;++r)negm[r]=-mhat; asm volatile("":"+v"(negm)); } \
    _Pragma("unroll") for(int r=0;r<16;++r)P0[r]=__builtin_amdgcn_exp2f(P0[r]); }while(0)
  #define RESC() do{ if(resc){ asm volatile("s_waitcnt lgkmcnt(0)":::"memory"); \
      _Pragma("unroll") for(int d_=0;d_<4;++d_) _Pragma("unroll") for(int r=0;r<16;++r)o[d_][r]*=wsf[crow(r,hi)]; } }while(0)
  f32x16 pA0,pA1,pB0,pB1;
  int sl_prev=0,sl_cur=0,sl_next=SLOTB;
  #define ROT() do{sl_prev=sl_cur;sl_cur=sl_next;sl_next=(sl_next==(NSLOT-1)*SLOTB)?0:sl_next+SLOTB;}while(0)
  DMA_K(2,2*SLOTB);
  WAIT_BAR(3);
  qkt(pA0,pA1,Kbase,qr,negm,r32,hi);asm volatile("s_nop 15\n\ts_nop 7":"+v"(pA0),"+v"(pA1));CMASK(pA0,pA1,0);
  START(pA0,pA1);
  _Pragma("unroll") for(int r=0;r<16;++r)pA1[r]=__builtin_amdgcn_exp2f(pA1[r]);
  WAIT_BAR(0);
  DMA_K(3,0);DMA_V(1,SLOTB);
  ROT();
  kload8(kf,kp0+sl_cur);
  WAIT_BAR(3);
  s16x4 vlo[8],vhi[8]; u32x4 pw0,pw1,pw2,pw3;
  #define PKW(P,B) cvtpk_s(P[B],P[B+1])
  #define PAF(k) __builtin_bit_cast(bf16x8,pw##k)
  #define VFR(i) (bf16x8){vlo[i][0],vlo[i][1],vlo[i][2],vlo[i][3],vhi[i][0],vhi[i][1],vhi[i][2],vhi[i][3]}
  #define PIN(x) asm volatile("":"+v"(x))
  #define MX3(a,b,c) __builtin_fmaxf(__builtin_fmaxf((a),(b)),(c))
  #define GAPA(MF,A0,A1,A2,A3,W0,W1,PW) do{ MF; sacc+=A0; sacc+=A1; sacc+=A2; sacc+=A3; PIN(sacc); W0; W1; PIN(PW); SBAR(); }while(0)
  #define EX(v) __builtin_amdgcn_exp2f(v)
  #define GAPB(MF,X,B) do{ MF; X[B]=EX(X[B]); X[B+1]=EX(X[B+1]); X[B+2]=EX(X[B+2]); X[B+3]=EX(X[B+3]); PIN(X); SBAR(); }while(0)
  #define GAPH(MF,X,B) do{ MF; X[B]=EX(X[B]); X[B+1]=EX(X[B+1]); PIN(X); SBAR(); }while(0)
  #define VRD(i) do{ vlo[i]=vtr(vp_+(((i)>>2)*4096+((i)&3)*1024)); vhi[i]=vtr(vp_+(((i)>>2)*4096+((i)&3)*1024+512)); }while(0)
  #define VRD2(i) do{ vlo[i]=vtr(vp_+(8192+((i)>>2)*4096+((i)&3)*1024)); vhi[i]=vtr(vp_+(8192+((i)>>2)*4096+((i)&3)*1024+512)); }while(0)
  #define KRD(G,j) do{ if(G){ kload2(kf,kp0+sl_next,j); SBAR(); } }while(0)
  #define STEP(C0,C1,P0,P1,t,GK,GV,GL) do{ SBAR(); \
    const lds_cptr vp_=vp0+2*sl_prev; \
    float sacc=(P0[0]+P0[1]); \
    GAPA(C0=__builtin_amdgcn_mfma_f32_32x32x16_bf16(kf[0],qr[0],negm,0,0,0), P0[2],P0[3],P0[4],P0[5],     pw0[0]=PKW(P0,0), pw0[1]=PKW(P0,2), pw0); \
    GAPA(C1=__builtin_amdgcn_mfma_f32_32x32x16_bf16(kf[1],qr[0],negm,0,0,0), P0[6],P0[7],P0[8],P0[9],     pw0[2]=PKW(P0,4), pw0[3]=PKW(P0,6), pw0); \
    GAPA(C0=__builtin_amdgcn_mfma_f32_32x32x16_bf16(kf[2],qr[1],C0,0,0,0),   P0[10],P0[11],P0[12],P0[13], pw1[0]=PKW(P0,8), pw1[1]=PKW(P0,10), pw1); \
    GAPA(C1=__builtin_amdgcn_mfma_f32_32x32x16_bf16(kf[3],qr[1],C1,0,0,0),   P0[14],P0[15],P1[0],P1[1],   pw1[2]=PKW(P0,12),pw1[3]=PKW(P0,14), pw1); \
    GAPA(C0=__builtin_amdgcn_mfma_f32_32x32x16_bf16(kf[4],qr[2],C0,0,0,0),   P1[2],P1[3],P1[4],P1[5],     pw2[0]=PKW(P1,0), pw2[1]=PKW(P1,2), pw2); \
    GAPA(C1=__builtin_amdgcn_mfma_f32_32x32x16_bf16(kf[5],qr[2],C1,0,0,0),   P1[6],P1[7],P1[8],P1[9],     pw2[2]=PKW(P1,4), pw2[3]=PKW(P1,6), pw2); \
    GAPA(C0=__builtin_amdgcn_mfma_f32_32x32x16_bf16(kf[6],qr[3],C0,0,0,0),   P1[10],P1[11],P1[12],P1[13], pw3[0]=PKW(P1,8), pw3[1]=PKW(P1,10), pw3); \
    GAPA(C1=__builtin_amdgcn_mfma_f32_32x32x16_bf16(kf[7],qr[3],C1,0,0,0),   P1[14],P1[15],0.f,0.f,       pw3[2]=PKW(P1,12),pw3[3]=PKW(P1,14), pw3); \
    l_reg+=sacc; \
    VRD(0);VRD(4);VRD(1);VRD(5);VRD(2);VRD(6);VRD(3);VRD(7); SBAR();   \
    if(GK){DMA_K((t)+3,sl_cur);} if(GV){DMA_V((t)+1,sl_next);} \
    CMASK(C0,C1,t); \
    { float a=MX3(C0[0],C0[1],C1[0]),b=MX3(C0[2],C0[3],C1[1]); a=MX3(a,C1[2],C1[3]); \
      _Pragma("unroll") for(int r=4;r<16;r+=4){a=MX3(a,C0[r],C0[r+1]);b=MX3(b,C0[r+2],C0[r+3]);a=MX3(a,C1[r],C1[r+1]);b=MX3(b,C1[r+2],C1[r+3]);} \
      float rm=__builtin_fmaxf(a,b); { auto rr=__builtin_amdgcn_permlane32_swap(__float_as_uint(rm),__float_as_uint(rm),false,false); rm=__builtin_fmaxf(__uint_as_float(rr[0]),__uint_as_float(rr[1])); } \
      resc=false; \
      if(__builtin_expect(__any(rm>(float)THRL),0)){ const float dl=__builtin_fmaxf(rm,0.f); mhat+=dl; \
        _Pragma("unroll") for(int r=0;r<16;++r){C0[r]-=dl;C1[r]-=dl;} \
        _Pragma("unroll") for(int r=0;r<16;++r)negm[r]=-mhat; asm volatile("":"+v"(negm)); \
        const float f=__builtin_amdgcn_exp2f(-dl); l_reg*=f; if(hi==0)wsf[r32]=f; resc=true; } } \
    SBAR(); \
    GAPH(o[0]=__builtin_amdgcn_mfma_f32_32x32x16_bf16(PAF(0),VFR(0),o[0],0,0,0), C0,0); VRD2(0); \
    GAPH(o[1]=__builtin_amdgcn_mfma_f32_32x32x16_bf16(PAF(0),VFR(4),o[1],0,0,0), C0,4); VRD2(4); \
    KRD(GL,0); GAPH(o[0]=__builtin_amdgcn_mfma_f32_32x32x16_bf16(PAF(1),VFR(1),o[0],0,0,0), C0,8); VRD2(1); \
    KRD(GL,1); GAPH(o[1]=__builtin_amdgcn_mfma_f32_32x32x16_bf16(PAF(1),VFR(5),o[1],0,0,0), C0,12); VRD2(5); \
    KRD(GL,2); GAPH(o[0]=__builtin_amdgcn_mfma_f32_32x32x16_bf16(PAF(2),VFR(2),o[0],0,0,0), C1,0); VRD2(2); \
    KRD(GL,3); GAPH(o[1]=__builtin_amdgcn_mfma_f32_32x32x16_bf16(PAF(2),VFR(6),o[1],0,0,0), C1,4); VRD2(6); \
    GAPH(o[0]=__builtin_amdgcn_mfma_f32_32x32x16_bf16(PAF(3),VFR(3),o[0],0,0,0), C1,8); VRD2(3); \
    GAPH(o[1]=__builtin_amdgcn_mfma_f32_32x32x16_bf16(PAF(3),VFR(7),o[1],0,0,0), C1,12); VRD2(7); SBAR(); \
      \
    GAPH(o[2]=__builtin_amdgcn_mfma_f32_32x32x16_bf16(PAF(0),VFR(0),o[2],0,0,0), C0,2); \
    GAPH(o[3]=__builtin_amdgcn_mfma_f32_32x32x16_bf16(PAF(0),VFR(4),o[3],0,0,0), C0,6); \
    GAPH(o[2]=__builtin_amdgcn_mfma_f32_32x32x16_bf16(PAF(1),VFR(1),o[2],0,0,0), C0,10); \
    GAPH(o[3]=__builtin_amdgcn_mfma_f32_32x32x16_bf16(PAF(1),VFR(5),o[3],0,0,0), C0,14); \
    GAPH(o[2]=__builtin_amdgcn_mfma_f32_32x32x16_bf16(PAF(2),VFR(2),o[2],0,0,0), C1,2); \
    GAPH(o[3]=__builtin_amdgcn_mfma_f32_32x32x16_bf16(PAF(2),VFR(6),o[3],0,0,0), C1,6); \
    GAPH(o[2]=__builtin_amdgcn_mfma_f32_32x32x16_bf16(PAF(3),VFR(3),o[2],0,0,0), C1,10); \
    GAPH(o[3]=__builtin_amdgcn_mfma_f32_32x32x16_bf16(PAF(3),VFR(7),o[3],0,0,0), C1,14); \
    }while(0)
  int t=1;
  #undef CMASK
  #define CMASK(P0,P1,t) do{}while(0)
  for(;t+5<NT;t+=2){
    STEP(pB0,pB1,pA0,pA1,t,true,true,true);     WAIT_BAR(3); RESC(); ROT();
    STEP(pA0,pA1,pB0,pB1,t+1,true,true,true);   WAIT_BAR(3); RESC(); ROT();
  }
  #undef CMASK
  #define CMASK(P0,P1,t) do{int jb_=(t)-(NT-4); if(jb_>=0)cmask(P0,P1,jb_,qrel,hi);}while(0)
  #define ENDW(tt) do{ if((tt)+3<NT){WAIT_BAR(3);} else if((tt)+2<NT){WAIT_BAR(2);} else {WAIT_BAR(0);} }while(0)
  for(;t+1<NT;t+=2){
    STEP(pB0,pB1,pA0,pA1,t,(t+3<NT),(t+1<NT),(t+1<NT));       ENDW(t);   RESC(); ROT();
    STEP(pA0,pA1,pB0,pB1,t+1,(t+4<NT),(t+2<NT),(t+2<NT));     ENDW(t+1); RESC(); ROT();
  }
  STEP(pB0,pB1,pA0,pA1,NT-1,false,false,false); RESC();
  { float sacc=pB0[0]+pB0[1]; _Pragma("unroll") for(int r=2;r<16;++r)sacc+=pB0[r]; _Pragma("unroll") for(int r=0;r<16;++r)sacc+=pB1[r]; l_reg+=sacc;
    pw0=(u32x4){PKW(pB0,0),PKW(pB0,2),PKW(pB0,4),PKW(pB0,6)};pw1=(u32x4){PKW(pB0,8),PKW(pB0,10),PKW(pB0,12),PKW(pB0,14)};pw2=(u32x4){PKW(pB1,0),PKW(pB1,2),PKW(pB1,4),PKW(pB1,6)};pw3=(u32x4){PKW(pB1,8),PKW(pB1,10),PKW(pB1,12),PKW(pB1,14)};
    SBAR(); const int vb0=(int)(lds0+LDS_V)+((lane>>4)&1)*32+(lane&3)*8+(4*hi+((lane&15)>>2))*64;     pv(o,vb0+2*sl_cur,PAF(0),PAF(1),PAF(2),PAF(3)); }
  #undef PKW
  #undef PAF
  #undef VFR
  #undef PIN
  #undef MX3
  #undef GAPA
  #undef GAPB
  #undef GAPH
  #undef EX
  #undef VRD
  #undef VRD2
  #undef KRD
  #undef STEP
  #undef ENDW
  {auto rr=__builtin_amdgcn_permlane32_swap(__float_as_uint(l_reg),__float_as_uint(l_reg),false,false);l_reg=__uint_as_float(rr[0])+__uint_as_float(rr[1]);}
  if(hi==0)wsf[32+r32]=l_reg;asm volatile("s_waitcnt lgkmcnt(0)":::"memory");
  float rli[16];
  #pragma unroll
  for(int r=0;r<16;++r)rli[r]=__builtin_amdgcn_rcpf(wsf[32+crow(r,hi)]);
  bf16*Ow=O+(rowbase+q0+wid*QBLK)*DM+hv*2*D;
  { bf16*stg=(bf16*)(shm+LDS_OST)+wid*2048;
    if constexpr(!COMB){
    #pragma unroll
    for(int hh=0;hh<2;++hh){
      #pragma unroll
      for(int r=0;r<16;++r){const int orow=crow(r,hi);
        #pragma unroll
        for(int d0=0;d0<2;++d0)stg[orow*64+d0*32+r32]=__float2bfloat16(o[2*hh+d0][r]*rli[r]);}
      asm volatile("s_waitcnt lgkmcnt(0)":::"memory");
      #pragma unroll
      for(int i=0;i<4;++i){const int row=i*8+(lane>>3),ch=lane&7; const u32x4 v=*(const u32x4*)(stg+row*64+ch*8); ATTN_STORE16(Ow+(long)row*DM+hh*64+ch*8,v);}
      asm volatile("s_waitcnt lgkmcnt(0)":::"memory"); }
    } else {
    float dv[2][4][8];
    #pragma unroll
    for(int hh=0;hh<2;++hh){
      #pragma unroll
      for(int r=0;r<16;++r){const int orow=crow(r,hi);
        #pragma unroll
        for(int d0=0;d0<2;++d0)stg[orow*64+d0*32+r32]=__float2bfloat16(o[2*hh+d0][r]*rli[r]);}
      asm volatile("s_waitcnt lgkmcnt(0)":::"memory");
      #pragma unroll
      for(int i=0;i<4;++i){const int row=i*8+(lane>>3),ch=lane&7; const u32x4 v2=*(const u32x4*)(stg+row*64+ch*8); const u32x4 v1=*(const u32x4*)(Ow+(long)row*DM+hh*64+ch*8);
        #define BL(w) __builtin_bit_cast(float,(w)<<16)
        #define BH(w) __builtin_bit_cast(float,(w)&0xffff0000u)
        dv[hh][i][0]=BL(v1[0])-lam*BL(v2[0]); dv[hh][i][1]=BH(v1[0])-lam*BH(v2[0]); dv[hh][i][2]=BL(v1[1])-lam*BL(v2[1]); dv[hh][i][3]=BH(v1[1])-lam*BH(v2[1]);
        dv[hh][i][4]=BL(v1[2])-lam*BL(v2[2]); dv[hh][i][5]=BH(v1[2])-lam*BH(v2[2]); dv[hh][i][6]=BL(v1[3])-lam*BL(v2[3]); dv[hh][i][7]=BH(v1[3])-lam*BH(v2[3]);
        #undef BL
        #undef BH
      }
      asm volatile("s_waitcnt lgkmcnt(0)":::"memory"); }
    bf16*Yw=YB+(rowbase+q0+wid*QBLK)*DM+hv*2*D;
    #pragma unroll
    for(int i=0;i<4;++i){const int row=i*8+(lane>>3),ch=lane&7; float ss=0.f;
      #pragma unroll
      for(int hh=0;hh<2;++hh){
        #pragma unroll
        for(int j=0;j<8;++j)ss+=dv[hh][i][j]*dv[hh][i][j];}
      ss+=__builtin_bit_cast(float,__builtin_amdgcn_ds_bpermute((lane^1)<<2,__builtin_bit_cast(int,ss)));
      ss+=__builtin_bit_cast(float,__builtin_amdgcn_ds_bpermute((lane^2)<<2,__builtin_bit_cast(int,ss)));
      ss+=__builtin_bit_cast(float,__builtin_amdgcn_ds_bpermute((lane^4)<<2,__builtin_bit_cast(int,ss)));
      const float rs=oscale/sqrtf(ss*(1.f/128.f)+1e-6f);
      #pragma unroll
      for(int hh=0;hh<2;++hh){const float*gp=gsub+hh*64+ch*8; float y[8];
        #pragma unroll
        for(int j=0;j<8;++j)y[j]=dv[hh][i][j]*rs*gp[j];
        u32x4 w; w[0]=cvtpk_s(y[0],y[1]); w[1]=cvtpk_s(y[2],y[3]); w[2]=cvtpk_s(y[4],y[5]); w[3]=cvtpk_s(y[6],y[7]);
        ATTN_STORE16(Yw+(long)row*DM+hh*64+ch*8,w);} }
    }
  }
  asm volatile("s_waitcnt lgkmcnt(0)\n\ts_barrier":::"memory");
  #undef DMA_K
  #undef DMA_V
  #undef CMASK
  #undef START
  #undef RESC
  #undef ROT
}
constexpr int ATTN_LDS_BYTES=LDS_BYTES;
#undef SBAR
#undef WAIT_BAR
}
#define LAS __attribute__((address_space(3)))
typedef unsigned short bf16;
typedef unsigned v4u __attribute__((ext_vector_type(4)));
typedef unsigned v2u __attribute__((ext_vector_type(2)));
typedef float f32x4 __attribute__((ext_vector_type(4)));
typedef short bf16x8 __attribute__((ext_vector_type(8)));
#define LDS_WAIT() asm volatile("s_waitcnt lgkmcnt(0)" ::: "memory")

constexpr int NWAVES = 8, NTHREADS = 512;
constexpr int DM = 1024, BATCH = 16, SEQ = 4096, DEPTH = 4, M = BATCH * SEQ, MH = M / 2, NIN = 7168, DFF = 2816, NUP = 2 * DFF, PLE = 256;
constexpr float EPS = 1e-6f;
constexpr size_t MiB = 1u << 20;
constexpr size_t WS_W = 2 * MiB, W_LAYER = 40 * MiB;
constexpr size_t WO_IN = 0, WO_UP = 14 * MiB, WO_DOWN = 25 * MiB, WO_PA = 31 * MiB, WO_PB = 33 * MiB, WO_O = 35 * MiB, WO_PG = 37 * MiB, WO_PLE = 39 * MiB, WO_S = 39 * MiB + 512 * 1024;
constexpr size_t WS_H = 162 * MiB;
constexpr size_t WS_Z = 290 * MiB, ZS = (size_t)MH * DM;
constexpr size_t WS_O1 = 738 * MiB, WS_O2 = 802 * MiB;
constexpr size_t WS_ACT = 290 * MiB, WS_XBB = 642 * MiB, WS_EDGE = 802 * MiB, WS_E = 290 * MiB;
constexpr size_t WS_SS = 866 * MiB, SSS = (size_t)M * 16, WS_PBF = 920 * MiB;
constexpr size_t WS_VST = 952 * MiB;
constexpr size_t WS_END = 956 * MiB;
constexpr int LDS_BYTES = 147456, XB_OFF = 131072 + 1024;

__device__ __forceinline__ unsigned f2bf(float f) { unsigned u = __builtin_bit_cast(unsigned, f); return (u + 0x7fffu + ((u >> 16) & 1u)) >> 16; }
__device__ __forceinline__ unsigned pk2(float lo, float hi) { return f2bf(lo) | (f2bf(hi) << 16); }
__device__ __forceinline__ unsigned pkh2(float lo, float hi) { return pg8::cvt_pk_f16(lo, hi); }
__device__ __forceinline__ float blo(unsigned w) { return __builtin_bit_cast(float, w << 16); }
__device__ __forceinline__ float bhi(unsigned w) { return __builtin_bit_cast(float, w & 0xffff0000u); }
__device__ __forceinline__ float bperm(float v, int srclane) { return __builtin_bit_cast(float, __builtin_amdgcn_ds_bpermute(srclane << 2, __builtin_bit_cast(int, v))); }
__device__ __forceinline__ float wave_sum(float v, int lane) {
#pragma unroll
    for (int o = 1; o < 64; o <<= 1) v += bperm(v, lane ^ o);
    return v;
}
__device__ __forceinline__ int up_row_map(int n) { return n < DFF ? (n >> 7) * 256 + (n & 127) : ((n - DFF) >> 7) * 256 + 128 + ((n - DFF) & 127); }
template <bool UPMAP, bool F16OUT = false> __device__ __forceinline__ void transpose_item(const float* W, int K, int N, bf16* WT, LAS float* scr, int item, int lane, const float* gk = nullptr) {
    const int nblk = N / 32, kb = item / nblk, nb = item % nblk, k0 = 64 * kb, n0 = 32 * nb;
#pragma unroll 8
    for (int i = 0; i < 32; ++i) { const int kk = 2 * i + (lane >> 5); float w = W[(size_t)(k0 + kk) * N + n0 + (lane & 31)]; if (gk) w *= gk[k0 + kk]; scr[kk * 33 + (lane & 31)] = w; }
    LDS_WAIT(); asm volatile("" ::: "memory");
    const int c = lane & 7;
#pragma unroll
    for (int j = 0; j < 4; ++j) { const int n = (lane >> 3) + 8 * j; const LAS float* s = scr + (8 * c) * 33 + n;
        v4u o; if (F16OUT) {
#define W8(v) __builtin_bit_cast(float, f2bf(v) << 16)
            o.x = pkh2(W8(s[0 * 33]), W8(s[1 * 33])); o.y = pkh2(W8(s[2 * 33]), W8(s[3 * 33])); o.z = pkh2(W8(s[4 * 33]), W8(s[5 * 33])); o.w = pkh2(W8(s[6 * 33]), W8(s[7 * 33]));
#undef W8
        }
        else { o.x = pk2(s[0 * 33], s[1 * 33]); o.y = pk2(s[2 * 33], s[3 * 33]); o.z = pk2(s[4 * 33], s[5 * 33]); o.w = pk2(s[6 * 33], s[7 * 33]); }
        const int dr = UPMAP ? up_row_map(n0 + n) : (n0 + n);
        *(v4u*)(WT + (size_t)dr * K + k0 + 8 * c) = o; }
    LDS_WAIT(); asm volatile("" ::: "memory");
}
template <bool OUTF32> __device__ __forceinline__ void rms_row(const float* xrow, const float* g, void* orow, int lane) {
    const f32x4* xr = (const f32x4*)xrow + lane;
    f32x4 v[4]; float s = 0.f;
#pragma unroll
    for (int j = 0; j < 4; ++j) { v[j] = xr[64 * j]; s += (v[j].x * v[j].x + v[j].y * v[j].y) + (v[j].z * v[j].z + v[j].w * v[j].w); }
    const float rstd = 1.0f / sqrtf(wave_sum(s, lane) * (1.f / DM) + EPS);
#pragma unroll
    for (int j = 0; j < 4; ++j) { const f32x4 gg = ((const f32x4*)g)[lane + 64 * j]; const f32x4 o = v[j] * rstd * gg;
        if (OUTF32) ((f32x4*)orow)[lane + 64 * j] = o;
        else ((unsigned long long*)orow)[lane + 64 * j] = (unsigned long long)pk2(o.x, o.y) | ((unsigned long long)pk2(o.z, o.w) << 32); }
}
__device__ __forceinline__ void sgu_unit(LAS unsigned char* lds, bf16* U, bf16* UO, const bf16* V, const float* VST, const bf16* Wsb, const float* bs, const float* lng, const float* lnb, size_t row0, int tid, int lane, int wave) {
    LAS float* st = (LAS float*)lds;
    LAS unsigned char* vt0 = lds + 1024;
    constexpr int VTB = 128 * 272;
    { const int r = tid >> 2, q = tid & 3; const f32x4* vp = (const f32x4*)(VST + (row0 + r) * 32 + q * 8);
      const f32x4 a = vp[0], c = vp[1];
      float sm = (a[0] + a[2]) + (c[0] + c[2]), sq = (a[1] + a[3]) + (c[1] + c[3]);
      sm += bperm(sm, lane ^ 1); sq += bperm(sq, lane ^ 1); sm += bperm(sm, lane ^ 2); sq += bperm(sq, lane ^ 2);
      const float mean = sm * (1.f / DM); float var = sq * (1.f / DM) - mean * mean; var = var > 0.f ? var : 0.f;
      if (q == 0) { st[2 * r] = mean; st[2 * r + 1] = 1.0f / sqrtf(var + EPS); } }
    __syncthreads();
    const int cg8 = tid & 15, rp = tid >> 4, fr = lane & 15, fq = lane >> 4;
    const int ksmax = (wave * 16 + 15) >> 5;
    const int t = 16 * wave + fr;
    float mu[4], rsd[4];
#pragma unroll
    for (int rr = 0; rr < 4; ++rr) { mu[rr] = st[2 * (4 * rp + rr)]; rsd[rr] = st[2 * (4 * rp + rr) + 1]; }
    v4u vraw[4]; bf16x8 bw[4]; v2u uraw[8]; f32x4 gm[2], bt[2]; float bias;
#define SGU_LOAD(g) do { \
        _Pragma("unroll") for (int rr = 0; rr < 4; ++rr) vraw[rr] = *(const v4u*)(V + (row0 + 4 * rp + rr) * DM + (g) * 128 + 8 * cg8); \
        gm[0] = *(const f32x4*)(lng + (g) * 128 + 8 * cg8); gm[1] = *(const f32x4*)(lng + (g) * 128 + 8 * cg8 + 4); bt[0] = *(const f32x4*)(lnb + (g) * 128 + 8 * cg8); bt[1] = *(const f32x4*)(lnb + (g) * 128 + 8 * cg8 + 4); \
        _Pragma("unroll") for (int ks = 0; ks < 4; ++ks) bw[ks] = *(const bf16x8*)(Wsb + (size_t)(g) * 16384 + (16 * wave + fr) * 128 + fq * 8 + ks * 32); \
        _Pragma("unroll") for (int cb = 0; cb < 8; ++cb) uraw[cb] = *(const v2u*)(U + (row0 + t) * DM + (g) * 128 + 16 * cb + 4 * fq); \
        bias = bs[(g) * 128 + t]; } while (0)
    SGU_LOAD(0);
#pragma unroll 1
    for (int g = 0; g < 8; ++g) {
        LAS unsigned char* vt = vt0 + (g & 1) * VTB;
        { float nv[4][8];
#pragma unroll
          for (int rr = 0; rr < 4; ++rr) { const v4u raw = vraw[rr]; const float mean = mu[rr], rstd = rsd[rr];
              nv[rr][0] = (blo(raw.x) - mean) * rstd * gm[0][0] + bt[0][0]; nv[rr][1] = (bhi(raw.x) - mean) * rstd * gm[0][1] + bt[0][1];
              nv[rr][2] = (blo(raw.y) - mean) * rstd * gm[0][2] + bt[0][2]; nv[rr][3] = (bhi(raw.y) - mean) * rstd * gm[0][3] + bt[0][3];
              nv[rr][4] = (blo(raw.z) - mean) * rstd * gm[1][0] + bt[1][0]; nv[rr][5] = (bhi(raw.z) - mean) * rstd * gm[1][1] + bt[1][1];
              nv[rr][6] = (blo(raw.w) - mean) * rstd * gm[1][2] + bt[1][2]; nv[rr][7] = (bhi(raw.w) - mean) * rstd * gm[1][3] + bt[1][3]; }
#pragma unroll
          for (int j = 0; j < 8; ++j) { v2u w; w.x = pk2(nv[0][j], nv[1][j]); w.y = pk2(nv[2][j], nv[3][j]); *(LAS v2u*)(vt + (8 * cg8 + j) * 272 + rp * 8) = w; } }
        bf16x8 bwc[4]; v2u uc[8]; const float biasc = bias;
#pragma unroll
        for (int ks = 0; ks < 4; ++ks) bwc[ks] = bw[ks];
#pragma unroll
        for (int cb = 0; cb < 8; ++cb) uc[cb] = uraw[cb];
        __syncthreads();
        if (g < 7) SGU_LOAD(g + 1);
        f32x4 acc[8];
#pragma unroll
        for (int cb = 0; cb < 8; ++cb) acc[cb] = (f32x4){0.f, 0.f, 0.f, 0.f};
#pragma unroll
        for (int ks = 0; ks < 4; ++ks) if (ks <= ksmax) {
#pragma unroll
            for (int cb = 0; cb < 8; ++cb) { const bf16x8 av = *(const LAS bf16x8*)(vt + (16 * cb + fr) * 272 + (ks * 32 + fq * 8) * 2);
                acc[cb] = __builtin_amdgcn_mfma_f32_16x16x32_bf16(av, bwc[ks], acc[cb], 0, 0, 0); } }
#pragma unroll
        for (int cb = 0; cb < 8; ++cb) { bf16* up = UO + (row0 + t) * DM + g * 128 + 16 * cb + 4 * fq; const v2u uu = uc[cb];
            v2u w; w.x = pk2(blo(uu.x) * (acc[cb][0] + biasc), bhi(uu.x) * (acc[cb][1] + biasc)); w.y = pk2(blo(uu.y) * (acc[cb][2] + biasc), bhi(uu.y) * (acc[cb][3] + biasc));
            *(v2u*)up = w; }
    }
#undef SGU_LOAD
    __syncthreads();
}

struct Args { const float* in[27]; float* out; unsigned char* ws; };

#define PH() \
    const Args* ap; { auto kp_ = __builtin_amdgcn_kernarg_segment_ptr(); asm volatile("" : "+s"(kp_)); ap = (const Args*)kp_; } \
    int tid_o = threadIdx.x, bx_o = blockIdx.x, G_o = gridDim.x; asm volatile("" : "+v"(tid_o)); asm volatile("" : "+s"(bx_o), "+s"(G_o)); \
    const int tid = tid_o, bx = bx_o, G = G_o, lane = tid & 63, wave = __builtin_amdgcn_readfirstlane(tid >> 6); \
    const int gw = bx * NWAVES + wave, NGW = G * NWAVES; const size_t gt = (size_t)bx * NTHREADS + tid, NGT = (size_t)G * NTHREADS; \
    unsigned char* const ws = ap->ws; float* const X = ap->out; bf16* const H = (bf16*)(ws + WS_H); bf16* const Z = (bf16*)(ws + WS_Z); \
    bf16 *const ZU = Z, *const ZV = Z + ZS, *const ZQ = Z + 2 * ZS, *const ZK = Z + 3 * ZS, *const ZVA = Z + 4 * ZS, *const ZGA = Z + 5 * ZS, *const ZGB = Z + 6 * ZS; \
    bf16 *const O1 = (bf16*)(ws + WS_O1), *const O2 = (bf16*)(ws + WS_O2), *const ACT = (bf16*)(ws + WS_ACT), *const EB = (bf16*)(ws + WS_E), *const PBF = (bf16*)(ws + WS_PBF); \
    float* const EDGE = (float*)(ws + WS_EDGE); unsigned char* const wl = ws + WS_W + (size_t)l * W_LAYER; bf16* const XBB = (bf16*)(ws + WS_XBB); float* const SS = (float*)(ws + WS_SS); (void)XBB; (void)SS; \
    (void)lane; (void)gw; (void)NGW; (void)gt; (void)NGT; (void)X; (void)H; (void)ZU; (void)ZV; (void)ZQ; (void)ZK; (void)ZVA; (void)ZGA; (void)ZGB; (void)O1; (void)O2; (void)ACT; (void)EB; (void)PBF; (void)EDGE; (void)wl

#define RLX_AGENT __ATOMIC_RELAXED, __HIP_MEMORY_SCOPE_AGENT
#define XB_TMO      128
#define XB_XCNT(j)  (256  + 64 * (j))
#define XB_XSUB(j)  (1280 + 64 * (j))
#define XB_XGEN(j)  (2304 + 64 * (j))
#define XB_TOP      3328
#define XB_TOPGEN   3392
#define XCD_BAR_WORDS 3456
#define XB_SPIN_CAP (1u << 18)

__device__ __forceinline__ unsigned xb_ld(unsigned* p)              { return __hip_atomic_load(p, __ATOMIC_RELAXED, __HIP_MEMORY_SCOPE_AGENT); }
__device__ __forceinline__ unsigned xb_add(unsigned* p, unsigned v) { return __hip_atomic_fetch_add(p, v, __ATOMIC_RELAXED, __HIP_MEMORY_SCOPE_AGENT); }
__device__ __forceinline__ unsigned xb_xcc_id() { return (unsigned)__builtin_amdgcn_s_getreg((3 << 11) | 20) & 0xFu; }
#define XB_SPIN(cond, bar) do { unsigned _sp = 0; while (cond) { __builtin_amdgcn_s_sleep(1); \
    if ((++_sp & 255u) == 0u) { if (xb_ld(&(bar)[XB_TMO])) break; if (_sp > XB_SPIN_CAP) { atomicAdd(&(bar)[XB_TMO], 1u); break; } } } } while (0)

__device__ __forceinline__ void xcd_barrier_complete(unsigned* bar, unsigned x, unsigned& nloc, unsigned& nx) {
    const unsigned G = gridDim.x * gridDim.y * gridDim.z;
    unsigned sum, cnt, mine, sp = 0u;
    for (;;) {
        sum = 0u; cnt = 0u; mine = 0u;
#pragma unroll
        for (unsigned j = 0; j < 16; ++j) { const unsigned c = xb_ld(&bar[XB_XCNT(j)]); sum += c; cnt += (c > 0u) ? 1u : 0u; mine = (j == x) ? c : mine; }
        if (sum == G) break;
        __builtin_amdgcn_s_sleep(1);
        if ((++sp & 255u) == 0u) { if (xb_ld(&bar[XB_TMO])) break; if (sp > XB_SPIN_CAP) { atomicAdd(&bar[XB_TMO], 1u); break; } }
    }
    nloc = mine > 0u ? mine : 1u; nx = cnt > 0u ? cnt : 1u;
}

__device__ __forceinline__ void xcd_barrier(unsigned* const bar_, volatile LAS unsigned* const st_) {
    struct { unsigned* bar; unsigned x; volatile LAS unsigned* st; } b; b.bar = bar_; b.x = xb_xcc_id(); b.st = st_;
    asm volatile("s_waitcnt vmcnt(0)" ::: "memory");
    __syncthreads();
    if (threadIdx.x == 0) {
        unsigned* bar = b.bar;
        __builtin_amdgcn_s_waitcnt(0);
        unsigned nloc = b.st[0], nx = b.st[1];
        if (nloc == 0u) { xcd_barrier_complete(bar, b.x, nloc, nx); b.st[0] = nloc; b.st[1] = nx; }
        const unsigned old = xb_add(&bar[XB_XSUB(b.x)], 1u);
        const unsigned gen = old / nloc;
        if (old + 1u == (gen + 1u) * nloc) {
            __builtin_amdgcn_fence(__ATOMIC_RELEASE, "agent");
            asm volatile("s_waitcnt vmcnt(0)" ::: "memory");
            const unsigned og = xb_add(&bar[XB_TOP], 1u);
            const unsigned tg = og / nx;
            if (og + 1u == (tg + 1u) * nx) xb_add(&bar[XB_TOPGEN], 1u);
            else XB_SPIN(xb_ld(&bar[XB_TOPGEN]) == tg, bar);
            __builtin_amdgcn_fence(__ATOMIC_ACQUIRE, "agent");
            xb_add(&bar[XB_XGEN(b.x)], 1u);
            asm volatile("s_waitcnt vmcnt(0)" ::: "memory");
        } else {
            XB_SPIN(xb_ld(&bar[XB_XGEN(b.x)]) == gen, bar);
            __builtin_amdgcn_fence(__ATOMIC_ACQUIRE, "agent");
            asm volatile("s_waitcnt vmcnt(0)" ::: "memory");
        }
    }
    __syncthreads();
}

__device__ __forceinline__ void ctr_grid_sync(unsigned* ctr, unsigned target) {
    asm volatile("s_waitcnt vmcnt(0) lgkmcnt(0)" ::: "memory");
    __syncthreads();
    if (threadIdx.x == 0) {
        __builtin_amdgcn_fence(__ATOMIC_RELEASE, "agent");
        asm volatile("s_waitcnt vmcnt(0)" ::: "memory");
        __hip_atomic_fetch_add(ctr, 1u, __ATOMIC_RELAXED, __HIP_MEMORY_SCOPE_AGENT);
        while (__hip_atomic_load(ctr, __ATOMIC_RELAXED, __HIP_MEMORY_SCOPE_AGENT) < target) __builtin_amdgcn_s_sleep(2);
    }
    __syncthreads();
    __builtin_amdgcn_fence(__ATOMIC_ACQUIRE, "agent");
    asm volatile("s_waitcnt vmcnt(0)" ::: "memory");
}
#define GRID_SYNC1() do { const Args* ap_s; { auto kp_ = __builtin_amdgcn_kernarg_segment_ptr(); asm volatile("" : "+s"(kp_)); ap_s = (const Args*)kp_; } xcd_barrier((unsigned*)(ap_s->ws + 4096), (volatile LAS unsigned*)(ldsl + LDS_BYTES - 16)); } while (0)
#ifndef DBG_REP_SYNC
#define DBG_REP_SYNC 0
#endif
#define GRID_SYNC() do { GRID_SYNC1(); if (DBG_REP_SYNC) GRID_SYNC1(); } while (0)
#ifndef DBG_REP_ATTN
#define DBG_REP_ATTN 0
#endif
#ifndef DBG_REP_IN
#define DBG_REP_IN 0
#endif
#ifndef DBG_REP_UP
#define DBG_REP_UP 0
#endif
#ifndef DBG_REP_PRO
#define DBG_REP_PRO 0
#endif
#ifndef DBG_REP_COMB
#define DBG_REP_COMB 0
#endif
#ifndef DBG_REP_P4
#define DBG_REP_P4 0
#endif
#ifndef DBG_REP_RES
#define DBG_REP_RES 0
#endif
#ifndef DBG_REP_SGU
#define DBG_REP_SGU 0
#endif
#ifndef DBG_REP_INNULL
#define DBG_REP_INNULL 0
#endif
#ifndef DBG_TIME
#define DBG_TIME 0
#endif
#ifndef SELA
#define SELA 0x4
#endif
#ifndef SELB
#define SELB 0x2
#endif
#define TSTAMP(id) do { if (DBG_TIME && blockIdx.x == 0 && threadIdx.x == 0) { const Args* ap_t; { auto kp_ = __builtin_amdgcn_kernarg_segment_ptr(); asm volatile("" : "+s"(kp_)); ap_t = (const Args*)kp_; } \
    unsigned long long* tb = (unsigned long long*)(ap_t->ws + 64); const unsigned long long t_ = __builtin_amdgcn_s_memrealtime(); tb[1 + (id)] += t_ - tb[0]; tb[0] = t_; } } while (0)
__global__ void __launch_bounds__(NTHREADS, 2) fwd_kernel(Args a_unused) {
    extern __shared__ __attribute__((aligned(16))) unsigned char lds[];
    cg::grid_group grid = cg::this_grid();
    LAS unsigned char* ldsl = (LAS unsigned char*)lds;
    if (threadIdx.x == 0) { ((volatile LAS unsigned*)(ldsl + LDS_BYTES - 16))[0] = 0u; ((volatile LAS unsigned*)(ldsl + LDS_BYTES - 16))[1] = 0u;
        const Args* ap_s; { auto kp_ = __builtin_amdgcn_kernarg_segment_ptr(); asm volatile("" : "+s"(kp_)); ap_s = (const Args*)kp_; } (void)xb_add(&((unsigned*)(ap_s->ws + 4096))[XB_XCNT(xb_xcc_id())], 1u); }
    __syncthreads();
    if (DBG_TIME && blockIdx.x == 0 && threadIdx.x == 0) { const Args* ap_t; { auto kp_ = __builtin_amdgcn_kernarg_segment_ptr(); asm volatile("" : "+s"(kp_)); ap_t = (const Args*)kp_; } ((unsigned long long*)(ap_t->ws + 64))[0] = __builtin_amdgcn_s_memrealtime(); }
    grid.sync();

    for (int rep_ = 0; rep_ < (DBG_REP_PRO ? 2 : 1); ++rep_)
    {
        const int l = 0; PH();
        LAS float* scr = (LAS float*)(ldsl + wave * 16384);
        constexpr int I_IN = (DM / 64) * (NIN / 32), I_SQ = (DM / 64) * (DM / 32), I_UP = (DM / 64) * (NUP / 32), I_DN = (DFF / 64) * (DM / 32), I_PLE = (PLE / 64) * (DM / 32);
        constexpr int I_LAYER = I_IN + 4 * I_SQ + I_UP + I_DN + I_PLE;
        for (int it = gw; it < DEPTH * I_LAYER; it += NGW) {
            const int ll = it / I_LAYER; int r = it % I_LAYER; unsigned char* wll = ws + WS_W + (size_t)ll * W_LAYER;
            if (r < I_IN) { transpose_item<false, true>(ap->in[3] + (size_t)ll * DM * NIN, DM, NIN, (bf16*)(wll + WO_IN), scr, r, lane, ap->in[2] + (size_t)ll * DM); continue; } r -= I_IN;
            if (r < I_SQ) { transpose_item<false>(ap->in[14] + (size_t)ll * DM * DM, DM, DM, (bf16*)(wll + WO_PA), scr, r, lane); continue; } r -= I_SQ;
            if (r < I_SQ) { transpose_item<false>(ap->in[15] + (size_t)ll * DM * DM, DM, DM, (bf16*)(wll + WO_PB), scr, r, lane); continue; } r -= I_SQ;
            if (r < I_SQ) { transpose_item<false>(ap->in[16] + (size_t)ll * DM * DM, DM, DM, (bf16*)(wll + WO_O), scr, r, lane); continue; } r -= I_SQ;
            if (r < I_SQ) { transpose_item<false, true>(ap->in[23] + (size_t)ll * DM * DM, DM, DM, (bf16*)(wll + WO_PG), scr, r, lane, ap->in[22] + (size_t)ll * DM); continue; } r -= I_SQ;
            if (r < I_UP) { transpose_item<true, true>(ap->in[18] + (size_t)ll * DM * NUP, DM, NUP, (bf16*)(wll + WO_UP), scr, r, lane, ap->in[17] + (size_t)ll * DM); continue; } r -= I_UP;
            if (r < I_DN) { transpose_item<false>(ap->in[21] + (size_t)ll * DFF * DM, DFF, DM, (bf16*)(wll + WO_DOWN), scr, r, lane); continue; } r -= I_DN;
            transpose_item<false>(ap->in[25] + (size_t)ll * PLE * DM, PLE, DM, (bf16*)(wll + WO_PLE), scr, r, lane);
        }
        { const float* wsrc = ap->in[7];
          for (size_t i = gt; i < (size_t)DEPTH * 8 * 128 * 128; i += NGT) { const int ll = (int)(i >> 17), rem = (int)(i & 131071), t = (rem >> 7) & 127, sc = rem & 127;
              const float w = wsrc[i]; ((bf16*)(ws + WS_W + (size_t)ll * W_LAYER + WO_S))[rem] = (bf16)f2bf(sc <= t ? w : 0.f); } }
        { const float* xin = ap->in[0];
          for (int m = gw; m < M; m += NGW) { const f32x4* xr = (const f32x4*)(xin + (size_t)m * DM) + lane; float sq = 0.f;
#pragma unroll
              for (int j = 0; j < 4; ++j) { const f32x4 v = xr[64 * j]; sq += (v.x * v.x + v.y * v.y) + (v.z * v.z + v.w * v.w);
                  ((unsigned long long*)(H + (size_t)m * DM))[lane + 64 * j] = (unsigned long long)pkh2(v.x, v.y) | ((unsigned long long)pkh2(v.z, v.w) << 32); }
              sq = wave_sum(sq, lane); if (lane < 16) SS[(size_t)m * 16 + lane] = lane == 0 ? sq : 0.f; } }
    }
    GRID_SYNC(); TSTAMP(0);

#ifndef DBG_STOP
#define DBG_STOP 0
#endif
#define DBG_DUMP_BF16(buf) do { PH(); for (size_t i = gt; i < (size_t)M * DM; i += NGT) X[i] = blo((unsigned)(buf)[i % ((size_t)MH * DM)]); return; } while (0)
#define DBG_DUMP3(b0, b1, b2) do { PH(); for (size_t i = gt; i < (size_t)M * DM; i += NGT) { const size_t k = i % ((size_t)MH * DM); X[i] = blo((unsigned)(b0)[k]) + blo((unsigned)(b1)[k]) + blo((unsigned)(b2)[k]); } return; } while (0)
#define DBG_ZERO_UPPER() do { PH(); for (size_t i = gt; i < (size_t)MH * DM; i += NGT) X[(size_t)MH * DM + i] = 0.f; return; } while (0)
#pragma unroll 1
    for (int l = 0; l < DEPTH; ++l) {
#pragma unroll 1
        for (int hf = 0; hf < 2; ++hf) {
            if (DBG_REP_INNULL) { PH(); pg8::Gemm g{H + (size_t)hf * MH * DM, (const bf16*)(wl + WO_IN), MH, NIN, DM}; pg8::StaticOrder S; S.init(MH, NIN, G, bx); pg8::EpiNull E; pg8::gemm_phase<pg8::EpiNull, pg8::StaticOrder, true, true, true>(ldsl, g, S, E); }
            for (int rep_ = 0; rep_ < (DBG_REP_IN ? 2 : 1); ++rep_)
            { PH(); pg8::Gemm g{H + (size_t)hf * MH * DM, (const bf16*)(wl + WO_IN), MH, NIN, DM}; pg8::StaticOrder S; S.init(MH, NIN, G, bx);
              pg8::EpiIn E{Z, ZS, ap->in[4] + (size_t)l * 2 * DM, 0.125f * 1.4426950408889634f, SS + (size_t)(3 * l) * SSS + (size_t)hf * MH * 16, (float*)(ws + WS_VST)};
              pg8::gemm_phase<pg8::EpiIn, pg8::StaticOrder, true, true, true>(ldsl, g, S, E); }
            GRID_SYNC(); TSTAMP(1);
            if (DBG_STOP == 2) DBG_DUMP3(ZU, ZQ, ZGA);
            if (DBG_STOP == 12) DBG_DUMP3(ZV, ZK, ZGB);
            if (DBG_STOP == 22) DBG_DUMP3(ZVA, ZVA, ZVA);
            if (DBG_STOP == 1) DBG_DUMP3(H, H, H);
            if (DBG_STOP == 32) DBG_DUMP3(ZGA, ZGA, ZGA);
            if (DBG_STOP == 42) DBG_DUMP3(ZU, ZU, ZU);
            if (DBG_STOP == 52) DBG_DUMP3(ZQ, ZQ, ZQ);
            { PH();
              int l_o = l; asm volatile("" : "+s"(l_o));
              const float lam_init = 0.8f - 0.6f * expf(-0.3f * (float)l_o);
              const float s1 = wave_sum(ap->in[9][l * 64 + lane] * ap->in[10][l * 64 + lane], lane), s2 = wave_sum(ap->in[11][l * 64 + lane] * ap->in[12][l * 64 + lane], lane);
              const float lam = __builtin_bit_cast(float, __builtin_amdgcn_readfirstlane(__builtin_bit_cast(int, expf(s1) - expf(s2) + lam_init)));
              const float oscale = __builtin_bit_cast(float, __builtin_amdgcn_readfirstlane(__builtin_bit_cast(int, 1.0f - lam_init)));
              const float* gsub = ap->in[13] + l * 128;
              for (int p = bx; p < 1024; p += G) {
                  const int combo = p & 255, qi = p >> 8, b = combo & 7, r = combo >> 3, h = r >> 2, sq = r & 3;
                  const int qb = qi == 0 ? 15 - sq : qi == 1 ? 8 + sq : qi == 2 ? 7 - sq : sq;
#pragma unroll 1
                  for (int mp = 0; mp < 2; ++mp)
                  if (mp == 0) attn_body::attn_unit<8, false>(b, 2 * h, h, qb, (const attn_body::bf16*)ZQ, (const attn_body::bf16*)ZK, (const attn_body::bf16*)ZVA, (attn_body::bf16*)O1, nullptr, 0.f, 0.f, nullptr, (char*)lds);
                  else attn_body::attn_unit<8, true>(b, 2 * h + 1, h, qb, (const attn_body::bf16*)ZQ, (const attn_body::bf16*)ZK, (const attn_body::bf16*)ZVA, (attn_body::bf16*)O1, (attn_body::bf16*)ZQ, lam, oscale, gsub, (char*)lds); } }
            __syncthreads();
            { PH();
              const float* bs = ap->in[8] + (size_t)l * 1024; const float* lng = ap->in[5] + (size_t)l * DM; const float* lnb = ap->in[6] + (size_t)l * DM;
              for (int i = bx; i < MH / 128; i += G) sgu_unit(ldsl, ZU, ZU, ZV, (const float*)(ws + WS_VST), (const bf16*)(wl + WO_S), bs, lng, lnb, (size_t)i * 128, tid, lane, wave); }
            GRID_SYNC(); TSTAMP(2);
            if (DBG_STOP == 3) DBG_DUMP3(O1, O2, ZU);
            if (DBG_STOP == 13) DBG_DUMP3(O1, O2, O1);
            if (DBG_STOP == 23) DBG_DUMP3(ZU, ZU, ZU);
            for (int rep_ = 0; rep_ < (DBG_REP_P4 ? 2 : 1); ++rep_) {
            { PH(); pg8::StaticOrder S; S.init(MH, DM, G, bx);
              pg8::Gemm g{ZU, (const bf16*)(wl + WO_PA), MH, DM, DM}; pg8::EpiGate<false> E{ZGA, ZK}; pg8::gemm_phase<pg8::EpiGate<false>, pg8::StaticOrder, true, true>(ldsl, g, S, E); }
            { PH(); pg8::StaticOrder S; S.init(MH, DM, G, bx);
              pg8::Gemm g{ZQ, (const bf16*)(wl + WO_PB), MH, DM, DM}; pg8::EpiGate<true> E{ZGB, ZK}; pg8::gemm_phase<pg8::EpiGate<true>, pg8::StaticOrder, true, true>(ldsl, g, S, E); }
            }
            GRID_SYNC(); TSTAMP(4);
            if (DBG_STOP == 5) DBG_DUMP3(ZK, ZK, ZK);
            { PH(); pg8::Gemm g{ZK, (const bf16*)(wl + WO_O), MH, DM, DM}; pg8::StaticOrder S; S.init(MH, DM, G, bx);
              pg8::EpiResid<false> E{H + (size_t)hf * MH * DM, H + (size_t)hf * MH * DM, nullptr, nullptr, SS + (size_t)(3 * l + 1) * SSS + (size_t)hf * MH * 16, nullptr};
              if (DBG_REP_RES) { pg8::EpiResid<false> E0 = E; E0.ascale = 0.f; pg8::gemm_phase<pg8::EpiResid<false>, pg8::StaticOrder, true, true>(ldsl, g, S, E0); }
              pg8::gemm_phase<pg8::EpiResid<false>, pg8::StaticOrder, true, true>(ldsl, g, S, E); }
            GRID_SYNC(); TSTAMP(5);
            if (DBG_STOP == 6) DBG_ZERO_UPPER();
        }
        for (int rep_ = 0; rep_ < (DBG_REP_UP ? 2 : 1); ++rep_)
        { PH(); pg8::Gemm g{H, (const bf16*)(wl + WO_UP), M, NUP, DM}; pg8::StaticOrder S; S.init(M, NUP, G, bx);
          pg8::EpiConv E{ACT, EDGE, ap->in[19] + (size_t)l * 3 * NUP, ap->in[20] + (size_t)l * NUP, (LAS float*)(ldsl + XB_OFF), SS + (size_t)(3 * l + 1) * SSS};
          pg8::gemm_phase<pg8::EpiConv, pg8::StaticOrder, true, true, true>(ldsl, g, S, E); }
        GRID_SYNC(); TSTAMP(7);
        { PH(); const float* cw = ap->in[19] + (size_t)l * 3 * NUP; const float* cb = ap->in[20] + (size_t)l * NUP;
          for (size_t i = gt; i < (size_t)(M / 256) * pg8::NTC * 2 * 32; i += NGT) {
              const int c = (int)(i & 31) * 4, row = (int)((i >> 5) & 1), tile = (int)(i >> 6), pn = tile % pg8::NTC, pm = tile / pg8::NTC;
              const bool first = (pm % (SEQ / 256)) == 0; const int gcol = pn * 128 + c;
              const float* e1 = EDGE + (size_t)tile * 1024; const float* e0 = EDGE + (size_t)(first ? tile : tile - pg8::NTC) * 1024;
              f32x4 av[2];
#pragma unroll
              for (int q = 0; q < 2; ++q) { const int jc = q * 128 + c, col = q * DFF + gcol;
                  const f32x4 z4 = (f32x4){0.f, 0.f, 0.f, 0.f};
                  const f32x4 pm2 = first ? z4 : *(const f32x4*)(e0 + 2 * 256 + jc), pm1 = first ? z4 : *(const f32x4*)(e0 + 3 * 256 + jc), r0 = *(const f32x4*)(e1 + jc), r1 = *(const f32x4*)(e1 + 256 + jc);
                  const f32x4 w0 = *(const f32x4*)(cw + col), w1 = *(const f32x4*)(cw + NUP + col), w2 = *(const f32x4*)(cw + 2 * NUP + col), bb = *(const f32x4*)(cb + col);
                  av[q] = row == 0 ? (w0 * pm2 + w1 * pm1 + w2 * r0 + bb) : (w0 * pm1 + w1 * r0 + w2 * r1 + bb); }
              v2u w; w.x = pk2(pg8::gelu_tanh_f(av[0][0]) * av[1][0], pg8::gelu_tanh_f(av[0][1]) * av[1][1]); w.y = pk2(pg8::gelu_tanh_f(av[0][2]) * av[1][2], pg8::gelu_tanh_f(av[0][3]) * av[1][3]);
              *(v2u*)(ACT + (size_t)(pm * 256 + row) * DFF + gcol) = w; }
          const float* pl = ap->in[1] + (size_t)l * M * PLE;
          for (size_t i = gt; i < (size_t)M * PLE / 8; i += NGT) { const f32x4 v0 = ((const f32x4*)pl)[2 * i], v1 = ((const f32x4*)pl)[2 * i + 1];
              v4u w; w.x = pk2(v0.x, v0.y); w.y = pk2(v0.z, v0.w); w.z = pk2(v1.x, v1.y); w.w = pk2(v1.z, v1.w); ((v4u*)PBF)[i] = w; } }
        GRID_SYNC(); TSTAMP(8);
        { PH(); pg8::Gemm g{ACT, (const bf16*)(wl + WO_DOWN), M, DM, DFF}; pg8::StaticOrder S; S.init(M, DM, G, bx);
          pg8::EpiResid<false> E{H, XBB, nullptr, nullptr, SS + (size_t)(3 * l + 2) * SSS, nullptr};
          if (DBG_REP_RES) { pg8::EpiResid<false> E0 = E; E0.ascale = 0.f; pg8::gemm_phase<pg8::EpiResid<false>, pg8::StaticOrder, true, true>(ldsl, g, S, E0); }
          pg8::gemm_phase<pg8::EpiResid<false>, pg8::StaticOrder, true, true>(ldsl, g, S, E); }
        GRID_SYNC(); TSTAMP(9);
        { PH(); pg8::Gemm g{PBF, (const bf16*)(wl + WO_PLE), M, DM, PLE}; pg8::StaticOrder S; S.init(M, DM, G, bx);
          pg8::EpiStore E{EB, DM}; pg8::gemm_phase<pg8::EpiStore, pg8::StaticOrder, true, true>(ldsl, g, S, E); }
        { PH(); pg8::Gemm g{XBB, (const bf16*)(wl + WO_PG), M, DM, DM}; pg8::StaticOrder S; S.init(M, DM, G, bx);
          pg8::EpiResid<true> E{XBB, H, ap->in[24] + (size_t)l * DM, EB, SS + (size_t)(3 * l + 3) * SSS, SS + (size_t)(3 * l + 2) * SSS};
          if (DBG_REP_RES) { pg8::EpiResid<true> E0 = E; E0.ascale = 0.f; E0.XBO = XBB; pg8::gemm_phase<pg8::EpiResid<true>, pg8::StaticOrder, true, true, true>(ldsl, g, S, E0); }
          pg8::gemm_phase<pg8::EpiResid<true>, pg8::StaticOrder, true, true, true>(ldsl, g, S, E); }
        GRID_SYNC(); TSTAMP(11);
        if (l + 1 == DEPTH) { PH(); const float* gfin = ap->in[26];
            for (int m = gw; m < M; m += NGW) { const bf16* xr = H + (size_t)m * DM + 16 * lane; const v4u a0 = *(const v4u*)xr, a1 = *(const v4u*)(xr + 8);
                float f[16]; f[0] = pg8::h_lo(a0.x); f[1] = pg8::h_hi(a0.x); f[2] = pg8::h_lo(a0.y); f[3] = pg8::h_hi(a0.y); f[4] = pg8::h_lo(a0.z); f[5] = pg8::h_hi(a0.z); f[6] = pg8::h_lo(a0.w); f[7] = pg8::h_hi(a0.w);
                f[8] = pg8::h_lo(a1.x); f[9] = pg8::h_hi(a1.x); f[10] = pg8::h_lo(a1.y); f[11] = pg8::h_hi(a1.y); f[12] = pg8::h_lo(a1.z); f[13] = pg8::h_hi(a1.z); f[14] = pg8::h_lo(a1.w); f[15] = pg8::h_hi(a1.w);
                float sq = 0.f;
#pragma unroll
                for (int j = 0; j < 16; ++j) sq += f[j] * f[j];
                const float rstd = 1.0f / sqrtf(wave_sum(sq, lane) * (1.f / DM) + EPS);
                float* orow = X + (size_t)m * DM + 16 * lane;
#pragma unroll
                for (int j = 0; j < 4; ++j) { const f32x4 gg = *(const f32x4*)(gfin + 16 * lane + 4 * j); *(f32x4*)(orow + 4 * j) = (f32x4){f[4 * j] * rstd * gg[0], f[4 * j + 1] * rstd * gg[1], f[4 * j + 2] * rstd * gg[2], f[4 * j + 3] * rstd * gg[3]}; } } }
        if (DBG_TIME && l + 1 == DEPTH) { GRID_SYNC(); TSTAMP(12); GRID_SYNC();
            PH(); const unsigned long long* tb = (const unsigned long long*)(ws + 64); unsigned long long sa = 0, sb = 0;
            for (int k = 0; k < 13; ++k) { const unsigned long long v = __hip_atomic_load(tb + 1 + k, __ATOMIC_RELAXED, __HIP_MEMORY_SCOPE_AGENT); if ((SELA >> k) & 1) sa += v; if ((SELB >> k) & 1) sb += v; }
            const float fb = (float)(sa + sb) * 0.00001f;
            for (size_t i = gt; i < (size_t)16384 * DM; i += NGT) X[i] = fb; }
    }
}

extern "C" void kernel_launch(void* const* d_in, const int* in_sizes, int n_in, void* d_out, int out_size, void* d_ws, size_t ws_size, hipStream_t stream) {
    static int grid = 0;
    if (grid == 0) {
        if (n_in != 27 || out_size != M * DM || ws_size < WS_END) { fprintf(stderr, "kernel_launch: unexpected shapes (n_in %d out %d ws %zu)\n", n_in, out_size, ws_size); grid = -1; return; }
        int dev = 0, cus = 0, per_cu = 0;
        if (hipGetDevice(&dev) != hipSuccess || hipDeviceGetAttribute(&cus, hipDeviceAttributeMultiprocessorCount, dev) != hipSuccess) { grid = -1; return; }
        if (hipFuncSetAttribute((const void*)fwd_kernel, hipFuncAttributeMaxDynamicSharedMemorySize, LDS_BYTES) != hipSuccess) { fprintf(stderr, "kernel_launch: hipFuncSetAttribute failed\n"); grid = -1; return; }
        if (hipOccupancyMaxActiveBlocksPerMultiprocessor(&per_cu, (const void*)fwd_kernel, NTHREADS, LDS_BYTES) != hipSuccess || per_cu < 1) { fprintf(stderr, "kernel_launch: occupancy query gives %d\n", per_cu); per_cu = 1; }
        (void)hipGetLastError();
        grid = cus * per_cu;
    }
    if (grid < 0) return;
    if (hipMemsetAsync(d_ws, 0, 32768, stream) != hipSuccess) { fprintf(stderr, "kernel_launch: memset failed\n"); return; }
    Args a{};
    for (int i = 0; i < 27; ++i) a.in[i] = (const float*)d_in[i];
    a.out = (float*)d_out; a.ws = (unsigned char*)d_ws;
    void* args[] = {&a};
    hipError_t e = hipLaunchCooperativeKernel((const void*)fwd_kernel, dim3(grid), dim3(NTHREADS), args, LDS_BYTES, stream);
    if (e != hipSuccess) fprintf(stderr, "kernel_launch: cooperative launch failed: %s (grid %d)\n", hipGetErrorString(e), grid);
}
```

```cpp
#include <hip/hip_runtime.h>
#include <hip/hip_cooperative_groups.h>
#include <cstdio>
#include <cstdint>
namespace cg = cooperative_groups;
namespace pg8 {
#define PG8_LAS __attribute__((address_space(3)))
typedef unsigned short bf16_t;
typedef short bf16x8 __attribute__((ext_vector_type(8)));
typedef float f32x4 __attribute__((ext_vector_type(4)));
typedef unsigned u32x4 __attribute__((ext_vector_type(4)));
constexpr int BM = 256, BK = 64, HALF = 128, HTB = HALF * BK * 2  , STAGE_BYTES = 8 * HTB, NXCD = 8, WGM = 8;

__host__ __device__ __forceinline__ int lds_byte(int r, int c) { const int st = (r >> 4) * 2 + (c >> 5), rr = r & 15, cc = c & 31, ob = rr * 64 + cc * 2; return st * 1024 + (ob ^ (((ob >> 9) & 1) << 5)); }
__host__ __device__ __forceinline__ void stage_rc(int b, int& R, int& C) { const int st = b / 1024, sb = b % 1024, swz = sb ^ (((sb >> 9) & 1) << 5); R = (st >> 1) * 16 + swz / 64; C = (st & 1) * 32 + (swz % 64) / 2; }
__host__ __device__ __forceinline__ int perm32(int rho) { const int n = rho >> 4, i = rho & 15; return 8 * (i >> 2) + 4 * n + (i & 3); }

struct Unit { int pm, pn; };
struct Gemm { const bf16_t* A; const bf16_t* Bt; int M, N, K; };

struct StaticOrder {
    int nM, nN, nwg, G, c;
    __host__ __device__ void init(int M, int N, int G_, int c_) { nM = M / BM; nN = N / BM; nwg = nM * nN; G = G_; c = c_; }
    __host__ __device__ bool next(int i, Unit& u) const {
        const long L = (long)i * G + c; if (L >= nwg) return false;
        int wgid = (int)L; { const int q = nwg / NXCD, r = nwg % NXCD, xcd = wgid % NXCD, off = wgid / NXCD; wgid = (xcd < r ? xcd * (q + 1) : r * (q + 1) + (xcd - r) * q) + off; }
        const int nig = WGM * nN, gid = wgid / nig, fm = gid * WGM, gsz = (nM - fm) < WGM ? (nM - fm) : WGM;
        u.pm = fm + ((wgid % nig) % gsz); u.pn = (wgid % nig) / gsz; return true;
    }
    __device__ __forceinline__ void a_ready(const Unit&) const {}
    __device__ __forceinline__ void done(const Unit&) const {}
};

typedef float cv_f32x2 __attribute__((ext_vector_type(2))); typedef __bf16 cv_bf16x2 __attribute__((ext_vector_type(2)));
__device__ __forceinline__ unsigned cvt_pk_bf16(float lo, float hi) { const cv_f32x2 v = {lo, hi}; const cv_bf16x2 b = __builtin_convertvector(v, cv_bf16x2); return __builtin_bit_cast(unsigned, b); }
typedef float f32x2 __attribute__((ext_vector_type(2)));
__device__ __forceinline__ f32x2 gelu_pk(f32x2 v) {
    const f32x2 av = __builtin_elementwise_abs(v), d = av * 0.2316418882f + 1.0f;
    f32x2 t; t.x = __builtin_amdgcn_rcpf(d.x); t.y = __builtin_amdgcn_rcpf(d.y);
    f32x2 q = t * 0.5307027145f + (-0.7265760135f); q = q * t + 0.7107068705f; q = q * t + (-0.142248368f); q = q * t + 0.127414796f; q = q * t;
    const f32x2 s = (v * v) * (-0.72134752044f);
    f32x2 e; e.x = __builtin_amdgcn_exp2f(s.x); e.y = __builtin_amdgcn_exp2f(s.y);
    const f32x2 m = v * (q * e), r = v - m;
    f32x2 o; o.x = v.x < 0.f ? m.x : r.x; o.y = v.y < 0.f ? m.y : r.y; return o;
}

template <int ACT  > struct EpiBf16 {
    static constexpr bool PERM = true, AFTER_DRAIN = false; static_assert(ACT == 0 || ACT == 1, "EpiBf16: ACT is 0 (none) or 1 (gelu_pk)");
    bf16_t* O; int ldc; const float* bias; int split_cols; size_t split_stride; float scale0;
    __device__ __forceinline__ void operator()(const f32x4 (&acc)[2][2][4][2], const Unit& u, int wr, int wc, int fr_, int fq_) const {
        int t_o = threadIdx.x; asm volatile("" : "+v"(t_o)); int fr = t_o & 15, fq = (t_o >> 4) & 3; (void)fr_; (void)fq_;

        const int row0 = u.pm * BM + wr * 64 + fr; int colt = u.pn * BM; bf16_t* base = O;
        float sc = 1.f; if (split_cols) { const int t = colt / split_cols; base += (size_t)t * split_stride; colt -= t * split_cols; if (t == 0) sc = scale0; }
        const int col0 = colt + wc * 32 + 8 * fq, bcol0 = u.pn * BM + wc * 32 + 8 * fq;
        f32x4 bv[2][2];
#pragma unroll
        for (int bj = 0; bj < 2; ++bj)
#pragma unroll
            for (int n = 0; n < 2; ++n) bv[bj][n] = bias ? *(const f32x4*)(bias + bcol0 + bj * HALF + 4 * n) : (f32x4){0.f, 0.f, 0.f, 0.f};
#pragma unroll
        for (int ai = 0; ai < 2; ++ai)
#pragma unroll
            for (int m = 0; m < 4; ++m) { bf16_t* rowp = base + (size_t)(row0 + ai * HALF + m * 16) * ldc + col0;
#pragma unroll
                for (int bj = 0; bj < 2; ++bj) { f32x4 v0 = acc[ai][bj][m][0] + bv[bj][0], v1 = acc[ai][bj][m][1] + bv[bj][1];
                    if (ACT == 1) { f32x2 a = gelu_pk((f32x2){v0[0], v0[1]}), b = gelu_pk((f32x2){v0[2], v0[3]}), c = gelu_pk((f32x2){v1[0], v1[1]}), d = gelu_pk((f32x2){v1[2], v1[3]});
                        v0 = (f32x4){a.x, a.y, b.x, b.y}; v1 = (f32x4){c.x, c.y, d.x, d.y}; }
                    v0 = v0 * sc; v1 = v1 * sc; u32x4 w; w.x = cvt_pk_bf16(v0[0], v0[1]); w.y = cvt_pk_bf16(v0[2], v0[3]); w.z = cvt_pk_bf16(v1[0], v1[1]); w.w = cvt_pk_bf16(v1[2], v1[3]);
                    *(u32x4*)(rowp + bj * HALF) = w; } }
    }
};
__device__ __forceinline__ float sigmoid_f(float x) { return __builtin_amdgcn_rcpf(1.0f + __builtin_amdgcn_exp2f(-1.4426950408889634f * x)); }
__device__ __forceinline__ float gelu_tanh_f(float x) { const float p = __builtin_fmaf(x * x, -0.10294324f, -2.3022082f); return x * __builtin_amdgcn_rcpf(1.0f + __builtin_amdgcn_exp2f(x * p)); }
__device__ __forceinline__ float bf_lo(unsigned w) { return __builtin_bit_cast(float, w << 16); }
__device__ __forceinline__ float bf_hi(unsigned w) { return __builtin_bit_cast(float, w & 0xffff0000u); }
typedef unsigned u32x2 __attribute__((ext_vector_type(2)));
typedef _Float16 h16x2 __attribute__((ext_vector_type(2)));
__device__ __forceinline__ float h_lo(unsigned w) { return (float)__builtin_bit_cast(h16x2, w)[0]; }
__device__ __forceinline__ float h_hi(unsigned w) { return (float)__builtin_bit_cast(h16x2, w)[1]; }
__device__ __forceinline__ unsigned cvt_pk_f16(float lo, float hi) { const h16x2 v = {(_Float16)lo, (_Float16)hi}; return __builtin_bit_cast(unsigned, v); }

__device__ __forceinline__ float rstd_row(const float* SSI, int row) { const f32x4* p = (const f32x4*)(SSI + (size_t)row * 16); const f32x4 a = p[0], b = p[1], c = p[2], d = p[3];
    const float s = ((a[0] + a[1]) + (a[2] + a[3])) + ((b[0] + b[1]) + (b[2] + b[3])) + ((c[0] + c[1]) + (c[2] + c[3])) + ((d[0] + d[1]) + (d[2] + d[3])); return __builtin_amdgcn_rsqf(s * (1.f / 1024.f) + 1e-6f); }
struct EpiIn {
    static constexpr bool PERM = true, AFTER_DRAIN = false;
    bf16_t* Z; size_t bufstride; const float* bgate; float qscale; const float* SSI; float* VST = nullptr;
    template <int MODE> __device__ __forceinline__ void body(const f32x4 (&acc)[2][2][4][2], bf16_t* base, const float* bias, int row0, int col0, int lane = 0, int slot = 0) const {
        f32x4 bv[2][2];
#pragma unroll
        for (int bj = 0; bj < 2; ++bj)
#pragma unroll
            for (int n = 0; n < 2; ++n) bv[bj][n] = (MODE == 3) ? *(const f32x4*)(bias + col0 + bj * HALF + 4 * n) : (f32x4){0.f, 0.f, 0.f, 0.f};
#pragma unroll
        for (int ai = 0; ai < 2; ++ai)
#pragma unroll
            for (int m = 0; m < 4; ++m) { bf16_t* rowp = base + (size_t)(row0 + ai * HALF + m * 16) * 1024 + col0;
                const float rs = rstd_row(SSI, row0 + ai * HALF + m * 16); float ps = 0.f, pq = 0.f;
#pragma unroll
                for (int bj = 0; bj < 2; ++bj) { f32x4 v0 = acc[ai][bj][m][0] * rs, v1 = acc[ai][bj][m][1] * rs;
                    if (MODE == 1 || MODE == 4) {
#pragma unroll
                        for (int x = 0; x < 4; ++x) { v0[x] = gelu_tanh_f(v0[x]); v1[x] = gelu_tanh_f(v1[x]); } }
                    if (MODE == 4) { ps += ((v0[0] + v0[1]) + (v0[2] + v0[3])) + ((v1[0] + v1[1]) + (v1[2] + v1[3]));
                        pq += ((v0[0] * v0[0] + v0[1] * v0[1]) + (v0[2] * v0[2] + v0[3] * v0[3])) + ((v1[0] * v1[0] + v1[1] * v1[1]) + (v1[2] * v1[2] + v1[3] * v1[3])); }
                    if (MODE == 2) { v0 = v0 * qscale; v1 = v1 * qscale; }
                    if (MODE == 3) { v0 = v0 + bv[bj][0]; v1 = v1 + bv[bj][1];
#pragma unroll
                        for (int x = 0; x < 4; ++x) { v0[x] = sigmoid_f(v0[x]); v1[x] = sigmoid_f(v1[x]); } }
                    u32x4 w; w.x = cvt_pk_bf16(v0[0], v0[1]); w.y = cvt_pk_bf16(v0[2], v0[3]); w.z = cvt_pk_bf16(v1[0], v1[1]); w.w = cvt_pk_bf16(v1[2], v1[3]);
                    *(u32x4*)(rowp + bj * HALF) = w; }
                if (MODE == 4) {
                    ps += __builtin_bit_cast(float, __builtin_amdgcn_ds_bpermute((lane ^ 16) << 2, __builtin_bit_cast(int, ps))); pq += __builtin_bit_cast(float, __builtin_amdgcn_ds_bpermute((lane ^ 16) << 2, __builtin_bit_cast(int, pq)));
                    ps += __builtin_bit_cast(float, __builtin_amdgcn_ds_bpermute((lane ^ 32) << 2, __builtin_bit_cast(int, ps))); pq += __builtin_bit_cast(float, __builtin_amdgcn_ds_bpermute((lane ^ 32) << 2, __builtin_bit_cast(int, pq)));
                    if ((lane >> 4) == 0) { float* vp = VST + (size_t)(row0 + ai * HALF + m * 16) * 32 + slot * 2; vp[0] = ps; vp[1] = pq; } }
                asm volatile("" ::: "memory"); }
    }
    __device__ __forceinline__ void operator()(const f32x4 (&acc)[2][2][4][2], const Unit& u, int wr, int wc, int fr_, int fq_) const {
        int t_o = threadIdx.x; asm volatile("" : "+v"(t_o)); int fr = t_o & 15, fq = (t_o >> 4) & 3; (void)fr_; (void)fq_;

        const int t = u.pn >> 2, colt = (u.pn & 3) * BM;
        bf16_t* base = Z + (size_t)t * bufstride;
        const int row0 = u.pm * BM + wr * 64 + fr, col0 = colt + wc * 32 + 8 * fq;
        if (t == 0) body<1>(acc, base, nullptr, row0, col0);
        else if (t == 1) body<4>(acc, base, nullptr, row0, col0, t_o & 63, (u.pn & 3) * 4 + wc);
        else if (t == 2) body<2>(acc, base, nullptr, row0, col0);
        else if (t < 5) body<0>(acc, base, nullptr, row0, col0);
        else body<3>(acc, base, bgate + (t - 5) * 1024, row0, col0);
    }
};
struct EpiNull {
    static constexpr bool PERM = true, AFTER_DRAIN = false;
    __device__ __forceinline__ void operator()(const f32x4 (&acc)[2][2][4][2], const Unit& u, int wr, int wc, int fr_, int fq_) const {
#pragma unroll
        for (int ai = 0; ai < 2; ++ai)
#pragma unroll
            for (int bj = 0; bj < 2; ++bj)
#pragma unroll
                for (int m = 0; m < 4; ++m)
#pragma unroll
                    for (int n = 0; n < 2; ++n) asm volatile("" :: "v"(acc[ai][bj][m][n]));
    }
};
struct EpiStore {
    static constexpr bool PERM = true, AFTER_DRAIN = false;
    bf16_t* O; int ldc;
    __device__ __forceinline__ void operator()(const f32x4 (&acc)[2][2][4][2], const Unit& u, int wr, int wc, int fr_, int fq_) const {
        int t_o = threadIdx.x; asm volatile("" : "+v"(t_o)); int fr = t_o & 15, fq = (t_o >> 4) & 3; (void)fr_; (void)fq_;

        const int row0 = u.pm * BM + wr * 64 + fr, col0 = u.pn * BM + wc * 32 + 8 * fq;
#pragma unroll
        for (int ai = 0; ai < 2; ++ai)
#pragma unroll
            for (int m = 0; m < 4; ++m) { bf16_t* rowp = O + (size_t)(row0 + ai * HALF + m * 16) * ldc + col0;
#pragma unroll
                for (int bj = 0; bj < 2; ++bj) { const f32x4 v0 = acc[ai][bj][m][0], v1 = acc[ai][bj][m][1];
                    u32x4 w; w.x = cvt_pk_bf16(v0[0], v0[1]); w.y = cvt_pk_bf16(v0[2], v0[3]); w.z = cvt_pk_bf16(v1[0], v1[1]); w.w = cvt_pk_bf16(v1[2], v1[3]);
                    *(u32x4*)(rowp + bj * HALF) = w; } }
    }
};
template <bool ADD> struct EpiGate {
    static constexpr bool PERM = true, AFTER_DRAIN = false;
    const bf16_t* G; bf16_t* MG;
    __device__ __forceinline__ void operator()(const f32x4 (&acc)[2][2][4][2], const Unit& u, int wr, int wc, int fr_, int fq_) const {
        int t_o = threadIdx.x; asm volatile("" : "+v"(t_o)); int fr = t_o & 15, fq = (t_o >> 4) & 3; (void)fr_; (void)fq_;

        const int row0 = u.pm * BM + wr * 64 + fr, col0 = u.pn * BM + wc * 32 + 8 * fq;
#pragma unroll
        for (int ai = 0; ai < 2; ++ai)
#pragma unroll
            for (int m = 0; m < 4; ++m) { const size_t off = (size_t)(row0 + ai * HALF + m * 16) * 1024 + col0;
#pragma unroll
                for (int bj = 0; bj < 2; ++bj) { const f32x4 v0 = acc[ai][bj][m][0], v1 = acc[ai][bj][m][1];
                    const u32x4 g = *(const u32x4*)(G + off + bj * HALF);
                    float r[8];
                    r[0] = bf_lo(g.x) * v0[0]; r[1] = bf_hi(g.x) * v0[1]; r[2] = bf_lo(g.y) * v0[2]; r[3] = bf_hi(g.y) * v0[3];
                    r[4] = bf_lo(g.z) * v1[0]; r[5] = bf_hi(g.z) * v1[1]; r[6] = bf_lo(g.w) * v1[2]; r[7] = bf_hi(g.w) * v1[3];
                    if (ADD) { const u32x4 o = *(const u32x4*)(MG + off + bj * HALF);
                        r[0] += bf_lo(o.x); r[1] += bf_hi(o.x); r[2] += bf_lo(o.y); r[3] += bf_hi(o.y); r[4] += bf_lo(o.z); r[5] += bf_hi(o.z); r[6] += bf_lo(o.w); r[7] += bf_hi(o.w); }
                    u32x4 w; w.x = cvt_pk_bf16(r[0], r[1]); w.y = cvt_pk_bf16(r[2], r[3]); w.z = cvt_pk_bf16(r[4], r[5]); w.w = cvt_pk_bf16(r[6], r[7]);
                    *(u32x4*)(MG + off + bj * HALF) = w; }
                asm volatile("" ::: "memory"); }
    }
};
template <bool PLE> struct EpiResid {
    static constexpr bool PERM = false, AFTER_DRAIN = false;
    const bf16_t* XIB; bf16_t* XBO; const float* bias; const bf16_t* E;
    float* SSO; const float* SSI;
    float ascale = 1.f;
    __device__ __forceinline__ void operator()(const f32x4 (&acc)[2][2][4][2], const Unit& u, int wr, int wc, int fr_, int fq_) const {
        int t_o = threadIdx.x; asm volatile("" : "+v"(t_o)); int fr = t_o & 15, fq = (t_o >> 4) & 3; (void)fr_; (void)fq_;
        const int lane = t_o & 63;
        const int col0 = u.pn * BM + wc * 32 + 4 * fq;
        constexpr int MG = PLE ? 2 : 4;
#pragma unroll
        for (int ai = 0; ai < 2; ++ai)
#pragma unroll
        for (int m0 = 0; m0 < 4; m0 += MG) {
            u32x2 xi[4][2][2]; u32x2 ev[4][2][2]; float rs[4];
#pragma unroll
            for (int m = m0; m < m0 + MG; ++m) { const int row = u.pm * BM + ai * HALF + wr * 64 + m * 16 + fr; const size_t off = (size_t)row * 1024 + col0;
                rs[m] = 1.f; if (PLE) rs[m] = rstd_row(SSI, row);
#pragma unroll
                for (int bj = 0; bj < 2; ++bj)
#pragma unroll
                    for (int n = 0; n < 2; ++n) { const size_t o2 = off + bj * HALF + n * 16; xi[m][bj][n] = *(const u32x2*)(XIB + o2); if (PLE) ev[m][bj][n] = *(const u32x2*)(E + o2); } }
#pragma unroll
            for (int m = m0; m < m0 + MG; ++m) { const int row = u.pm * BM + ai * HALF + wr * 64 + m * 16 + fr; const size_t off = (size_t)row * 1024 + col0;
                float q = 0.f;
#pragma unroll
                for (int bj = 0; bj < 2; ++bj)
#pragma unroll
                    for (int n = 0; n < 2; ++n) { const size_t o2 = off + bj * HALF + n * 16; f32x4 a = acc[ai][bj][m][n];
                        if (PLE) { const f32x4 bv = *(const f32x4*)(bias + col0 + bj * HALF + n * 16); const u32x2 e = ev[m][bj][n]; a = a * rs[m] + bv;
                            a[0] = sigmoid_f(a[0]) * bf_lo(e.x); a[1] = sigmoid_f(a[1]) * bf_hi(e.x); a[2] = sigmoid_f(a[2]) * bf_lo(e.y); a[3] = sigmoid_f(a[3]) * bf_hi(e.y); }
                        const u32x2 xo = xi[m][bj][n];
                        const f32x4 xn = (f32x4){h_lo(xo.x), h_hi(xo.x), h_lo(xo.y), h_hi(xo.y)} + a * ascale;
                        u32x2 w; w.x = cvt_pk_f16(xn[0], xn[1]); w.y = cvt_pk_f16(xn[2], xn[3]); *(u32x2*)(XBO + o2) = w;
                        q += (xn[0] * xn[0] + xn[1] * xn[1]) + (xn[2] * xn[2] + xn[3] * xn[3]); }
                q += __builtin_bit_cast(float, __builtin_amdgcn_ds_bpermute((lane ^ 16) << 2, __builtin_bit_cast(int, q)));
                q += __builtin_bit_cast(float, __builtin_amdgcn_ds_bpermute((lane ^ 32) << 2, __builtin_bit_cast(int, q)));
                if (fq == 0) SSO[(size_t)row * 16 + u.pn * 4 + wc] = q; }
            asm volatile("" ::: "memory"); }
    }
};
constexpr int FFC = 2816, NTC = FFC / 128;
struct EpiConv {
    static constexpr bool PERM = true, AFTER_DRAIN = false;
    bf16_t* ACT; float* EDGE; const float* cw; const float* cb; PG8_LAS float* xb; const float* SSI;
    __device__ __forceinline__ void operator()(f32x4 (&acc)[2][2][4][2], const Unit& u, int wr, int wc, int fr_, int fq_) const {
        int t_o = threadIdx.x; asm volatile("" : "+v"(t_o)); int fr = t_o & 15, fq = (t_o >> 4) & 3; (void)fr_; (void)fq_;

        const int lane = t_o & 63;
        const int jc0 = wc * 32 + 8 * fq;
        { PG8_LAS float* rtab = xb + 2048; const int tt = t_o & 511;
          if (tt < 256) rtab[tt] = rstd_row(SSI, u.pm * BM + tt);
          asm volatile("s_waitcnt lgkmcnt(0)" ::: "memory"); __builtin_amdgcn_s_barrier(); asm volatile("" ::: "memory");
#pragma unroll
          for (int ai = 0; ai < 2; ++ai)
#pragma unroll
            for (int m = 0; m < 4; ++m) { const float rs = rtab[ai * HALF + wr * 64 + m * 16 + fr];
#pragma unroll
                for (int bj = 0; bj < 2; ++bj)
#pragma unroll
                    for (int n = 0; n < 2; ++n) acc[ai][bj][m][n] = acc[ai][bj][m][n] * rs; } }
        if (fr >= 14) {
#pragma unroll
            for (int ai = 0; ai < 2; ++ai)
#pragma unroll
                for (int bj = 0; bj < 2; ++bj)
#pragma unroll
                    for (int n = 0; n < 2; ++n) *(PG8_LAS f32x4*)(xb + (((ai * 2 + wr) * 2 + (fr - 14)) * 256 + bj * HALF + jc0 + 4 * n)) = acc[ai][bj][3][n];
        }
        float* eb = EDGE + (size_t)(u.pm * NTC + u.pn) * 4 * 256;
        if (wr == 0 && fr < 2) {
#pragma unroll
            for (int bj = 0; bj < 2; ++bj)
#pragma unroll
                for (int n = 0; n < 2; ++n) *(f32x4*)(eb + fr * 256 + bj * HALF + jc0 + 4 * n) = acc[0][bj][0][n];
        }
        if (wr == 1 && fr >= 14) {
#pragma unroll
            for (int bj = 0; bj < 2; ++bj)
#pragma unroll
                for (int n = 0; n < 2; ++n) *(f32x4*)(eb + (2 + fr - 14) * 256 + bj * HALF + jc0 + 4 * n) = acc[1][bj][3][n];
        }
        asm volatile("s_waitcnt lgkmcnt(0)" ::: "memory"); __builtin_amdgcn_s_barrier(); asm volatile("" ::: "memory");
        const int src1 = (lane & 48) | ((fr + 15) & 15), src2 = (lane & 48) | ((fr + 14) & 15);
#pragma unroll
        for (int bj = 0; bj < 2; ++bj)
#pragma unroll
            for (int n = 0; n < 2; ++n) {
                const int gc = bj * FFC + u.pn * 128 + jc0 + 4 * n;
                const f32x4 w0 = *(const f32x4*)(cw + gc), w1 = *(const f32x4*)(cw + 2 * FFC + gc), w2 = *(const f32x4*)(cw + 4 * FFC + gc), bb = *(const f32x4*)(cb + gc);
#pragma unroll
                for (int ai = 0; ai < 2; ++ai) {
                    const int grp = ai * 2 + wr;
                    f32x4 xp = (f32x4){0.f, 0.f, 0.f, 0.f};
                    if (grp > 0 && fr >= 14) xp = *(const PG8_LAS f32x4*)(xb + (((grp - 1) * 2 + (fr - 14)) * 256 + bj * HALF + jc0 + 4 * n));
#pragma unroll
                    for (int m = 3; m >= 0; --m) {
                        f32x4 cur = acc[ai][bj][m][n]; f32x4 prv = (m > 0) ? acc[ai][bj][m > 0 ? m - 1 : 0][n] : xp;
                        asm volatile("" : "+v"(cur), "+v"(prv));
                        f32x4 r;
#pragma unroll
                        for (int x = 0; x < 4; ++x) {
                            const float s1 = (fr == 15) ? prv[x] : cur[x], s2 = (fr >= 14) ? prv[x] : cur[x];
                            const float p1 = __builtin_bit_cast(float, __builtin_amdgcn_update_dpp(0, __builtin_bit_cast(int, s1), 0x121, 0xf, 0xf, false)), p2 = __builtin_bit_cast(float, __builtin_amdgcn_update_dpp(0, __builtin_bit_cast(int, s2), 0x122, 0xf, 0xf, false));
                            r[x] = w0[x] * p2 + w1[x] * p1 + w2[x] * cur[x] + bb[x];
                        }
                        asm volatile("" : "+v"(r));
                        acc[ai][bj][m][n] = r;
                    }
                    __builtin_amdgcn_sched_barrier(0);
                }
                asm volatile("" ::: "memory");
            }
#pragma unroll
        for (int ai = 0; ai < 2; ++ai)
#pragma unroll
            for (int m = 0; m < 4; ++m) {
                const bool skip = (ai == 0 && wr == 0 && m == 0 && fr < 2);
                bf16_t* rowp = ACT + (size_t)(u.pm * BM + ai * HALF + wr * 64 + m * 16 + fr) * FFC + u.pn * 128 + jc0;
                const f32x4 g0 = acc[ai][0][m][0], g1 = acc[ai][0][m][1], v0 = acc[ai][1][m][0], v1 = acc[ai][1][m][1];
                float r[8];
#pragma unroll
                for (int x = 0; x < 4; ++x) { r[x] = gelu_tanh_f(g0[x]) * v0[x]; r[4 + x] = gelu_tanh_f(g1[x]) * v1[x]; }
                u32x4 w; w.x = cvt_pk_bf16(r[0], r[1]); w.y = cvt_pk_bf16(r[2], r[3]); w.z = cvt_pk_bf16(r[4], r[5]); w.w = cvt_pk_bf16(r[6], r[7]);
                if (!skip) *(u32x4*)rowp = w;
                asm volatile("" ::: "memory"); __builtin_amdgcn_sched_barrier(0);
            }
        asm volatile("s_waitcnt lgkmcnt(0)" ::: "memory"); __builtin_amdgcn_s_barrier(); asm volatile("" ::: "memory");
    }
};
typedef _Float16 f16x8 __attribute__((ext_vector_type(8)));
template <class Epi, class Sched, bool ALIGN_EPI = false, bool SP2 = false, bool F16 = false>
__device__ __forceinline__ void gemm_phase(PG8_LAS unsigned char* lds, const Gemm g, const Sched& S, const Epi& E) {
    int tid_o = threadIdx.x; asm volatile("" : "+v"(tid_o));
    const int tid = tid_o, wid = __builtin_amdgcn_readfirstlane(tid >> 6), lane = tid & 63, wr = wid >> 2, wc = wid & 3, fr = lane & 15, fq = lane >> 4;
    int K_o = g.K; asm volatile("" : "+s"(K_o)); const int K = K_o, nt = K / BK;
    unsigned voffA[2], voffB[2];
#pragma unroll
    for (int i = 0; i < 2; ++i) { int R, C; stage_rc(tid * 16 + i * 8192, R, C); const int Rb = Epi::PERM ? ((R & ~31) + perm32(R & 31)) : R;
        voffA[i] = (unsigned)(R * K + C) * 2u; voffB[i] = (unsigned)(Rb * K + C) * 2u; }
    const size_t kstep = (size_t)(BK * 2);
    const size_t hstep = (size_t)HALF * K * 2;
    const size_t tstep = 2 * hstep;
    const unsigned ldsw = (unsigned)wid * 1024u;
    const int aoff = lds_byte(wr * 64 + fr, fq * 8), boff = lds_byte(wc * 32 + fr, fq * 8);
#define PG8_SA(b, h) (((b) * 2 + (h)) * HTB)
#define PG8_SB(b, h) ((4 + (b) * 2 + (h)) * HTB)
#define PG8_STAGE(bufoff, gbase, voff) do { _Pragma("unroll") for (int _i = 0; _i < 2; ++_i) \
        __builtin_amdgcn_global_load_lds((const unsigned*)((const char*)(gbase) + (voff)[_i]), (PG8_LAS unsigned*)(lds + (bufoff) + ldsw + _i * 8192), 16, 0, 0); } while (0)
#define PG8_LDA(dst, b, h) do { _Pragma("unroll") for (int m = 0; m < 4; ++m) _Pragma("unroll") for (int k = 0; k < 2; ++k) dst[m][k] = *(const PG8_LAS bf16x8*)(lds + PG8_SA(b, h) + aoff + m * 2048 + k * 1024); } while (0)
#define PG8_LDB(dst, b, h) do { _Pragma("unroll") for (int n = 0; n < 2; ++n) _Pragma("unroll") for (int k = 0; k < 2; ++k) dst[n][k] = *(const PG8_LAS bf16x8*)(lds + PG8_SB(b, h) + boff + n * 2048 + k * 1024); } while (0)
#define PG8_MMA(ai, bj, At, Bt) do { __builtin_amdgcn_s_setprio(1); _Pragma("unroll") for (int m = 0; m < 4; ++m) _Pragma("unroll") for (int n = 0; n < 2; ++n) _Pragma("unroll") for (int k = 0; k < 2; ++k) \
        { if constexpr (F16) acc[ai][bj][m][n] = __builtin_amdgcn_mfma_f32_16x16x32_f16(__builtin_bit_cast(f16x8, Bt[n][k]), __builtin_bit_cast(f16x8, At[m][k]), acc[ai][bj][m][n], 0, 0, 0); \
          else acc[ai][bj][m][n] = __builtin_amdgcn_mfma_f32_16x16x32_bf16(Bt[n][k], At[m][k], acc[ai][bj][m][n], 0, 0, 0); } __builtin_amdgcn_s_setprio(0); } while (0)
#define PG8_WAIT_V(n) asm volatile("s_waitcnt vmcnt(" #n ")" ::: "memory")
#define PG8_WAIT_L(n) asm volatile("s_waitcnt lgkmcnt(" #n ")" ::: "memory")
#define PG8_BAR __builtin_amdgcn_s_barrier()
#define PG8_SCHED __builtin_amdgcn_sched_barrier(0)
    Unit cur, nxt; int ui = 0;
    if (!S.next(0, cur)) return;
    f32x4 acc[2][2][4][2];
#pragma unroll
    for (int a = 0; a < 2; ++a)
#pragma unroll
        for (int b = 0; b < 2; ++b)
#pragma unroll
            for (int m = 0; m < 4; ++m)
#pragma unroll
                for (int n = 0; n < 2; ++n) acc[a][b][m][n] = (f32x4){0.f, 0.f, 0.f, 0.f};
    bf16x8 At[4][2], B0[2][2], B1[2][2];
    const char* cA = (const char*)g.A + (size_t)cur.pm * tstep; const char* cB = (const char*)g.Bt + (size_t)cur.pn * tstep;
    S.a_ready(cur);
    if constexpr (SP2) {
        PG8_STAGE(PG8_SB(0, 0), cB, voffB); PG8_STAGE(PG8_SB(0, 1), cB + hstep, voffB); PG8_STAGE(PG8_SA(0, 0), cA, voffA); PG8_STAGE(PG8_SA(0, 1), cA + hstep, voffA);
        if (wr == 1) PG8_BAR;
        PG8_WAIT_V(2); PG8_BAR;
        PG8_STAGE(PG8_SB(1, 0), cB + kstep, voffB); PG8_STAGE(PG8_SA(1, 0), cA + kstep, voffA); PG8_STAGE(PG8_SB(1, 1), cB + hstep + kstep, voffB);
        PG8_WAIT_V(6); PG8_BAR;
    } else {
        PG8_STAGE(PG8_SB(0, 0), cB, voffB); PG8_STAGE(PG8_SA(0, 0), cA, voffA); PG8_STAGE(PG8_SB(0, 1), cB + hstep, voffB); PG8_STAGE(PG8_SA(0, 1), cA + hstep, voffA);
        if (wr == 1) PG8_BAR;
        PG8_WAIT_V(4); PG8_BAR;
        PG8_STAGE(PG8_SB(1, 0), cB + kstep, voffB); PG8_STAGE(PG8_SA(1, 0), cA + kstep, voffA); PG8_STAGE(PG8_SB(1, 1), cB + hstep + kstep, voffB);
        PG8_WAIT_V(6); PG8_BAR;
    }
    for (;;) {
        const bool has_next = S.next(ui + 1, nxt);
        const char* nA = has_next ? (const char*)g.A + (size_t)nxt.pm * tstep : cA; const char* nB = has_next ? (const char*)g.Bt + (size_t)nxt.pn * tstep : cB;
        for (int t = 0; t < nt; t += 2) {
            const bool last = (t == nt - 2);
            const char* a1 = cA + (size_t)(t + 1) * kstep;
            const char* a2 = last ? nA : cA + (size_t)(t + 2) * kstep; const char* b2 = last ? nB : cB + (size_t)(t + 2) * kstep;
            const char* a3 = a2 + kstep; const char* b3 = b2 + kstep;
            if (last && has_next) S.a_ready(nxt);
            if constexpr (SP2) {
            PG8_LDB(B0, 0, 0); PG8_LDB(B1, 0, 1); PG8_SCHED; PG8_LDA(At, 0, 0); PG8_STAGE(PG8_SA(1, 1), a1 + hstep, voffA);
            PG8_WAIT_V(8); PG8_WAIT_L(0); PG8_BAR; PG8_MMA(0, 0, At, B0); PG8_MMA(0, 1, At, B1); PG8_BAR; PG8_SCHED;
            PG8_LDA(At, 0, 1); PG8_STAGE(PG8_SB(0, 0), b2, voffB); PG8_STAGE(PG8_SB(0, 1), b2 + hstep, voffB); PG8_STAGE(PG8_SA(0, 0), a2, voffA);
            PG8_WAIT_V(8); PG8_WAIT_L(0); PG8_BAR; PG8_MMA(1, 0, At, B0); PG8_MMA(1, 1, At, B1); PG8_BAR; PG8_SCHED;
            PG8_LDB(B0, 1, 0); PG8_LDB(B1, 1, 1); PG8_SCHED; PG8_LDA(At, 1, 0); PG8_STAGE(PG8_SA(0, 1), a2 + hstep, voffA);
            PG8_WAIT_V(8); PG8_WAIT_L(0); PG8_BAR; PG8_MMA(0, 0, At, B0); PG8_MMA(0, 1, At, B1); PG8_BAR; PG8_SCHED;
            PG8_LDA(At, 1, 1); PG8_STAGE(PG8_SB(1, 0), b3, voffB); PG8_STAGE(PG8_SB(1, 1), b3 + hstep, voffB); PG8_STAGE(PG8_SA(1, 0), a3, voffA);
            PG8_WAIT_V(8); PG8_WAIT_L(0); PG8_BAR; PG8_MMA(1, 0, At, B0); PG8_MMA(1, 1, At, B1); PG8_BAR; PG8_SCHED;
            } else {
            PG8_LDB(B0, 0, 0); PG8_SCHED; PG8_LDA(At, 0, 0); PG8_STAGE(PG8_SA(1, 1), a1 + hstep, voffA);
            PG8_WAIT_L(8); PG8_BAR; PG8_WAIT_L(0); PG8_MMA(0, 0, At, B0); PG8_BAR; PG8_SCHED;
            PG8_LDB(B1, 0, 1); PG8_STAGE(PG8_SB(0, 0), b2, voffB);
            PG8_BAR; PG8_WAIT_L(0); PG8_MMA(0, 1, At, B1); PG8_BAR;
            PG8_LDA(At, 0, 1); PG8_STAGE(PG8_SA(0, 0), a2, voffA);
            PG8_BAR; PG8_WAIT_L(0); PG8_MMA(1, 0, At, B0); PG8_BAR; PG8_SCHED;
            PG8_STAGE(PG8_SB(0, 1), b2 + hstep, voffB);
            PG8_WAIT_V(6); PG8_BAR; PG8_MMA(1, 1, At, B1); PG8_BAR;
            PG8_LDB(B0, 1, 0); PG8_SCHED; PG8_LDA(At, 1, 0); PG8_STAGE(PG8_SA(0, 1), a2 + hstep, voffA);
            PG8_WAIT_L(8); PG8_BAR; PG8_WAIT_L(0); PG8_MMA(0, 0, At, B0); PG8_BAR; PG8_SCHED;
            PG8_LDB(B1, 1, 1); PG8_STAGE(PG8_SB(1, 0), b3, voffB);
            PG8_BAR; PG8_WAIT_L(0); PG8_MMA(0, 1, At, B1); PG8_BAR;
            PG8_LDA(At, 1, 1); PG8_STAGE(PG8_SA(1, 0), a3, voffA);
            PG8_BAR; PG8_WAIT_L(0); PG8_MMA(1, 0, At, B0); PG8_BAR; PG8_SCHED;
            PG8_STAGE(PG8_SB(1, 1), b3 + hstep, voffB);
            PG8_WAIT_V(6); PG8_BAR; PG8_MMA(1, 1, At, B1); PG8_BAR;
            }
        }
        if constexpr (ALIGN_EPI) { if (wr == 0) PG8_BAR; }
        if constexpr (!Epi::AFTER_DRAIN) { E(acc, cur, wr, wc, fr, fq); S.done(cur); }
        if (!has_next) break;
#pragma unroll
        for (int a = 0; a < 2; ++a)
#pragma unroll
            for (int b = 0; b < 2; ++b)
#pragma unroll
                for (int m = 0; m < 4; ++m)
#pragma unroll
                    for (int n = 0; n < 2; ++n) acc[a][b][m][n] = (f32x4){0.f, 0.f, 0.f, 0.f};
        cur = nxt; cA = nA; cB = nB; ++ui;
        if constexpr (ALIGN_EPI) { if (wr == 1) PG8_BAR; }
    }
    PG8_WAIT_V(0);
    if constexpr (!ALIGN_EPI) { if (wr == 0) PG8_BAR; }
    PG8_BAR;
    if constexpr (Epi::AFTER_DRAIN) { E.fused(acc, cur, wr, wc, fr, fq, lds, wid, lane); S.done(cur); }
#undef PG8_SA
#undef PG8_SB
#undef PG8_STAGE
#undef PG8_LDA
#undef PG8_LDB
#undef PG8_MMA
#undef PG8_WAIT_V
#undef PG8_WAIT_L
#undef PG8_BAR
#undef PG8_SCHED
}
}
#include <hip/hip_bf16.h>
#include <cmath>
namespace attn_body {
using bf16=__hip_bfloat16;
using bf16x8=__attribute__((ext_vector_type(8)))short;
using s16x4=__attribute__((ext_vector_type(4)))short;
using f32x16=__attribute__((ext_vector_type(16)))float;
using u32x4=__attribute__((ext_vector_type(4)))unsigned;
constexpr int NHEAD=16,SEQ=4096,D=64,DM=NHEAD*D;
constexpr int NW=8,QBLK=32,QB=QBLK*NW,KVBLK=64,NQB=SEQ/QB;
constexpr int ATTN_PITCH=DM, ATTN_UNIT_ROWS=QB;
__device__ __forceinline__ int crow(int r,int hi){return (r&3)+8*(r>>2)+4*hi;}
#define SBAR() __builtin_amdgcn_sched_barrier(0)
__device__ __forceinline__ void cmask(f32x16&p0,f32x16&p1,int jb,int qrel,int hi){
  const float NEG=-INFINITY; int kb=64*jb+4*hi;
  #pragma unroll
  for(int r=0;r<16;++r){int kv=kb+(r&3)+8*(r>>2); if(kv>qrel)p0[r]=NEG; if(kv+32>qrel)p1[r]=NEG;}
}

constexpr int NSLOT=3, SLOTB=8192, VSLOTB=2*SLOTB;
constexpr int LDS_K=0, LDS_V=NSLOT*SLOTB, LDS_WS=LDS_V+NSLOT*VSLOTB, LDS_OST=LDS_WS+NW*64*4, LDS_BYTES=LDS_OST+NW*4096;
constexpr float C2=0.125f*1.4426950408889634f;
__device__ __forceinline__ void glds16(const void*gsrc,unsigned lds_dst){unsigned keep;
  asm volatile("s_mov_b32 %0, m0\n\ts_mov_b32 m0, %2\n\ts_nop 0\n\tglobal_load_lds_dwordx4 %1, off\n\ts_mov_b32 m0, %0":"=&s"(keep):"v"(gsrc),"s"(lds_dst):"memory");}
__device__ __forceinline__ void glds16s(const void*sbase,unsigned voff,unsigned lds_dst){unsigned keep;
  asm volatile("s_mov_b32 %0, m0\n\ts_mov_b32 m0, %3\n\ts_nop 0\n\tglobal_load_lds_dwordx4 %1, %2\n\ts_mov_b32 m0, %0":"=&s"(keep):"v"(voff),"s"(sbase),"s"(lds_dst):"memory");}
__device__ __forceinline__ float max3f(float a,float b,float c){float r;asm("v_max3_f32 %0, %1, %2, %3":"=v"(r):"v"(a),"v"(b),"v"(c));return r;}
__device__ __forceinline__ float max2f(float a,float b){float r;asm("v_max_f32_e32 %0, %1, %2":"=v"(r):"v"(a),"v"(b));return r;}
__device__ __forceinline__ float fadd_s(float a,float b){float r;asm("v_add_f32_e32 %0, %1, %2":"=v"(r):"v"(a),"v"(b));return r;}
__device__ __forceinline__ float fsub_s(float a,float b){float r;asm("v_sub_f32_e32 %0, %1, %2":"=v"(r):"v"(a),"v"(b));return r;}
typedef float f32x2_t __attribute__((ext_vector_type(2))); typedef __bf16 bf16x2_t __attribute__((ext_vector_type(2)));
__device__ __forceinline__ unsigned cvtpk_s(float lo,float hi){f32x2_t v={lo,hi};bf16x2_t b=__builtin_convertvector(v,bf16x2_t);return __builtin_bit_cast(unsigned,b);}
#define WAIT_BAR(N) asm volatile("s_waitcnt vmcnt(" #N ") lgkmcnt(0)\n\ts_barrier":::"memory")

__device__ __forceinline__ void qkt(f32x16&p0,f32x16&p1,const char*Kslot,const bf16x8*qr,const f32x16&negm,int r32,int hi){
  const char*kb=Kslot+hi*1024+r32*16;
  #pragma unroll
  for(int d0=0;d0<4;++d0){
    const bf16x8 b0=*reinterpret_cast<const bf16x8*>(kb+d0*2048);
    const bf16x8 b1=*reinterpret_cast<const bf16x8*>(kb+d0*2048+512);
    if(d0==0){p0=__builtin_amdgcn_mfma_f32_32x32x16_bf16(b0,qr[0],negm,0,0,0);p1=__builtin_amdgcn_mfma_f32_32x32x16_bf16(b1,qr[0],negm,0,0,0);}
    else{p0=__builtin_amdgcn_mfma_f32_32x32x16_bf16(b0,qr[d0],p0,0,0,0);p1=__builtin_amdgcn_mfma_f32_32x32x16_bf16(b1,qr[d0],p1,0,0,0);}}
}
typedef __attribute__((address_space(3))) const char* lds_cptr;
typedef short v4i16_t __attribute__((ext_vector_type(4)));
__device__ __forceinline__ void kload8(bf16x8*kf,lds_cptr kp){
  kf[0]=*(const __attribute__((address_space(3))) bf16x8*)(kp);      kf[1]=*(const __attribute__((address_space(3))) bf16x8*)(kp+512);
  kf[2]=*(const __attribute__((address_space(3))) bf16x8*)(kp+2048); kf[3]=*(const __attribute__((address_space(3))) bf16x8*)(kp+2560);
  kf[4]=*(const __attribute__((address_space(3))) bf16x8*)(kp+4096); kf[5]=*(const __attribute__((address_space(3))) bf16x8*)(kp+4608);
  kf[6]=*(const __attribute__((address_space(3))) bf16x8*)(kp+6144); kf[7]=*(const __attribute__((address_space(3))) bf16x8*)(kp+6656);
}
__device__ __forceinline__ void kload2(bf16x8*kf,lds_cptr kp,int j){ kf[2*j]=*(const __attribute__((address_space(3))) bf16x8*)(kp+j*2048); kf[2*j+1]=*(const __attribute__((address_space(3))) bf16x8*)(kp+j*2048+512); }
__device__ __forceinline__ s16x4 vtr(lds_cptr p){ return __builtin_bit_cast(s16x4,__builtin_amdgcn_ds_read_tr16_b64_v4i16((__attribute__((address_space(3))) v4i16_t*)p)); }
__device__ __forceinline__ float rowmax(const f32x16&p0,const f32x16&p1){
  float a=max3f(p0[0],p0[1],p1[0]),b=max3f(p0[2],p0[3],p1[1]);a=max3f(a,p1[2],p1[3]);
  #pragma unroll
  for(int r=4;r<16;r+=4){a=max3f(a,p0[r],p0[r+1]);b=max3f(b,p0[r+2],p0[r+3]);a=max3f(a,p1[r],p1[r+1]);b=max3f(b,p1[r+2],p1[r+3]);}
  const float m=max2f(a,b);
  auto rr=__builtin_amdgcn_permlane32_swap(__float_as_uint(m),__float_as_uint(m),false,false);
  return max2f(__uint_as_float(rr[0]),__uint_as_float(rr[1]));
}
__device__ __forceinline__ void pv(f32x16*o,int vb,bf16x8 pa0,bf16x8 pa1,bf16x8 pa2,bf16x8 pa3){
  #pragma unroll
  for(int d0=0;d0<4;++d0){s16x4 lo[4],hi[4];
    #pragma unroll
    for(int ks=0;ks<4;++ks){
      asm volatile("ds_read_b64_tr_b16 %0,%1 offset:%c2":"=&v"(lo[ks]):"v"(vb),"i"(d0*4096+ks*1024):"memory");
      asm volatile("ds_read_b64_tr_b16 %0,%1 offset:%c2":"=&v"(hi[ks]):"v"(vb),"i"(d0*4096+ks*1024+512):"memory");}
    asm volatile("s_waitcnt lgkmcnt(0)":::"memory");SBAR();
    #define PK(k) (bf16x8){lo[k][0],lo[k][1],lo[k][2],lo[k][3],hi[k][0],hi[k][1],hi[k][2],hi[k][3]}
    o[d0]=__builtin_amdgcn_mfma_f32_32x32x16_bf16(pa0,PK(0),o[d0],0,0,0);
    o[d0]=__builtin_amdgcn_mfma_f32_32x32x16_bf16(pa1,PK(1),o[d0],0,0,0);
    o[d0]=__builtin_amdgcn_mfma_f32_32x32x16_bf16(pa2,PK(2),o[d0],0,0,0);
    o[d0]=__builtin_amdgcn_mfma_f32_32x32x16_bf16(pa3,PK(3),o[d0],0,0,0);
    #undef PK
  }
}

#ifndef ATTN_STORE16
#define ATTN_STORE16(p,v) (*(u32x4*)(p)=(v))
#endif
template<int THRL,bool COMB> __device__ __forceinline__ void attn_unit(bool pre,int nb,int nh,int nhv,int b,int h,int hv,int qb,const bf16*Q,const bf16*__restrict__ K,const bf16*__restrict__ V,bf16*O,bf16*YB,float lam,float oscale,const float*gsub,char*shm){
  int tid_o=threadIdx.x; asm volatile("":"+v"(tid_o)); const int tid=tid_o,lane=tid&63,r32=lane&31,hi=lane>>5; const int wid=__builtin_amdgcn_readfirstlane(tid>>6);
  const long rowbase=(long)b*SEQ; const int q0=qb*QB;
  const bf16*Qw=Q+(rowbase+q0+wid*QBLK)*DM+h*D;
  const bf16*Kh=K+rowbase*DM+h*D,*Vh=V+rowbase*DM+hv*2*D;
  const unsigned lds0=(unsigned)(uintptr_t)shm;
  float*wsf=(float*)(shm+LDS_WS)+wid*64;
  const unsigned koff=(unsigned)(lane*DM+wid*8)*2u;
  const unsigned voff=(unsigned)((16*(wid&3)+(lane>>2))*DM+(wid>>2)*32+(lane&3)*8)*2u;
  const unsigned kdst=lds0+LDS_K+wid*1024, vdst=lds0+LDS_V+wid*1024;
  #define DMA_K(t,slot) glds16s(Kh+(long)(t)*KVBLK*DM,koff,(unsigned)__builtin_amdgcn_readfirstlane(kdst+(slot)))
  #define DMA_V(t,slot) do{ glds16s(Vh+(long)(t)*KVBLK*DM,voff,(unsigned)__builtin_amdgcn_readfirstlane(vdst+2*(slot))); glds16s(Vh+64+(long)(t)*KVBLK*DM,voff,(unsigned)__builtin_amdgcn_readfirstlane(vdst+2*(slot)+8192)); }while(0)
  const char*Kbase=shm+LDS_K; bf16x8 kf[8];
  const lds_cptr shm3=(lds_cptr)shm; const lds_cptr kp0=shm3+LDS_K+hi*1024+r32*16; const lds_cptr vp0=shm3+LDS_V+((lane>>4)&1)*32+(lane&3)*8+(4*hi+((lane&15)>>2))*64;
  const int NT=(q0+QB)/KVBLK;
  if(!pre){DMA_K(0,0);DMA_V(0,0);DMA_K(1,SLOTB);}
  bf16x8 qr[4];
  #pragma unroll
  for(int d0=0;d0<4;++d0)qr[d0]=*reinterpret_cast<const bf16x8*>(&Qw[(long)r32*DM+d0*16+hi*8]);
  float mhat=0.f,l_reg=0.f;f32x16 o[4];o[0]=f32x16{};o[1]=f32x16{};o[2]=f32x16{};o[3]=f32x16{};f32x16 negm=f32x16{};asm volatile("":"+v"(negm));
  const int qrel=wid*QBLK+r32;
  #define CMASK(P0,P1,t) do{int jb_=(t)-(NT-4); if(jb_>=0)cmask(P0,P1,jb_,qrel,hi);}while(0)
  bool resc=false;
  #define START(P0,P1) do{ const float rm=rowmax(P0,P1); resc=false; \
    { const float dl=rm; mhat=fadd_s(mhat,dl); \
      _Pragma("unroll") for(int r=0;r<16;++r){P0[r]=fsub_s(P0[r],dl);P1[r]=fsub_s(P1[r],dl);} \
      _Pragma("unroll") for(int r=0;r<16;++r)negm[r]=-mhat; asm volatile("":"+v"(negm)); } \
    _Pragma("unroll") for(int r=0;r<16;++r)P0[r]=__builtin_amdgcn_exp2f(P0[r]); }while(0)
  #define RESC() do{ if(resc){ asm volatile("s_waitcnt lgkmcnt(0)":::"memory"); \
      _Pragma("unroll") for(int d_=0;d_<4;++d_) _Pragma("unroll") for(int r=0;r<16;++r)o[d_][r]*=wsf[crow(r,hi)]; } }while(0)
  f32x16 pA0,pA1,pB0,pB1;
  int sl_prev=0,sl_cur=0,sl_next=SLOTB;
  #define ROT() do{sl_prev=sl_cur;sl_cur=sl_next;sl_next=(sl_next==(NSLOT-1)*SLOTB)?0:sl_next+SLOTB;}while(0)
  DMA_K(2,2*SLOTB);
  WAIT_BAR(3);
  qkt(pA0,pA1,Kbase,qr,negm,r32,hi);asm volatile("s_nop 15\n\ts_nop 7":"+v"(pA0),"+v"(pA1));CMASK(pA0,pA1,0);
  START(pA0,pA1);
  _Pragma("unroll") for(int r=0;r<16;++r)pA1[r]=__builtin_amdgcn_exp2f(pA1[r]);
  WAIT_BAR(0);
  DMA_K(3,0);DMA_V(1,SLOTB);
  ROT();
  kload8(kf,kp0+sl_cur);
  WAIT_BAR(3);
  s16x4 vlo[8],vhi[8]; u32x4 pw0,pw1,pw2,pw3;
  #define PKW(P,B) cvtpk_s(P[B],P[B+1])
  #define PAF(k) __builtin_bit_cast(bf16x8,pw##k)
  #define VFR(i) (bf16x8){vlo[i][0],vlo[i][1],vlo[i][2],vlo[i][3],vhi[i][0],vhi[i][1],vhi[i][2],vhi[i][3]}
  #define PIN(x) asm volatile("":"+v"(x))
  #define MX3(a,b,c) __builtin_fmaxf(__builtin_fmaxf((a),(b)),(c))
  #define GAPA(MF,A0,A1,A2,A3,W0,W1,PW) do{ MF; sacc+=A0; sacc+=A1; sacc+=A2; sacc+=A3; PIN(sacc); W0; W1; PIN(PW); SBAR(); }while(0)
  #define EX(v) __builtin_amdgcn_exp2f(v)
  #define GAPB(MF,X,B) do{ MF; X[B]=EX(X[B]); X[B+1]=EX(X[B+1]); X[B+2]=EX(X[B+2]); X[B+3]=EX(X[B+3]); PIN(X); SBAR(); }while(0)
  #define GAPH(MF,X,B) do{ MF; X[B]=EX(X[B]); X[B+1]=EX(X[B+1]); PIN(X); SBAR(); }while(0)
  #define VRD(i) do{ vlo[i]=vtr(vp_+(((i)>>2)*4096+((i)&3)*1024)); vhi[i]=vtr(vp_+(((i)>>2)*4096+((i)&3)*1024+512)); }while(0)
  #define VRD2(i) do{ vlo[i]=vtr(vp_+(8192+((i)>>2)*4096+((i)&3)*1024)); vhi[i]=vtr(vp_+(8192+((i)>>2)*4096+((i)&3)*1024+512)); }while(0)
  #define KRD(G,j) do{ if(G){ kload2(kf,kp0+sl_next,j); SBAR(); } }while(0)
  #define STEP(C0,C1,P0,P1,t,GK,GV,GL) do{ SBAR(); \
    const lds_cptr vp_=vp0+2*sl_prev; \
    float sacc=(P0[0]+P0[1]); \
    GAPA(C0=__builtin_amdgcn_mfma_f32_32x32x16_bf16(kf[0],qr[0],negm,0,0,0), P0[2],P0[3],P0[4],P0[5],     pw0[0]=PKW(P0,0), pw0[1]=PKW(P0,2), pw0); \
    GAPA(C1=__builtin_amdgcn_mfma_f32_32x32x16_bf16(kf[1],qr[0],negm,0,0,0), P0[6],P0[7],P0[8],P0[9],     pw0[2]=PKW(P0,4), pw0[3]=PKW(P0,6), pw0); \
    GAPA(C0=__builtin_amdgcn_mfma_f32_32x32x16_bf16(kf[2],qr[1],C0,0,0,0),   P0[10],P0[11],P0[12],P0[13], pw1[0]=PKW(P0,8), pw1[1]=PKW(P0,10), pw1); \
    GAPA(C1=__builtin_amdgcn_mfma_f32_32x32x16_bf16(kf[3],qr[1],C1,0,0,0),   P0[14],P0[15],P1[0],P1[1],   pw1[2]=PKW(P0,12),pw1[3]=PKW(P0,14), pw1); \
    GAPA(C0=__builtin_amdgcn_mfma_f32_32x32x16_bf16(kf[4],qr[2],C0,0,0,0),   P1[2],P1[3],P1[4],P1[5],     pw2[0]=PKW(P1,0), pw2[1]=PKW(P1,2), pw2); \
    GAPA(C1=__builtin_amdgcn_mfma_f32_32x32x16_bf16(kf[5],qr[2],C1,0,0,0),   P1[6],P1[7],P1[8],P1[9],     pw2[2]=PKW(P1,4), pw2[3]=PKW(P1,6), pw2); \
    GAPA(C0=__builtin_amdgcn_mfma_f32_32x32x16_bf16(kf[6],qr[3],C0,0,0,0),   P1[10],P1[11],P1[12],P1[13], pw3[0]=PKW(P1,8), pw3[1]=PKW(P1,10), pw3); \
    GAPA(C1=__builtin_amdgcn_mfma_f32_32x32x16_bf16(kf[7],qr[3],C1,0,0,0),   P1[14],P1[15],0.f,0.f,       pw3[2]=PKW(P1,12),pw3[3]=PKW(P1,14), pw3); \
    l_reg+=sacc; \
    VRD(0);VRD(4);VRD(1);VRD(5);VRD(2);VRD(6);VRD(3);VRD(7); SBAR();   \
    if(GK){DMA_K((t)+3,sl_cur);} if(GV){DMA_V((t)+1,sl_next);} \
    CMASK(C0,C1,t); \
    { float a=MX3(C0[0],C0[1],C1[0]),b=MX3(C0[2],C0[3],C1[1]); a=MX3(a,C1[2],C1[3]); \
      _Pragma("unroll") for(int r=4;r<16;r+=4){a=MX3(a,C0[r],C0[r+1]);b=MX3(b,C0[r+2],C0[r+3]);a=MX3(a,C1[r],C1[r+1]);b=MX3(b,C1[r+2],C1[r+3]);} \
      float rm=__builtin_fmaxf(a,b); { auto rr=__builtin_amdgcn_permlane32_swap(__float_as_uint(rm),__float_as_uint(rm),false,false); rm=__builtin_fmaxf(__uint_as_float(rr[0]),__uint_as_float(rr[1])); } \
      resc=false; \
      if(__builtin_expect(__any(rm>(float)THRL),0)){ const float dl=__builtin_fmaxf(rm,0.f); mhat+=dl; \
        _Pragma("unroll") for(int r=0;r<16;++r){C0[r]-=dl;C1[r]-=dl;} \
        _Pragma("unroll") for(int r=0;r<16;++r)negm[r]=-mhat; asm volatile("":"+v"(negm)); \
        const float f=__builtin_amdgcn_exp2f(-dl); l_reg*=f; if(hi==0)wsf[r32]=f; resc=true; } } \
    SBAR(); \
    GAPH(o[0]=__builtin_amdgcn_mfma_f32_32x32x16_bf16(PAF(0),VFR(0),o[0],0,0,0), C0,0); VRD2(0); \
    GAPH(o[1]=__builtin_amdgcn_mfma_f32_32x32x16_bf16(PAF(0),VFR(4),o[1],0,0,0), C0,4); VRD2(4); \
    KRD(GL,0); GAPH(o[0]=__builtin_amdgcn_mfma_f32_32x32x16_bf16(PAF(1),VFR(1),o[0],0,0,0), C0,8); VRD2(1); \
    KRD(GL,1); GAPH(o[1]=__builtin_amdgcn_mfma_f32_32x32x16_bf16(PAF(1),VFR(5),o[1],0,0,0), C0,12); VRD2(5); \
    KRD(GL,2); GAPH(o[0]=__builtin_amdgcn_mfma_f32_32x32x16_bf16(PAF(2),VFR(2),o[0],0,0,0), C1,0); VRD2(2); \
    KRD(GL,3); GAPH(o[1]=__builtin_amdgcn_mfma_f32_32x32x16_bf16(PAF(2),VFR(6),o[1],0,0,0), C1,4); VRD2(6); \
    GAPH(o[0]=__builtin_amdgcn_mfma_f32_32x32x16_bf16(PAF(3),VFR(3),o[0],0,0,0), C1,8); VRD2(3); \
    GAPH(o[1]=__builtin_amdgcn_mfma_f32_32x32x16_bf16(PAF(3),VFR(7),o[1],0,0,0), C1,12); VRD2(7); SBAR(); \
      \
    GAPH(o[2]=__builtin_amdgcn_mfma_f32_32x32x16_bf16(PAF(0),VFR(0),o[2],0,0,0), C0,2); \
    GAPH(o[3]=__builtin_amdgcn_mfma_f32_32x32x16_bf16(PAF(0),VFR(4),o[3],0,0,0), C0,6); \
    GAPH(o[2]=__builtin_amdgcn_mfma_f32_32x32x16_bf16(PAF(1),VFR(1),o[2],0,0,0), C0,10); \
    GAPH(o[3]=__builtin_amdgcn_mfma_f32_32x32x16_bf16(PAF(1),VFR(5),o[3],0,0,0), C0,14); \
    GAPH(o[2]=__builtin_amdgcn_mfma_f32_32x32x16_bf16(PAF(2),VFR(2),o[2],0,0,0), C1,2); \
    GAPH(o[3]=__builtin_amdgcn_mfma_f32_32x32x16_bf16(PAF(2),VFR(6),o[3],0,0,0), C1,6); \
    GAPH(o[2]=__builtin_amdgcn_mfma_f32_32x32x16_bf16(PAF(3),VFR(3),o[2],0,0,0), C1,10); \
    GAPH(o[3]=__builtin_amdgcn_mfma_f32_32x32x16_bf16(PAF(3),VFR(7),o[3],0,0,0), C1,14); \
    }while(0)
  int t=1;
  #undef CMASK
  #define CMASK(P0,P1,t) do{}while(0)
  for(;t+5<NT;t+=2){
    STEP(pB0,pB1,pA0,pA1,t,true,true,true);     WAIT_BAR(3); RESC(); ROT();
    STEP(pA0,pA1,pB0,pB1,t+1,true,true,true);   WAIT_BAR(3); RESC(); ROT();
  }
  #undef CMASK
  #define CMASK(P0,P1,t) do{int jb_=(t)-(NT-4); if(jb_>=0)cmask(P0,P1,jb_,qrel,hi);}while(0)
  #define ENDW(tt) do{ if((tt)+3<NT){WAIT_BAR(3);} else if((tt)+2<NT){WAIT_BAR(2);} else {WAIT_BAR(0);} }while(0)
  for(;t+1<NT;t+=2){
    STEP(pB0,pB1,pA0,pA1,t,(t+3<NT),(t+1<NT),(t+1<NT));       ENDW(t);   RESC(); ROT();
    STEP(pA0,pA1,pB0,pB1,t+1,(t+4<NT),(t+2<NT),(t+2<NT));     ENDW(t+1); RESC(); ROT();
  }
  STEP(pB0,pB1,pA0,pA1,NT-1,false,false,false); RESC();
  { float sacc=pB0[0]+pB0[1]; _Pragma("unroll") for(int r=2;r<16;++r)sacc+=pB0[r]; _Pragma("unroll") for(int r=0;r<16;++r)sacc+=pB1[r]; l_reg+=sacc;
    pw0=(u32x4){PKW(pB0,0),PKW(pB0,2),PKW(pB0,4),PKW(pB0,6)};pw1=(u32x4){PKW(pB0,8),PKW(pB0,10),PKW(pB0,12),PKW(pB0,14)};pw2=(u32x4){PKW(pB1,0),PKW(pB1,2),PKW(pB1,4),PKW(pB1,6)};pw3=(u32x4){PKW(pB1,8),PKW(pB1,10),PKW(pB1,12),PKW(pB1,14)};
    SBAR(); const int vb0=(int)(lds0+LDS_V)+((lane>>4)&1)*32+(lane&3)*8+(4*hi+((lane&15)>>2))*64;     pv(o,vb0+2*sl_cur,PAF(0),PAF(1),PAF(2),PAF(3)); }
  #undef PKW
  #undef PAF
  #undef VFR
  #undef PIN
  #undef MX3
  #undef GAPA
  #undef GAPB
  #undef GAPH
  #undef EX
  #undef VRD
  #undef VRD2
  #undef KRD
  #undef STEP
  #undef ENDW
  asm volatile("s_waitcnt lgkmcnt(0)\n\ts_barrier":::"memory");
  if(nb>=0){ const bf16*nKh=K+(long)nb*SEQ*DM+nh*D,*nVh=V+(long)nb*SEQ*DM+nhv*2*D;
    glds16s(nKh,koff,(unsigned)__builtin_amdgcn_readfirstlane(kdst)); glds16s(nVh,voff,(unsigned)__builtin_amdgcn_readfirstlane(vdst)); glds16s(nVh+64,voff,(unsigned)__builtin_amdgcn_readfirstlane(vdst+8192)); glds16s(nKh+(long)KVBLK*DM,koff,(unsigned)__builtin_amdgcn_readfirstlane(kdst+SLOTB)); }
  {auto rr=__builtin_amdgcn_permlane32_swap(__float_as_uint(l_reg),__float_as_uint(l_reg),false,false);l_reg=__uint_as_float(rr[0])+__uint_as_float(rr[1]);}
  if(hi==0)wsf[32+r32]=l_reg;asm volatile("s_waitcnt lgkmcnt(0)":::"memory");
  float rli[16];
  #pragma unroll
  for(int r=0;r<16;++r)rli[r]=__builtin_amdgcn_rcpf(wsf[32+crow(r,hi)]);
  bf16*Ow=O+(rowbase+q0+wid*QBLK)*DM+hv*2*D;
  { bf16*stg=(bf16*)(shm+LDS_OST)+wid*2048;
    if constexpr(!COMB){
    #pragma unroll
    for(int hh=0;hh<2;++hh){
      #pragma unroll
      for(int r=0;r<16;++r){const int orow=crow(r,hi);
        #pragma unroll
        for(int d0=0;d0<2;++d0)stg[orow*64+d0*32+r32]=__float2bfloat16(o[2*hh+d0][r]*rli[r]);}
      asm volatile("s_waitcnt lgkmcnt(0)":::"memory");
      #pragma unroll
      for(int i=0;i<4;++i){const int row=i*8+(lane>>3),ch=lane&7; const u32x4 v=*(const u32x4*)(stg+row*64+ch*8); ATTN_STORE16(Ow+(long)row*DM+hh*64+ch*8,v);}
      asm volatile("s_waitcnt lgkmcnt(0)":::"memory"); }
    } else {
    float dv[2][4][8];
    #pragma unroll
    for(int hh=0;hh<2;++hh){
      #pragma unroll
      for(int r=0;r<16;++r){const int orow=crow(r,hi);
        #pragma unroll
        for(int d0=0;d0<2;++d0)stg[orow*64+d0*32+r32]=__float2bfloat16(o[2*hh+d0][r]*rli[r]);}
      asm volatile("s_waitcnt lgkmcnt(0)":::"memory");
      #pragma unroll
      for(int i=0;i<4;++i){const int row=i*8+(lane>>3),ch=lane&7; const u32x4 v2=*(const u32x4*)(stg+row*64+ch*8); const u32x4 v1=*(const u32x4*)(Ow+(long)row*DM+hh*64+ch*8);
        #define BL(w) __builtin_bit_cast(float,(w)<<16)
        #define BH(w) __builtin_bit_cast(float,(w)&0xffff0000u)
        dv[hh][i][0]=BL(v1[0])-lam*BL(v2[0]); dv[hh][i][1]=BH(v1[0])-lam*BH(v2[0]); dv[hh][i][2]=BL(v1[1])-lam*BL(v2[1]); dv[hh][i][3]=BH(v1[1])-lam*BH(v2[1]);
        dv[hh][i][4]=BL(v1[2])-lam*BL(v2[2]); dv[hh][i][5]=BH(v1[2])-lam*BH(v2[2]); dv[hh][i][6]=BL(v1[3])-lam*BL(v2[3]); dv[hh][i][7]=BH(v1[3])-lam*BH(v2[3]);
        #undef BL
        #undef BH
      }
      asm volatile("s_waitcnt lgkmcnt(0)":::"memory"); }
    bf16*Yw=YB+(rowbase+q0+wid*QBLK)*DM+hv*2*D;
    #pragma unroll
    for(int i=0;i<4;++i){const int row=i*8+(lane>>3),ch=lane&7; float ss=0.f;
      #pragma unroll
      for(int hh=0;hh<2;++hh){
        #pragma unroll
        for(int j=0;j<8;++j)ss+=dv[hh][i][j]*dv[hh][i][j];}
      ss+=__builtin_bit_cast(float,__builtin_amdgcn_ds_bpermute((lane^1)<<2,__builtin_bit_cast(int,ss)));
      ss+=__builtin_bit_cast(float,__builtin_amdgcn_ds_bpermute((lane^2)<<2,__builtin_bit_cast(int,ss)));
      ss+=__builtin_bit_cast(float,__builtin_amdgcn_ds_bpermute((lane^4)<<2,__builtin_bit_cast(int,ss)));
      const float rs=oscale/sqrtf(ss*(1.f/128.f)+1e-6f);
      #pragma unroll
      for(int hh=0;hh<2;++hh){const float*gp=gsub+hh*64+ch*8; float y[8];
        #pragma unroll
        for(int j=0;j<8;++j)y[j]=dv[hh][i][j]*rs*gp[j];
        u32x4 w; w[0]=cvtpk_s(y[0],y[1]); w[1]=cvtpk_s(y[2],y[3]); w[2]=cvtpk_s(y[4],y[5]); w[3]=cvtpk_s(y[6],y[7]);
        ATTN_STORE16(Yw+(long)row*DM+hh*64+ch*8,w);} }
    }
  }
  asm volatile("s_waitcnt lgkmcnt(0)\n\ts_barrier":::"memory");
  #undef DMA_K
  #undef DMA_V
  #undef CMASK
  #undef START
  #undef RESC
  #undef ROT
}
constexpr int ATTN_LDS_BYTES=LDS_BYTES;
#undef SBAR
#undef WAIT_BAR
}
#define LAS __attribute__((address_space(3)))
typedef unsigned short bf16;
typedef unsigned v4u __attribute__((ext_vector_type(4)));
typedef unsigned v2u __attribute__((ext_vector_type(2)));
typedef float f32x4 __attribute__((ext_vector_type(4)));
typedef short bf16x8 __attribute__((ext_vector_type(8)));
#define LDS_WAIT() asm volatile("s_waitcnt lgkmcnt(0)" ::: "memory")

constexpr int NWAVES = 8, NTHREADS = 512;
constexpr int DM = 1024, BATCH = 16, SEQ = 4096, DEPTH = 4, M = BATCH * SEQ, MH = M / 2, NIN = 7168, DFF = 2816, NUP = 2 * DFF, PLE = 256;
constexpr float EPS = 1e-6f;
constexpr size_t MiB = 1u << 20;
constexpr size_t WS_W = 2 * MiB, W_LAYER = 40 * MiB;
constexpr size_t WO_IN = 0, WO_UP = 14 * MiB, WO_DOWN = 25 * MiB, WO_PA = 31 * MiB, WO_PB = 33 * MiB, WO_O = 35 * MiB, WO_PG = 37 * MiB, WO_PLE = 39 * MiB, WO_S = 39 * MiB + 512 * 1024;
constexpr size_t WS_H = 162 * MiB;
constexpr size_t WS_Z = 290 * MiB, ZS = (size_t)MH * DM;
constexpr size_t WS_O1 = 738 * MiB, WS_O2 = 802 * MiB;
constexpr size_t WS_ACT = 290 * MiB, WS_XBB = 642 * MiB, WS_EDGE = 802 * MiB, WS_E = 290 * MiB;
constexpr size_t WS_SS = 866 * MiB, SSS = (size_t)M * 16, WS_PBF = 920 * MiB;
constexpr size_t WS_VST = 952 * MiB;
constexpr size_t WS_END = 956 * MiB;
constexpr int LDS_BYTES = 147456, XB_OFF = 131072 + 1024;

__device__ __forceinline__ unsigned f2bf(float f) { unsigned u = __builtin_bit_cast(unsigned, f); return (u + 0x7fffu + ((u >> 16) & 1u)) >> 16; }
__device__ __forceinline__ unsigned pk2(float lo, float hi) { return f2bf(lo) | (f2bf(hi) << 16); }
__device__ __forceinline__ unsigned pkh2(float lo, float hi) { return pg8::cvt_pk_f16(lo, hi); }
__device__ __forceinline__ float blo(unsigned w) { return __builtin_bit_cast(float, w << 16); }
__device__ __forceinline__ float bhi(unsigned w) { return __builtin_bit_cast(float, w & 0xffff0000u); }
__device__ __forceinline__ float bperm(float v, int srclane) { return __builtin_bit_cast(float, __builtin_amdgcn_ds_bpermute(srclane << 2, __builtin_bit_cast(int, v))); }
__device__ __forceinline__ float wave_sum(float v, int lane) {
#pragma unroll
    for (int o = 1; o < 64; o <<= 1) v += bperm(v, lane ^ o);
    return v;
}
__device__ __forceinline__ int up_row_map(int n) { return n < DFF ? (n >> 7) * 256 + (n & 127) : ((n - DFF) >> 7) * 256 + 128 + ((n - DFF) & 127); }
template <bool UPMAP, bool F16OUT = false> __device__ __forceinline__ void transpose_item(const float* W, int K, int N, bf16* WT, LAS float* scr, int item, int lane, const float* gk = nullptr) {
    const int nblk = N / 32, kb = item / nblk, nb = item % nblk, k0 = 64 * kb, n0 = 32 * nb;
#pragma unroll 8
    for (int i = 0; i < 32; ++i) { const int kk = 2 * i + (lane >> 5); float w = W[(size_t)(k0 + kk) * N + n0 + (lane & 31)]; if (gk) w *= gk[k0 + kk]; scr[kk * 33 + (lane & 31)] = w; }
    LDS_WAIT(); asm volatile("" ::: "memory");
    const int c = lane & 7;
#pragma unroll
    for (int j = 0; j < 4; ++j) { const int n = (lane >> 3) + 8 * j; const LAS float* s = scr + (8 * c) * 33 + n;
        v4u o; if (F16OUT) {
#define W8(v) __builtin_bit_cast(float, f2bf(v) << 16)
            o.x = pkh2(W8(s[0 * 33]), W8(s[1 * 33])); o.y = pkh2(W8(s[2 * 33]), W8(s[3 * 33])); o.z = pkh2(W8(s[4 * 33]), W8(s[5 * 33])); o.w = pkh2(W8(s[6 * 33]), W8(s[7 * 33]));
#undef W8
        }
        else { o.x = pk2(s[0 * 33], s[1 * 33]); o.y = pk2(s[2 * 33], s[3 * 33]); o.z = pk2(s[4 * 33], s[5 * 33]); o.w = pk2(s[6 * 33], s[7 * 33]); }
        const int dr = UPMAP ? up_row_map(n0 + n) : (n0 + n);
        *(v4u*)(WT + (size_t)dr * K + k0 + 8 * c) = o; }
    LDS_WAIT(); asm volatile("" ::: "memory");
}
template <bool OUTF32> __device__ __forceinline__ void rms_row(const float* xrow, const float* g, void* orow, int lane) {
    const f32x4* xr = (const f32x4*)xrow + lane;
    f32x4 v[4]; float s = 0.f;
#pragma unroll
    for (int j = 0; j < 4; ++j) { v[j] = xr[64 * j]; s += (v[j].x * v[j].x + v[j].y * v[j].y) + (v[j].z * v[j].z + v[j].w * v[j].w); }
    const float rstd = 1.0f / sqrtf(wave_sum(s, lane) * (1.f / DM) + EPS);
#pragma unroll
    for (int j = 0; j < 4; ++j) { const f32x4 gg = ((const f32x4*)g)[lane + 64 * j]; const f32x4 o = v[j] * rstd * gg;
        if (OUTF32) ((f32x4*)orow)[lane + 64 * j] = o;
        else ((unsigned long long*)orow)[lane + 64 * j] = (unsigned long long)pk2(o.x, o.y) | ((unsigned long long)pk2(o.z, o.w) << 32); }
}
__device__ __forceinline__ void sgu_unit(LAS unsigned char* lds, bf16* U, bf16* UO, const bf16* V, const float* VST, const bf16* Wsb, const float* bs, const float* lng, const float* lnb, size_t row0, int tid, int lane, int wave) {
    LAS float* st = (LAS float*)lds;
    LAS unsigned char* vt0 = lds + 1024;
    constexpr int VTB = 128 * 272;
    { const int r = tid >> 2, q = tid & 3; const f32x4* vp = (const f32x4*)(VST + (row0 + r) * 32 + q * 8);
      const f32x4 a = vp[0], c = vp[1];
      float sm = (a[0] + a[2]) + (c[0] + c[2]), sq = (a[1] + a[3]) + (c[1] + c[3]);
      sm += bperm(sm, lane ^ 1); sq += bperm(sq, lane ^ 1); sm += bperm(sm, lane ^ 2); sq += bperm(sq, lane ^ 2);
      const float mean = sm * (1.f / DM); float var = sq * (1.f / DM) - mean * mean; var = var > 0.f ? var : 0.f;
      if (q == 0) { st[2 * r] = mean; st[2 * r + 1] = 1.0f / sqrtf(var + EPS); } }
    __syncthreads();
    const int cg8 = tid & 15, rp = tid >> 4, fr = lane & 15, fq = lane >> 4;
    const int ksmax = (wave * 16 + 15) >> 5;
    const int t = 16 * wave + fr;
    float mu[4], rsd[4];
#pragma unroll
    for (int rr = 0; rr < 4; ++rr) { mu[rr] = st[2 * (4 * rp + rr)]; rsd[rr] = st[2 * (4 * rp + rr) + 1]; }
    v4u vraw[4]; bf16x8 bw[4]; v2u uraw[8]; f32x4 gm[2], bt[2]; float bias;
#define SGU_LOAD(g) do { \
        _Pragma("unroll") for (int rr = 0; rr < 4; ++rr) vraw[rr] = *(const v4u*)(V + (row0 + 4 * rp + rr) * DM + (g) * 128 + 8 * cg8); \
        gm[0] = *(const f32x4*)(lng + (g) * 128 + 8 * cg8); gm[1] = *(const f32x4*)(lng + (g) * 128 + 8 * cg8 + 4); bt[0] = *(const f32x4*)(lnb + (g) * 128 + 8 * cg8); bt[1] = *(const f32x4*)(lnb + (g) * 128 + 8 * cg8 + 4); \
        _Pragma("unroll") for (int ks = 0; ks < 4; ++ks) bw[ks] = *(const bf16x8*)(Wsb + (size_t)(g) * 16384 + (16 * wave + fr) * 128 + fq * 8 + ks * 32); \
        _Pragma("unroll") for (int cb = 0; cb < 8; ++cb) uraw[cb] = *(const v2u*)(U + (row0 + t) * DM + (g) * 128 + 16 * cb + 4 * fq); \
        bias = bs[(g) * 128 + t]; } while (0)
    SGU_LOAD(0);
#pragma unroll 1
    for (int g = 0; g < 8; ++g) {
        LAS unsigned char* vt = vt0 + (g & 1) * VTB;
        { float nv[4][8];
#pragma unroll
          for (int rr = 0; rr < 4; ++rr) { const v4u raw = vraw[rr]; const float mean = mu[rr], rstd = rsd[rr];
              nv[rr][0] = (blo(raw.x) - mean) * rstd * gm[0][0] + bt[0][0]; nv[rr][1] = (bhi(raw.x) - mean) * rstd * gm[0][1] + bt[0][1];
              nv[rr][2] = (blo(raw.y) - mean) * rstd * gm[0][2] + bt[0][2]; nv[rr][3] = (bhi(raw.y) - mean) * rstd * gm[0][3] + bt[0][3];
              nv[rr][4] = (blo(raw.z) - mean) * rstd * gm[1][0] + bt[1][0]; nv[rr][5] = (bhi(raw.z) - mean) * rstd * gm[1][1] + bt[1][1];
              nv[rr][6] = (blo(raw.w) - mean) * rstd * gm[1][2] + bt[1][2]; nv[rr][7] = (bhi(raw.w) - mean) * rstd * gm[1][3] + bt[1][3]; }
#pragma unroll
          for (int j = 0; j < 8; ++j) { v2u w; w.x = pk2(nv[0][j], nv[1][j]); w.y = pk2(nv[2][j], nv[3][j]); *(LAS v2u*)(vt + (8 * cg8 + j) * 272 + rp * 8) = w; } }
        bf16x8 bwc[4]; v2u uc[8]; const float biasc = bias;
#pragma unroll
        for (int ks = 0; ks < 4; ++ks) bwc[ks] = bw[ks];
#pragma unroll
        for (int cb = 0; cb < 8; ++cb) uc[cb] = uraw[cb];
        __syncthreads();
        if (g < 7) SGU_LOAD(g + 1);
        f32x4 acc[8];
#pragma unroll
        for (int cb = 0; cb < 8; ++cb) acc[cb] = (f32x4){0.f, 0.f, 0.f, 0.f};
#pragma unroll
        for (int ks = 0; ks < 4; ++ks) if (ks <= ksmax) {
#pragma unroll
            for (int cb = 0; cb < 8; ++cb) { const bf16x8 av = *(const LAS bf16x8*)(vt + (16 * cb + fr) * 272 + (ks * 32 + fq * 8) * 2);
                acc[cb] = __builtin_amdgcn_mfma_f32_16x16x32_bf16(av, bwc[ks], acc[cb], 0, 0, 0); } }
#pragma unroll
        for (int cb = 0; cb < 8; ++cb) { bf16* up = UO + (row0 + t) * DM + g * 128 + 16 * cb + 4 * fq; const v2u uu = uc[cb];
            v2u w; w.x = pk2(blo(uu.x) * (acc[cb][0] + biasc), bhi(uu.x) * (acc[cb][1] + biasc)); w.y = pk2(blo(uu.y) * (acc[cb][2] + biasc), bhi(uu.y) * (acc[cb][3] + biasc));
            *(v2u*)up = w; }
    }
#undef SGU_LOAD
    __syncthreads();
}

struct Args { const float* in[27]; float* out; unsigned char* ws; };

#define PH() \
    const Args* ap; { auto kp_ = __builtin_amdgcn_kernarg_segment_ptr(); asm volatile("" : "+s"(kp_)); ap = (const Args*)kp_; } \
    int tid_o = threadIdx.x, bx_o = blockIdx.x, G_o = gridDim.x; asm volatile("" : "+v"(tid_o)); asm volatile("" : "+s"(bx_o), "+s"(G_o)); \
    const int tid = tid_o, bx = bx_o, G = G_o, lane = tid & 63, wave = __builtin_amdgcn_readfirstlane(tid >> 6); \
    const int gw = bx * NWAVES + wave, NGW = G * NWAVES; const size_t gt = (size_t)bx * NTHREADS + tid, NGT = (size_t)G * NTHREADS; \
    unsigned char* const ws = ap->ws; float* const X = ap->out; bf16* const H = (bf16*)(ws + WS_H); bf16* const Z = (bf16*)(ws + WS_Z); \
    bf16 *const ZU = Z, *const ZV = Z + ZS, *const ZQ = Z + 2 * ZS, *const ZK = Z + 3 * ZS, *const ZVA = Z + 4 * ZS, *const ZGA = Z + 5 * ZS, *const ZGB = Z + 6 * ZS; \
    bf16 *const O1 = (bf16*)(ws + WS_O1), *const O2 = (bf16*)(ws + WS_O2), *const ACT = (bf16*)(ws + WS_ACT), *const EB = (bf16*)(ws + WS_E), *const PBF = (bf16*)(ws + WS_PBF); \
    float* const EDGE = (float*)(ws + WS_EDGE); unsigned char* const wl = ws + WS_W + (size_t)l * W_LAYER; bf16* const XBB = (bf16*)(ws + WS_XBB); float* const SS = (float*)(ws + WS_SS); (void)XBB; (void)SS; \
    (void)lane; (void)gw; (void)NGW; (void)gt; (void)NGT; (void)X; (void)H; (void)ZU; (void)ZV; (void)ZQ; (void)ZK; (void)ZVA; (void)ZGA; (void)ZGB; (void)O1; (void)O2; (void)ACT; (void)EB; (void)PBF; (void)EDGE; (void)wl

#define RLX_AGENT __ATOMIC_RELAXED, __HIP_MEMORY_SCOPE_AGENT
#define XB_TMO      128
#define XB_XCNT(j)  (256  + 64 * (j))
#define XB_XSUB(j)  (1280 + 64 * (j))
#define XB_XGEN(j)  (2304 + 64 * (j))
#define XB_TOP      3328
#define XB_TOPGEN   3392
#define XCD_BAR_WORDS 3456
#define XB_SPIN_CAP (1u << 18)

__device__ __forceinline__ unsigned xb_ld(unsigned* p)              { return __hip_atomic_load(p, __ATOMIC_RELAXED, __HIP_MEMORY_SCOPE_AGENT); }
__device__ __forceinline__ unsigned xb_add(unsigned* p, unsigned v) { return __hip_atomic_fetch_add(p, v, __ATOMIC_RELAXED, __HIP_MEMORY_SCOPE_AGENT); }
__device__ __forceinline__ unsigned xb_xcc_id() { return (unsigned)__builtin_amdgcn_s_getreg((3 << 11) | 20) & 0xFu; }
#define XB_SPIN(cond, bar) do { unsigned _sp = 0; while (cond) { __builtin_amdgcn_s_sleep(1); \
    if ((++_sp & 255u) == 0u) { if (xb_ld(&(bar)[XB_TMO])) break; if (_sp > XB_SPIN_CAP) { atomicAdd(&(bar)[XB_TMO], 1u); break; } } } } while (0)

__device__ __forceinline__ void xcd_barrier_complete(unsigned* bar, unsigned x, unsigned& nloc, unsigned& nx) {
    const unsigned G = gridDim.x * gridDim.y * gridDim.z;
    unsigned sum, cnt, mine, sp = 0u;
    for (;;) {
        sum = 0u; cnt = 0u; mine = 0u;
#pragma unroll
        for (unsigned j = 0; j < 16; ++j) { const unsigned c = xb_ld(&bar[XB_XCNT(j)]); sum += c; cnt += (c > 0u) ? 1u : 0u; mine = (j == x) ? c : mine; }
        if (sum == G) break;
        __builtin_amdgcn_s_sleep(1);
        if ((++sp & 255u) == 0u) { if (xb_ld(&bar[XB_TMO])) break; if (sp > XB_SPIN_CAP) { atomicAdd(&bar[XB_TMO], 1u); break; } }
    }
    nloc = mine > 0u ? mine : 1u; nx = cnt > 0u ? cnt : 1u;
}

__device__ __forceinline__ void xcd_barrier(unsigned* const bar_, volatile LAS unsigned* const st_) {
    struct { unsigned* bar; unsigned x; volatile LAS unsigned* st; } b; b.bar = bar_; b.x = xb_xcc_id(); b.st = st_;
    asm volatile("s_waitcnt vmcnt(0)" ::: "memory");
    __syncthreads();
    if (threadIdx.x == 0) {
        unsigned* bar = b.bar;
        __builtin_amdgcn_s_waitcnt(0);
        unsigned nloc = b.st[0], nx = b.st[1];
        if (nloc == 0u) { xcd_barrier_complete(bar, b.x, nloc, nx); b.st[0] = nloc; b.st[1] = nx; }
        const unsigned old = xb_add(&bar[XB_XSUB(b.x)], 1u);
        const unsigned gen = old / nloc;
        if (old + 1u == (gen + 1u) * nloc) {
            __builtin_amdgcn_fence(__ATOMIC_RELEASE, "agent");
            asm volatile("s_waitcnt vmcnt(0)" ::: "memory");
            const unsigned og = xb_add(&bar[XB_TOP], 1u);
            const unsigned tg = og / nx;
            if (og + 1u == (tg + 1u) * nx) xb_add(&bar[XB_TOPGEN], 1u);
            else XB_SPIN(xb_ld(&bar[XB_TOPGEN]) == tg, bar);
            __builtin_amdgcn_fence(__ATOMIC_ACQUIRE, "agent");
            xb_add(&bar[XB_XGEN(b.x)], 1u);
            asm volatile("s_waitcnt vmcnt(0)" ::: "memory");
        } else {
            XB_SPIN(xb_ld(&bar[XB_XGEN(b.x)]) == gen, bar);
            __builtin_amdgcn_fence(__ATOMIC_ACQUIRE, "agent");
            asm volatile("s_waitcnt vmcnt(0)" ::: "memory");
        }
    }
    __syncthreads();
}

__device__ __forceinline__ void ctr_grid_sync(unsigned* ctr, unsigned target) {
    asm volatile("s_waitcnt vmcnt(0) lgkmcnt(0)" ::: "memory");
    __syncthreads();
    if (threadIdx.x == 0) {
        __builtin_amdgcn_fence(__ATOMIC_RELEASE, "agent");
        asm volatile("s_waitcnt vmcnt(0)" ::: "memory");
        __hip_atomic_fetch_add(ctr, 1u, __ATOMIC_RELAXED, __HIP_MEMORY_SCOPE_AGENT);
        while (__hip_atomic_load(ctr, __ATOMIC_RELAXED, __HIP_MEMORY_SCOPE_AGENT) < target) __builtin_amdgcn_s_sleep(2);
    }
    __syncthreads();
    __builtin_amdgcn_fence(__ATOMIC_ACQUIRE, "agent");
    asm volatile("s_waitcnt vmcnt(0)" ::: "memory");
}
#define GRID_SYNC1() do { const Args* ap_s; { auto kp_ = __builtin_amdgcn_kernarg_segment_ptr(); asm volatile("" : "+s"(kp_)); ap_s = (const Args*)kp_; } xcd_barrier((unsigned*)(ap_s->ws + 4096), (volatile LAS unsigned*)(ldsl + LDS_BYTES - 16)); } while (0)
#ifndef DBG_REP_SYNC
#define DBG_REP_SYNC 0
#endif
#define GRID_SYNC() do { GRID_SYNC1(); if (DBG_REP_SYNC) GRID_SYNC1(); } while (0)
#ifndef DBG_REP_ATTN
#define DBG_REP_ATTN 0
#endif
#ifndef DBG_REP_IN
#define DBG_REP_IN 0
#endif
#ifndef DBG_REP_UP
#define DBG_REP_UP 0
#endif
#ifndef DBG_REP_PRO
#define DBG_REP_PRO 0
#endif
#ifndef DBG_REP_COMB
#define DBG_REP_COMB 0
#endif
#ifndef DBG_REP_P4
#define DBG_REP_P4 0
#endif
#ifndef DBG_REP_RES
#define DBG_REP_RES 0
#endif
#ifndef DBG_REP_SGU
#define DBG_REP_SGU 0
#endif
#ifndef DBG_REP_INNULL
#define DBG_REP_INNULL 0
#endif
#ifndef DBG_TIME
#define DBG_TIME 0
#endif
#ifndef SELA
#define SELA 0x4
#endif
#ifndef SELB
#define SELB 0x2
#endif
#define TSTAMP(id) do { if (DBG_TIME && blockIdx.x == 0 && threadIdx.x == 0) { const Args* ap_t; { auto kp_ = __builtin_amdgcn_kernarg_segment_ptr(); asm volatile("" : "+s"(kp_)); ap_t = (const Args*)kp_; } \
    unsigned long long* tb = (unsigned long long*)(ap_t->ws + 64); const unsigned long long t_ = __builtin_amdgcn_s_memrealtime(); tb[1 + (id)] += t_ - tb[0]; tb[0] = t_; } } while (0)
__global__ void __launch_bounds__(NTHREADS, 2) fwd_kernel(Args a_unused) {
    extern __shared__ __attribute__((aligned(16))) unsigned char lds[];
    cg::grid_group grid = cg::this_grid();
    LAS unsigned char* ldsl = (LAS unsigned char*)lds;
    if (threadIdx.x == 0) { ((volatile LAS unsigned*)(ldsl + LDS_BYTES - 16))[0] = 0u; ((volatile LAS unsigned*)(ldsl + LDS_BYTES - 16))[1] = 0u;
        const Args* ap_s; { auto kp_ = __builtin_amdgcn_kernarg_segment_ptr(); asm volatile("" : "+s"(kp_)); ap_s = (const Args*)kp_; } (void)xb_add(&((unsigned*)(ap_s->ws + 4096))[XB_XCNT(xb_xcc_id())], 1u); }
    __syncthreads();
    if (DBG_TIME && blockIdx.x == 0 && threadIdx.x == 0) { const Args* ap_t; { auto kp_ = __builtin_amdgcn_kernarg_segment_ptr(); asm volatile("" : "+s"(kp_)); ap_t = (const Args*)kp_; } ((unsigned long long*)(ap_t->ws + 64))[0] = __builtin_amdgcn_s_memrealtime(); }
    grid.sync();

    for (int rep_ = 0; rep_ < (DBG_REP_PRO ? 2 : 1); ++rep_)
    {
        const int l = 0; PH();
        LAS float* scr = (LAS float*)(ldsl + wave * 16384);
        constexpr int I_IN = (DM / 64) * (NIN / 32), I_SQ = (DM / 64) * (DM / 32), I_UP = (DM / 64) * (NUP / 32), I_DN = (DFF / 64) * (DM / 32), I_PLE = (PLE / 64) * (DM / 32);
        constexpr int I_LAYER = I_IN + 4 * I_SQ + I_UP + I_DN + I_PLE;
        for (int it = gw; it < DEPTH * I_LAYER; it += NGW) {
            const int ll = it / I_LAYER; int r = it % I_LAYER; unsigned char* wll = ws + WS_W + (size_t)ll * W_LAYER;
            if (r < I_IN) { transpose_item<false, true>(ap->in[3] + (size_t)ll * DM * NIN, DM, NIN, (bf16*)(wll + WO_IN), scr, r, lane, ap->in[2] + (size_t)ll * DM); continue; } r -= I_IN;
            if (r < I_SQ) { transpose_item<false>(ap->in[14] + (size_t)ll * DM * DM, DM, DM, (bf16*)(wll + WO_PA), scr, r, lane); continue; } r -= I_SQ;
            if (r < I_SQ) { transpose_item<false>(ap->in[15] + (size_t)ll * DM * DM, DM, DM, (bf16*)(wll + WO_PB), scr, r, lane); continue; } r -= I_SQ;
            if (r < I_SQ) { transpose_item<false>(ap->in[16] + (size_t)ll * DM * DM, DM, DM, (bf16*)(wll + WO_O), scr, r, lane); continue; } r -= I_SQ;
            if (r < I_SQ) { transpose_item<false, true>(ap->in[23] + (size_t)ll * DM * DM, DM, DM, (bf16*)(wll + WO_PG), scr, r, lane, ap->in[22] + (size_t)ll * DM); continue; } r -= I_SQ;
            if (r < I_UP) { transpose_item<true, true>(ap->in[18] + (size_t)ll * DM * NUP, DM, NUP, (bf16*)(wll + WO_UP), scr, r, lane, ap->in[17] + (size_t)ll * DM); continue; } r -= I_UP;
            if (r < I_DN) { transpose_item<false>(ap->in[21] + (size_t)ll * DFF * DM, DFF, DM, (bf16*)(wll + WO_DOWN), scr, r, lane); continue; } r -= I_DN;
            transpose_item<false>(ap->in[25] + (size_t)ll * PLE * DM, PLE, DM, (bf16*)(wll + WO_PLE), scr, r, lane);
        }
        { const float* wsrc = ap->in[7];
          for (size_t i = gt; i < (size_t)DEPTH * 8 * 128 * 128; i += NGT) { const int ll = (int)(i >> 17), rem = (int)(i & 131071), t = (rem >> 7) & 127, sc = rem & 127;
              const float w = wsrc[i]; ((bf16*)(ws + WS_W + (size_t)ll * W_LAYER + WO_S))[rem] = (bf16)f2bf(sc <= t ? w : 0.f); } }
        { const float* xin = ap->in[0];
          for (int m = gw; m < M; m += NGW) { const f32x4* xr = (const f32x4*)(xin + (size_t)m * DM) + lane; float sq = 0.f;
#pragma unroll
              for (int j = 0; j < 4; ++j) { const f32x4 v = xr[64 * j]; sq += (v.x * v.x + v.y * v.y) + (v.z * v.z + v.w * v.w);
                  ((unsigned long long*)(H + (size_t)m * DM))[lane + 64 * j] = (unsigned long long)pkh2(v.x, v.y) | ((unsigned long long)pkh2(v.z, v.w) << 32); }
              sq = wave_sum(sq, lane); if (lane < 16) SS[(size_t)m * 16 + lane] = lane == 0 ? sq : 0.f; } }
    }
    GRID_SYNC(); TSTAMP(0);

#ifndef DBG_STOP
#define DBG_STOP 0
#endif
#define DBG_DUMP_BF16(buf) do { PH(); for (size_t i = gt; i < (size_t)M * DM; i += NGT) X[i] = blo((unsigned)(buf)[i % ((size_t)MH * DM)]); return; } while (0)
#define DBG_DUMP3(b0, b1, b2) do { PH(); for (size_t i = gt; i < (size_t)M * DM; i += NGT) { const size_t k = i % ((size_t)MH * DM); X[i] = blo((unsigned)(b0)[k]) + blo((unsigned)(b1)[k]) + blo((unsigned)(b2)[k]); } return; } while (0)
#define DBG_ZERO_UPPER() do { PH(); for (size_t i = gt; i < (size_t)MH * DM; i += NGT) X[(size_t)MH * DM + i] = 0.f; return; } while (0)
#pragma unroll 1
    for (int l = 0; l < DEPTH; ++l) {
#pragma unroll 1
        for (int hf = 0; hf < 2; ++hf) {
            if (DBG_REP_INNULL) { PH(); pg8::Gemm g{H + (size_t)hf * MH * DM, (const bf16*)(wl + WO_IN), MH, NIN, DM}; pg8::StaticOrder S; S.init(MH, NIN, G, bx); pg8::EpiNull E; pg8::gemm_phase<pg8::EpiNull, pg8::StaticOrder, true, true, true>(ldsl, g, S, E); }
            for (int rep_ = 0; rep_ < (DBG_REP_IN ? 2 : 1); ++rep_)
            { PH(); pg8::Gemm g{H + (size_t)hf * MH * DM, (const bf16*)(wl + WO_IN), MH, NIN, DM}; pg8::StaticOrder S; S.init(MH, NIN, G, bx);
              pg8::EpiIn E{Z, ZS, ap->in[4] + (size_t)l * 2 * DM, 0.125f * 1.4426950408889634f, SS + (size_t)(3 * l) * SSS + (size_t)hf * MH * 16, (float*)(ws + WS_VST)};
              pg8::gemm_phase<pg8::EpiIn, pg8::StaticOrder, true, true, true>(ldsl, g, S, E); }
            GRID_SYNC(); TSTAMP(1);
            if (DBG_STOP == 2) DBG_DUMP3(ZU, ZQ, ZGA);
            if (DBG_STOP == 12) DBG_DUMP3(ZV, ZK, ZGB);
            if (DBG_STOP == 22) DBG_DUMP3(ZVA, ZVA, ZVA);
            if (DBG_STOP == 1) DBG_DUMP3(H, H, H);
            if (DBG_STOP == 32) DBG_DUMP3(ZGA, ZGA, ZGA);
            if (DBG_STOP == 42) DBG_DUMP3(ZU, ZU, ZU);
            if (DBG_STOP == 52) DBG_DUMP3(ZQ, ZQ, ZQ);
            { PH();
              int l_o = l; asm volatile("" : "+s"(l_o));
              const float lam_init = 0.8f - 0.6f * expf(-0.3f * (float)l_o);
              const float s1 = wave_sum(ap->in[9][l * 64 + lane] * ap->in[10][l * 64 + lane], lane), s2 = wave_sum(ap->in[11][l * 64 + lane] * ap->in[12][l * 64 + lane], lane);
              const float lam = __builtin_bit_cast(float, __builtin_amdgcn_readfirstlane(__builtin_bit_cast(int, expf(s1) - expf(s2) + lam_init)));
              const float oscale = __builtin_bit_cast(float, __builtin_amdgcn_readfirstlane(__builtin_bit_cast(int, 1.0f - lam_init)));
              const float* gsub = ap->in[13] + l * 128;
              bool pre = false;
              for (int p = bx; p < 1024; p += G) {
                  const int combo = p & 255, qi = p >> 8, b = combo & 7, r = combo >> 3, h = r >> 2, sq = r & 3;
                  const int qb = qi == 0 ? 15 - sq : qi == 1 ? 8 + sq : qi == 2 ? 7 - sq : sq;
                  const int pn = p + G; const bool more = pn < 1024; const int ncombo = pn & 255, nb2 = more ? (ncombo & 7) : -1, nh2 = (ncombo >> 3) >> 2;
#pragma unroll 1
                  for (int mp = 0; mp < 2; ++mp) {
                  if (mp == 0) attn_body::attn_unit<8, false>(pre, b, 2 * h + 1, h, b, 2 * h, h, qb, (const attn_body::bf16*)ZQ, (const attn_body::bf16*)ZK, (const attn_body::bf16*)ZVA, (attn_body::bf16*)O1, nullptr, 0.f, 0.f, nullptr, (char*)lds);
                  else attn_body::attn_unit<8, true>(pre, nb2, 2 * nh2, nh2, b, 2 * h + 1, h, qb, (const attn_body::bf16*)ZQ, (const attn_body::bf16*)ZK, (const attn_body::bf16*)ZVA, (attn_body::bf16*)O1, (attn_body::bf16*)ZQ, lam, oscale, gsub, (char*)lds);
                  pre = (mp == 0) ? true : more; } } }
            __syncthreads();
            { PH();
              const float* bs = ap->in[8] + (size_t)l * 1024; const float* lng = ap->in[5] + (size_t)l * DM; const float* lnb = ap->in[6] + (size_t)l * DM;
              for (int i = bx; i < MH / 128; i += G) sgu_unit(ldsl, ZU, ZU, ZV, (const float*)(ws + WS_VST), (const bf16*)(wl + WO_S), bs, lng, lnb, (size_t)i * 128, tid, lane, wave); }
            GRID_SYNC(); TSTAMP(2);
            if (DBG_STOP == 3) DBG_DUMP3(O1, O2, ZU);
            if (DBG_STOP == 13) DBG_DUMP3(O1, O2, O1);
            if (DBG_STOP == 23) DBG_DUMP3(ZU, ZU, ZU);
            for (int rep_ = 0; rep_ < (DBG_REP_P4 ? 2 : 1); ++rep_) {
            { PH(); pg8::StaticOrder S; S.init(MH, DM, G, bx);
              pg8::Gemm g{ZU, (const bf16*)(wl + WO_PA), MH, DM, DM}; pg8::EpiGate<false> E{ZGA, ZK}; pg8::gemm_phase<pg8::EpiGate<false>, pg8::StaticOrder, true, true>(ldsl, g, S, E); }
            { PH(); pg8::StaticOrder S; S.init(MH, DM, G, bx);
              pg8::Gemm g{ZQ, (const bf16*)(wl + WO_PB), MH, DM, DM}; pg8::EpiGate<true> E{ZGB, ZK}; pg8::gemm_phase<pg8::EpiGate<true>, pg8::StaticOrder, true, true>(ldsl, g, S, E); }
            }
            GRID_SYNC(); TSTAMP(4);
            if (DBG_STOP == 5) DBG_DUMP3(ZK, ZK, ZK);
            { PH(); pg8::Gemm g{ZK, (const bf16*)(wl + WO_O), MH, DM, DM}; pg8::StaticOrder S; S.init(MH, DM, G, bx);
              pg8::EpiResid<false> E{H + (size_t)hf * MH * DM, H + (size_t)hf * MH * DM, nullptr, nullptr, SS + (size_t)(3 * l + 1) * SSS + (size_t)hf * MH * 16, nullptr};
              if (DBG_REP_RES) { pg8::EpiResid<false> E0 = E; E0.ascale = 0.f; pg8::gemm_phase<pg8::EpiResid<false>, pg8::StaticOrder, true, true>(ldsl, g, S, E0); }
              pg8::gemm_phase<pg8::EpiResid<false>, pg8::StaticOrder, true, true>(ldsl, g, S, E); }
            GRID_SYNC(); TSTAMP(5);
            if (DBG_STOP == 6) DBG_ZERO_UPPER();
        }
        for (int rep_ = 0; rep_ < (DBG_REP_UP ? 2 : 1); ++rep_)
        { PH(); pg8::Gemm g{H, (const bf16*)(wl + WO_UP), M, NUP, DM}; pg8::StaticOrder S; S.init(M, NUP, G, bx);
          pg8::EpiConv E{ACT, EDGE, ap->in[19] + (size_t)l * 3 * NUP, ap->in[20] + (size_t)l * NUP, (LAS float*)(ldsl + XB_OFF), SS + (size_t)(3 * l + 1) * SSS};
          pg8::gemm_phase<pg8::EpiConv, pg8::StaticOrder, true, true, true>(ldsl, g, S, E); }
        GRID_SYNC(); TSTAMP(7);
        { PH(); const float* cw = ap->in[19] + (size_t)l * 3 * NUP; const float* cb = ap->in[20] + (size_t)l * NUP;
          for (size_t i = gt; i < (size_t)(M / 256) * pg8::NTC * 2 * 32; i += NGT) {
              const int c = (int)(i & 31) * 4, row = (int)((i >> 5) & 1), tile = (int)(i >> 6), pn = tile % pg8::NTC, pm = tile / pg8::NTC;
              const bool first = (pm % (SEQ / 256)) == 0; const int gcol = pn * 128 + c;
              const float* e1 = EDGE + (size_t)tile * 1024; const float* e0 = EDGE + (size_t)(first ? tile : tile - pg8::NTC) * 1024;
              f32x4 av[2];
#pragma unroll
              for (int q = 0; q < 2; ++q) { const int jc = q * 128 + c, col = q * DFF + gcol;
                  const f32x4 z4 = (f32x4){0.f, 0.f, 0.f, 0.f};
                  const f32x4 pm2 = first ? z4 : *(const f32x4*)(e0 + 2 * 256 + jc), pm1 = first ? z4 : *(const f32x4*)(e0 + 3 * 256 + jc), r0 = *(const f32x4*)(e1 + jc), r1 = *(const f32x4*)(e1 + 256 + jc);
                  const f32x4 w0 = *(const f32x4*)(cw + col), w1 = *(const f32x4*)(cw + NUP + col), w2 = *(const f32x4*)(cw + 2 * NUP + col), bb = *(const f32x4*)(cb + col);
                  av[q] = row == 0 ? (w0 * pm2 + w1 * pm1 + w2 * r0 + bb) : (w0 * pm1 + w1 * r0 + w2 * r1 + bb); }
              v2u w; w.x = pk2(pg8::gelu_tanh_f(av[0][0]) * av[1][0], pg8::gelu_tanh_f(av[0][1]) * av[1][1]); w.y = pk2(pg8::gelu_tanh_f(av[0][2]) * av[1][2], pg8::gelu_tanh_f(av[0][3]) * av[1][3]);
              *(v2u*)(ACT + (size_t)(pm * 256 + row) * DFF + gcol) = w; }
          const float* pl = ap->in[1] + (size_t)l * M * PLE;
          for (size_t i = gt; i < (size_t)M * PLE / 8; i += NGT) { const f32x4 v0 = ((const f32x4*)pl)[2 * i], v1 = ((const f32x4*)pl)[2 * i + 1];
              v4u w; w.x = pk2(v0.x, v0.y); w.y = pk2(v0.z, v0.w); w.z = pk2(v1.x, v1.y); w.w = pk2(v1.z, v1.w); ((v4u*)PBF)[i] = w; } }
        GRID_SYNC(); TSTAMP(8);
        { PH(); pg8::Gemm g{ACT, (const bf16*)(wl + WO_DOWN), M, DM, DFF}; pg8::StaticOrder S; S.init(M, DM, G, bx);
          pg8::EpiResid<false> E{H, XBB, nullptr, nullptr, SS + (size_t)(3 * l + 2) * SSS, nullptr};
          if (DBG_REP_RES) { pg8::EpiResid<false> E0 = E; E0.ascale = 0.f; pg8::gemm_phase<pg8::EpiResid<false>, pg8::StaticOrder, true, true>(ldsl, g, S, E0); }
          pg8::gemm_phase<pg8::EpiResid<false>, pg8::StaticOrder, true, true>(ldsl, g, S, E); }
        GRID_SYNC(); TSTAMP(9);
        { PH(); pg8::Gemm g{PBF, (const bf16*)(wl + WO_PLE), M, DM, PLE}; pg8::StaticOrder S; S.init(M, DM, G, bx);
          pg8::EpiStore E{EB, DM}; pg8::gemm_phase<pg8::EpiStore, pg8::StaticOrder, true, true>(ldsl, g, S, E); }
        { PH(); pg8::Gemm g{XBB, (const bf16*)(wl + WO_PG), M, DM, DM}; pg8::StaticOrder S; S.init(M, DM, G, bx);
          pg8::EpiResid<true> E{XBB, H, ap->in[24] + (size_t)l * DM, EB, SS + (size_t)(3 * l + 3) * SSS, SS + (size_t)(3 * l + 2) * SSS};
          if (DBG_REP_RES) { pg8::EpiResid<true> E0 = E; E0.ascale = 0.f; E0.XBO = XBB; pg8::gemm_phase<pg8::EpiResid<true>, pg8::StaticOrder, true, true, true>(ldsl, g, S, E0); }
          pg8::gemm_phase<pg8::EpiResid<true>, pg8::StaticOrder, true, true, true>(ldsl, g, S, E); }
        GRID_SYNC(); TSTAMP(11);
        if (l + 1 == DEPTH) { PH(); const float* gfin = ap->in[26];
            for (int m = gw; m < M; m += NGW) { const bf16* xr = H + (size_t)m * DM + 16 * lane; const v4u a0 = *(const v4u*)xr, a1 = *(const v4u*)(xr + 8);
                float f[16]; f[0] = pg8::h_lo(a0.x); f[1] = pg8::h_hi(a0.x); f[2] = pg8::h_lo(a0.y); f[3] = pg8::h_hi(a0.y); f[4] = pg8::h_lo(a0.z); f[5] = pg8::h_hi(a0.z); f[6] = pg8::h_lo(a0.w); f[7] = pg8::h_hi(a0.w);
                f[8] = pg8::h_lo(a1.x); f[9] = pg8::h_hi(a1.x); f[10] = pg8::h_lo(a1.y); f[11] = pg8::h_hi(a1.y); f[12] = pg8::h_lo(a1.z); f[13] = pg8::h_hi(a1.z); f[14] = pg8::h_lo(a1.w); f[15] = pg8::h_hi(a1.w);
                float sq = 0.f;
#pragma unroll
                for (int j = 0; j < 16; ++j) sq += f[j] * f[j];
                const float rstd = 1.0f / sqrtf(wave_sum(sq, lane) * (1.f / DM) + EPS);
                float* orow = X + (size_t)m * DM + 16 * lane;
#pragma unroll
                for (int j = 0; j < 4; ++j) { const f32x4 gg = *(const f32x4*)(gfin + 16 * lane + 4 * j); *(f32x4*)(orow + 4 * j) = (f32x4){f[4 * j] * rstd * gg[0], f[4 * j + 1] * rstd * gg[1], f[4 * j + 2] * rstd * gg[2], f[4 * j + 3] * rstd * gg[3]}; } } }
        if (DBG_TIME && l + 1 == DEPTH) { GRID_SYNC(); TSTAMP(12); GRID_SYNC();
            PH(); const unsigned long long* tb = (const unsigned long long*)(ws + 64); unsigned long long sa = 0, sb = 0;
            for (int k = 0; k < 13; ++k) { const unsigned long long v = __hip_atomic_load(tb + 1 + k, __ATOMIC_RELAXED, __HIP_MEMORY_SCOPE_AGENT); if ((SELA >> k) & 1) sa += v; if ((SELB >> k) & 1) sb += v; }
            const float fb = (float)(sa + sb) * 0.00001f;
            for (size_t i = gt; i < (size_t)16384 * DM; i += NGT) X[i] = fb; }
    }
}

extern "C" void kernel_launch(void* const* d_in, const int* in_sizes, int n_in, void* d_out, int out_size, void* d_ws, size_t ws_size, hipStream_t stream) {
    static int grid = 0;
    if (grid == 0) {
        if (n_in != 27 || out_size != M * DM || ws_size < WS_END) { fprintf(stderr, "kernel_launch: unexpected shapes (n_in %d out %d ws %zu)\n", n_in, out_size, ws_size); grid = -1; return; }
        int dev = 0, cus = 0, per_cu = 0;
        if (hipGetDevice(&dev) != hipSuccess || hipDeviceGetAttribute(&cus, hipDeviceAttributeMultiprocessorCount, dev) != hipSuccess) { grid = -1; return; }
        if (hipFuncSetAttribute((const void*)fwd_kernel, hipFuncAttributeMaxDynamicSharedMemorySize, LDS_BYTES) != hipSuccess) { fprintf(stderr, "kernel_launch: hipFuncSetAttribute failed\n"); grid = -1; return; }
        if (hipOccupancyMaxActiveBlocksPerMultiprocessor(&per_cu, (const void*)fwd_kernel, NTHREADS, LDS_BYTES) != hipSuccess || per_cu < 1) { fprintf(stderr, "kernel_launch: occupancy query gives %d\n", per_cu); per_cu = 1; }
        (void)hipGetLastError();
        grid = cus * per_cu;
    }
    if (grid < 0) return;
    if (hipMemsetAsync(d_ws, 0, 32768, stream) != hipSuccess) { fprintf(stderr, "kernel_launch: memset failed\n"); return; }
    Args a{};
    for (int i = 0; i < 27; ++i) a.in[i] = (const float*)d_in[i];
    a.out = (float*)d_out; a.ws = (unsigned char*)d_ws;
    void* args[] = {&a};
    hipError_t e = hipLaunchCooperativeKernel((const void*)fwd_kernel, dim3(grid), dim3(NTHREADS), args, LDS_BYTES, stream);
    if (e != hipSuccess) fprintf(stderr, "kernel_launch: cooperative launch failed: %s (grid %d)\n", hipGetErrorString(e), grid);
}
```

```cpp
#include <hip/hip_runtime.h>
#include <hip/hip_cooperative_groups.h>
#include <cstdio>
#include <cstdint>
namespace cg = cooperative_groups;
namespace pg8 {
#define PG8_LAS __attribute__((address_space(3)))
typedef unsigned short bf16_t;
typedef short bf16x8 __attribute__((ext_vector_type(8)));
typedef float f32x4 __attribute__((ext_vector_type(4)));
typedef unsigned u32x4 __attribute__((ext_vector_type(4)));
constexpr int BM = 256, BK = 64, HALF = 128, HTB = HALF * BK * 2  , STAGE_BYTES = 8 * HTB, NXCD = 8, WGM = 8;

__host__ __device__ __forceinline__ int lds_byte(int r, int c) { const int st = (r >> 4) * 2 + (c >> 5), rr = r & 15, cc = c & 31, ob = rr * 64 + cc * 2; return st * 1024 + (ob ^ (((ob >> 9) & 1) << 5)); }
__host__ __device__ __forceinline__ void stage_rc(int b, int& R, int& C) { const int st = b / 1024, sb = b % 1024, swz = sb ^ (((sb >> 9) & 1) << 5); R = (st >> 1) * 16 + swz / 64; C = (st & 1) * 32 + (swz % 64) / 2; }
__host__ __device__ __forceinline__ int perm32(int rho) { const int n = rho >> 4, i = rho & 15; return 8 * (i >> 2) + 4 * n + (i & 3); }

struct Unit { int pm, pn; };
struct Gemm { const bf16_t* A; const bf16_t* Bt; int M, N, K; };

struct StaticOrder {
    int nM, nN, nwg, G, c;
    __host__ __device__ void init(int M, int N, int G_, int c_) { nM = M / BM; nN = N / BM; nwg = nM * nN; G = G_; c = c_; }
    __host__ __device__ bool next(int i, Unit& u) const {
        const long L = (long)i * G + c; if (L >= nwg) return false;
        int wgid = (int)L; { const int q = nwg / NXCD, r = nwg % NXCD, xcd = wgid % NXCD, off = wgid / NXCD; wgid = (xcd < r ? xcd * (q + 1) : r * (q + 1) + (xcd - r) * q) + off; }
        const int nig = WGM * nN, gid = wgid / nig, fm = gid * WGM, gsz = (nM - fm) < WGM ? (nM - fm) : WGM;
        u.pm = fm + ((wgid % nig) % gsz); u.pn = (wgid % nig) / gsz; return true;
    }
    __device__ __forceinline__ void a_ready(const Unit&) const {}
    __device__ __forceinline__ void done(const Unit&) const {}
};

typedef float cv_f32x2 __attribute__((ext_vector_type(2))); typedef __bf16 cv_bf16x2 __attribute__((ext_vector_type(2)));
__device__ __forceinline__ unsigned cvt_pk_bf16(float lo, float hi) { const cv_f32x2 v = {lo, hi}; const cv_bf16x2 b = __builtin_convertvector(v, cv_bf16x2); return __builtin_bit_cast(unsigned, b); }
typedef float f32x2 __attribute__((ext_vector_type(2)));
__device__ __forceinline__ f32x2 gelu_pk(f32x2 v) {
    const f32x2 av = __builtin_elementwise_abs(v), d = av * 0.2316418882f + 1.0f;
    f32x2 t; t.x = __builtin_amdgcn_rcpf(d.x); t.y = __builtin_amdgcn_rcpf(d.y);
    f32x2 q = t * 0.5307027145f + (-0.7265760135f); q = q * t + 0.7107068705f; q = q * t + (-0.142248368f); q = q * t + 0.127414796f; q = q * t;
    const f32x2 s = (v * v) * (-0.72134752044f);
    f32x2 e; e.x = __builtin_amdgcn_exp2f(s.x); e.y = __builtin_amdgcn_exp2f(s.y);
    const f32x2 m = v * (q * e), r = v - m;
    f32x2 o; o.x = v.x < 0.f ? m.x : r.x; o.y = v.y < 0.f ? m.y : r.y; return o;
}

template <int ACT  > struct EpiBf16 {
    static constexpr bool PERM = true, AFTER_DRAIN = false; static_assert(ACT == 0 || ACT == 1, "EpiBf16: ACT is 0 (none) or 1 (gelu_pk)");
    bf16_t* O; int ldc; const float* bias; int split_cols; size_t split_stride; float scale0;
    __device__ __forceinline__ void operator()(const f32x4 (&acc)[2][2][4][2], const Unit& u, int wr, int wc, int fr_, int fq_) const {
        int t_o = threadIdx.x; asm volatile("" : "+v"(t_o)); int fr = t_o & 15, fq = (t_o >> 4) & 3; (void)fr_; (void)fq_;

        const int row0 = u.pm * BM + wr * 64 + fr; int colt = u.pn * BM; bf16_t* base = O;
        float sc = 1.f; if (split_cols) { const int t = colt / split_cols; base += (size_t)t * split_stride; colt -= t * split_cols; if (t == 0) sc = scale0; }
        const int col0 = colt + wc * 32 + 8 * fq, bcol0 = u.pn * BM + wc * 32 + 8 * fq;
        f32x4 bv[2][2];
#pragma unroll
        for (int bj = 0; bj < 2; ++bj)
#pragma unroll
            for (int n = 0; n < 2; ++n) bv[bj][n] = bias ? *(const f32x4*)(bias + bcol0 + bj * HALF + 4 * n) : (f32x4){0.f, 0.f, 0.f, 0.f};
#pragma unroll
        for (int ai = 0; ai < 2; ++ai)
#pragma unroll
            for (int m = 0; m < 4; ++m) { bf16_t* rowp = base + (size_t)(row0 + ai * HALF + m * 16) * ldc + col0;
#pragma unroll
                for (int bj = 0; bj < 2; ++bj) { f32x4 v0 = acc[ai][bj][m][0] + bv[bj][0], v1 = acc[ai][bj][m][1] + bv[bj][1];
                    if (ACT == 1) { f32x2 a = gelu_pk((f32x2){v0[0], v0[1]}), b = gelu_pk((f32x2){v0[2], v0[3]}), c = gelu_pk((f32x2){v1[0], v1[1]}), d = gelu_pk((f32x2){v1[2], v1[3]});
                        v0 = (f32x4){a.x, a.y, b.x, b.y}; v1 = (f32x4){c.x, c.y, d.x, d.y}; }
                    v0 = v0 * sc; v1 = v1 * sc; u32x4 w; w.x = cvt_pk_bf16(v0[0], v0[1]); w.y = cvt_pk_bf16(v0[2], v0[3]); w.z = cvt_pk_bf16(v1[0], v1[1]); w.w = cvt_pk_bf16(v1[2], v1[3]);
                    *(u32x4*)(rowp + bj * HALF) = w; } }
    }
};
__device__ __forceinline__ float sigmoid_f(float x) { return __builtin_amdgcn_rcpf(1.0f + __builtin_amdgcn_exp2f(-1.4426950408889634f * x)); }
__device__ __forceinline__ float gelu_tanh_f(float x) { const float p = __builtin_fmaf(x * x, -0.10294324f, -2.3022082f); return x * __builtin_amdgcn_rcpf(1.0f + __builtin_amdgcn_exp2f(x * p)); }
__device__ __forceinline__ float bf_lo(unsigned w) { return __builtin_bit_cast(float, w << 16); }
__device__ __forceinline__ float bf_hi(unsigned w) { return __builtin_bit_cast(float, w & 0xffff0000u); }
typedef unsigned u32x2 __attribute__((ext_vector_type(2)));
typedef _Float16 h16x2 __attribute__((ext_vector_type(2)));
__device__ __forceinline__ float h_lo(unsigned w) { return (float)__builtin_bit_cast(h16x2, w)[0]; }
__device__ __forceinline__ float h_hi(unsigned w) { return (float)__builtin_bit_cast(h16x2, w)[1]; }
__device__ __forceinline__ unsigned cvt_pk_f16(float lo, float hi) { const h16x2 v = {(_Float16)lo, (_Float16)hi}; return __builtin_bit_cast(unsigned, v); }

__device__ __forceinline__ float rstd_row(const float* SSI, int row) { const f32x4* p = (const f32x4*)(SSI + (size_t)row * 16); const f32x4 a = p[0], b = p[1], c = p[2], d = p[3];
    const float s = ((a[0] + a[1]) + (a[2] + a[3])) + ((b[0] + b[1]) + (b[2] + b[3])) + ((c[0] + c[1]) + (c[2] + c[3])) + ((d[0] + d[1]) + (d[2] + d[3])); return __builtin_amdgcn_rsqf(s * (1.f / 1024.f) + 1e-6f); }
struct EpiIn {
    static constexpr bool PERM = true, AFTER_DRAIN = false;
    bf16_t* Z; size_t bufstride; const float* bgate; float qscale; const float* SSI; float* VST = nullptr;
    template <int MODE> __device__ __forceinline__ void body(const f32x4 (&acc)[2][2][4][2], bf16_t* base, const float* bias, int row0, int col0, int lane = 0, int slot = 0) const {
        f32x4 bv[2][2];
#pragma unroll
        for (int bj = 0; bj < 2; ++bj)
#pragma unroll
            for (int n = 0; n < 2; ++n) bv[bj][n] = (MODE == 3) ? *(const f32x4*)(bias + col0 + bj * HALF + 4 * n) : (f32x4){0.f, 0.f, 0.f, 0.f};
#pragma unroll
        for (int ai = 0; ai < 2; ++ai)
#pragma unroll
            for (int m = 0; m < 4; ++m) { bf16_t* rowp = base + (size_t)(row0 + ai * HALF + m * 16) * 1024 + col0;
                const float rs = rstd_row(SSI, row0 + ai * HALF + m * 16); float ps = 0.f, pq = 0.f;
#pragma unroll
                for (int bj = 0; bj < 2; ++bj) { f32x4 v0 = acc[ai][bj][m][0] * rs, v1 = acc[ai][bj][m][1] * rs;
                    if (MODE == 1 || MODE == 4) {
#pragma unroll
                        for (int x = 0; x < 4; ++x) { v0[x] = gelu_tanh_f(v0[x]); v1[x] = gelu_tanh_f(v1[x]); } }
                    if (MODE == 4) { ps += ((v0[0] + v0[1]) + (v0[2] + v0[3])) + ((v1[0] + v1[1]) + (v1[2] + v1[3]));
                        pq += ((v0[0] * v0[0] + v0[1] * v0[1]) + (v0[2] * v0[2] + v0[3] * v0[3])) + ((v1[0] * v1[0] + v1[1] * v1[1]) + (v1[2] * v1[2] + v1[3] * v1[3])); }
                    if (MODE == 2) { v0 = v0 * qscale; v1 = v1 * qscale; }
                    if (MODE == 3) { v0 = v0 + bv[bj][0]; v1 = v1 + bv[bj][1];
#pragma unroll
                        for (int x = 0; x < 4; ++x) { v0[x] = sigmoid_f(v0[x]); v1[x] = sigmoid_f(v1[x]); } }
                    u32x4 w; w.x = cvt_pk_bf16(v0[0], v0[1]); w.y = cvt_pk_bf16(v0[2], v0[3]); w.z = cvt_pk_bf16(v1[0], v1[1]); w.w = cvt_pk_bf16(v1[2], v1[3]);
                    *(u32x4*)(rowp + bj * HALF) = w; }
                if (MODE == 4) {
                    ps += __builtin_bit_cast(float, __builtin_amdgcn_ds_bpermute((lane ^ 16) << 2, __builtin_bit_cast(int, ps))); pq += __builtin_bit_cast(float, __builtin_amdgcn_ds_bpermute((lane ^ 16) << 2, __builtin_bit_cast(int, pq)));
                    ps += __builtin_bit_cast(float, __builtin_amdgcn_ds_bpermute((lane ^ 32) << 2, __builtin_bit_cast(int, ps))); pq += __builtin_bit_cast(float, __builtin_amdgcn_ds_bpermute((lane ^ 32) << 2, __builtin_bit_cast(int, pq)));
                    if ((lane >> 4) == 0) { float* vp = VST + (size_t)(row0 + ai * HALF + m * 16) * 32 + slot * 2; vp[0] = ps; vp[1] = pq; } }
                asm volatile("" ::: "memory"); }
    }
    __device__ __forceinline__ void operator()(const f32x4 (&acc)[2][2][4][2], const Unit& u, int wr, int wc, int fr_, int fq_) const {
        int t_o = threadIdx.x; asm volatile("" : "+v"(t_o)); int fr = t_o & 15, fq = (t_o >> 4) & 3; (void)fr_; (void)fq_;

        const int t = u.pn >> 2, colt = (u.pn & 3) * BM;
        bf16_t* base = Z + (size_t)t * bufstride;
        const int row0 = u.pm * BM + wr * 64 + fr, col0 = colt + wc * 32 + 8 * fq;
        if (t == 0) body<1>(acc, base, nullptr, row0, col0);
        else if (t == 1) body<4>(acc, base, nullptr, row0, col0, t_o & 63, (u.pn & 3) * 4 + wc);
        else if (t == 2) body<2>(acc, base, nullptr, row0, col0);
        else if (t < 5) body<0>(acc, base, nullptr, row0, col0);
        else body<3>(acc, base, bgate + (t - 5) * 1024, row0, col0);
    }
};
struct EpiNull {
    static constexpr bool PERM = true, AFTER_DRAIN = false;
    __device__ __forceinline__ void operator()(const f32x4 (&acc)[2][2][4][2], const Unit& u, int wr, int wc, int fr_, int fq_) const {
#pragma unroll
        for (int ai = 0; ai < 2; ++ai)
#pragma unroll
            for (int bj = 0; bj < 2; ++bj)
#pragma unroll
                for (int m = 0; m < 4; ++m)
#pragma unroll
                    for (int n = 0; n < 2; ++n) asm volatile("" :: "v"(acc[ai][bj][m][n]));
    }
};
struct EpiStore {
    static constexpr bool PERM = true, AFTER_DRAIN = false;
    bf16_t* O; int ldc;
    __device__ __forceinline__ void operator()(const f32x4 (&acc)[2][2][4][2], const Unit& u, int wr, int wc, int fr_, int fq_) const {
        int t_o = threadIdx.x; asm volatile("" : "+v"(t_o)); int fr = t_o & 15, fq = (t_o >> 4) & 3; (void)fr_; (void)fq_;

        const int row0 = u.pm * BM + wr * 64 + fr, col0 = u.pn * BM + wc * 32 + 8 * fq;
#pragma unroll
        for (int ai = 0; ai < 2; ++ai)
#pragma unroll
            for (int m = 0; m < 4; ++m) { bf16_t* rowp = O + (size_t)(row0 + ai * HALF + m * 16) * ldc + col0;
#pragma unroll
                for (int bj = 0; bj < 2; ++bj) { const f32x4 v0 = acc[ai][bj][m][0], v1 = acc[ai][bj][m][1];
                    u32x4 w; w.x = cvt_pk_bf16(v0[0], v0[1]); w.y = cvt_pk_bf16(v0[2], v0[3]); w.z = cvt_pk_bf16(v1[0], v1[1]); w.w = cvt_pk_bf16(v1[2], v1[3]);
                    *(u32x4*)(rowp + bj * HALF) = w; } }
    }
};
template <bool ADD> struct EpiGate {
    static constexpr bool PERM = true, AFTER_DRAIN = false;
    const bf16_t* G; bf16_t* MG;
    __device__ __forceinline__ void operator()(const f32x4 (&acc)[2][2][4][2], const Unit& u, int wr, int wc, int fr_, int fq_) const {
        int t_o = threadIdx.x; asm volatile("" : "+v"(t_o)); int fr = t_o & 15, fq = (t_o >> 4) & 3; (void)fr_; (void)fq_;

        const int row0 = u.pm * BM + wr * 64 + fr, col0 = u.pn * BM + wc * 32 + 8 * fq;
#pragma unroll
        for (int ai = 0; ai < 2; ++ai)
#pragma unroll
            for (int m = 0; m < 4; ++m) { const size_t off = (size_t)(row0 + ai * HALF + m * 16) * 1024 + col0;
#pragma unroll
                for (int bj = 0; bj < 2; ++bj) { const f32x4 v0 = acc[ai][bj][m][0], v1 = acc[ai][bj][m][1];
                    const u32x4 g = *(const u32x4*)(G + off + bj * HALF);
                    float r[8];
                    r[0] = bf_lo(g.x) * v0[0]; r[1] = bf_hi(g.x) * v0[1]; r[2] = bf_lo(g.y) * v0[2]; r[3] = bf_hi(g.y) * v0[3];
                    r[4] = bf_lo(g.z) * v1[0]; r[5] = bf_hi(g.z) * v1[1]; r[6] = bf_lo(g.w) * v1[2]; r[7] = bf_hi(g.w) * v1[3];
                    if (ADD) { const u32x4 o = *(const u32x4*)(MG + off + bj * HALF);
                        r[0] += bf_lo(o.x); r[1] += bf_hi(o.x); r[2] += bf_lo(o.y); r[3] += bf_hi(o.y); r[4] += bf_lo(o.z); r[5] += bf_hi(o.z); r[6] += bf_lo(o.w); r[7] += bf_hi(o.w); }
                    u32x4 w; w.x = cvt_pk_bf16(r[0], r[1]); w.y = cvt_pk_bf16(r[2], r[3]); w.z = cvt_pk_bf16(r[4], r[5]); w.w = cvt_pk_bf16(r[6], r[7]);
                    *(u32x4*)(MG + off + bj * HALF) = w; }
                asm volatile("" ::: "memory"); }
    }
};
template <bool PLE> struct EpiResid {
    static constexpr bool PERM = true, AFTER_DRAIN = false;
    const bf16_t* XIB; bf16_t* XBO; const float* bias; const bf16_t* E;
    float* SSO; const float* SSI;
    float ascale = 1.f;
    __device__ __forceinline__ void operator()(const f32x4 (&acc)[2][2][4][2], const Unit& u, int wr, int wc, int fr_, int fq_) const {
        int t_o = threadIdx.x; asm volatile("" : "+v"(t_o)); int fr = t_o & 15, fq = (t_o >> 4) & 3; (void)fr_; (void)fq_;
        const int lane = t_o & 63;
        const int col0 = u.pn * BM + wc * 32 + 8 * fq;
        constexpr int MG = PLE ? 2 : 4;
#pragma unroll
        for (int ai = 0; ai < 2; ++ai)
#pragma unroll
        for (int m0 = 0; m0 < 4; m0 += MG) {
            u32x4 xi[4][2]; u32x4 ev[4][2]; float rs[4];
#pragma unroll
            for (int m = m0; m < m0 + MG; ++m) { const int row = u.pm * BM + ai * HALF + wr * 64 + m * 16 + fr; const size_t off = (size_t)row * 1024 + col0;
                rs[m] = 1.f; if (PLE) rs[m] = rstd_row(SSI, row);
#pragma unroll
                for (int bj = 0; bj < 2; ++bj) { xi[m][bj] = *(const u32x4*)(XIB + off + bj * HALF); if (PLE) ev[m][bj] = *(const u32x4*)(E + off + bj * HALF); } }
#pragma unroll
            for (int m = m0; m < m0 + MG; ++m) { const int row = u.pm * BM + ai * HALF + wr * 64 + m * 16 + fr; const size_t off = (size_t)row * 1024 + col0;
                float q = 0.f;
#pragma unroll
                for (int bj = 0; bj < 2; ++bj) { f32x4 a0 = acc[ai][bj][m][0], a1 = acc[ai][bj][m][1];
                    if (PLE) { const f32x4 bv0 = *(const f32x4*)(bias + col0 + bj * HALF), bv1 = *(const f32x4*)(bias + col0 + bj * HALF + 4); const u32x4 e = ev[m][bj];
                        a0 = a0 * rs[m] + bv0; a1 = a1 * rs[m] + bv1;
                        a0[0] = sigmoid_f(a0[0]) * bf_lo(e.x); a0[1] = sigmoid_f(a0[1]) * bf_hi(e.x); a0[2] = sigmoid_f(a0[2]) * bf_lo(e.y); a0[3] = sigmoid_f(a0[3]) * bf_hi(e.y);
                        a1[0] = sigmoid_f(a1[0]) * bf_lo(e.z); a1[1] = sigmoid_f(a1[1]) * bf_hi(e.z); a1[2] = sigmoid_f(a1[2]) * bf_lo(e.w); a1[3] = sigmoid_f(a1[3]) * bf_hi(e.w); }
                    const u32x4 xo = xi[m][bj];
                    const f32x4 xn0 = (f32x4){h_lo(xo.x), h_hi(xo.x), h_lo(xo.y), h_hi(xo.y)} + a0 * ascale, xn1 = (f32x4){h_lo(xo.z), h_hi(xo.z), h_lo(xo.w), h_hi(xo.w)} + a1 * ascale;
                    u32x4 w; w.x = cvt_pk_f16(xn0[0], xn0[1]); w.y = cvt_pk_f16(xn0[2], xn0[3]); w.z = cvt_pk_f16(xn1[0], xn1[1]); w.w = cvt_pk_f16(xn1[2], xn1[3]);
                    *(u32x4*)(XBO + off + bj * HALF) = w;
                    q += ((xn0[0] * xn0[0] + xn0[1] * xn0[1]) + (xn0[2] * xn0[2] + xn0[3] * xn0[3])) + ((xn1[0] * xn1[0] + xn1[1] * xn1[1]) + (xn1[2] * xn1[2] + xn1[3] * xn1[3])); }
                q += __builtin_bit_cast(float, __builtin_amdgcn_ds_bpermute((lane ^ 16) << 2, __builtin_bit_cast(int, q)));
                q += __builtin_bit_cast(float, __builtin_amdgcn_ds_bpermute((lane ^ 32) << 2, __builtin_bit_cast(int, q)));
                if (fq == 0) SSO[(size_t)row * 16 + u.pn * 4 + wc] = q; }
            asm volatile("" ::: "memory"); }
    }
};
constexpr int FFC = 2816, NTC = FFC / 128;
struct EpiConv {
    static constexpr bool PERM = true, AFTER_DRAIN = false;
    bf16_t* ACT; float* EDGE; const float* cw; const float* cb; PG8_LAS float* xb; const float* SSI;
    __device__ __forceinline__ void operator()(f32x4 (&acc)[2][2][4][2], const Unit& u, int wr, int wc, int fr_, int fq_) const {
        int t_o = threadIdx.x; asm volatile("" : "+v"(t_o)); int fr = t_o & 15, fq = (t_o >> 4) & 3; (void)fr_; (void)fq_;

        const int lane = t_o & 63;
        const int jc0 = wc * 32 + 8 * fq;
        { PG8_LAS float* rtab = xb + 2048; const int tt = t_o & 511;
          if (tt < 256) rtab[tt] = rstd_row(SSI, u.pm * BM + tt);
          asm volatile("s_waitcnt lgkmcnt(0)" ::: "memory"); __builtin_amdgcn_s_barrier(); asm volatile("" ::: "memory");
#pragma unroll
          for (int ai = 0; ai < 2; ++ai)
#pragma unroll
            for (int m = 0; m < 4; ++m) { const float rs = rtab[ai * HALF + wr * 64 + m * 16 + fr];
#pragma unroll
                for (int bj = 0; bj < 2; ++bj)
#pragma unroll
                    for (int n = 0; n < 2; ++n) acc[ai][bj][m][n] = acc[ai][bj][m][n] * rs; } }
        if (fr >= 14) {
#pragma unroll
            for (int ai = 0; ai < 2; ++ai)
#pragma unroll
                for (int bj = 0; bj < 2; ++bj)
#pragma unroll
                    for (int n = 0; n < 2; ++n) *(PG8_LAS f32x4*)(xb + (((ai * 2 + wr) * 2 + (fr - 14)) * 256 + bj * HALF + jc0 + 4 * n)) = acc[ai][bj][3][n];
        }
        float* eb = EDGE + (size_t)(u.pm * NTC + u.pn) * 4 * 256;
        if (wr == 0 && fr < 2) {
#pragma unroll
            for (int bj = 0; bj < 2; ++bj)
#pragma unroll
                for (int n = 0; n < 2; ++n) *(f32x4*)(eb + fr * 256 + bj * HALF + jc0 + 4 * n) = acc[0][bj][0][n];
        }
        if (wr == 1 && fr >= 14) {
#pragma unroll
            for (int bj = 0; bj < 2; ++bj)
#pragma unroll
                for (int n = 0; n < 2; ++n) *(f32x4*)(eb + (2 + fr - 14) * 256 + bj * HALF + jc0 + 4 * n) = acc[1][bj][3][n];
        }
        asm volatile("s_waitcnt lgkmcnt(0)" ::: "memory"); __builtin_amdgcn_s_barrier(); asm volatile("" ::: "memory");
        const int src1 = (lane & 48) | ((fr + 15) & 15), src2 = (lane & 48) | ((fr + 14) & 15);
#pragma unroll
        for (int bj = 0; bj < 2; ++bj)
#pragma unroll
            for (int n = 0; n < 2; ++n) {
                const int gc = bj * FFC + u.pn * 128 + jc0 + 4 * n;
                const f32x4 w0 = *(const f32x4*)(cw + gc), w1 = *(const f32x4*)(cw + 2 * FFC + gc), w2 = *(const f32x4*)(cw + 4 * FFC + gc), bb = *(const f32x4*)(cb + gc);
#pragma unroll
                for (int ai = 0; ai < 2; ++ai) {
                    const int grp = ai * 2 + wr;
                    f32x4 xp = (f32x4){0.f, 0.f, 0.f, 0.f};
                    if (grp > 0 && fr >= 14) xp = *(const PG8_LAS f32x4*)(xb + (((grp - 1) * 2 + (fr - 14)) * 256 + bj * HALF + jc0 + 4 * n));
#pragma unroll
                    for (int m = 3; m >= 0; --m) {
                        f32x4 cur = acc[ai][bj][m][n]; f32x4 prv = (m > 0) ? acc[ai][bj][m > 0 ? m - 1 : 0][n] : xp;
                        asm volatile("" : "+v"(cur), "+v"(prv));
                        f32x4 r;
#pragma unroll
                        for (int x = 0; x < 4; ++x) {
                            const float s1 = (fr == 15) ? prv[x] : cur[x], s2 = (fr >= 14) ? prv[x] : cur[x];
                            const float p1 = __builtin_bit_cast(float, __builtin_amdgcn_update_dpp(0, __builtin_bit_cast(int, s1), 0x121, 0xf, 0xf, false)), p2 = __builtin_bit_cast(float, __builtin_amdgcn_update_dpp(0, __builtin_bit_cast(int, s2), 0x122, 0xf, 0xf, false));
                            r[x] = w0[x] * p2 + w1[x] * p1 + w2[x] * cur[x] + bb[x];
                        }
                        asm volatile("" : "+v"(r));
                        acc[ai][bj][m][n] = r;
                    }
                    __builtin_amdgcn_sched_barrier(0);
                }
                asm volatile("" ::: "memory");
            }
#pragma unroll
        for (int ai = 0; ai < 2; ++ai)
#pragma unroll
            for (int m = 0; m < 4; ++m) {
                const bool skip = (ai == 0 && wr == 0 && m == 0 && fr < 2);
                bf16_t* rowp = ACT + (size_t)(u.pm * BM + ai * HALF + wr * 64 + m * 16 + fr) * FFC + u.pn * 128 + jc0;
                const f32x4 g0 = acc[ai][0][m][0], g1 = acc[ai][0][m][1], v0 = acc[ai][1][m][0], v1 = acc[ai][1][m][1];
                float r[8];
#pragma unroll
                for (int x = 0; x < 4; ++x) { r[x] = gelu_tanh_f(g0[x]) * v0[x]; r[4 + x] = gelu_tanh_f(g1[x]) * v1[x]; }
                u32x4 w; w.x = cvt_pk_bf16(r[0], r[1]); w.y = cvt_pk_bf16(r[2], r[3]); w.z = cvt_pk_bf16(r[4], r[5]); w.w = cvt_pk_bf16(r[6], r[7]);
                if (!skip) *(u32x4*)rowp = w;
                asm volatile("" ::: "memory"); __builtin_amdgcn_sched_barrier(0);
            }
        asm volatile("s_waitcnt lgkmcnt(0)" ::: "memory"); __builtin_amdgcn_s_barrier(); asm volatile("" ::: "memory");
    }
};
typedef _Float16 f16x8 __attribute__((ext_vector_type(8)));
template <class Epi, class Sched, bool ALIGN_EPI = false, bool SP2 = false, bool F16 = false>
__device__ __forceinline__ void gemm_phase(PG8_LAS unsigned char* lds, const Gemm g, const Sched& S, const Epi& E) {
    int tid_o = threadIdx.x; asm volatile("" : "+v"(tid_o));
    const int tid = tid_o, wid = __builtin_amdgcn_readfirstlane(tid >> 6), lane = tid & 63, wr = wid >> 2, wc = wid & 3, fr = lane & 15, fq = lane >> 4;
    int K_o = g.K; asm volatile("" : "+s"(K_o)); const int K = K_o, nt = K / BK;
    unsigned voffA[2], voffB[2];
#pragma unroll
    for (int i = 0; i < 2; ++i) { int R, C; stage_rc(tid * 16 + i * 8192, R, C); const int Rb = Epi::PERM ? ((R & ~31) + perm32(R & 31)) : R;
        voffA[i] = (unsigned)(R * K + C) * 2u; voffB[i] = (unsigned)(Rb * K + C) * 2u; }
    const size_t kstep = (size_t)(BK * 2);
    const size_t hstep = (size_t)HALF * K * 2;
    const size_t tstep = 2 * hstep;
    const unsigned ldsw = (unsigned)wid * 1024u;
    const int aoff = lds_byte(wr * 64 + fr, fq * 8), boff = lds_byte(wc * 32 + fr, fq * 8);
#define PG8_SA(b, h) (((b) * 2 + (h)) * HTB)
#define PG8_SB(b, h) ((4 + (b) * 2 + (h)) * HTB)
#define PG8_STAGE(bufoff, gbase, voff) do { _Pragma("unroll") for (int _i = 0; _i < 2; ++_i) \
        __builtin_amdgcn_global_load_lds((const unsigned*)((const char*)(gbase) + (voff)[_i]), (PG8_LAS unsigned*)(lds + (bufoff) + ldsw + _i * 8192), 16, 0, 0); } while (0)
#define PG8_LDA(dst, b, h) do { _Pragma("unroll") for (int m = 0; m < 4; ++m) _Pragma("unroll") for (int k = 0; k < 2; ++k) dst[m][k] = *(const PG8_LAS bf16x8*)(lds + PG8_SA(b, h) + aoff + m * 2048 + k * 1024); } while (0)
#define PG8_LDB(dst, b, h) do { _Pragma("unroll") for (int n = 0; n < 2; ++n) _Pragma("unroll") for (int k = 0; k < 2; ++k) dst[n][k] = *(const PG8_LAS bf16x8*)(lds + PG8_SB(b, h) + boff + n * 2048 + k * 1024); } while (0)
#define PG8_MMA(ai, bj, At, Bt) do { __builtin_amdgcn_s_setprio(1); _Pragma("unroll") for (int m = 0; m < 4; ++m) _Pragma("unroll") for (int n = 0; n < 2; ++n) _Pragma("unroll") for (int k = 0; k < 2; ++k) \
        { if constexpr (F16) acc[ai][bj][m][n] = __builtin_amdgcn_mfma_f32_16x16x32_f16(__builtin_bit_cast(f16x8, Bt[n][k]), __builtin_bit_cast(f16x8, At[m][k]), acc[ai][bj][m][n], 0, 0, 0); \
          else acc[ai][bj][m][n] = __builtin_amdgcn_mfma_f32_16x16x32_bf16(Bt[n][k], At[m][k], acc[ai][bj][m][n], 0, 0, 0); } __builtin_amdgcn_s_setprio(0); } while (0)
#define PG8_WAIT_V(n) asm volatile("s_waitcnt vmcnt(" #n ")" ::: "memory")
#define PG8_WAIT_L(n) asm volatile("s_waitcnt lgkmcnt(" #n ")" ::: "memory")
#define PG8_BAR __builtin_amdgcn_s_barrier()
#define PG8_SCHED __builtin_amdgcn_sched_barrier(0)
    Unit cur, nxt; int ui = 0;
    if (!S.next(0, cur)) return;
    f32x4 acc[2][2][4][2];
#pragma unroll
    for (int a = 0; a < 2; ++a)
#pragma unroll
        for (int b = 0; b < 2; ++b)
#pragma unroll
            for (int m = 0; m < 4; ++m)
#pragma unroll
                for (int n = 0; n < 2; ++n) acc[a][b][m][n] = (f32x4){0.f, 0.f, 0.f, 0.f};
    bf16x8 At[4][2], B0[2][2], B1[2][2];
    const char* cA = (const char*)g.A + (size_t)cur.pm * tstep; const char* cB = (const char*)g.Bt + (size_t)cur.pn * tstep;
    S.a_ready(cur);
    if constexpr (SP2) {
        PG8_STAGE(PG8_SB(0, 0), cB, voffB); PG8_STAGE(PG8_SB(0, 1), cB + hstep, voffB); PG8_STAGE(PG8_SA(0, 0), cA, voffA); PG8_STAGE(PG8_SA(0, 1), cA + hstep, voffA);
        if (wr == 1) PG8_BAR;
        PG8_WAIT_V(2); PG8_BAR;
        PG8_STAGE(PG8_SB(1, 0), cB + kstep, voffB); PG8_STAGE(PG8_SA(1, 0), cA + kstep, voffA); PG8_STAGE(PG8_SB(1, 1), cB + hstep + kstep, voffB);
        PG8_WAIT_V(6); PG8_BAR;
    } else {
        PG8_STAGE(PG8_SB(0, 0), cB, voffB); PG8_STAGE(PG8_SA(0, 0), cA, voffA); PG8_STAGE(PG8_SB(0, 1), cB + hstep, voffB); PG8_STAGE(PG8_SA(0, 1), cA + hstep, voffA);
        if (wr == 1) PG8_BAR;
        PG8_WAIT_V(4); PG8_BAR;
        PG8_STAGE(PG8_SB(1, 0), cB + kstep, voffB); PG8_STAGE(PG8_SA(1, 0), cA + kstep, voffA); PG8_STAGE(PG8_SB(1, 1), cB + hstep + kstep, voffB);
        PG8_WAIT_V(6); PG8_BAR;
    }
    for (;;) {
        const bool has_next = S.next(ui + 1, nxt);
        const char* nA = has_next ? (const char*)g.A + (size_t)nxt.pm * tstep : cA; const char* nB = has_next ? (const char*)g.Bt + (size_t)nxt.pn * tstep : cB;
        for (int t = 0; t < nt; t += 2) {
            const bool last = (t == nt - 2);
            const char* a1 = cA + (size_t)(t + 1) * kstep;
            const char* a2 = last ? nA : cA + (size_t)(t + 2) * kstep; const char* b2 = last ? nB : cB + (size_t)(t + 2) * kstep;
            const char* a3 = a2 + kstep; const char* b3 = b2 + kstep;
            if (last && has_next) S.a_ready(nxt);
            if constexpr (SP2) {
            PG8_LDB(B0, 0, 0); PG8_LDB(B1, 0, 1); PG8_SCHED; PG8_LDA(At, 0, 0); PG8_STAGE(PG8_SA(1, 1), a1 + hstep, voffA);
            PG8_WAIT_V(8); PG8_WAIT_L(0); PG8_BAR; PG8_MMA(0, 0, At, B0); PG8_MMA(0, 1, At, B1); PG8_BAR; PG8_SCHED;
            PG8_LDA(At, 0, 1); PG8_STAGE(PG8_SB(0, 0), b2, voffB); PG8_STAGE(PG8_SB(0, 1), b2 + hstep, voffB); PG8_STAGE(PG8_SA(0, 0), a2, voffA);
            PG8_WAIT_V(8); PG8_WAIT_L(0); PG8_BAR; PG8_MMA(1, 0, At, B0); PG8_MMA(1, 1, At, B1); PG8_BAR; PG8_SCHED;
            PG8_LDB(B0, 1, 0); PG8_LDB(B1, 1, 1); PG8_SCHED; PG8_LDA(At, 1, 0); PG8_STAGE(PG8_SA(0, 1), a2 + hstep, voffA);
            PG8_WAIT_V(8); PG8_WAIT_L(0); PG8_BAR; PG8_MMA(0, 0, At, B0); PG8_MMA(0, 1, At, B1); PG8_BAR; PG8_SCHED;
            PG8_LDA(At, 1, 1); PG8_STAGE(PG8_SB(1, 0), b3, voffB); PG8_STAGE(PG8_SB(1, 1), b3 + hstep, voffB); PG8_STAGE(PG8_SA(1, 0), a3, voffA);
            PG8_WAIT_V(8); PG8_WAIT_L(0); PG8_BAR; PG8_MMA(1, 0, At, B0); PG8_MMA(1, 1, At, B1); PG8_BAR; PG8_SCHED;
            } else {
            PG8_LDB(B0, 0, 0); PG8_SCHED; PG8_LDA(At, 0, 0); PG8_STAGE(PG8_SA(1, 1), a1 + hstep, voffA);
            PG8_WAIT_L(8); PG8_BAR; PG8_WAIT_L(0); PG8_MMA(0, 0, At, B0); PG8_BAR; PG8_SCHED;
            PG8_LDB(B1, 0, 1); PG8_STAGE(PG8_SB(0, 0), b2, voffB);
            PG8_BAR; PG8_WAIT_L(0); PG8_MMA(0, 1, At, B1); PG8_BAR;
            PG8_LDA(At, 0, 1); PG8_STAGE(PG8_SA(0, 0), a2, voffA);
            PG8_BAR; PG8_WAIT_L(0); PG8_MMA(1, 0, At, B0); PG8_BAR; PG8_SCHED;
            PG8_STAGE(PG8_SB(0, 1), b2 + hstep, voffB);
            PG8_WAIT_V(6); PG8_BAR; PG8_MMA(1, 1, At, B1); PG8_BAR;
            PG8_LDB(B0, 1, 0); PG8_SCHED; PG8_LDA(At, 1, 0); PG8_STAGE(PG8_SA(0, 1), a2 + hstep, voffA);
            PG8_WAIT_L(8); PG8_BAR; PG8_WAIT_L(0); PG8_MMA(0, 0, At, B0); PG8_BAR; PG8_SCHED;
            PG8_LDB(B1, 1, 1); PG8_STAGE(PG8_SB(1, 0), b3, voffB);
            PG8_BAR; PG8_WAIT_L(0); PG8_MMA(0, 1, At, B1); PG8_BAR;
            PG8_LDA(At, 1, 1); PG8_STAGE(PG8_SA(1, 0), a3, voffA);
            PG8_BAR; PG8_WAIT_L(0); PG8_MMA(1, 0, At, B0); PG8_BAR; PG8_SCHED;
            PG8_STAGE(PG8_SB(1, 1), b3 + hstep, voffB);
            PG8_WAIT_V(6); PG8_BAR; PG8_MMA(1, 1, At, B1); PG8_BAR;
            }
        }
        if constexpr (ALIGN_EPI) { if (wr == 0) PG8_BAR; }
        if constexpr (!Epi::AFTER_DRAIN) { E(acc, cur, wr, wc, fr, fq); S.done(cur); }
        if (!has_next) break;
#pragma unroll
        for (int a = 0; a < 2; ++a)
#pragma unroll
            for (int b = 0; b < 2; ++b)
#pragma unroll
                for (int m = 0; m < 4; ++m)
#pragma unroll
                    for (int n = 0; n < 2; ++n) acc[a][b][m][n] = (f32x4){0.f, 0.f, 0.f, 0.f};
        cur = nxt; cA = nA; cB = nB; ++ui;
        if constexpr (ALIGN_EPI) { if (wr == 1) PG8_BAR; }
    }
    PG8_WAIT_V(0);
    if constexpr (!ALIGN_EPI) { if (wr == 0) PG8_BAR; }
    PG8_BAR;
    if constexpr (Epi::AFTER_DRAIN) { E.fused(acc, cur, wr, wc, fr, fq, lds, wid, lane); S.done(cur); }
#undef PG8_SA
#undef PG8_SB
#undef PG8_STAGE
#undef PG8_LDA
#undef PG8_LDB
#undef PG8_MMA
#undef PG8_WAIT_V
#undef PG8_WAIT_L
#undef PG8_BAR
#undef PG8_SCHED
}
}
#include <hip/hip_bf16.h>
#include <cmath>
namespace attn_body {
using bf16=__hip_bfloat16;
using bf16x8=__attribute__((ext_vector_type(8)))short;
using s16x4=__attribute__((ext_vector_type(4)))short;
using f32x16=__attribute__((ext_vector_type(16)))float;
using u32x4=__attribute__((ext_vector_type(4)))unsigned;
constexpr int NHEAD=16,SEQ=4096,D=64,DM=NHEAD*D;
constexpr int NW=8,QBLK=32,QB=QBLK*NW,KVBLK=64,NQB=SEQ/QB;
constexpr int ATTN_PITCH=DM, ATTN_UNIT_ROWS=QB;
__device__ __forceinline__ int crow(int r,int hi){return (r&3)+8*(r>>2)+4*hi;}
#define SBAR() __builtin_amdgcn_sched_barrier(0)
__device__ __forceinline__ void cmask(f32x16&p0,f32x16&p1,int jb,int qrel,int hi){
  const float NEG=-INFINITY; int kb=64*jb+4*hi;
  #pragma unroll
  for(int r=0;r<16;++r){int kv=kb+(r&3)+8*(r>>2); if(kv>qrel)p0[r]=NEG; if(kv+32>qrel)p1[r]=NEG;}
}

constexpr int NSLOT=3, SLOTB=8192, VSLOTB=2*SLOTB;
constexpr int LDS_K=0, LDS_V=NSLOT*SLOTB, LDS_WS=LDS_V+NSLOT*VSLOTB, LDS_OST=LDS_WS+NW*64*4, LDS_BYTES=LDS_OST+NW*4096;
constexpr float C2=0.125f*1.4426950408889634f;
__device__ __forceinline__ void glds16(const void*gsrc,unsigned lds_dst){unsigned keep;
  asm volatile("s_mov_b32 %0, m0\n\ts_mov_b32 m0, %2\n\ts_nop 0\n\tglobal_load_lds_dwordx4 %1, off\n\ts_mov_b32 m0, %0":"=&s"(keep):"v"(gsrc),"s"(lds_dst):"memory");}
__device__ __forceinline__ void glds16s(const void*sbase,unsigned voff,unsigned lds_dst){unsigned keep;
  asm volatile("s_mov_b32 %0, m0\n\ts_mov_b32 m0, %3\n\ts_nop 0\n\tglobal_load_lds_dwordx4 %1, %2\n\ts_mov_b32 m0, %0":"=&s"(keep):"v"(voff),"s"(sbase),"s"(lds_dst):"memory");}
__device__ __forceinline__ float max3f(float a,float b,float c){float r;asm("v_max3_f32 %0, %1, %2, %3":"=v"(r):"v"(a),"v"(b),"v"(c));return r;}
__device__ __forceinline__ float max2f(float a,float b){float r;asm("v_max_f32_e32 %0, %1, %2":"=v"(r):"v"(a),"v"(b));return r;}
__device__ __forceinline__ float fadd_s(float a,float b){float r;asm("v_add_f32_e32 %0, %1, %2":"=v"(r):"v"(a),"v"(b));return r;}
__device__ __forceinline__ float fsub_s(float a,float b){float r;asm("v_sub_f32_e32 %0, %1, %2":"=v"(r):"v"(a),"v"(b));return r;}
typedef float f32x2_t __attribute__((ext_vector_type(2))); typedef __bf16 bf16x2_t __attribute__((ext_vector_type(2)));
__device__ __forceinline__ unsigned cvtpk_s(float lo,float hi){f32x2_t v={lo,hi};bf16x2_t b=__builtin_convertvector(v,bf16x2_t);return __builtin_bit_cast(unsigned,b);}
#define WAIT_BAR(N) asm volatile("s_waitcnt vmcnt(" #N ") lgkmcnt(0)\n\ts_barrier":::"memory")

__device__ __forceinline__ void qkt(f32x16&p0,f32x16&p1,const char*Kslot,const bf16x8*qr,const f32x16&negm,int r32,int hi){
  const char*kb=Kslot+hi*1024+r32*16;
  #pragma unroll
  for(int d0=0;d0<4;++d0){
    const bf16x8 b0=*reinterpret_cast<const bf16x8*>(kb+d0*2048);
    const bf16x8 b1=*reinterpret_cast<const bf16x8*>(kb+d0*2048+512);
    if(d0==0){p0=__builtin_amdgcn_mfma_f32_32x32x16_bf16(b0,qr[0],negm,0,0,0);p1=__builtin_amdgcn_mfma_f32_32x32x16_bf16(b1,qr[0],negm,0,0,0);}
    else{p0=__builtin_amdgcn_mfma_f32_32x32x16_bf16(b0,qr[d0],p0,0,0,0);p1=__builtin_amdgcn_mfma_f32_32x32x16_bf16(b1,qr[d0],p1,0,0,0);}}
}
typedef __attribute__((address_space(3))) const char* lds_cptr;
typedef short v4i16_t __attribute__((ext_vector_type(4)));
__device__ __forceinline__ void kload8(bf16x8*kf,lds_cptr kp){
  kf[0]=*(const __attribute__((address_space(3))) bf16x8*)(kp);      kf[1]=*(const __attribute__((address_space(3))) bf16x8*)(kp+512);
  kf[2]=*(const __attribute__((address_space(3))) bf16x8*)(kp+2048); kf[3]=*(const __attribute__((address_space(3))) bf16x8*)(kp+2560);
  kf[4]=*(const __attribute__((address_space(3))) bf16x8*)(kp+4096); kf[5]=*(const __attribute__((address_space(3))) bf16x8*)(kp+4608);
  kf[6]=*(const __attribute__((address_space(3))) bf16x8*)(kp+6144); kf[7]=*(const __attribute__((address_space(3))) bf16x8*)(kp+6656);
}
__device__ __forceinline__ void kload2(bf16x8*kf,lds_cptr kp,int j){ kf[2*j]=*(const __attribute__((address_space(3))) bf16x8*)(kp+j*2048); kf[2*j+1]=*(const __attribute__((address_space(3))) bf16x8*)(kp+j*2048+512); }
__device__ __forceinline__ s16x4 vtr(lds_cptr p){ return __builtin_bit_cast(s16x4,__builtin_amdgcn_ds_read_tr16_b64_v4i16((__attribute__((address_space(3))) v4i16_t*)p)); }
__device__ __forceinline__ float rowmax(const f32x16&p0,const f32x16&p1){
  float a=max3f(p0[0],p0[1],p1[0]),b=max3f(p0[2],p0[3],p1[1]);a=max3f(a,p1[2],p1[3]);
  #pragma unroll
  for(int r=4;r<16;r+=4){a=max3f(a,p0[r],p0[r+1]);b=max3f(b,p0[r+2],p0[r+3]);a=max3f(a,p1[r],p1[r+1]);b=max3f(b,p1[r+2],p1[r+3]);}
  const float m=max2f(a,b);
  auto rr=__builtin_amdgcn_permlane32_swap(__float_as_uint(m),__float_as_uint(m),false,false);
  return max2f(__uint_as_float(rr[0]),__uint_as_float(rr[1]));
}
__device__ __forceinline__ void pv(f32x16*o,int vb,bf16x8 pa0,bf16x8 pa1,bf16x8 pa2,bf16x8 pa3){
  #pragma unroll
  for(int d0=0;d0<4;++d0){s16x4 lo[4],hi[4];
    #pragma unroll
    for(int ks=0;ks<4;++ks){
      asm volatile("ds_read_b64_tr_b16 %0,%1 offset:%c2":"=&v"(lo[ks]):"v"(vb),"i"(d0*4096+ks*1024):"memory");
      asm volatile("ds_read_b64_tr_b16 %0,%1 offset:%c2":"=&v"(hi[ks]):"v"(vb),"i"(d0*4096+ks*1024+512):"memory");}
    asm volatile("s_waitcnt lgkmcnt(0)":::"memory");SBAR();
    #define PK(k) (bf16x8){lo[k][0],lo[k][1],lo[k][2],lo[k][3],hi[k][0],hi[k][1],hi[k][2],hi[k][3]}
    o[d0]=__builtin_amdgcn_mfma_f32_32x32x16_bf16(pa0,PK(0),o[d0],0,0,0);
    o[d0]=__builtin_amdgcn_mfma_f32_32x32x16_bf16(pa1,PK(1),o[d0],0,0,0);
    o[d0]=__builtin_amdgcn_mfma_f32_32x32x16_bf16(pa2,PK(2),o[d0],0,0,0);
    o[d0]=__builtin_amdgcn_mfma_f32_32x32x16_bf16(pa3,PK(3),o[d0],0,0,0);
    #undef PK
  }
}

#ifndef ATTN_STORE16
#define ATTN_STORE16(p,v) (*(u32x4*)(p)=(v))
#endif
template<int THRL,bool COMB> __device__ __forceinline__ void attn_unit(bool pre,int nb,int nh,int nhv,int b,int h,int hv,int qb,const bf16*Q,const bf16*__restrict__ K,const bf16*__restrict__ V,bf16*O,bf16*YB,float lam,float oscale,const float*gsub,char*shm){
  int tid_o=threadIdx.x; asm volatile("":"+v"(tid_o)); const int tid=tid_o,lane=tid&63,r32=lane&31,hi=lane>>5; const int wid=__builtin_amdgcn_readfirstlane(tid>>6);
  const long rowbase=(long)b*SEQ; const int q0=qb*QB;
  const bf16*Qw=Q+(rowbase+q0+wid*QBLK)*DM+h*D;
  const bf16*Kh=K+rowbase*DM+h*D,*Vh=V+rowbase*DM+hv*2*D;
  const unsigned lds0=(unsigned)(uintptr_t)shm;
  float*wsf=(float*)(shm+LDS_WS)+wid*64;
  const unsigned koff=(unsigned)(lane*DM+wid*8)*2u;
  const unsigned voff=(unsigned)((16*(wid&3)+(lane>>2))*DM+(wid>>2)*32+(lane&3)*8)*2u;
  const unsigned kdst=lds0+LDS_K+wid*1024, vdst=lds0+LDS_V+wid*1024;
  #define DMA_K(t,slot) glds16s(Kh+(long)(t)*KVBLK*DM,koff,(unsigned)__builtin_amdgcn_readfirstlane(kdst+(slot)))
  #define DMA_V(t,slot) do{ glds16s(Vh+(long)(t)*KVBLK*DM,voff,(unsigned)__builtin_amdgcn_readfirstlane(vdst+2*(slot))); glds16s(Vh+64+(long)(t)*KVBLK*DM,voff,(unsigned)__builtin_amdgcn_readfirstlane(vdst+2*(slot)+8192)); }while(0)
  const char*Kbase=shm+LDS_K; bf16x8 kf[8];
  const lds_cptr shm3=(lds_cptr)shm; const lds_cptr kp0=shm3+LDS_K+hi*1024+r32*16; const lds_cptr vp0=shm3+LDS_V+((lane>>4)&1)*32+(lane&3)*8+(4*hi+((lane&15)>>2))*64;
  const int NT=(q0+QB)/KVBLK;
  if(!pre){DMA_K(0,0);DMA_V(0,0);DMA_K(1,SLOTB);}
  bf16x8 qr[4];
  #pragma unroll
  for(int d0=0;d0<4;++d0)qr[d0]=*reinterpret_cast<const bf16x8*>(&Qw[(long)r32*DM+d0*16+hi*8]);
  float mhat=0.f,l_reg=0.f;f32x16 o[4];o[0]=f32x16{};o[1]=f32x16{};o[2]=f32x16{};o[3]=f32x16{};f32x16 negm=f32x16{};asm volatile("":"+v"(negm));
  const int qrel=wid*QBLK+r32;
  #define CMASK(P0,P1,t) do{int jb_=(t)-(NT-4); if(jb_>=0)cmask(P0,P1,jb_,qrel,hi);}while(0)
  bool resc=false;
  #define START(P0,P1) do{ const float rm=rowmax(P0,P1); resc=false; \
    { const float dl=rm; mhat=fadd_s(mhat,dl); \
      _Pragma("unroll") for(int r=0;r<16;++r){P0[r]=fsub_s(P0[r],dl);P1[r]=fsub_s(P1[r],dl);} \
      _Pragma("unroll") for(int r=0;r<16;++r)negm[r]=-mhat; asm volatile("":"+v"(negm)); } \
    _Pragma("unroll") for(int r=0;r<16;++r)P0[r]=__builtin_amdgcn_exp2f(P0[r]); }while(0)
  #define RESC() do{ if(resc){ asm volatile("s_waitcnt lgkmcnt(0)":::"memory"); \
      _Pragma("unroll") for(int d_=0;d_<4;++d_) _Pragma("unroll") for(int r=0;r<16;++r)o[d_][r]*=wsf[crow(r,hi)]; } }while(0)
  f32x16 pA0,pA1,pB0,pB1;
  int sl_prev=0,sl_cur=0,sl_next=SLOTB;
  #define ROT() do{sl_prev=sl_cur;sl_cur=sl_next;sl_next=(sl_next==(NSLOT-1)*SLOTB)?0:sl_next+SLOTB;}while(0)
  DMA_K(2,2*SLOTB);
  WAIT_BAR(3);
  qkt(pA0,pA1,Kbase,qr,negm,r32,hi);asm volatile("s_nop 15\n\ts_nop 7":"+v"(pA0),"+v"(pA1));CMASK(pA0,pA1,0);
  START(pA0,pA1);
  _Pragma("unroll") for(int r=0;r<16;++r)pA1[r]=__builtin_amdgcn_exp2f(pA1[r]);
  WAIT_BAR(0);
  DMA_K(3,0);DMA_V(1,SLOTB);
  ROT();
  kload8(kf,kp0+sl_cur);
  WAIT_BAR(3);
  s16x4 vlo[8],vhi[8]; u32x4 pw0,pw1,pw2,pw3;
  #define PKW(P,B) cvtpk_s(P[B],P[B+1])
  #define PAF(k) __builtin_bit_cast(bf16x8,pw##k)
  #define VFR(i) (bf16x8){vlo[i][0],vlo[i][1],vlo[i][2],vlo[i][3],vhi[i][0],vhi[i][1],vhi[i][2],vhi[i][3]}
  #define PIN(x) asm volatile("":"+v"(x))
  #define MX3(a,b,c) __builtin_fmaxf(__builtin_fmaxf((a),(b)),(c))
  #define GAPA(MF,A0,A1,A2,A3,W0,W1,PW) do{ MF; sacc+=A0; sacc+=A1; sacc+=A2; sacc+=A3; PIN(sacc); W0; W1; PIN(PW); SBAR(); }while(0)
  #define EX(v) __builtin_amdgcn_exp2f(v)
  #define GAPB(MF,X,B) do{ MF; X[B]=EX(X[B]); X[B+1]=EX(X[B+1]); X[B+2]=EX(X[B+2]); X[B+3]=EX(X[B+3]); PIN(X); SBAR(); }while(0)
  #define GAPH(MF,X,B) do{ MF; X[B]=EX(X[B]); X[B+1]=EX(X[B+1]); PIN(X); SBAR(); }while(0)
  #define VRD(i) do{ vlo[i]=vtr(vp_+(((i)>>2)*4096+((i)&3)*1024)); vhi[i]=vtr(vp_+(((i)>>2)*4096+((i)&3)*1024+512)); }while(0)
  #define VRD2(i) do{ vlo[i]=vtr(vp_+(8192+((i)>>2)*4096+((i)&3)*1024)); vhi[i]=vtr(vp_+(8192+((i)>>2)*4096+((i)&3)*1024+512)); }while(0)
  #define KRD(G,j) do{ if(G){ kload2(kf,kp0+sl_next,j); SBAR(); } }while(0)
  #define STEP(C0,C1,P0,P1,t,GK,GV,GL) do{ SBAR(); \
    const lds_cptr vp_=vp0+2*sl_prev; \
    float sacc=(P0[0]+P0[1]); \
    GAPA(C0=__builtin_amdgcn_mfma_f32_32x32x16_bf16(kf[0],qr[0],negm,0,0,0), P0[2],P0[3],P0[4],P0[5],     pw0[0]=PKW(P0,0), pw0[1]=PKW(P0,2), pw0); \
    GAPA(C1=__builtin_amdgcn_mfma_f32_32x32x16_bf16(kf[1],qr[0],negm,0,0,0), P0[6],P0[7],P0[8],P0[9],     pw0[2]=PKW(P0,4), pw0[3]=PKW(P0,6), pw0); \
    GAPA(C0=__builtin_amdgcn_mfma_f32_32x32x16_bf16(kf[2],qr[1],C0,0,0,0),   P0[10],P0[11],P0[12],P0[13], pw1[0]=PKW(P0,8), pw1[1]=PKW(P0,10), pw1); \
    GAPA(C1=__builtin_amdgcn_mfma_f32_32x32x16_bf16(kf[3],qr[1],C1,0,0,0),   P0[14],P0[15],P1[0],P1[1],   pw1[2]=PKW(P0,12),pw1[3]=PKW(P0,14), pw1); \
    GAPA(C0=__builtin_amdgcn_mfma_f32_32x32x16_bf16(kf[4],qr[2],C0,0,0,0),   P1[2],P1[3],P1[4],P1[5],     pw2[0]=PKW(P1,0), pw2[1]=PKW(P1,2), pw2); \
    GAPA(C1=__builtin_amdgcn_mfma_f32_32x32x16_bf16(kf[5],qr[2],C1,0,0,0),   P1[6],P1[7],P1[8],P1[9],     pw2[2]=PKW(P1,4), pw2[3]=PKW(P1,6), pw2); \
    GAPA(C0=__builtin_amdgcn_mfma_f32_32x32x16_bf16(kf[6],qr[3],C0,0,0,0),   P1[10],P1[11],P1[12],P1[13], pw3[0]=PKW(P1,8), pw3[1]=PKW(P1,10), pw3); \
    GAPA(C1=__builtin_amdgcn_mfma_f32_32x32x16_bf16(kf[7],qr[3],C1,0,0,0),   P1[14],P1[15],0.f,0.f,       pw3[2]=PKW(P1,12),pw3[3]=PKW(P1,14), pw3); \
    l_reg+=sacc; \
    VRD(0);VRD(4);VRD(1);VRD(5);VRD(2);VRD(6);VRD(3);VRD(7); SBAR();   \
    if(GK){DMA_K((t)+3,sl_cur);} if(GV){DMA_V((t)+1,sl_next);} \
    CMASK(C0,C1,t); \
    { float a=MX3(C0[0],C0[1],C1[0]),b=MX3(C0[2],C0[3],C1[1]); a=MX3(a,C1[2],C1[3]); \
      _Pragma("unroll") for(int r=4;r<16;r+=4){a=MX3(a,C0[r],C0[r+1]);b=MX3(b,C0[r+2],C0[r+3]);a=MX3(a,C1[r],C1[r+1]);b=MX3(b,C1[r+2],C1[r+3]);} \
      float rm=__builtin_fmaxf(a,b); { auto rr=__builtin_amdgcn_permlane32_swap(__float_as_uint(rm),__float_as_uint(rm),false,false); rm=__builtin_fmaxf(__uint_as_float(rr[0]),__uint_as_float(rr[1])); } \
      resc=false; \
      if(__builtin_expect(__any(rm>(float)THRL),0)){ const float dl=__builtin_fmaxf(rm,0.f); mhat+=dl; \
        _Pragma("unroll") for(int r=0;r<16;++r){C0[r]-=dl;C1[r]-=dl;} \
        _Pragma("unroll") for(int r=0;r<16;++r)negm[r]=-mhat; asm volatile("":"+v"(negm)); \
        const float f=__builtin_amdgcn_exp2f(-dl); l_reg*=f; if(hi==0)wsf[r32]=f; resc=true; } } \
    SBAR(); \
    GAPH(o[0]=__builtin_amdgcn_mfma_f32_32x32x16_bf16(PAF(0),VFR(0),o[0],0,0,0), C0,0); VRD2(0); \
    GAPH(o[1]=__builtin_amdgcn_mfma_f32_32x32x16_bf16(PAF(0),VFR(4),o[1],0,0,0), C0,4); VRD2(4); \
    KRD(GL,0); GAPH(o[0]=__builtin_amdgcn_mfma_f32_32x32x16_bf16(PAF(1),VFR(1),o[0],0,0,0), C0,8); VRD2(1); \
    KRD(GL,1); GAPH(o[1]=__builtin_amdgcn_mfma_f32_32x32x16_bf16(PAF(1),VFR(5),o[1],0,0,0), C0,12); VRD2(5); \
    KRD(GL,2); GAPH(o[0]=__builtin_amdgcn_mfma_f32_32x32x16_bf16(PAF(2),VFR(2),o[0],0,0,0), C1,0); VRD2(2); \
    KRD(GL,3); GAPH(o[1]=__builtin_amdgcn_mfma_f32_32x32x16_bf16(PAF(2),VFR(6),o[1],0,0,0), C1,4); VRD2(6); \
    GAPH(o[0]=__builtin_amdgcn_mfma_f32_32x32x16_bf16(PAF(3),VFR(3),o[0],0,0,0), C1,8); VRD2(3); \
    GAPH(o[1]=__builtin_amdgcn_mfma_f32_32x32x16_bf16(PAF(3),VFR(7),o[1],0,0,0), C1,12); VRD2(7); SBAR(); \
      \
    GAPH(o[2]=__builtin_amdgcn_mfma_f32_32x32x16_bf16(PAF(0),VFR(0),o[2],0,0,0), C0,2); \
    GAPH(o[3]=__builtin_amdgcn_mfma_f32_32x32x16_bf16(PAF(0),VFR(4),o[3],0,0,0), C0,6); \
    GAPH(o[2]=__builtin_amdgcn_mfma_f32_32x32x16_bf16(PAF(1),VFR(1),o[2],0,0,0), C0,10); \
    GAPH(o[3]=__builtin_amdgcn_mfma_f32_32x32x16_bf16(PAF(1),VFR(5),o[3],0,0,0), C0,14); \
    GAPH(o[2]=__builtin_amdgcn_mfma_f32_32x32x16_bf16(PAF(2),VFR(2),o[2],0,0,0), C1,2); \
    GAPH(o[3]=__builtin_amdgcn_mfma_f32_32x32x16_bf16(PAF(2),VFR(6),o[3],0,0,0), C1,6); \
    GAPH(o[2]=__builtin_amdgcn_mfma_f32_32x32x16_bf16(PAF(3),VFR(3),o[2],0,0,0), C1,10); \
    GAPH(o[3]=__builtin_amdgcn_mfma_f32_32x32x16_bf16(PAF(3),VFR(7),o[3],0,0,0), C1,14); \
    }while(0)
  int t=1;
  #undef CMASK
  #define CMASK(P0,P1,t) do{}while(0)
  for(;t+5<NT;t+=2){
    STEP(pB0,pB1,pA0,pA1,t,true,true,true);     WAIT_BAR(3); RESC(); ROT();
    STEP(pA0,pA1,pB0,pB1,t+1,true,true,true);   WAIT_BAR(3); RESC(); ROT();
  }
  #undef CMASK
  #define CMASK(P0,P1,t) do{int jb_=(t)-(NT-4); if(jb_>=0)cmask(P0,P1,jb_,qrel,hi);}while(0)
  #define ENDW(tt) do{ if((tt)+3<NT){WAIT_BAR(3);} else if((tt)+2<NT){WAIT_BAR(2);} else {WAIT_BAR(0);} }while(0)
  for(;t+1<NT;t+=2){
    STEP(pB0,pB1,pA0,pA1,t,(t+3<NT),(t+1<NT),(t+1<NT));       ENDW(t);   RESC(); ROT();
    STEP(pA0,pA1,pB0,pB1,t+1,(t+4<NT),(t+2<NT),(t+2<NT));     ENDW(t+1); RESC(); ROT();
  }
  STEP(pB0,pB1,pA0,pA1,NT-1,false,false,false); RESC();
  { float sacc=pB0[0]+pB0[1]; _Pragma("unroll") for(int r=2;r<16;++r)sacc+=pB0[r]; _Pragma("unroll") for(int r=0;r<16;++r)sacc+=pB1[r]; l_reg+=sacc;
    pw0=(u32x4){PKW(pB0,0),PKW(pB0,2),PKW(pB0,4),PKW(pB0,6)};pw1=(u32x4){PKW(pB0,8),PKW(pB0,10),PKW(pB0,12),PKW(pB0,14)};pw2=(u32x4){PKW(pB1,0),PKW(pB1,2),PKW(pB1,4),PKW(pB1,6)};pw3=(u32x4){PKW(pB1,8),PKW(pB1,10),PKW(pB1,12),PKW(pB1,14)};
    SBAR(); const int vb0=(int)(lds0+LDS_V)+((lane>>4)&1)*32+(lane&3)*8+(4*hi+((lane&15)>>2))*64;     pv(o,vb0+2*sl_cur,PAF(0),PAF(1),PAF(2),PAF(3)); }
  #undef PKW
  #undef PAF
  #undef VFR
  #undef PIN
  #undef MX3
  #undef GAPA
  #undef GAPB
  #undef GAPH
  #undef EX
  #undef VRD
  #undef VRD2
  #undef KRD
  #undef STEP
  #undef ENDW
  asm volatile("s_waitcnt lgkmcnt(0)\n\ts_barrier":::"memory");
  if(nb>=0){ const bf16*nKh=K+(long)nb*SEQ*DM+nh*D,*nVh=V+(long)nb*SEQ*DM+nhv*2*D;
    glds16s(nKh,koff,(unsigned)__builtin_amdgcn_readfirstlane(kdst)); glds16s(nVh,voff,(unsigned)__builtin_amdgcn_readfirstlane(vdst)); glds16s(nVh+64,voff,(unsigned)__builtin_amdgcn_readfirstlane(vdst+8192)); glds16s(nKh+(long)KVBLK*DM,koff,(unsigned)__builtin_amdgcn_readfirstlane(kdst+SLOTB)); }
  {auto rr=__builtin_amdgcn_permlane32_swap(__float_as_uint(l_reg),__float_as_uint(l_reg),false,false);l_reg=__uint_as_float(rr[0])+__uint_as_float(rr[1]);}
  if(hi==0)wsf[32+r32]=l_reg;asm volatile("s_waitcnt lgkmcnt(0)":::"memory");
  float rli[16];
  #pragma unroll
  for(int r=0;r<16;++r)rli[r]=__builtin_amdgcn_rcpf(wsf[32+crow(r,hi)]);
  bf16*Ow=O+(rowbase+q0+wid*QBLK)*DM+hv*2*D;
  { bf16*stg=(bf16*)(shm+LDS_OST)+wid*2048;
    if constexpr(!COMB){
    #pragma unroll
    for(int hh=0;hh<2;++hh){
      #pragma unroll
      for(int r=0;r<16;++r){const int orow=crow(r,hi);
        #pragma unroll
        for(int d0=0;d0<2;++d0)stg[orow*64+d0*32+r32]=__float2bfloat16(o[2*hh+d0][r]*rli[r]);}
      asm volatile("s_waitcnt lgkmcnt(0)":::"memory");
      #pragma unroll
      for(int i=0;i<4;++i){const int row=i*8+(lane>>3),ch=lane&7; const u32x4 v=*(const u32x4*)(stg+row*64+ch*8); ATTN_STORE16(Ow+(long)row*DM+hh*64+ch*8,v);}
      asm volatile("s_waitcnt lgkmcnt(0)":::"memory"); }
    } else {
    float dv[2][4][8];
    #pragma unroll
    for(int hh=0;hh<2;++hh){
      #pragma unroll
      for(int r=0;r<16;++r){const int orow=crow(r,hi);
        #pragma unroll
        for(int d0=0;d0<2;++d0)stg[orow*64+d0*32+r32]=__float2bfloat16(o[2*hh+d0][r]*rli[r]);}
      asm volatile("s_waitcnt lgkmcnt(0)":::"memory");
      #pragma unroll
      for(int i=0;i<4;++i){const int row=i*8+(lane>>3),ch=lane&7; const u32x4 v2=*(const u32x4*)(stg+row*64+ch*8); const u32x4 v1=*(const u32x4*)(Ow+(long)row*DM+hh*64+ch*8);
        #define BL(w) __builtin_bit_cast(float,(w)<<16)
        #define BH(w) __builtin_bit_cast(float,(w)&0xffff0000u)
        dv[hh][i][0]=BL(v1[0])-lam*BL(v2[0]); dv[hh][i][1]=BH(v1[0])-lam*BH(v2[0]); dv[hh][i][2]=BL(v1[1])-lam*BL(v2[1]); dv[hh][i][3]=BH(v1[1])-lam*BH(v2[1]);
        dv[hh][i][4]=BL(v1[2])-lam*BL(v2[2]); dv[hh][i][5]=BH(v1[2])-lam*BH(v2[2]); dv[hh][i][6]=BL(v1[3])-lam*BL(v2[3]); dv[hh][i][7]=BH(v1[3])-lam*BH(v2[3]);
        #undef BL
        #undef BH
      }
      asm volatile("s_waitcnt lgkmcnt(0)":::"memory"); }
    bf16*Yw=YB+(rowbase+q0+wid*QBLK)*DM+hv*2*D;
    #pragma unroll
    for(int i=0;i<4;++i){const int row=i*8+(lane>>3),ch=lane&7; float ss=0.f;
      #pragma unroll
      for(int hh=0;hh<2;++hh){
        #pragma unroll
        for(int j=0;j<8;++j)ss+=dv[hh][i][j]*dv[hh][i][j];}
      ss+=__builtin_bit_cast(float,__builtin_amdgcn_ds_bpermute((lane^1)<<2,__builtin_bit_cast(int,ss)));
      ss+=__builtin_bit_cast(float,__builtin_amdgcn_ds_bpermute((lane^2)<<2,__builtin_bit_cast(int,ss)));
      ss+=__builtin_bit_cast(float,__builtin_amdgcn_ds_bpermute((lane^4)<<2,__builtin_bit_cast(int,ss)));
      const float rs=oscale/sqrtf(ss*(1.f/128.f)+1e-6f);
      #pragma unroll
      for(int hh=0;hh<2;++hh){const float*gp=gsub+hh*64+ch*8; float y[8];
        #pragma unroll
        for(int j=0;j<8;++j)y[j]=dv[hh][i][j]*rs*gp[j];
        u32x4 w; w[0]=cvtpk_s(y[0],y[1]); w[1]=cvtpk_s(y[2],y[3]); w[2]=cvtpk_s(y[4],y[5]); w[3]=cvtpk_s(y[6],y[7]);
        ATTN_STORE16(Yw+(long)row*DM+hh*64+ch*8,w);} }
    }
  }
  asm volatile("s_waitcnt lgkmcnt(0)\n\ts_barrier":::"memory");
  #undef DMA_K
  #undef DMA_V
  #undef CMASK
  #undef START
  #undef RESC
  #undef ROT
}
constexpr int ATTN_LDS_BYTES=LDS_BYTES;
#undef SBAR
#undef WAIT_BAR
}
#define LAS __attribute__((address_space(3)))
typedef unsigned short bf16;
typedef unsigned v4u __attribute__((ext_vector_type(4)));
typedef unsigned v2u __attribute__((ext_vector_type(2)));
typedef float f32x4 __attribute__((ext_vector_type(4)));
typedef short bf16x8 __attribute__((ext_vector_type(8)));
#define LDS_WAIT() asm volatile("s_waitcnt lgkmcnt(0)" ::: "memory")

constexpr int NWAVES = 8, NTHREADS = 512;
constexpr int DM = 1024, BATCH = 16, SEQ = 4096, DEPTH = 4, M = BATCH * SEQ, MH = M / 2, NIN = 7168, DFF = 2816, NUP = 2 * DFF, PLE = 256;
constexpr float EPS = 1e-6f;
constexpr size_t MiB = 1u << 20;
constexpr size_t WS_W = 2 * MiB, W_LAYER = 40 * MiB;
constexpr size_t WO_IN = 0, WO_UP = 14 * MiB, WO_DOWN = 25 * MiB, WO_PA = 31 * MiB, WO_PB = 33 * MiB, WO_O = 35 * MiB, WO_PG = 37 * MiB, WO_PLE = 39 * MiB, WO_S = 39 * MiB + 512 * 1024;
constexpr size_t WS_H = 162 * MiB;
constexpr size_t WS_Z = 290 * MiB, ZS = (size_t)MH * DM;
constexpr size_t WS_O1 = 738 * MiB, WS_O2 = 802 * MiB;
constexpr size_t WS_ACT = 290 * MiB, WS_XBB = 642 * MiB, WS_EDGE = 802 * MiB, WS_E = 290 * MiB;
constexpr size_t WS_SS = 866 * MiB, SSS = (size_t)M * 16, WS_PBF = 920 * MiB;
constexpr size_t WS_VST = 952 * MiB;
constexpr size_t WS_END = 956 * MiB;
constexpr int LDS_BYTES = 147456, XB_OFF = 131072 + 1024;

__device__ __forceinline__ unsigned f2bf(float f) { unsigned u = __builtin_bit_cast(unsigned, f); return (u + 0x7fffu + ((u >> 16) & 1u)) >> 16; }
__device__ __forceinline__ unsigned pk2(float lo, float hi) { return f2bf(lo) | (f2bf(hi) << 16); }
__device__ __forceinline__ unsigned pkh2(float lo, float hi) { return pg8::cvt_pk_f16(lo, hi); }
__device__ __forceinline__ float blo(unsigned w) { return __builtin_bit_cast(float, w << 16); }
__device__ __forceinline__ float bhi(unsigned w) { return __builtin_bit_cast(float, w & 0xffff0000u); }
__device__ __forceinline__ float bperm(float v, int srclane) { return __builtin_bit_cast(float, __builtin_amdgcn_ds_bpermute(srclane << 2, __builtin_bit_cast(int, v))); }
__device__ __forceinline__ float wave_sum(float v, int lane) {
#pragma unroll
    for (int o = 1; o < 64; o <<= 1) v += bperm(v, lane ^ o);
    return v;
}
__device__ __forceinline__ int up_row_map(int n) { return n < DFF ? (n >> 7) * 256 + (n & 127) : ((n - DFF) >> 7) * 256 + 128 + ((n - DFF) & 127); }
template <bool UPMAP, bool F16OUT = false> __device__ __forceinline__ void transpose_item(const float* W, int K, int N, bf16* WT, LAS float* scr, int item, int lane, const float* gk = nullptr) {
    const int nblk = N / 32, kb = item / nblk, nb = item % nblk, k0 = 64 * kb, n0 = 32 * nb;
#pragma unroll 8
    for (int i = 0; i < 32; ++i) { const int kk = 2 * i + (lane >> 5); float w = W[(size_t)(k0 + kk) * N + n0 + (lane & 31)]; if (gk) w *= gk[k0 + kk]; scr[kk * 33 + (lane & 31)] = w; }
    LDS_WAIT(); asm volatile("" ::: "memory");
    const int c = lane & 7;
#pragma unroll
    for (int j = 0; j < 4; ++j) { const int n = (lane >> 3) + 8 * j; const LAS float* s = scr + (8 * c) * 33 + n;
        v4u o; if (F16OUT) {
#define W8(v) __builtin_bit_cast(float, f2bf(v) << 16)
            o.x = pkh2(W8(s[0 * 33]), W8(s[1 * 33])); o.y = pkh2(W8(s[2 * 33]), W8(s[3 * 33])); o.z = pkh2(W8(s[4 * 33]), W8(s[5 * 33])); o.w = pkh2(W8(s[6 * 33]), W8(s[7 * 33]));
#undef W8
        }
        else { o.x = pk2(s[0 * 33], s[1 * 33]); o.y = pk2(s[2 * 33], s[3 * 33]); o.z = pk2(s[4 * 33], s[5 * 33]); o.w = pk2(s[6 * 33], s[7 * 33]); }
        const int dr = UPMAP ? up_row_map(n0 + n) : (n0 + n);
        *(v4u*)(WT + (size_t)dr * K + k0 + 8 * c) = o; }
    LDS_WAIT(); asm volatile("" ::: "memory");
}
template <bool OUTF32> __device__ __forceinline__ void rms_row(const float* xrow, const float* g, void* orow, int lane) {
    const f32x4* xr = (const f32x4*)xrow + lane;
    f32x4 v[4]; float s = 0.f;
#pragma unroll
    for (int j = 0; j < 4; ++j) { v[j] = xr[64 * j]; s += (v[j].x * v[j].x + v[j].y * v[j].y) + (v[j].z * v[j].z + v[j].w * v[j].w); }
    const float rstd = 1.0f / sqrtf(wave_sum(s, lane) * (1.f / DM) + EPS);
#pragma unroll
    for (int j = 0; j < 4; ++j) { const f32x4 gg = ((const f32x4*)g)[lane + 64 * j]; const f32x4 o = v[j] * rstd * gg;
        if (OUTF32) ((f32x4*)orow)[lane + 64 * j] = o;
        else ((unsigned long long*)orow)[lane + 64 * j] = (unsigned long long)pk2(o.x, o.y) | ((unsigned long long)pk2(o.z, o.w) << 32); }
}
__device__ __forceinline__ void sgu_unit(LAS unsigned char* lds, bf16* U, bf16* UO, const bf16* V, const float* VST, const bf16* Wsb, const float* bs, const float* lng, const float* lnb, size_t row0, int tid, int lane, int wave) {
    LAS float* st = (LAS float*)lds;
    LAS unsigned char* vt0 = lds + 1024;
    constexpr int VTB = 128 * 272;
    { const int r = tid >> 2, q = tid & 3; const f32x4* vp = (const f32x4*)(VST + (row0 + r) * 32 + q * 8);
      const f32x4 a = vp[0], c = vp[1];
      float sm = (a[0] + a[2]) + (c[0] + c[2]), sq = (a[1] + a[3]) + (c[1] + c[3]);
      sm += bperm(sm, lane ^ 1); sq += bperm(sq, lane ^ 1); sm += bperm(sm, lane ^ 2); sq += bperm(sq, lane ^ 2);
      const float mean = sm * (1.f / DM); float var = sq * (1.f / DM) - mean * mean; var = var > 0.f ? var : 0.f;
      if (q == 0) { st[2 * r] = mean; st[2 * r + 1] = 1.0f / sqrtf(var + EPS); } }
    __syncthreads();
    const int cg8 = tid & 15, rp = tid >> 4, fr = lane & 15, fq = lane >> 4;
    const int ksmax = (wave * 16 + 15) >> 5;
    const int t = 16 * wave + fr;
    float mu[4], rsd[4];
#pragma unroll
    for (int rr = 0; rr < 4; ++rr) { mu[rr] = st[2 * (4 * rp + rr)]; rsd[rr] = st[2 * (4 * rp + rr) + 1]; }
    v4u vraw[4]; bf16x8 bw[4]; v2u uraw[8]; f32x4 gm[2], bt[2]; float bias;
#define SGU_LOAD(g) do { \
        _Pragma("unroll") for (int rr = 0; rr < 4; ++rr) vraw[rr] = *(const v4u*)(V + (row0 + 4 * rp + rr) * DM + (g) * 128 + 8 * cg8); \
        gm[0] = *(const f32x4*)(lng + (g) * 128 + 8 * cg8); gm[1] = *(const f32x4*)(lng + (g) * 128 + 8 * cg8 + 4); bt[0] = *(const f32x4*)(lnb + (g) * 128 + 8 * cg8); bt[1] = *(const f32x4*)(lnb + (g) * 128 + 8 * cg8 + 4); \
        _Pragma("unroll") for (int ks = 0; ks < 4; ++ks) bw[ks] = *(const bf16x8*)(Wsb + (size_t)(g) * 16384 + (16 * wave + fr) * 128 + fq * 8 + ks * 32); \
        _Pragma("unroll") for (int cb = 0; cb < 8; ++cb) uraw[cb] = *(const v2u*)(U + (row0 + t) * DM + (g) * 128 + 16 * cb + 4 * fq); \
        bias = bs[(g) * 128 + t]; } while (0)
    SGU_LOAD(0);
#pragma unroll 1
    for (int g = 0; g < 8; ++g) {
        LAS unsigned char* vt = vt0 + (g & 1) * VTB;
        { float nv[4][8];
#pragma unroll
          for (int rr = 0; rr < 4; ++rr) { const v4u raw = vraw[rr]; const float mean = mu[rr], rstd = rsd[rr];
              nv[rr][0] = (blo(raw.x) - mean) * rstd * gm[0][0] + bt[0][0]; nv[rr][1] = (bhi(raw.x) - mean) * rstd * gm[0][1] + bt[0][1];
              nv[rr][2] = (blo(raw.y) - mean) * rstd * gm[0][2] + bt[0][2]; nv[rr][3] = (bhi(raw.y) - mean) * rstd * gm[0][3] + bt[0][3];
              nv[rr][4] = (blo(raw.z) - mean) * rstd * gm[1][0] + bt[1][0]; nv[rr][5] = (bhi(raw.z) - mean) * rstd * gm[1][1] + bt[1][1];
              nv[rr][6] = (blo(raw.w) - mean) * rstd * gm[1][2] + bt[1][2]; nv[rr][7] = (bhi(raw.w) - mean) * rstd * gm[1][3] + bt[1][3]; }
#pragma unroll
          for (int j = 0; j < 8; ++j) { v2u w; w.x = pk2(nv[0][j], nv[1][j]); w.y = pk2(nv[2][j], nv[3][j]); *(LAS v2u*)(vt + (8 * cg8 + j) * 272 + rp * 8) = w; } }
        bf16x8 bwc[4]; v2u uc[8]; const float biasc = bias;
#pragma unroll
        for (int ks = 0; ks < 4; ++ks) bwc[ks] = bw[ks];
#pragma unroll
        for (int cb = 0; cb < 8; ++cb) uc[cb] = uraw[cb];
        __syncthreads();
        if (g < 7) SGU_LOAD(g + 1);
        f32x4 acc[8];
#pragma unroll
        for (int cb = 0; cb < 8; ++cb) acc[cb] = (f32x4){0.f, 0.f, 0.f, 0.f};
#pragma unroll
        for (int ks = 0; ks < 4; ++ks) if (ks <= ksmax) {
#pragma unroll
            for (int cb = 0; cb < 8; ++cb) { const bf16x8 av = *(const LAS bf16x8*)(vt + (16 * cb + fr) * 272 + (ks * 32 + fq * 8) * 2);
                acc[cb] = __builtin_amdgcn_mfma_f32_16x16x32_bf16(av, bwc[ks], acc[cb], 0, 0, 0); } }
#pragma unroll
        for (int cb = 0; cb < 8; ++cb) { bf16* up = UO + (row0 + t) * DM + g * 128 + 16 * cb + 4 * fq; const v2u uu = uc[cb];
            v2u w; w.x = pk2(blo(uu.x) * (acc[cb][0] + biasc), bhi(uu.x) * (acc[cb][1] + biasc)); w.y = pk2(blo(uu.y) * (acc[cb][2] + biasc), bhi(uu.y) * (acc[cb][3] + biasc));
            *(v2u*)up = w; }
    }
#undef SGU_LOAD
    __syncthreads();
}

struct Args { const float* in[27]; float* out; unsigned char* ws; };

#define PH() \
    const Args* ap; { auto kp_ = __builtin_amdgcn_kernarg_segment_ptr(); asm volatile("" : "+s"(kp_)); ap = (const Args*)kp_; } \
    int tid_o = threadIdx.x, bx_o = blockIdx.x, G_o = gridDim.x; asm volatile("" : "+v"(tid_o)); asm volatile("" : "+s"(bx_o), "+s"(G_o)); \
    const int tid = tid_o, bx = bx_o, G = G_o, lane = tid & 63, wave = __builtin_amdgcn_readfirstlane(tid >> 6); \
    const int gw = bx * NWAVES + wave, NGW = G * NWAVES; const size_t gt = (size_t)bx * NTHREADS + tid, NGT = (size_t)G * NTHREADS; \
    unsigned char* const ws = ap->ws; float* const X = ap->out; bf16* const H = (bf16*)(ws + WS_H); bf16* const Z = (bf16*)(ws + WS_Z); \
    bf16 *const ZU = Z, *const ZV = Z + ZS, *const ZQ = Z + 2 * ZS, *const ZK = Z + 3 * ZS, *const ZVA = Z + 4 * ZS, *const ZGA = Z + 5 * ZS, *const ZGB = Z + 6 * ZS; \
    bf16 *const O1 = (bf16*)(ws + WS_O1), *const O2 = (bf16*)(ws + WS_O2), *const ACT = (bf16*)(ws + WS_ACT), *const EB = (bf16*)(ws + WS_E), *const PBF = (bf16*)(ws + WS_PBF); \
    float* const EDGE = (float*)(ws + WS_EDGE); unsigned char* const wl = ws + WS_W + (size_t)l * W_LAYER; bf16* const XBB = (bf16*)(ws + WS_XBB); float* const SS = (float*)(ws + WS_SS); (void)XBB; (void)SS; \
    (void)lane; (void)gw; (void)NGW; (void)gt; (void)NGT; (void)X; (void)H; (void)ZU; (void)ZV; (void)ZQ; (void)ZK; (void)ZVA; (void)ZGA; (void)ZGB; (void)O1; (void)O2; (void)ACT; (void)EB; (void)PBF; (void)EDGE; (void)wl

#define RLX_AGENT __ATOMIC_RELAXED, __HIP_MEMORY_SCOPE_AGENT
#define XB_TMO      128
#define XB_XCNT(j)  (256  + 64 * (j))
#define XB_XSUB(j)  (1280 + 64 * (j))
#define XB_XGEN(j)  (2304 + 64 * (j))
#define XB_TOP      3328
#define XB_TOPGEN   3392
#define XCD_BAR_WORDS 3456
#define XB_SPIN_CAP (1u << 18)

__device__ __forceinline__ unsigned xb_ld(unsigned* p)              { return __hip_atomic_load(p, __ATOMIC_RELAXED, __HIP_MEMORY_SCOPE_AGENT); }
__device__ __forceinline__ unsigned xb_add(unsigned* p, unsigned v) { return __hip_atomic_fetch_add(p, v, __ATOMIC_RELAXED, __HIP_MEMORY_SCOPE_AGENT); }
__device__ __forceinline__ unsigned xb_xcc_id() { return (unsigned)__builtin_amdgcn_s_getreg((3 << 11) | 20) & 0xFu; }
#define XB_SPIN(cond, bar) do { unsigned _sp = 0; while (cond) { __builtin_amdgcn_s_sleep(1); \
    if ((++_sp & 255u) == 0u) { if (xb_ld(&(bar)[XB_TMO])) break; if (_sp > XB_SPIN_CAP) { atomicAdd(&(bar)[XB_TMO], 1u); break; } } } } while (0)

__device__ __forceinline__ void xcd_barrier_complete(unsigned* bar, unsigned x, unsigned& nloc, unsigned& nx) {
    const unsigned G = gridDim.x * gridDim.y * gridDim.z;
    unsigned sum, cnt, mine, sp = 0u;
    for (;;) {
        sum = 0u; cnt = 0u; mine = 0u;
#pragma unroll
        for (unsigned j = 0; j < 16; ++j) { const unsigned c = xb_ld(&bar[XB_XCNT(j)]); sum += c; cnt += (c > 0u) ? 1u : 0u; mine = (j == x) ? c : mine; }
        if (sum == G) break;
        __builtin_amdgcn_s_sleep(1);
        if ((++sp & 255u) == 0u) { if (xb_ld(&bar[XB_TMO])) break; if (sp > XB_SPIN_CAP) { atomicAdd(&bar[XB_TMO], 1u); break; } }
    }
    nloc = mine > 0u ? mine : 1u; nx = cnt > 0u ? cnt : 1u;
}

__device__ __forceinline__ void xcd_barrier(unsigned* const bar_, volatile LAS unsigned* const st_) {
    struct { unsigned* bar; unsigned x; volatile LAS unsigned* st; } b; b.bar = bar_; b.x = xb_xcc_id(); b.st = st_;
    asm volatile("s_waitcnt vmcnt(0)" ::: "memory");
    __syncthreads();
    if (threadIdx.x == 0) {
        unsigned* bar = b.bar;
        __builtin_amdgcn_s_waitcnt(0);
        unsigned nloc = b.st[0], nx = b.st[1];
        if (nloc == 0u) { xcd_barrier_complete(bar, b.x, nloc, nx); b.st[0] = nloc; b.st[1] = nx; }
        const unsigned old = xb_add(&bar[XB_XSUB(b.x)], 1u);
        const unsigned gen = old / nloc;
        if (old + 1u == (gen + 1u) * nloc) {
            __builtin_amdgcn_fence(__ATOMIC_RELEASE, "agent");
            asm volatile("s_waitcnt vmcnt(0)" ::: "memory");
            const unsigned og = xb_add(&bar[XB_TOP], 1u);
            const unsigned tg = og / nx;
            if (og + 1u == (tg + 1u) * nx) xb_add(&bar[XB_TOPGEN], 1u);
            else XB_SPIN(xb_ld(&bar[XB_TOPGEN]) == tg, bar);
            __builtin_amdgcn_fence(__ATOMIC_ACQUIRE, "agent");
            xb_add(&bar[XB_XGEN(b.x)], 1u);
            asm volatile("s_waitcnt vmcnt(0)" ::: "memory");
        } else {
            XB_SPIN(xb_ld(&bar[XB_XGEN(b.x)]) == gen, bar);
            __builtin_amdgcn_fence(__ATOMIC_ACQUIRE, "agent");
            asm volatile("s_waitcnt vmcnt(0)" ::: "memory");
        }
    }
    __syncthreads();
}

__device__ __forceinline__ void ctr_grid_sync(unsigned* ctr, unsigned target) {
    asm volatile("s_waitcnt vmcnt(0) lgkmcnt(0)" ::: "memory");
    __syncthreads();
    if (threadIdx.x == 0) {
        __builtin_amdgcn_fence(__ATOMIC_RELEASE, "agent");
        asm volatile("s_waitcnt vmcnt(0)" ::: "memory");
        __hip_atomic_fetch_add(ctr, 1u, __ATOMIC_RELAXED, __HIP_MEMORY_SCOPE_AGENT);
        while (__hip_atomic_load(ctr, __ATOMIC_RELAXED, __HIP_MEMORY_SCOPE_AGENT) < target) __builtin_amdgcn_s_sleep(2);
    }
    __syncthreads();
    __builtin_amdgcn_fence(__ATOMIC_ACQUIRE, "agent");
    asm volatile("s_waitcnt vmcnt(0)" ::: "memory");
}
#define GRID_SYNC1() do { const Args* ap_s; { auto kp_ = __builtin_amdgcn_kernarg_segment_ptr(); asm volatile("" : "+s"(kp_)); ap_s = (const Args*)kp_; } xcd_barrier((unsigned*)(ap_s->ws + 4096), (volatile LAS unsigned*)(ldsl + LDS_BYTES - 16)); } while (0)
#ifndef DBG_REP_SYNC
#define DBG_REP_SYNC 0
#endif
#define GRID_SYNC() do { GRID_SYNC1(); if (DBG_REP_SYNC) GRID_SYNC1(); } while (0)
#ifndef DBG_REP_ATTN
#define DBG_REP_ATTN 0
#endif
#ifndef DBG_REP_IN
#define DBG_REP_IN 0
#endif
#ifndef DBG_REP_UP
#define DBG_REP_UP 0
#endif
#ifndef DBG_REP_PRO
#define DBG_REP_PRO 0
#endif
#ifndef DBG_REP_COMB
#define DBG_REP_COMB 0
#endif
#ifndef DBG_REP_P4
#define DBG_REP_P4 0
#endif
#ifndef DBG_REP_RES
#define DBG_REP_RES 0
#endif
#ifndef DBG_REP_SGU
#define DBG_REP_SGU 0
#endif
#ifndef DBG_REP_INNULL
#define DBG_REP_INNULL 0
#endif
#ifndef DBG_TIME
#define DBG_TIME 0
#endif
#ifndef SELA
#define SELA 0x4
#endif
#ifndef SELB
#define SELB 0x2
#endif
#define TSTAMP(id) do { if (DBG_TIME && blockIdx.x == 0 && threadIdx.x == 0) { const Args* ap_t; { auto kp_ = __builtin_amdgcn_kernarg_segment_ptr(); asm volatile("" : "+s"(kp_)); ap_t = (const Args*)kp_; } \
    unsigned long long* tb = (unsigned long long*)(ap_t->ws + 64); const unsigned long long t_ = __builtin_amdgcn_s_memrealtime(); tb[1 + (id)] += t_ - tb[0]; tb[0] = t_; } } while (0)
__global__ void __launch_bounds__(NTHREADS, 2) fwd_kernel(Args a_unused) {
    extern __shared__ __attribute__((aligned(16))) unsigned char lds[];
    cg::grid_group grid = cg::this_grid();
    LAS unsigned char* ldsl = (LAS unsigned char*)lds;
    if (threadIdx.x == 0) { ((volatile LAS unsigned*)(ldsl + LDS_BYTES - 16))[0] = 0u; ((volatile LAS unsigned*)(ldsl + LDS_BYTES - 16))[1] = 0u;
        const Args* ap_s; { auto kp_ = __builtin_amdgcn_kernarg_segment_ptr(); asm volatile("" : "+s"(kp_)); ap_s = (const Args*)kp_; } (void)xb_add(&((unsigned*)(ap_s->ws + 4096))[XB_XCNT(xb_xcc_id())], 1u); }
    __syncthreads();
    if (DBG_TIME && blockIdx.x == 0 && threadIdx.x == 0) { const Args* ap_t; { auto kp_ = __builtin_amdgcn_kernarg_segment_ptr(); asm volatile("" : "+s"(kp_)); ap_t = (const Args*)kp_; } ((unsigned long long*)(ap_t->ws + 64))[0] = __builtin_amdgcn_s_memrealtime(); }
    grid.sync();

    for (int rep_ = 0; rep_ < (DBG_REP_PRO ? 2 : 1); ++rep_)
    {
        const int l = 0; PH();
        LAS float* scr = (LAS float*)(ldsl + wave * 16384);
        constexpr int I_IN = (DM / 64) * (NIN / 32), I_SQ = (DM / 64) * (DM / 32), I_UP = (DM / 64) * (NUP / 32), I_DN = (DFF / 64) * (DM / 32), I_PLE = (PLE / 64) * (DM / 32);
        constexpr int I_LAYER = I_IN + 4 * I_SQ + I_UP + I_DN + I_PLE;
        for (int it = gw; it < DEPTH * I_LAYER; it += NGW) {
            const int ll = it / I_LAYER; int r = it % I_LAYER; unsigned char* wll = ws + WS_W + (size_t)ll * W_LAYER;
            if (r < I_IN) { transpose_item<false, true>(ap->in[3] + (size_t)ll * DM * NIN, DM, NIN, (bf16*)(wll + WO_IN), scr, r, lane, ap->in[2] + (size_t)ll * DM); continue; } r -= I_IN;
            if (r < I_SQ) { transpose_item<false>(ap->in[14] + (size_t)ll * DM * DM, DM, DM, (bf16*)(wll + WO_PA), scr, r, lane); continue; } r -= I_SQ;
            if (r < I_SQ) { transpose_item<false>(ap->in[15] + (size_t)ll * DM * DM, DM, DM, (bf16*)(wll + WO_PB), scr, r, lane); continue; } r -= I_SQ;
            if (r < I_SQ) { transpose_item<false>(ap->in[16] + (size_t)ll * DM * DM, DM, DM, (bf16*)(wll + WO_O), scr, r, lane); continue; } r -= I_SQ;
            if (r < I_SQ) { transpose_item<false, true>(ap->in[23] + (size_t)ll * DM * DM, DM, DM, (bf16*)(wll + WO_PG), scr, r, lane, ap->in[22] + (size_t)ll * DM); continue; } r -= I_SQ;
            if (r < I_UP) { transpose_item<true, true>(ap->in[18] + (size_t)ll * DM * NUP, DM, NUP, (bf16*)(wll + WO_UP), scr, r, lane, ap->in[17] + (size_t)ll * DM); continue; } r -= I_UP;
            if (r < I_DN) { transpose_item<false>(ap->in[21] + (size_t)ll * DFF * DM, DFF, DM, (bf16*)(wll + WO_DOWN), scr, r, lane); continue; } r -= I_DN;
            transpose_item<false>(ap->in[25] + (size_t)ll * PLE * DM, PLE, DM, (bf16*)(wll + WO_PLE), scr, r, lane);
        }
        { const float* wsrc = ap->in[7];
          for (size_t i = gt; i < (size_t)DEPTH * 8 * 128 * 128; i += NGT) { const int ll = (int)(i >> 17), rem = (int)(i & 131071), t = (rem >> 7) & 127, sc = rem & 127;
              const float w = wsrc[i]; ((bf16*)(ws + WS_W + (size_t)ll * W_LAYER + WO_S))[rem] = (bf16)f2bf(sc <= t ? w : 0.f); } }
        { const float* xin = ap->in[0];
          for (int m = gw; m < M; m += NGW) { const f32x4* xr = (const f32x4*)(xin + (size_t)m * DM) + lane; float sq = 0.f;
#pragma unroll
              for (int j = 0; j < 4; ++j) { const f32x4 v = xr[64 * j]; sq += (v.x * v.x + v.y * v.y) + (v.z * v.z + v.w * v.w);
                  ((unsigned long long*)(H + (size_t)m * DM))[lane + 64 * j] = (unsigned long long)pkh2(v.x, v.y) | ((unsigned long long)pkh2(v.z, v.w) << 32); }
              sq = wave_sum(sq, lane); if (lane < 16) SS[(size_t)m * 16 + lane] = lane == 0 ? sq : 0.f; } }
    }
    GRID_SYNC(); TSTAMP(0);

#ifndef DBG_STOP
#define DBG_STOP 0
#endif
#define DBG_DUMP_BF16(buf) do { PH(); for (size_t i = gt; i < (size_t)M * DM; i += NGT) X[i] = blo((unsigned)(buf)[i % ((size_t)MH * DM)]); return; } while (0)
#define DBG_DUMP3(b0, b1, b2) do { PH(); for (size_t i = gt; i < (size_t)M * DM; i += NGT) { const size_t k = i % ((size_t)MH * DM); X[i] = blo((unsigned)(b0)[k]) + blo((unsigned)(b1)[k]) + blo((unsigned)(b2)[k]); } return; } while (0)
#define DBG_ZERO_UPPER() do { PH(); for (size_t i = gt; i < (size_t)MH * DM; i += NGT) X[(size_t)MH * DM + i] = 0.f; return; } while (0)
#pragma unroll 1
    for (int l = 0; l < DEPTH; ++l) {
#pragma unroll 1
        for (int hf = 0; hf < 2; ++hf) {
            if (DBG_REP_INNULL) { PH(); pg8::Gemm g{H + (size_t)hf * MH * DM, (const bf16*)(wl + WO_IN), MH, NIN, DM}; pg8::StaticOrder S; S.init(MH, NIN, G, bx); pg8::EpiNull E; pg8::gemm_phase<pg8::EpiNull, pg8::StaticOrder, true, true, true>(ldsl, g, S, E); }
            for (int rep_ = 0; rep_ < (DBG_REP_IN ? 2 : 1); ++rep_)
            { PH(); pg8::Gemm g{H + (size_t)hf * MH * DM, (const bf16*)(wl + WO_IN), MH, NIN, DM}; pg8::StaticOrder S; S.init(MH, NIN, G, bx);
              pg8::EpiIn E{Z, ZS, ap->in[4] + (size_t)l * 2 * DM, 0.125f * 1.4426950408889634f, SS + (size_t)(3 * l) * SSS + (size_t)hf * MH * 16, (float*)(ws + WS_VST)};
              pg8::gemm_phase<pg8::EpiIn, pg8::StaticOrder, true, true, true>(ldsl, g, S, E); }
            GRID_SYNC(); TSTAMP(1);
            if (DBG_STOP == 2) DBG_DUMP3(ZU, ZQ, ZGA);
            if (DBG_STOP == 12) DBG_DUMP3(ZV, ZK, ZGB);
            if (DBG_STOP == 22) DBG_DUMP3(ZVA, ZVA, ZVA);
            if (DBG_STOP == 1) DBG_DUMP3(H, H, H);
            if (DBG_STOP == 32) DBG_DUMP3(ZGA, ZGA, ZGA);
            if (DBG_STOP == 42) DBG_DUMP3(ZU, ZU, ZU);
            if (DBG_STOP == 52) DBG_DUMP3(ZQ, ZQ, ZQ);
            { PH();
              int l_o = l; asm volatile("" : "+s"(l_o));
              const float lam_init = 0.8f - 0.6f * expf(-0.3f * (float)l_o);
              const float s1 = wave_sum(ap->in[9][l * 64 + lane] * ap->in[10][l * 64 + lane], lane), s2 = wave_sum(ap->in[11][l * 64 + lane] * ap->in[12][l * 64 + lane], lane);
              const float lam = __builtin_bit_cast(float, __builtin_amdgcn_readfirstlane(__builtin_bit_cast(int, expf(s1) - expf(s2) + lam_init)));
              const float oscale = __builtin_bit_cast(float, __builtin_amdgcn_readfirstlane(__builtin_bit_cast(int, 1.0f - lam_init)));
              const float* gsub = ap->in[13] + l * 128;
              bool pre = false;
              for (int p = bx; p < 1024; p += G) {
                  const int combo = p & 255, qi = p >> 8, b = combo & 7, r = combo >> 3, h = r >> 2, sq = r & 3;
                  const int qb = qi == 0 ? 15 - sq : qi == 1 ? 8 + sq : qi == 2 ? 7 - sq : sq;
                  const int pn = p + G; const bool more = pn < 1024; const int ncombo = pn & 255, nb2 = more ? (ncombo & 7) : -1, nh2 = (ncombo >> 3) >> 2;
#pragma unroll 1
                  for (int mp = 0; mp < 2; ++mp) {
                  if (mp == 0) attn_body::attn_unit<8, false>(pre, b, 2 * h + 1, h, b, 2 * h, h, qb, (const attn_body::bf16*)ZQ, (const attn_body::bf16*)ZK, (const attn_body::bf16*)ZVA, (attn_body::bf16*)O1, nullptr, 0.f, 0.f, nullptr, (char*)lds);
                  else attn_body::attn_unit<8, true>(pre, nb2, 2 * nh2, nh2, b, 2 * h + 1, h, qb, (const attn_body::bf16*)ZQ, (const attn_body::bf16*)ZK, (const attn_body::bf16*)ZVA, (attn_body::bf16*)O1, (attn_body::bf16*)ZQ, lam, oscale, gsub, (char*)lds);
                  pre = (mp == 0) ? true : more; } } }
            __syncthreads();
            { PH();
              const float* bs = ap->in[8] + (size_t)l * 1024; const float* lng = ap->in[5] + (size_t)l * DM; const float* lnb = ap->in[6] + (size_t)l * DM;
              for (int i = bx; i < MH / 128; i += G) sgu_unit(ldsl, ZU, ZU, ZV, (const float*)(ws + WS_VST), (const bf16*)(wl + WO_S), bs, lng, lnb, (size_t)i * 128, tid, lane, wave); }
            GRID_SYNC(); TSTAMP(2);
            if (DBG_STOP == 3) DBG_DUMP3(O1, O2, ZU);
            if (DBG_STOP == 13) DBG_DUMP3(O1, O2, O1);
            if (DBG_STOP == 23) DBG_DUMP3(ZU, ZU, ZU);
            for (int rep_ = 0; rep_ < (DBG_REP_P4 ? 2 : 1); ++rep_) {
            { PH(); pg8::StaticOrder S; S.init(MH, DM, G, bx);
              pg8::Gemm g{ZU, (const bf16*)(wl + WO_PA), MH, DM, DM}; pg8::EpiGate<false> E{ZGA, ZK}; pg8::gemm_phase<pg8::EpiGate<false>, pg8::StaticOrder, true, true>(ldsl, g, S, E); }
            { PH(); pg8::StaticOrder S; S.init(MH, DM, G, bx);
              pg8::Gemm g{ZQ, (const bf16*)(wl + WO_PB), MH, DM, DM}; pg8::EpiGate<true> E{ZGB, ZK}; pg8::gemm_phase<pg8::EpiGate<true>, pg8::StaticOrder, true, true>(ldsl, g, S, E); }
            }
            GRID_SYNC(); TSTAMP(4);
            if (DBG_STOP == 5) DBG_DUMP3(ZK, ZK, ZK);
            { PH(); pg8::Gemm g{ZK, (const bf16*)(wl + WO_O), MH, DM, DM}; pg8::StaticOrder S; S.init(MH, DM, G, bx);
              pg8::EpiResid<false> E{H + (size_t)hf * MH * DM, H + (size_t)hf * MH * DM, nullptr, nullptr, SS + (size_t)(3 * l + 1) * SSS + (size_t)hf * MH * 16, nullptr};
              if (DBG_REP_RES) { pg8::EpiResid<false> E0 = E; E0.ascale = 0.f; pg8::gemm_phase<pg8::EpiResid<false>, pg8::StaticOrder, true, true>(ldsl, g, S, E0); }
              pg8::gemm_phase<pg8::EpiResid<false>, pg8::StaticOrder, true, true>(ldsl, g, S, E); }
            GRID_SYNC(); TSTAMP(5);
            if (DBG_STOP == 6) DBG_ZERO_UPPER();
        }
        for (int rep_ = 0; rep_ < (DBG_REP_UP ? 2 : 1); ++rep_)
        { PH(); pg8::Gemm g{H, (const bf16*)(wl + WO_UP), M, NUP, DM}; pg8::StaticOrder S; S.init(M, NUP, G, bx);
          pg8::EpiConv E{ACT, EDGE, ap->in[19] + (size_t)l * 3 * NUP, ap->in[20] + (size_t)l * NUP, (LAS float*)(ldsl + XB_OFF), SS + (size_t)(3 * l + 1) * SSS};
          pg8::gemm_phase<pg8::EpiConv, pg8::StaticOrder, true, true, true>(ldsl, g, S, E); }
        GRID_SYNC(); TSTAMP(7);
        { PH(); const float* cw = ap->in[19] + (size_t)l * 3 * NUP; const float* cb = ap->in[20] + (size_t)l * NUP;
          for (size_t i = gt; i < (size_t)(M / 256) * pg8::NTC * 2 * 32; i += NGT) {
              const int c = (int)(i & 31) * 4, row = (int)((i >> 5) & 1), tile = (int)(i >> 6), pn = tile % pg8::NTC, pm = tile / pg8::NTC;
              const bool first = (pm % (SEQ / 256)) == 0; const int gcol = pn * 128 + c;
              const float* e1 = EDGE + (size_t)tile * 1024; const float* e0 = EDGE + (size_t)(first ? tile : tile - pg8::NTC) * 1024;
              f32x4 av[2];
#pragma unroll
              for (int q = 0; q < 2; ++q) { const int jc = q * 128 + c, col = q * DFF + gcol;
                  const f32x4 z4 = (f32x4){0.f, 0.f, 0.f, 0.f};
                  const f32x4 pm2 = first ? z4 : *(const f32x4*)(e0 + 2 * 256 + jc), pm1 = first ? z4 : *(const f32x4*)(e0 + 3 * 256 + jc), r0 = *(const f32x4*)(e1 + jc), r1 = *(const f32x4*)(e1 + 256 + jc);
                  const f32x4 w0 = *(const f32x4*)(cw + col), w1 = *(const f32x4*)(cw + NUP + col), w2 = *(const f32x4*)(cw + 2 * NUP + col), bb = *(const f32x4*)(cb + col);
                  av[q] = row == 0 ? (w0 * pm2 + w1 * pm1 + w2 * r0 + bb) : (w0 * pm1 + w1 * r0 + w2 * r1 + bb); }
              v2u w; w.x = pk2(pg8::gelu_tanh_f(av[0][0]) * av[1][0], pg8::gelu_tanh_f(av[0][1]) * av[1][1]); w.y = pk2(pg8::gelu_tanh_f(av[0][2]) * av[1][2], pg8::gelu_tanh_f(av[0][3]) * av[1][3]);
              *(v2u*)(ACT + (size_t)(pm * 256 + row) * DFF + gcol) = w; }
          const float* pl = ap->in[1] + (size_t)l * M * PLE;
          for (size_t i = gt; i < (size_t)M * PLE / 8; i += NGT) { const f32x4 v0 = ((const f32x4*)pl)[2 * i], v1 = ((const f32x4*)pl)[2 * i + 1];
              v4u w; w.x = pk2(v0.x, v0.y); w.y = pk2(v0.z, v0.w); w.z = pk2(v1.x, v1.y); w.w = pk2(v1.z, v1.w); ((v4u*)PBF)[i] = w; } }
        GRID_SYNC(); TSTAMP(8);
        { PH(); pg8::Gemm g{ACT, (const bf16*)(wl + WO_DOWN), M, DM, DFF}; pg8::StaticOrder S; S.init(M, DM, G, bx);
          pg8::EpiResid<false> E{H, XBB, nullptr, nullptr, SS + (size_t)(3 * l + 2) * SSS, nullptr};
          if (DBG_REP_RES) { pg8::EpiResid<false> E0 = E; E0.ascale = 0.f; pg8::gemm_phase<pg8::EpiResid<false>, pg8::StaticOrder, true, true>(ldsl, g, S, E0); }
          pg8::gemm_phase<pg8::EpiResid<false>, pg8::StaticOrder, true, true>(ldsl, g, S, E); }
        GRID_SYNC(); TSTAMP(9);
        { PH(); pg8::Gemm g{PBF, (const bf16*)(wl + WO_PLE), M, DM, PLE}; pg8::StaticOrder S; S.init(M, DM, G, bx);
          pg8::EpiStore E{EB, DM}; pg8::gemm_phase<pg8::EpiStore, pg8::StaticOrder, true, true>(ldsl, g, S, E); }
        { PH(); pg8::Gemm g{XBB, (const bf16*)(wl + WO_PG), M, DM, DM}; pg8::StaticOrder S; S.init(M, DM, G, bx);
          pg8::EpiResid<true> E{XBB, H, ap->in[24] + (size_t)l * DM, EB, SS + (size_t)(3 * l + 3) * SSS, SS + (size_t)(3 * l + 2) * SSS};
          if (DBG_REP_RES) { pg8::EpiResid<true> E0 = E; E0.ascale = 0.f; E0.XBO = XBB; pg8::gemm_phase<pg8::EpiResid<true>, pg8::StaticOrder, true, true, true>(ldsl, g, S, E0); }
          pg8::gemm_phase<pg8::EpiResid<true>, pg8::StaticOrder, true, true, true>(ldsl, g, S, E); }
        GRID_SYNC(); TSTAMP(11);
        if (l + 1 == DEPTH) { PH(); const float* gfin = ap->in[26];
            for (int m = gw; m < M; m += NGW) { const bf16* xr = H + (size_t)m * DM + 16 * lane; const v4u a0 = *(const v4u*)xr, a1 = *(const v4u*)(xr + 8);
                float f[16]; f[0] = pg8::h_lo(a0.x); f[1] = pg8::h_hi(a0.x); f[2] = pg8::h_lo(a0.y); f[3] = pg8::h_hi(a0.y); f[4] = pg8::h_lo(a0.z); f[5] = pg8::h_hi(a0.z); f[6] = pg8::h_lo(a0.w); f[7] = pg8::h_hi(a0.w);
                f[8] = pg8::h_lo(a1.x); f[9] = pg8::h_hi(a1.x); f[10] = pg8::h_lo(a1.y); f[11] = pg8::h_hi(a1.y); f[12] = pg8::h_lo(a1.z); f[13] = pg8::h_hi(a1.z); f[14] = pg8::h_lo(a1.w); f[15] = pg8::h_hi(a1.w);
                float sq = 0.f;
#pragma unroll
                for (int j = 0; j < 16; ++j) sq += f[j] * f[j];
                const float rstd = 1.0f / sqrtf(wave_sum(sq, lane) * (1.f / DM) + EPS);
                float* orow = X + (size_t)m * DM + 16 * lane;
#pragma unroll
                for (int j = 0; j < 4; ++j) { const f32x4 gg = *(const f32x4*)(gfin + 16 * lane + 4 * j); *(f32x4*)(orow + 4 * j) = (f32x4){f[4 * j] * rstd * gg[0], f[4 * j + 1] * rstd * gg[1], f[4 * j + 2] * rstd * gg[2], f[4 * j + 3] * rstd * gg[3]}; } } }
        if (DBG_TIME && l + 1 == DEPTH) { GRID_SYNC(); TSTAMP(12); GRID_SYNC();
            PH(); const unsigned long long* tb = (const unsigned long long*)(ws + 64); unsigned long long sa = 0, sb = 0;
            for (int k = 0; k < 13; ++k) { const unsigned long long v = __hip_atomic_load(tb + 1 + k, __ATOMIC_RELAXED, __HIP_MEMORY_SCOPE_AGENT); if ((SELA >> k) & 1) sa += v; if ((SELB >> k) & 1) sb += v; }
            const float fb = (float)(sa + sb) * 0.00001f;
            for (size_t i = gt; i < (size_t)16384 * DM; i += NGT) X[i] = fb; }
    }
}

extern "C" void kernel_launch(void* const* d_in, const int* in_sizes, int n_in, void* d_out, int out_size, void* d_ws, size_t ws_size, hipStream_t stream) {
    static int grid = 0;
    if (grid == 0) {
        if (n_in != 27 || out_size != M * DM || ws_size < WS_END) { fprintf(stderr, "kernel_launch: unexpected shapes (n_in %d out %d ws %zu)\n", n_in, out_size, ws_size); grid = -1; return; }
        int dev = 0, cus = 0, per_cu = 0;
        if (hipGetDevice(&dev) != hipSuccess || hipDeviceGetAttribute(&cus, hipDeviceAttributeMultiprocessorCount, dev) != hipSuccess) { grid = -1; return; }
        if (hipFuncSetAttribute((const void*)fwd_kernel, hipFuncAttributeMaxDynamicSharedMemorySize, LDS_BYTES) != hipSuccess) { fprintf(stderr, "kernel_launch: hipFuncSetAttribute failed\n"); grid = -1; return; }
        if (hipOccupancyMaxActiveBlocksPerMultiprocessor(&per_cu, (const void*)fwd_kernel, NTHREADS, LDS_BYTES) != hipSuccess || per_cu < 1) { fprintf(stderr, "kernel_launch: occupancy query gives %d\n", per_cu); per_cu = 1; }
        (void)hipGetLastError();
        grid = cus * per_cu;
    }
    if (grid < 0) return;
    if (hipMemsetAsync(d_ws, 0, 32768, stream) != hipSuccess) { fprintf(stderr, "kernel_launch: memset failed\n"); return; }
    Args a{};
    for (int i = 0; i < 27; ++i) a.in[i] = (const float*)d_in[i];
    a.out = (float*)d_out; a.ws = (unsigned char*)d_ws;
    void* args[] = {&a};
    hipError_t e = hipLaunchCooperativeKernel((const void*)fwd_kernel, dim3(grid), dim3(NTHREADS), args, LDS_BYTES, stream);
    if (e != hipSuccess) fprintf(stderr, "kernel_launch: cooperative launch failed: %s (grid %d)\n", hipGetErrorString(e), grid);
}
```

```cpp
#include <hip/hip_runtime.h>
#include <hip/hip_cooperative_groups.h>
#include <cstdio>
#include <cstdint>
namespace cg = cooperative_groups;
namespace pg8 {
#define PG8_LAS __attribute__((address_space(3)))
typedef unsigned short bf16_t;
typedef short bf16x8 __attribute__((ext_vector_type(8)));
typedef float f32x4 __attribute__((ext_vector_type(4)));
typedef unsigned u32x4 __attribute__((ext_vector_type(4)));
constexpr int BM = 256, BK = 64, HALF = 128, HTB = HALF * BK * 2  , STAGE_BYTES = 8 * HTB, NXCD = 8, WGM = 8;

__host__ __device__ __forceinline__ int lds_byte(int r, int c) { const int st = (r >> 4) * 2 + (c >> 5), rr = r & 15, cc = c & 31, ob = rr * 64 + cc * 2; return st * 1024 + (ob ^ (((ob >> 9) & 1) << 5)); }
__host__ __device__ __forceinline__ void stage_rc(int b, int& R, int& C) { const int st = b / 1024, sb = b % 1024, swz = sb ^ (((sb >> 9) & 1) << 5); R = (st >> 1) * 16 + swz / 64; C = (st & 1) * 32 + (swz % 64) / 2; }
__host__ __device__ __forceinline__ int perm32(int rho) { const int n = rho >> 4, i = rho & 15; return 8 * (i >> 2) + 4 * n + (i & 3); }

struct Unit { int pm, pn; };
struct Gemm { const bf16_t* A; const bf16_t* Bt; int M, N, K; };

struct StaticOrder {
    int nM, nN, nwg, G, c;
    __host__ __device__ void init(int M, int N, int G_, int c_) { nM = M / BM; nN = N / BM; nwg = nM * nN; G = G_; c = c_; }
    __host__ __device__ bool next(int i, Unit& u) const {
        const long L = (long)i * G + c; if (L >= nwg) return false;
        int wgid = (int)L; { const int q = nwg / NXCD, r = nwg % NXCD, xcd = wgid % NXCD, off = wgid / NXCD; wgid = (xcd < r ? xcd * (q + 1) : r * (q + 1) + (xcd - r) * q) + off; }
        const int nig = WGM * nN, gid = wgid / nig, fm = gid * WGM, gsz = (nM - fm) < WGM ? (nM - fm) : WGM;
        u.pm = fm + ((wgid % nig) % gsz); u.pn = (wgid % nig) / gsz; return true;
    }
    __device__ __forceinline__ void a_ready(const Unit&) const {}
    __device__ __forceinline__ void done(const Unit&) const {}
};

typedef float cv_f32x2 __attribute__((ext_vector_type(2))); typedef __bf16 cv_bf16x2 __attribute__((ext_vector_type(2)));
__device__ __forceinline__ unsigned cvt_pk_bf16(float lo, float hi) { const cv_f32x2 v = {lo, hi}; const cv_bf16x2 b = __builtin_convertvector(v, cv_bf16x2); return __builtin_bit_cast(unsigned, b); }
typedef float f32x2 __attribute__((ext_vector_type(2)));
__device__ __forceinline__ f32x2 gelu_pk(f32x2 v) {
    const f32x2 av = __builtin_elementwise_abs(v), d = av * 0.2316418882f + 1.0f;
    f32x2 t; t.x = __builtin_amdgcn_rcpf(d.x); t.y = __builtin_amdgcn_rcpf(d.y);
    f32x2 q = t * 0.5307027145f + (-0.7265760135f); q = q * t + 0.7107068705f; q = q * t + (-0.142248368f); q = q * t + 0.127414796f; q = q * t;
    const f32x2 s = (v * v) * (-0.72134752044f);
    f32x2 e; e.x = __builtin_amdgcn_exp2f(s.x); e.y = __builtin_amdgcn_exp2f(s.y);
    const f32x2 m = v * (q * e), r = v - m;
    f32x2 o; o.x = v.x < 0.f ? m.x : r.x; o.y = v.y < 0.f ? m.y : r.y; return o;
}

template <int ACT  > struct EpiBf16 {
    static constexpr bool PERM = true, AFTER_DRAIN = false; static_assert(ACT == 0 || ACT == 1, "EpiBf16: ACT is 0 (none) or 1 (gelu_pk)");
    bf16_t* O; int ldc; const float* bias; int split_cols; size_t split_stride; float scale0;
    __device__ __forceinline__ void operator()(const f32x4 (&acc)[2][2][4][2], const Unit& u, int wr, int wc, int fr_, int fq_) const {
        int t_o = threadIdx.x; asm volatile("" : "+v"(t_o)); int fr = t_o & 15, fq = (t_o >> 4) & 3; (void)fr_; (void)fq_;

        const int row0 = u.pm * BM + wr * 64 + fr; int colt = u.pn * BM; bf16_t* base = O;
        float sc = 1.f; if (split_cols) { const int t = colt / split_cols; base += (size_t)t * split_stride; colt -= t * split_cols; if (t == 0) sc = scale0; }
        const int col0 = colt + wc * 32 + 8 * fq, bcol0 = u.pn * BM + wc * 32 + 8 * fq;
        f32x4 bv[2][2];
#pragma unroll
        for (int bj = 0; bj < 2; ++bj)
#pragma unroll
            for (int n = 0; n < 2; ++n) bv[bj][n] = bias ? *(const f32x4*)(bias + bcol0 + bj * HALF + 4 * n) : (f32x4){0.f, 0.f, 0.f, 0.f};
#pragma unroll
        for (int ai = 0; ai < 2; ++ai)
#pragma unroll
            for (int m = 0; m < 4; ++m) { bf16_t* rowp = base + (size_t)(row0 + ai * HALF + m * 16) * ldc + col0;
#pragma unroll
                for (int bj = 0; bj < 2; ++bj) { f32x4 v0 = acc[ai][bj][m][0] + bv[bj][0], v1 = acc[ai][bj][m][1] + bv[bj][1];
                    if (ACT == 1) { f32x2 a = gelu_pk((f32x2){v0[0], v0[1]}), b = gelu_pk((f32x2){v0[2], v0[3]}), c = gelu_pk((f32x2){v1[0], v1[1]}), d = gelu_pk((f32x2){v1[2], v1[3]});
                        v0 = (f32x4){a.x, a.y, b.x, b.y}; v1 = (f32x4){c.x, c.y, d.x, d.y}; }
                    v0 = v0 * sc; v1 = v1 * sc; u32x4 w; w.x = cvt_pk_bf16(v0[0], v0[1]); w.y = cvt_pk_bf16(v0[2], v0[3]); w.z = cvt_pk_bf16(v1[0], v1[1]); w.w = cvt_pk_bf16(v1[2], v1[3]);
                    *(u32x4*)(rowp + bj * HALF) = w; } }
    }
};
__device__ __forceinline__ float sigmoid_f(float x) { return __builtin_amdgcn_rcpf(1.0f + __builtin_amdgcn_exp2f(-1.4426950408889634f * x)); }
__device__ __forceinline__ float gelu_tanh_f(float x) { const float p = __builtin_fmaf(x * x, -0.10294324f, -2.3022082f); return x * __builtin_amdgcn_rcpf(1.0f + __builtin_amdgcn_exp2f(x * p)); }
__device__ __forceinline__ float bf_lo(unsigned w) { return __builtin_bit_cast(float, w << 16); }
__device__ __forceinline__ float bf_hi(unsigned w) { return __builtin_bit_cast(float, w & 0xffff0000u); }
typedef unsigned u32x2 __attribute__((ext_vector_type(2)));
typedef _Float16 h16x2 __attribute__((ext_vector_type(2)));
__device__ __forceinline__ float h_lo(unsigned w) { return (float)__builtin_bit_cast(h16x2, w)[0]; }
__device__ __forceinline__ float h_hi(unsigned w) { return (float)__builtin_bit_cast(h16x2, w)[1]; }
__device__ __forceinline__ unsigned cvt_pk_f16(float lo, float hi) { const h16x2 v = {(_Float16)lo, (_Float16)hi}; return __builtin_bit_cast(unsigned, v); }

__device__ __forceinline__ float rstd_row(const float* SSI, int row) { const f32x4* p = (const f32x4*)(SSI + (size_t)row * 16); const f32x4 a = p[0], b = p[1], c = p[2], d = p[3];
    const float s = ((a[0] + a[1]) + (a[2] + a[3])) + ((b[0] + b[1]) + (b[2] + b[3])) + ((c[0] + c[1]) + (c[2] + c[3])) + ((d[0] + d[1]) + (d[2] + d[3])); return __builtin_amdgcn_rsqf(s * (1.f / 1024.f) + 1e-6f); }
struct EpiIn {
    static constexpr bool PERM = true, AFTER_DRAIN = false;
    bf16_t* Z; size_t bufstride; const float* bgate; float qscale; const float* SSI; float* VST = nullptr;
    template <int MODE> __device__ __forceinline__ void body(const f32x4 (&acc)[2][2][4][2], bf16_t* base, const float* bias, int row0, int col0, int lane = 0, int slot = 0) const {
        f32x4 bv[2][2];
#pragma unroll
        for (int bj = 0; bj < 2; ++bj)
#pragma unroll
            for (int n = 0; n < 2; ++n) bv[bj][n] = (MODE == 3) ? *(const f32x4*)(bias + col0 + bj * HALF + 4 * n) : (f32x4){0.f, 0.f, 0.f, 0.f};
#pragma unroll
        for (int ai = 0; ai < 2; ++ai)
#pragma unroll
            for (int m = 0; m < 4; ++m) { bf16_t* rowp = base + (size_t)(row0 + ai * HALF + m * 16) * 1024 + col0;
                const float rs = rstd_row(SSI, row0 + ai * HALF + m * 16); float ps = 0.f, pq = 0.f;
#pragma unroll
                for (int bj = 0; bj < 2; ++bj) { f32x4 v0 = acc[ai][bj][m][0] * rs, v1 = acc[ai][bj][m][1] * rs;
                    if (MODE == 1 || MODE == 4) {
#pragma unroll
                        for (int x = 0; x < 4; ++x) { v0[x] = gelu_tanh_f(v0[x]); v1[x] = gelu_tanh_f(v1[x]); } }
                    if (MODE == 4) { ps += ((v0[0] + v0[1]) + (v0[2] + v0[3])) + ((v1[0] + v1[1]) + (v1[2] + v1[3]));
                        pq += ((v0[0] * v0[0] + v0[1] * v0[1]) + (v0[2] * v0[2] + v0[3] * v0[3])) + ((v1[0] * v1[0] + v1[1] * v1[1]) + (v1[2] * v1[2] + v1[3] * v1[3])); }
                    if (MODE == 2) { v0 = v0 * qscale; v1 = v1 * qscale; }
                    if (MODE == 3) { v0 = v0 + bv[bj][0]; v1 = v1 + bv[bj][1];
#pragma unroll
                        for (int x = 0; x < 4; ++x) { v0[x] = sigmoid_f(v0[x]); v1[x] = sigmoid_f(v1[x]); } }
                    u32x4 w; w.x = cvt_pk_bf16(v0[0], v0[1]); w.y = cvt_pk_bf16(v0[2], v0[3]); w.z = cvt_pk_bf16(v1[0], v1[1]); w.w = cvt_pk_bf16(v1[2], v1[3]);
                    *(u32x4*)(rowp + bj * HALF) = w; }
                if (MODE == 4) {
                    ps += __builtin_bit_cast(float, __builtin_amdgcn_ds_bpermute((lane ^ 16) << 2, __builtin_bit_cast(int, ps))); pq += __builtin_bit_cast(float, __builtin_amdgcn_ds_bpermute((lane ^ 16) << 2, __builtin_bit_cast(int, pq)));
                    ps += __builtin_bit_cast(float, __builtin_amdgcn_ds_bpermute((lane ^ 32) << 2, __builtin_bit_cast(int, ps))); pq += __builtin_bit_cast(float, __builtin_amdgcn_ds_bpermute((lane ^ 32) << 2, __builtin_bit_cast(int, pq)));
                    if ((lane >> 4) == 0) { float* vp = VST + (size_t)(row0 + ai * HALF + m * 16) * 32 + slot * 2; vp[0] = ps; vp[1] = pq; } }
                asm volatile("" ::: "memory"); }
    }
    __device__ __forceinline__ void operator()(const f32x4 (&acc)[2][2][4][2], const Unit& u, int wr, int wc, int fr_, int fq_) const {
        int t_o = threadIdx.x; asm volatile("" : "+v"(t_o)); int fr = t_o & 15, fq = (t_o >> 4) & 3; (void)fr_; (void)fq_;

        const int t = u.pn >> 2, colt = (u.pn & 3) * BM;
        bf16_t* base = Z + (size_t)t * bufstride;
        const int row0 = u.pm * BM + wr * 64 + fr, col0 = colt + wc * 32 + 8 * fq;
        if (t == 0) body<1>(acc, base, nullptr, row0, col0);
        else if (t == 1) body<4>(acc, base, nullptr, row0, col0, t_o & 63, (u.pn & 3) * 4 + wc);
        else if (t == 2) body<2>(acc, base, nullptr, row0, col0);
        else if (t < 5) body<0>(acc, base, nullptr, row0, col0);
        else body<3>(acc, base, bgate + (t - 5) * 1024, row0, col0);
    }
};
struct EpiNull {
    static constexpr bool PERM = true, AFTER_DRAIN = false;
    __device__ __forceinline__ void operator()(const f32x4 (&acc)[2][2][4][2], const Unit& u, int wr, int wc, int fr_, int fq_) const {
#pragma unroll
        for (int ai = 0; ai < 2; ++ai)
#pragma unroll
            for (int bj = 0; bj < 2; ++bj)
#pragma unroll
                for (int m = 0; m < 4; ++m)
#pragma unroll
                    for (int n = 0; n < 2; ++n) asm volatile("" :: "v"(acc[ai][bj][m][n]));
    }
};
struct EpiStore {
    static constexpr bool PERM = true, AFTER_DRAIN = false;
    bf16_t* O; int ldc;
    __device__ __forceinline__ void operator()(const f32x4 (&acc)[2][2][4][2], const Unit& u, int wr, int wc, int fr_, int fq_) const {
        int t_o = threadIdx.x; asm volatile("" : "+v"(t_o)); int fr = t_o & 15, fq = (t_o >> 4) & 3; (void)fr_; (void)fq_;

        const int row0 = u.pm * BM + wr * 64 + fr, col0 = u.pn * BM + wc * 32 + 8 * fq;
#pragma unroll
        for (int ai = 0; ai < 2; ++ai)
#pragma unroll
            for (int m = 0; m < 4; ++m) { bf16_t* rowp = O + (size_t)(row0 + ai * HALF + m * 16) * ldc + col0;
#pragma unroll
                for (int bj = 0; bj < 2; ++bj) { const f32x4 v0 = acc[ai][bj][m][0], v1 = acc[ai][bj][m][1];
                    u32x4 w; w.x = cvt_pk_bf16(v0[0], v0[1]); w.y = cvt_pk_bf16(v0[2], v0[3]); w.z = cvt_pk_bf16(v1[0], v1[1]); w.w = cvt_pk_bf16(v1[2], v1[3]);
                    *(u32x4*)(rowp + bj * HALF) = w; } }
    }
};
template <bool ADD> struct EpiGate {
    static constexpr bool PERM = true, AFTER_DRAIN = false;
    const bf16_t* G; bf16_t* MG;
    __device__ __forceinline__ void operator()(const f32x4 (&acc)[2][2][4][2], const Unit& u, int wr, int wc, int fr_, int fq_) const {
        int t_o = threadIdx.x; asm volatile("" : "+v"(t_o)); int fr = t_o & 15, fq = (t_o >> 4) & 3; (void)fr_; (void)fq_;

        const int row0 = u.pm * BM + wr * 64 + fr, col0 = u.pn * BM + wc * 32 + 8 * fq;
#pragma unroll
        for (int ai = 0; ai < 2; ++ai)
#pragma unroll
            for (int m = 0; m < 4; ++m) { const size_t off = (size_t)(row0 + ai * HALF + m * 16) * 1024 + col0;
#pragma unroll
                for (int bj = 0; bj < 2; ++bj) { const f32x4 v0 = acc[ai][bj][m][0], v1 = acc[ai][bj][m][1];
                    const u32x4 g = *(const u32x4*)(G + off + bj * HALF);
                    float r[8];
                    r[0] = bf_lo(g.x) * v0[0]; r[1] = bf_hi(g.x) * v0[1]; r[2] = bf_lo(g.y) * v0[2]; r[3] = bf_hi(g.y) * v0[3];
                    r[4] = bf_lo(g.z) * v1[0]; r[5] = bf_hi(g.z) * v1[1]; r[6] = bf_lo(g.w) * v1[2]; r[7] = bf_hi(g.w) * v1[3];
                    if (ADD) { const u32x4 o = *(const u32x4*)(MG + off + bj * HALF);
                        r[0] += bf_lo(o.x); r[1] += bf_hi(o.x); r[2] += bf_lo(o.y); r[3] += bf_hi(o.y); r[4] += bf_lo(o.z); r[5] += bf_hi(o.z); r[6] += bf_lo(o.w); r[7] += bf_hi(o.w); }
                    u32x4 w; w.x = cvt_pk_bf16(r[0], r[1]); w.y = cvt_pk_bf16(r[2], r[3]); w.z = cvt_pk_bf16(r[4], r[5]); w.w = cvt_pk_bf16(r[6], r[7]);
                    *(u32x4*)(MG + off + bj * HALF) = w; }
                asm volatile("" ::: "memory"); }
    }
};
template <bool PLE> struct EpiResid {
    static constexpr bool PERM = true, AFTER_DRAIN = false;
    const bf16_t* XIB; bf16_t* XBO; const float* bias; const bf16_t* E;
    float* SSO; const float* SSI;
    float ascale = 1.f;
    __device__ __forceinline__ void operator()(const f32x4 (&acc)[2][2][4][2], const Unit& u, int wr, int wc, int fr_, int fq_) const {
        int t_o = threadIdx.x; asm volatile("" : "+v"(t_o)); int fr = t_o & 15, fq = (t_o >> 4) & 3; (void)fr_; (void)fq_;
        const int lane = t_o & 63;
        const int col0 = u.pn * BM + wc * 32 + 8 * fq;
        constexpr int MG = PLE ? 2 : 4;
#pragma unroll
        for (int ai = 0; ai < 2; ++ai)
#pragma unroll
        for (int m0 = 0; m0 < 4; m0 += MG) {
            u32x4 xi[4][2]; u32x4 ev[4][2]; float rs[4];
#pragma unroll
            for (int m = m0; m < m0 + MG; ++m) { const int row = u.pm * BM + ai * HALF + wr * 64 + m * 16 + fr; const size_t off = (size_t)row * 1024 + col0;
                rs[m] = 1.f; if (PLE) rs[m] = rstd_row(SSI, row);
#pragma unroll
                for (int bj = 0; bj < 2; ++bj) { xi[m][bj] = *(const u32x4*)(XIB + off + bj * HALF); if (PLE) ev[m][bj] = *(const u32x4*)(E + off + bj * HALF); } }
#pragma unroll
            for (int m = m0; m < m0 + MG; ++m) { const int row = u.pm * BM + ai * HALF + wr * 64 + m * 16 + fr; const size_t off = (size_t)row * 1024 + col0;
                float q = 0.f;
#pragma unroll
                for (int bj = 0; bj < 2; ++bj) { f32x4 a0 = acc[ai][bj][m][0], a1 = acc[ai][bj][m][1];
                    if (PLE) { const f32x4 bv0 = *(const f32x4*)(bias + col0 + bj * HALF), bv1 = *(const f32x4*)(bias + col0 + bj * HALF + 4); const u32x4 e = ev[m][bj];
                        a0 = a0 * rs[m] + bv0; a1 = a1 * rs[m] + bv1;
                        a0[0] = sigmoid_f(a0[0]) * bf_lo(e.x); a0[1] = sigmoid_f(a0[1]) * bf_hi(e.x); a0[2] = sigmoid_f(a0[2]) * bf_lo(e.y); a0[3] = sigmoid_f(a0[3]) * bf_hi(e.y);
                        a1[0] = sigmoid_f(a1[0]) * bf_lo(e.z); a1[1] = sigmoid_f(a1[1]) * bf_hi(e.z); a1[2] = sigmoid_f(a1[2]) * bf_lo(e.w); a1[3] = sigmoid_f(a1[3]) * bf_hi(e.w); }
                    const u32x4 xo = xi[m][bj];
                    const f32x4 xn0 = (f32x4){h_lo(xo.x), h_hi(xo.x), h_lo(xo.y), h_hi(xo.y)} + a0 * ascale, xn1 = (f32x4){h_lo(xo.z), h_hi(xo.z), h_lo(xo.w), h_hi(xo.w)} + a1 * ascale;
                    u32x4 w; w.x = cvt_pk_f16(xn0[0], xn0[1]); w.y = cvt_pk_f16(xn0[2], xn0[3]); w.z = cvt_pk_f16(xn1[0], xn1[1]); w.w = cvt_pk_f16(xn1[2], xn1[3]);
                    *(u32x4*)(XBO + off + bj * HALF) = w;
                    q += ((xn0[0] * xn0[0] + xn0[1] * xn0[1]) + (xn0[2] * xn0[2] + xn0[3] * xn0[3])) + ((xn1[0] * xn1[0] + xn1[1] * xn1[1]) + (xn1[2] * xn1[2] + xn1[3] * xn1[3])); }
                q += __builtin_bit_cast(float, __builtin_amdgcn_ds_bpermute((lane ^ 16) << 2, __builtin_bit_cast(int, q)));
                q += __builtin_bit_cast(float, __builtin_amdgcn_ds_bpermute((lane ^ 32) << 2, __builtin_bit_cast(int, q)));
                if (fq == 0) SSO[(size_t)row * 16 + u.pn * 4 + wc] = q; }
            asm volatile("" ::: "memory"); }
    }
};
constexpr int FFC = 2816, NTC = FFC / 128;
struct EpiConv {
    static constexpr bool PERM = true, AFTER_DRAIN = false;
    bf16_t* ACT; float* EDGE; const float* cw; const float* cb; PG8_LAS float* xb; const float* SSI;
    __device__ __forceinline__ void operator()(f32x4 (&acc)[2][2][4][2], const Unit& u, int wr, int wc, int fr_, int fq_) const {
        int t_o = threadIdx.x; asm volatile("" : "+v"(t_o)); int fr = t_o & 15, fq = (t_o >> 4) & 3; (void)fr_; (void)fq_;

        const int lane = t_o & 63;
        const int jc0 = wc * 32 + 8 * fq;
        { PG8_LAS float* rtab = xb + 2048; const int tt = t_o & 511;
          if (tt < 256) rtab[tt] = rstd_row(SSI, u.pm * BM + tt);
          asm volatile("s_waitcnt lgkmcnt(0)" ::: "memory"); __builtin_amdgcn_s_barrier(); asm volatile("" ::: "memory");
#pragma unroll
          for (int ai = 0; ai < 2; ++ai)
#pragma unroll
            for (int m = 0; m < 4; ++m) { const float rs = rtab[ai * HALF + wr * 64 + m * 16 + fr];
#pragma unroll
                for (int bj = 0; bj < 2; ++bj)
#pragma unroll
                    for (int n = 0; n < 2; ++n) acc[ai][bj][m][n] = acc[ai][bj][m][n] * rs; } }
        if (fr >= 14) {
#pragma unroll
            for (int ai = 0; ai < 2; ++ai)
#pragma unroll
                for (int bj = 0; bj < 2; ++bj)
#pragma unroll
                    for (int n = 0; n < 2; ++n) *(PG8_LAS f32x4*)(xb + (((ai * 2 + wr) * 2 + (fr - 14)) * 256 + bj * HALF + jc0 + 4 * n)) = acc[ai][bj][3][n];
        }
        float* eb = EDGE + (size_t)(u.pm * NTC + u.pn) * 4 * 256;
        if (wr == 0 && fr < 2) {
#pragma unroll
            for (int bj = 0; bj < 2; ++bj)
#pragma unroll
                for (int n = 0; n < 2; ++n) *(f32x4*)(eb + fr * 256 + bj * HALF + jc0 + 4 * n) = acc[0][bj][0][n];
        }
        if (wr == 1 && fr >= 14) {
#pragma unroll
            for (int bj = 0; bj < 2; ++bj)
#pragma unroll
                for (int n = 0; n < 2; ++n) *(f32x4*)(eb + (2 + fr - 14) * 256 + bj * HALF + jc0 + 4 * n) = acc[1][bj][3][n];
        }
        asm volatile("s_waitcnt lgkmcnt(0)" ::: "memory"); __builtin_amdgcn_s_barrier(); asm volatile("" ::: "memory");
        const int src1 = (lane & 48) | ((fr + 15) & 15), src2 = (lane & 48) | ((fr + 14) & 15);
#pragma unroll
        for (int bj = 0; bj < 2; ++bj)
#pragma unroll
            for (int n = 0; n < 2; ++n) {
                const int gc = bj * FFC + u.pn * 128 + jc0 + 4 * n;
                const f32x4 w0 = *(const f32x4*)(cw + gc), w1 = *(const f32x4*)(cw + 2 * FFC + gc), w2 = *(const f32x4*)(cw + 4 * FFC + gc), bb = *(const f32x4*)(cb + gc);
#pragma unroll
                for (int ai = 0; ai < 2; ++ai) {
                    const int grp = ai * 2 + wr;
                    f32x4 xp = (f32x4){0.f, 0.f, 0.f, 0.f};
                    if (grp > 0 && fr >= 14) xp = *(const PG8_LAS f32x4*)(xb + (((grp - 1) * 2 + (fr - 14)) * 256 + bj * HALF + jc0 + 4 * n));
#pragma unroll
                    for (int m = 3; m >= 0; --m) {
                        f32x4 cur = acc[ai][bj][m][n]; f32x4 prv = (m > 0) ? acc[ai][bj][m > 0 ? m - 1 : 0][n] : xp;
                        asm volatile("" : "+v"(cur), "+v"(prv));
                        f32x4 r;
#pragma unroll
                        for (int x = 0; x < 4; ++x) {
                            const float s1 = (fr == 15) ? prv[x] : cur[x], s2 = (fr >= 14) ? prv[x] : cur[x];
                            const float p1 = __builtin_bit_cast(float, __builtin_amdgcn_update_dpp(0, __builtin_bit_cast(int, s1), 0x121, 0xf, 0xf, false)), p2 = __builtin_bit_cast(float, __builtin_amdgcn_update_dpp(0, __builtin_bit_cast(int, s2), 0x122, 0xf, 0xf, false));
                            r[x] = w0[x] * p2 + w1[x] * p1 + w2[x] * cur[x] + bb[x];
                        }
                        asm volatile("" : "+v"(r));
                        acc[ai][bj][m][n] = r;
                    }
                    __builtin_amdgcn_sched_barrier(0);
                }
                asm volatile("" ::: "memory");
            }
#pragma unroll
        for (int ai = 0; ai < 2; ++ai)
#pragma unroll
            for (int m = 0; m < 4; ++m) {
                const bool skip = (ai == 0 && wr == 0 && m == 0 && fr < 2);
                bf16_t* rowp = ACT + (size_t)(u.pm * BM + ai * HALF + wr * 64 + m * 16 + fr) * FFC + u.pn * 128 + jc0;
                const f32x4 g0 = acc[ai][0][m][0], g1 = acc[ai][0][m][1], v0 = acc[ai][1][m][0], v1 = acc[ai][1][m][1];
                float r[8];
#pragma unroll
                for (int x = 0; x < 4; ++x) { r[x] = gelu_tanh_f(g0[x]) * v0[x]; r[4 + x] = gelu_tanh_f(g1[x]) * v1[x]; }
                u32x4 w; w.x = cvt_pk_bf16(r[0], r[1]); w.y = cvt_pk_bf16(r[2], r[3]); w.z = cvt_pk_bf16(r[4], r[5]); w.w = cvt_pk_bf16(r[6], r[7]);
                if (!skip) *(u32x4*)rowp = w;
                asm volatile("" ::: "memory"); __builtin_amdgcn_sched_barrier(0);
            }
        asm volatile("s_waitcnt lgkmcnt(0)" ::: "memory"); __builtin_amdgcn_s_barrier(); asm volatile("" ::: "memory");
    }
};
typedef _Float16 f16x8 __attribute__((ext_vector_type(8)));
template <class Epi, class Sched, bool ALIGN_EPI = false, bool SP2 = false, bool F16 = false>
__device__ __forceinline__ void gemm_phase(PG8_LAS unsigned char* lds, const Gemm g, const Sched& S, const Epi& E) {
    int tid_o = threadIdx.x; asm volatile("" : "+v"(tid_o));
    const int tid = tid_o, wid = __builtin_amdgcn_readfirstlane(tid >> 6), lane = tid & 63, wr = wid >> 2, wc = wid & 3, fr = lane & 15, fq = lane >> 4;
    int K_o = g.K; asm volatile("" : "+s"(K_o)); const int K = K_o, nt = K / BK;
    unsigned voffA[2], voffB[2];
#pragma unroll
    for (int i = 0; i < 2; ++i) { int R, C; stage_rc(tid * 16 + i * 8192, R, C); const int Rb = Epi::PERM ? ((R & ~31) + perm32(R & 31)) : R;
        voffA[i] = (unsigned)(R * K + C) * 2u; voffB[i] = (unsigned)(Rb * K + C) * 2u; }
    const size_t kstep = (size_t)(BK * 2);
    const size_t hstep = (size_t)HALF * K * 2;
    const size_t tstep = 2 * hstep;
    const unsigned ldsw = (unsigned)wid * 1024u;
    const int aoff = lds_byte(wr * 64 + fr, fq * 8), boff = lds_byte(wc * 32 + fr, fq * 8);
#define PG8_SA(b, h) (((b) * 2 + (h)) * HTB)
#define PG8_SB(b, h) ((4 + (b) * 2 + (h)) * HTB)
#define PG8_STAGE(bufoff, gbase, voff) do { _Pragma("unroll") for (int _i = 0; _i < 2; ++_i) \
        __builtin_amdgcn_global_load_lds((const unsigned*)((const char*)(gbase) + (voff)[_i]), (PG8_LAS unsigned*)(lds + (bufoff) + ldsw + _i * 8192), 16, 0, 0); } while (0)
#define PG8_LDA(dst, b, h) do { _Pragma("unroll") for (int m = 0; m < 4; ++m) _Pragma("unroll") for (int k = 0; k < 2; ++k) dst[m][k] = *(const PG8_LAS bf16x8*)(lds + PG8_SA(b, h) + aoff + m * 2048 + k * 1024); } while (0)
#define PG8_LDB(dst, b, h) do { _Pragma("unroll") for (int n = 0; n < 2; ++n) _Pragma("unroll") for (int k = 0; k < 2; ++k) dst[n][k] = *(const PG8_LAS bf16x8*)(lds + PG8_SB(b, h) + boff + n * 2048 + k * 1024); } while (0)
#define PG8_MMA(ai, bj, At, Bt) do { __builtin_amdgcn_s_setprio(1); _Pragma("unroll") for (int m = 0; m < 4; ++m) _Pragma("unroll") for (int n = 0; n < 2; ++n) _Pragma("unroll") for (int k = 0; k < 2; ++k) \
        { if constexpr (F16) acc[ai][bj][m][n] = __builtin_amdgcn_mfma_f32_16x16x32_f16(__builtin_bit_cast(f16x8, Bt[n][k]), __builtin_bit_cast(f16x8, At[m][k]), acc[ai][bj][m][n], 0, 0, 0); \
          else acc[ai][bj][m][n] = __builtin_amdgcn_mfma_f32_16x16x32_bf16(Bt[n][k], At[m][k], acc[ai][bj][m][n], 0, 0, 0); } __builtin_amdgcn_s_setprio(0); } while (0)
#define PG8_WAIT_V(n) asm volatile("s_waitcnt vmcnt(" #n ")" ::: "memory")
#define PG8_WAIT_L(n) asm volatile("s_waitcnt lgkmcnt(" #n ")" ::: "memory")
#define PG8_BAR __builtin_amdgcn_s_barrier()
#define PG8_SCHED __builtin_amdgcn_sched_barrier(0)
    Unit cur, nxt; int ui = 0;
    if (!S.next(0, cur)) return;
    f32x4 acc[2][2][4][2];
#pragma unroll
    for (int a = 0; a < 2; ++a)
#pragma unroll
        for (int b = 0; b < 2; ++b)
#pragma unroll
            for (int m = 0; m < 4; ++m)
#pragma unroll
                for (int n = 0; n < 2; ++n) acc[a][b][m][n] = (f32x4){0.f, 0.f, 0.f, 0.f};
    bf16x8 At[4][2], B0[2][2], B1[2][2];
    const char* cA = (const char*)g.A + (size_t)cur.pm * tstep; const char* cB = (const char*)g.Bt + (size_t)cur.pn * tstep;
    S.a_ready(cur);
    if constexpr (SP2) {
        PG8_STAGE(PG8_SB(0, 0), cB, voffB); PG8_STAGE(PG8_SB(0, 1), cB + hstep, voffB); PG8_STAGE(PG8_SA(0, 0), cA, voffA); PG8_STAGE(PG8_SA(0, 1), cA + hstep, voffA);
        if (wr == 1) PG8_BAR;
        PG8_WAIT_V(2); PG8_BAR;
        PG8_STAGE(PG8_SB(1, 0), cB + kstep, voffB); PG8_STAGE(PG8_SA(1, 0), cA + kstep, voffA); PG8_STAGE(PG8_SB(1, 1), cB + hstep + kstep, voffB);
        PG8_WAIT_V(6); PG8_BAR;
    } else {
        PG8_STAGE(PG8_SB(0, 0), cB, voffB); PG8_STAGE(PG8_SA(0, 0), cA, voffA); PG8_STAGE(PG8_SB(0, 1), cB + hstep, voffB); PG8_STAGE(PG8_SA(0, 1), cA + hstep, voffA);
        if (wr == 1) PG8_BAR;
        PG8_WAIT_V(4); PG8_BAR;
        PG8_STAGE(PG8_SB(1, 0), cB + kstep, voffB); PG8_STAGE(PG8_SA(1, 0), cA + kstep, voffA); PG8_STAGE(PG8_SB(1, 1), cB + hstep + kstep, voffB);
        PG8_WAIT_V(6); PG8_BAR;
    }
    for (;;) {
        const bool has_next = S.next(ui + 1, nxt);
        const char* nA = has_next ? (const char*)g.A + (size_t)nxt.pm * tstep : cA; const char* nB = has_next ? (const char*)g.Bt + (size_t)nxt.pn * tstep : cB;
        for (int t = 0; t < nt; t += 2) {
            const bool last = (t == nt - 2);
            const char* a1 = cA + (size_t)(t + 1) * kstep;
            const char* a2 = last ? nA : cA + (size_t)(t + 2) * kstep; const char* b2 = last ? nB : cB + (size_t)(t + 2) * kstep;
            const char* a3 = a2 + kstep; const char* b3 = b2 + kstep;
            if (last && has_next) S.a_ready(nxt);
            if constexpr (SP2) {
            PG8_LDB(B0, 0, 0); PG8_LDB(B1, 0, 1); PG8_SCHED; PG8_LDA(At, 0, 0); PG8_STAGE(PG8_SA(1, 1), a1 + hstep, voffA);
            PG8_WAIT_V(8); PG8_WAIT_L(0); PG8_BAR; PG8_MMA(0, 0, At, B0); PG8_MMA(0, 1, At, B1); PG8_BAR; PG8_SCHED;
            PG8_LDA(At, 0, 1); PG8_STAGE(PG8_SB(0, 0), b2, voffB); PG8_STAGE(PG8_SB(0, 1), b2 + hstep, voffB); PG8_STAGE(PG8_SA(0, 0), a2, voffA);
            PG8_WAIT_V(8); PG8_WAIT_L(0); PG8_BAR; PG8_MMA(1, 0, At, B0); PG8_MMA(1, 1, At, B1); PG8_BAR; PG8_SCHED;
            PG8_LDB(B0, 1, 0); PG8_LDB(B1, 1, 1); PG8_SCHED; PG8_LDA(At, 1, 0); PG8_STAGE(PG8_SA(0, 1), a2 + hstep, voffA);
            PG8_WAIT_V(8); PG8_WAIT_L(0); PG8_BAR; PG8_MMA(0, 0, At, B0); PG8_MMA(0, 1, At, B1); PG8_BAR; PG8_SCHED;
            PG8_LDA(At, 1, 1); PG8_STAGE(PG8_SB(1, 0), b3, voffB); PG8_STAGE(PG8_SB(1, 1), b3 + hstep, voffB); PG8_STAGE(PG8_SA(1, 0), a3, voffA);
            PG8_WAIT_V(8); PG8_WAIT_L(0); PG8_BAR; PG8_MMA(1, 0, At, B0); PG8_MMA(1, 1, At, B1); PG8_BAR; PG8_SCHED;
            } else {
            PG8_LDB(B0, 0, 0); PG8_SCHED; PG8_LDA(At, 0, 0); PG8_STAGE(PG8_SA(1, 1), a1 + hstep, voffA);
            PG8_WAIT_L(8); PG8_BAR; PG8_WAIT_L(0); PG8_MMA(0, 0, At, B0); PG8_BAR; PG8_SCHED;
            PG8_LDB(B1, 0, 1); PG8_STAGE(PG8_SB(0, 0), b2, voffB);
            PG8_BAR; PG8_WAIT_L(0); PG8_MMA(0, 1, At, B1); PG8_BAR;
            PG8_LDA(At, 0, 1); PG8_STAGE(PG8_SA(0, 0), a2, voffA);
            PG8_BAR; PG8_WAIT_L(0); PG8_MMA(1, 0, At, B0); PG8_BAR; PG8_SCHED;
            PG8_STAGE(PG8_SB(0, 1), b2 + hstep, voffB);
            PG8_WAIT_V(6); PG8_BAR; PG8_MMA(1, 1, At, B1); PG8_BAR;
            PG8_LDB(B0, 1, 0); PG8_SCHED; PG8_LDA(At, 1, 0); PG8_STAGE(PG8_SA(0, 1), a2 + hstep, voffA);
            PG8_WAIT_L(8); PG8_BAR; PG8_WAIT_L(0); PG8_MMA(0, 0, At, B0); PG8_BAR; PG8_SCHED;
            PG8_LDB(B1, 1, 1); PG8_STAGE(PG8_SB(1, 0), b3, voffB);
            PG8_BAR; PG8_WAIT_L(0); PG8_MMA(0, 1, At, B1); PG8_BAR;
            PG8_LDA(At, 1, 1); PG8_STAGE(PG8_SA(1, 0), a3, voffA);
            PG8_BAR; PG8_WAIT_L(0); PG8_MMA(1, 0, At, B0); PG8_BAR; PG8_SCHED;
            PG8_STAGE(PG8_SB(1, 1), b3 + hstep, voffB);
            PG8_WAIT_V(6); PG8_BAR; PG8_MMA(1, 1, At, B1); PG8_BAR;
            }
        }
        if constexpr (ALIGN_EPI) { if (wr == 0) PG8_BAR; }
        if constexpr (!Epi::AFTER_DRAIN) { E(acc, cur, wr, wc, fr, fq); S.done(cur); }
        if (!has_next) break;
#pragma unroll
        for (int a = 0; a < 2; ++a)
#pragma unroll
            for (int b = 0; b < 2; ++b)
#pragma unroll
                for (int m = 0; m < 4; ++m)
#pragma unroll
                    for (int n = 0; n < 2; ++n) acc[a][b][m][n] = (f32x4){0.f, 0.f, 0.f, 0.f};
        cur = nxt; cA = nA; cB = nB; ++ui;
        if constexpr (ALIGN_EPI) { if (wr == 1) PG8_BAR; }
    }
    PG8_WAIT_V(0);
    if constexpr (!ALIGN_EPI) { if (wr == 0) PG8_BAR; }
    PG8_BAR;
    if constexpr (Epi::AFTER_DRAIN) { E.fused(acc, cur, wr, wc, fr, fq, lds, wid, lane); S.done(cur); }
#undef PG8_SA
#undef PG8_SB
#undef PG8_STAGE
#undef PG8_LDA
#undef PG8_LDB
#undef PG8_MMA
#undef PG8_WAIT_V
#undef PG8_WAIT_L
#undef PG8_BAR
#undef PG8_SCHED
}
}
#include <hip/hip_bf16.h>
#include <cmath>
namespace attn_body {
using bf16=__hip_bfloat16;
using bf16x8=__attribute__((ext_vector_type(8)))short;
using s16x4=__attribute__((ext_vector_type(4)))short;
using f32x16=__attribute__((ext_vector_type(16)))float;
using u32x4=__attribute__((ext_vector_type(4)))unsigned;
constexpr int NHEAD=16,SEQ=4096,D=64,DM=NHEAD*D;
constexpr int NW=8,QBLK=32,QB=QBLK*NW,KVBLK=64,NQB=SEQ/QB;
constexpr int ATTN_PITCH=DM, ATTN_UNIT_ROWS=QB;
__device__ __forceinline__ int crow(int r,int hi){return (r&3)+8*(r>>2)+4*hi;}
#define SBAR() __builtin_amdgcn_sched_barrier(0)
__device__ __forceinline__ void cmask(f32x16&p0,f32x16&p1,int jb,int qrel,int hi){
  const float NEG=-INFINITY; int kb=64*jb+4*hi;
  #pragma unroll
  for(int r=0;r<16;++r){int kv=kb+(r&3)+8*(r>>2); if(kv>qrel)p0[r]=NEG; if(kv+32>qrel)p1[r]=NEG;}
}

constexpr int NSLOT=3, SLOTB=8192, VSLOTB=2*SLOTB;
constexpr int LDS_K=0, LDS_V=NSLOT*SLOTB, LDS_WS=LDS_V+NSLOT*VSLOTB, LDS_OST=LDS_WS+NW*64*4, LDS_BYTES=LDS_OST+NW*4096;
constexpr float C2=0.125f*1.4426950408889634f;
__device__ __forceinline__ void glds16(const void*gsrc,unsigned lds_dst){unsigned keep;
  asm volatile("s_mov_b32 %0, m0\n\ts_mov_b32 m0, %2\n\ts_nop 0\n\tglobal_load_lds_dwordx4 %1, off\n\ts_mov_b32 m0, %0":"=&s"(keep):"v"(gsrc),"s"(lds_dst):"memory");}
__device__ __forceinline__ void glds16s(const void*sbase,unsigned voff,unsigned lds_dst){unsigned keep;
  asm volatile("s_mov_b32 %0, m0\n\ts_mov_b32 m0, %3\n\ts_nop 0\n\tglobal_load_lds_dwordx4 %1, %2\n\ts_mov_b32 m0, %0":"=&s"(keep):"v"(voff),"s"(sbase),"s"(lds_dst):"memory");}
__device__ __forceinline__ float max3f(float a,float b,float c){float r;asm("v_max3_f32 %0, %1, %2, %3":"=v"(r):"v"(a),"v"(b),"v"(c));return r;}
__device__ __forceinline__ float max2f(float a,float b){float r;asm("v_max_f32_e32 %0, %1, %2":"=v"(r):"v"(a),"v"(b));return r;}
__device__ __forceinline__ float fadd_s(float a,float b){float r;asm("v_add_f32_e32 %0, %1, %2":"=v"(r):"v"(a),"v"(b));return r;}
__device__ __forceinline__ float fsub_s(float a,float b){float r;asm("v_sub_f32_e32 %0, %1, %2":"=v"(r):"v"(a),"v"(b));return r;}
typedef float f32x2_t __attribute__((ext_vector_type(2))); typedef __bf16 bf16x2_t __attribute__((ext_vector_type(2)));
__device__ __forceinline__ unsigned cvtpk_s(float lo,float hi){f32x2_t v={lo,hi};bf16x2_t b=__builtin_convertvector(v,bf16x2_t);return __builtin_bit_cast(unsigned,b);}
#define WAIT_BAR(N) asm volatile("s_waitcnt vmcnt(" #N ") lgkmcnt(0)\n\ts_barrier":::"memory")

__device__ __forceinline__ void qkt(f32x16&p0,f32x16&p1,const char*Kslot,const bf16x8*qr,const f32x16&negm,int r32,int hi){
  const char*kb=Kslot+hi*1024+r32*16;
  #pragma unroll
  for(int d0=0;d0<4;++d0){
    const bf16x8 b0=*reinterpret_cast<const bf16x8*>(kb+d0*2048);
    const bf16x8 b1=*reinterpret_cast<const bf16x8*>(kb+d0*2048+512);
    if(d0==0){p0=__builtin_amdgcn_mfma_f32_32x32x16_bf16(b0,qr[0],negm,0,0,0);p1=__builtin_amdgcn_mfma_f32_32x32x16_bf16(b1,qr[0],negm,0,0,0);}
    else{p0=__builtin_amdgcn_mfma_f32_32x32x16_bf16(b0,qr[d0],p0,0,0,0);p1=__builtin_amdgcn_mfma_f32_32x32x16_bf16(b1,qr[d0],p1,0,0,0);}}
}
typedef __attribute__((address_space(3))) const char* lds_cptr;
typedef short v4i16_t __attribute__((ext_vector_type(4)));
__device__ __forceinline__ void kload8(bf16x8*kf,lds_cptr kp){
  kf[0]=*(const __attribute__((address_space(3))) bf16x8*)(kp);      kf[1]=*(const __attribute__((address_space(3))) bf16x8*)(kp+512);
  kf[2]=*(const __attribute__((address_space(3))) bf16x8*)(kp+2048); kf[3]=*(const __attribute__((address_space(3))) bf16x8*)(kp+2560);
  kf[4]=*(const __attribute__((address_space(3))) bf16x8*)(kp+4096); kf[5]=*(const __attribute__((address_space(3))) bf16x8*)(kp+4608);
  kf[6]=*(const __attribute__((address_space(3))) bf16x8*)(kp+6144); kf[7]=*(const __attribute__((address_space(3))) bf16x8*)(kp+6656);
}
__device__ __forceinline__ void kload2(bf16x8*kf,lds_cptr kp,int j){ kf[2*j]=*(const __attribute__((address_space(3))) bf16x8*)(kp+j*2048); kf[2*j+1]=*(const __attribute__((address_space(3))) bf16x8*)(kp+j*2048+512); }
__device__ __forceinline__ s16x4 vtr(lds_cptr p){ return __builtin_bit_cast(s16x4,__builtin_amdgcn_ds_read_tr16_b64_v4i16((__attribute__((address_space(3))) v4i16_t*)p)); }
__device__ __forceinline__ float rowmax(const f32x16&p0,const f32x16&p1){
  float a=max3f(p0[0],p0[1],p1[0]),b=max3f(p0[2],p0[3],p1[1]);a=max3f(a,p1[2],p1[3]);
  #pragma unroll
  for(int r=4;r<16;r+=4){a=max3f(a,p0[r],p0[r+1]);b=max3f(b,p0[r+2],p0[r+3]);a=max3f(a,p1[r],p1[r+1]);b=max3f(b,p1[r+2],p1[r+3]);}
  const float m=max2f(a,b);
  auto rr=__builtin_amdgcn_permlane32_swap(__float_as_uint(m),__float_as_uint(m),false,false);
  return max2f(__uint_as_float(rr[0]),__uint_as_float(rr[1]));
}
__device__ __forceinline__ void pv(f32x16*o,int vb,bf16x8 pa0,bf16x8 pa1,bf16x8 pa2,bf16x8 pa3){
  #pragma unroll
  for(int d0=0;d0<4;++d0){s16x4 lo[4],hi[4];
    #pragma unroll
    for(int ks=0;ks<4;++ks){
      asm volatile("ds_read_b64_tr_b16 %0,%1 offset:%c2":"=&v"(lo[ks]):"v"(vb),"i"(d0*4096+ks*1024):"memory");
      asm volatile("ds_read_b64_tr_b16 %0,%1 offset:%c2":"=&v"(hi[ks]):"v"(vb),"i"(d0*4096+ks*1024+512):"memory");}
    asm volatile("s_waitcnt lgkmcnt(0)":::"memory");SBAR();
    #define PK(k) (bf16x8){lo[k][0],lo[k][1],lo[k][2],lo[k][3],hi[k][0],hi[k][1],hi[k][2],hi[k][3]}
    o[d0]=__builtin_amdgcn_mfma_f32_32x32x16_bf16(pa0,PK(0),o[d0],0,0,0);
    o[d0]=__builtin_amdgcn_mfma_f32_32x32x16_bf16(pa1,PK(1),o[d0],0,0,0);
    o[d0]=__builtin_amdgcn_mfma_f32_32x32x16_bf16(pa2,PK(2),o[d0],0,0,0);
    o[d0]=__builtin_amdgcn_mfma_f32_32x32x16_bf16(pa3,PK(3),o[d0],0,0,0);
    #undef PK
  }
}

#ifndef ATTN_STORE16
#define ATTN_STORE16(p,v) (*(u32x4*)(p)=(v))
#endif
template<int THRL,bool COMB> __device__ __forceinline__ void attn_unit(bool pre,int nb,int nh,int nhv,int b,int h,int hv,int qb,const bf16*Q,const bf16*__restrict__ K,const bf16*__restrict__ V,bf16*O,bf16*YB,float lam,float oscale,const float*gsub,char*shm){
  int tid_o=threadIdx.x; asm volatile("":"+v"(tid_o)); const int tid=tid_o,lane=tid&63,r32=lane&31,hi=lane>>5; const int wid=__builtin_amdgcn_readfirstlane(tid>>6);
  const long rowbase=(long)b*SEQ; const int q0=qb*QB;
  const bf16*Qw=Q+(rowbase+q0+wid*QBLK)*DM+h*D;
  const bf16*Kh=K+rowbase*DM+h*D,*Vh=V+rowbase*DM+hv*2*D;
  const unsigned lds0=(unsigned)(uintptr_t)shm;
  float*wsf=(float*)(shm+LDS_WS)+wid*64;
  const unsigned koff=(unsigned)(lane*DM+wid*8)*2u;
  const unsigned voff=(unsigned)((16*(wid&3)+(lane>>2))*DM+(wid>>2)*32+(lane&3)*8)*2u;
  const unsigned kdst=lds0+LDS_K+wid*1024, vdst=lds0+LDS_V+wid*1024;
  #define DMA_K(t,slot) glds16s(Kh+(long)(t)*KVBLK*DM,koff,(unsigned)__builtin_amdgcn_readfirstlane(kdst+(slot)))
  #define DMA_V(t,slot) do{ glds16s(Vh+(long)(t)*KVBLK*DM,voff,(unsigned)__builtin_amdgcn_readfirstlane(vdst+2*(slot))); glds16s(Vh+64+(long)(t)*KVBLK*DM,voff,(unsigned)__builtin_amdgcn_readfirstlane(vdst+2*(slot)+8192)); }while(0)
  const char*Kbase=shm+LDS_K; bf16x8 kf[8];
  const lds_cptr shm3=(lds_cptr)shm; const lds_cptr kp0=shm3+LDS_K+hi*1024+r32*16; const lds_cptr vp0=shm3+LDS_V+((lane>>4)&1)*32+(lane&3)*8+(4*hi+((lane&15)>>2))*64;
  const int NT=(q0+QB)/KVBLK;
  if(!pre){DMA_K(0,0);DMA_V(0,0);DMA_K(1,SLOTB);}
  bf16x8 qr[4];
  #pragma unroll
  for(int d0=0;d0<4;++d0)qr[d0]=*reinterpret_cast<const bf16x8*>(&Qw[(long)r32*DM+d0*16+hi*8]);
  float mhat=0.f,l_reg=0.f;f32x16 o[4];o[0]=f32x16{};o[1]=f32x16{};o[2]=f32x16{};o[3]=f32x16{};f32x16 negm=f32x16{};asm volatile("":"+v"(negm));
  const int qrel=wid*QBLK+r32;
  #define CMASK(P0,P1,t) do{int jb_=(t)-(NT-4); if(jb_>=0)cmask(P0,P1,jb_,qrel,hi);}while(0)
  bool resc=false;
  #define START(P0,P1) do{ const float rm=rowmax(P0,P1); resc=false; \
    { const float dl=rm; mhat=fadd_s(mhat,dl); \
      _Pragma("unroll") for(int r=0;r<16;++r){P0[r]=fsub_s(P0[r],dl);P1[r]=fsub_s(P1[r],dl);} \
      _Pragma("unroll") for(int r=0;r<16;++r)negm[r]=-mhat; asm volatile("":"+v"(negm)); } \
    _Pragma("unroll") for(int r=0;r<16;++r)P0[r]=__builtin_amdgcn_exp2f(P0[r]); }while(0)
  #define RESC() do{ if(resc){ asm volatile("s_waitcnt lgkmcnt(0)":::"memory"); \
      _Pragma("unroll") for(int d_=0;d_<4;++d_) _Pragma("unroll") for(int r=0;r<16;++r)o[d_][r]*=wsf[crow(r,hi)]; } }while(0)
  f32x16 pA0,pA1,pB0,pB1;
  int sl_prev=0,sl_cur=0,sl_next=SLOTB;
  #define ROT() do{sl_prev=sl_cur;sl_cur=sl_next;sl_next=(sl_next==(NSLOT-1)*SLOTB)?0:sl_next+SLOTB;}while(0)
  DMA_K(2,2*SLOTB);
  WAIT_BAR(3);
  qkt(pA0,pA1,Kbase,qr,negm,r32,hi);asm volatile("s_nop 15\n\ts_nop 7":"+v"(pA0),"+v"(pA1));CMASK(pA0,pA1,0);
  START(pA0,pA1);
  _Pragma("unroll") for(int r=0;r<16;++r)pA1[r]=__builtin_amdgcn_exp2f(pA1[r]);
  WAIT_BAR(0);
  DMA_K(3,0);DMA_V(1,SLOTB);
  ROT();
  kload8(kf,kp0+sl_cur);
  WAIT_BAR(3);
  s16x4 vlo[8],vhi[8]; u32x4 pw0,pw1,pw2,pw3;
  #define PKW(P,B) cvtpk_s(P[B],P[B+1])
  #define PAF(k) __builtin_bit_cast(bf16x8,pw##k)
  #define VFR(i) (bf16x8){vlo[i][0],vlo[i][1],vlo[i][2],vlo[i][3],vhi[i][0],vhi[i][1],vhi[i][2],vhi[i][3]}
  #define PIN(x) asm volatile("":"+v"(x))
  #define MX3(a,b,c) __builtin_fmaxf(__builtin_fmaxf((a),(b)),(c))
  #define GAPA(MF,A0,A1,A2,A3,W0,W1,PW) do{ MF; sacc+=A0; sacc+=A1; sacc+=A2; sacc+=A3; PIN(sacc); W0; W1; PIN(PW); SBAR(); }while(0)
  #define EX(v) __builtin_amdgcn_exp2f(v)
  #define GAPB(MF,X,B) do{ MF; X[B]=EX(X[B]); X[B+1]=EX(X[B+1]); X[B+2]=EX(X[B+2]); X[B+3]=EX(X[B+3]); PIN(X); SBAR(); }while(0)
  #define GAPH(MF,X,B) do{ MF; X[B]=EX(X[B]); X[B+1]=EX(X[B+1]); PIN(X); SBAR(); }while(0)
  #define VRD(i) do{ vlo[i]=vtr(vp_+(((i)>>2)*4096+((i)&3)*1024)); vhi[i]=vtr(vp_+(((i)>>2)*4096+((i)&3)*1024+512)); }while(0)
  #define VRD2(i) do{ vlo[i]=vtr(vp_+(8192+((i)>>2)*4096+((i)&3)*1024)); vhi[i]=vtr(vp_+(8192+((i)>>2)*4096+((i)&3)*1024+512)); }while(0)
  #define KRD(G,j) do{ if(G){ kload2(kf,kp0+sl_next,j); SBAR(); } }while(0)
  #define STEP(C0,C1,P0,P1,t,GK,GV,GL) do{ SBAR(); \
    const lds_cptr vp_=vp0+2*sl_prev; \
    float sacc=(P0[0]+P0[1]); \
    GAPA(C0=__builtin_amdgcn_mfma_f32_32x32x16_bf16(kf[0],qr[0],negm,0,0,0), P0[2],P0[3],P0[4],P0[5],     pw0[0]=PKW(P0,0), pw0[1]=PKW(P0,2), pw0); \
    GAPA(C1=__builtin_amdgcn_mfma_f32_32x32x16_bf16(kf[1],qr[0],negm,0,0,0), P0[6],P0[7],P0[8],P0[9],     pw0[2]=PKW(P0,4), pw0[3]=PKW(P0,6), pw0); \
    GAPA(C0=__builtin_amdgcn_mfma_f32_32x32x16_bf16(kf[2],qr[1],C0,0,0,0),   P0[10],P0[11],P0[12],P0[13], pw1[0]=PKW(P0,8), pw1[1]=PKW(P0,10), pw1); \
    GAPA(C1=__builtin_amdgcn_mfma_f32_32x32x16_bf16(kf[3],qr[1],C1,0,0,0),   P0[14],P0[15],P1[0],P1[1],   pw1[2]=PKW(P0,12),pw1[3]=PKW(P0,14), pw1); \
    GAPA(C0=__builtin_amdgcn_mfma_f32_32x32x16_bf16(kf[4],qr[2],C0,0,0,0),   P1[2],P1[3],P1[4],P1[5],     pw2[0]=PKW(P1,0), pw2[1]=PKW(P1,2), pw2); \
    GAPA(C1=__builtin_amdgcn_mfma_f32_32x32x16_bf16(kf[5],qr[2],C1,0,0,0),   P1[6],P1[7],P1[8],P1[9],     pw2[2]=PKW(P1,4), pw2[3]=PKW(P1,6), pw2); \
    GAPA(C0=__builtin_amdgcn_mfma_f32_32x32x16_bf16(kf[6],qr[3],C0,0,0,0),   P1[10],P1[11],P1[12],P1[13], pw3[0]=PKW(P1,8), pw3[1]=PKW(P1,10), pw3); \
    GAPA(C1=__builtin_amdgcn_mfma_f32_32x32x16_bf16(kf[7],qr[3],C1,0,0,0),   P1[14],P1[15],0.f,0.f,       pw3[2]=PKW(P1,12),pw3[3]=PKW(P1,14), pw3); \
    l_reg+=sacc; \
    VRD(0);VRD(4);VRD(1);VRD(5);VRD(2);VRD(6);VRD(3);VRD(7); SBAR();   \
    if(GK){DMA_K((t)+3,sl_cur);} if(GV){DMA_V((t)+1,sl_next);} \
    CMASK(C0,C1,t); \
    { float a=MX3(C0[0],C0[1],C1[0]),b=MX3(C0[2],C0[3],C1[1]); a=MX3(a,C1[2],C1[3]); \
      _Pragma("unroll") for(int r=4;r<16;r+=4){a=MX3(a,C0[r],C0[r+1]);b=MX3(b,C0[r+2],C0[r+3]);a=MX3(a,C1[r],C1[r+1]);b=MX3(b,C1[r+2],C1[r+3]);} \
      float rm=__builtin_fmaxf(a,b); { auto rr=__builtin_amdgcn_permlane32_swap(__float_as_uint(rm),__float_as_uint(rm),false,false); rm=__builtin_fmaxf(__uint_as_float(rr[0]),__uint_as_float(rr[1])); } \
      resc=false; \
      if(__builtin_expect(__any(rm>(float)THRL),0)){ const float dl=__builtin_fmaxf(rm,0.f); mhat+=dl; \
        _Pragma("unroll") for(int r=0;r<16;++r){C0[r]-=dl;C1[r]-=dl;} \
        _Pragma("unroll") for(int r=0;r<16;++r)negm[r]=-mhat; asm volatile("":"+v"(negm)); \
        const float f=__builtin_amdgcn_exp2f(-dl); l_reg*=f; if(hi==0)wsf[r32]=f; resc=true; } } \
    SBAR(); \
    GAPH(o[0]=__builtin_amdgcn_mfma_f32_32x32x16_bf16(PAF(0),VFR(0),o[0],0,0,0), C0,0); VRD2(0); \
    GAPH(o[1]=__builtin_amdgcn_mfma_f32_32x32x16_bf16(PAF(0),VFR(4),o[1],0,0,0), C0,4); VRD2(4); \
    KRD(GL,0); GAPH(o[0]=__builtin_amdgcn_mfma_f32_32x32x16_bf16(PAF(1),VFR(1),o[0],0,0,0), C0,8); VRD2(1); \
    KRD(GL,1); GAPH(o[1]=__builtin_amdgcn_mfma_f32_32x32x16_bf16(PAF(1),VFR(5),o[1],0,0,0), C0,12); VRD2(5); \
    KRD(GL,2); GAPH(o[0]=__builtin_amdgcn_mfma_f32_32x32x16_bf16(PAF(2),VFR(2),o[0],0,0,0), C1,0); VRD2(2); \
    KRD(GL,3); GAPH(o[1]=__builtin_amdgcn_mfma_f32_32x32x16_bf16(PAF(2),VFR(6),o[1],0,0,0), C1,4); VRD2(6); \
    GAPH(o[0]=__builtin_amdgcn_mfma_f32_32x32x16_bf16(PAF(3),VFR(3),o[0],0,0,0), C1,8); VRD2(3); \
    GAPH(o[1]=__builtin_amdgcn_mfma_f32_32x32x16_bf16(PAF(3),VFR(7),o[1],0,0,0), C1,12); VRD2(7); SBAR(); \
      \
    GAPH(o[2]=__builtin_amdgcn_mfma_f32_32x32x16_bf16(PAF(0),VFR(0),o[2],0,0,0), C0,2); \
    GAPH(o[3]=__builtin_amdgcn_mfma_f32_32x32x16_bf16(PAF(0),VFR(4),o[3],0,0,0), C0,6); \
    GAPH(o[2]=__builtin_amdgcn_mfma_f32_32x32x16_bf16(PAF(1),VFR(1),o[2],0,0,0), C0,10); \
    GAPH(o[3]=__builtin_amdgcn_mfma_f32_32x32x16_bf16(PAF(1),VFR(5),o[3],0,0,0), C0,14); \
    GAPH(o[2]=__builtin_amdgcn_mfma_f32_32x32x16_bf16(PAF(2),VFR(2),o[2],0,0,0), C1,2); \
    GAPH(o[3]=__builtin_amdgcn_mfma_f32_32x32x16_bf16(PAF(2),VFR(6),o[3],0,0,0), C1,6); \
    GAPH(o[2]=__builtin_amdgcn_mfma_f32_32x32x16_bf16(PAF(3),VFR(3),o[2],0,0,0), C1,10); \
    GAPH(o[3]=__builtin_amdgcn_mfma_f32_32x32x16_bf16(PAF(3),VFR(7),o[3],0,0,0), C1,14); \
    }while(0)
  int t=1;
  #undef CMASK
  #define CMASK(P0,P1,t) do{}while(0)
  for(;t+5<NT;t+=2){
    STEP(pB0,pB1,pA0,pA1,t,true,true,true);     WAIT_BAR(3); RESC(); ROT();
    STEP(pA0,pA1,pB0,pB1,t+1,true,true,true);   WAIT_BAR(3); RESC(); ROT();
  }
  #undef CMASK
  #define CMASK(P0,P1,t) do{int jb_=(t)-(NT-4); if(jb_>=0)cmask(P0,P1,jb_,qrel,hi);}while(0)
  #define ENDW(tt) do{ if((tt)+3<NT){WAIT_BAR(3);} else if((tt)+2<NT){WAIT_BAR(2);} else {WAIT_BAR(0);} }while(0)
  for(;t+1<NT;t+=2){
    STEP(pB0,pB1,pA0,pA1,t,(t+3<NT),(t+1<NT),(t+1<NT));       ENDW(t);   RESC(); ROT();
    STEP(pA0,pA1,pB0,pB1,t+1,(t+4<NT),(t+2<NT),(t+2<NT));     ENDW(t+1); RESC(); ROT();
  }
  STEP(pB0,pB1,pA0,pA1,NT-1,false,false,false); RESC();
  { float sacc=pB0[0]+pB0[1]; _Pragma("unroll") for(int r=2;r<16;++r)sacc+=pB0[r]; _Pragma("unroll") for(int r=0;r<16;++r)sacc+=pB1[r]; l_reg+=sacc;
    pw0=(u32x4){PKW(pB0,0),PKW(pB0,2),PKW(pB0,4),PKW(pB0,6)};pw1=(u32x4){PKW(pB0,8),PKW(pB0,10),PKW(pB0,12),PKW(pB0,14)};pw2=(u32x4){PKW(pB1,0),PKW(pB1,2),PKW(pB1,4),PKW(pB1,6)};pw3=(u32x4){PKW(pB1,8),PKW(pB1,10),PKW(pB1,12),PKW(pB1,14)};
    SBAR(); const int vb0=(int)(lds0+LDS_V)+((lane>>4)&1)*32+(lane&3)*8+(4*hi+((lane&15)>>2))*64;     pv(o,vb0+2*sl_cur,PAF(0),PAF(1),PAF(2),PAF(3)); }
  #undef PKW
  #undef PAF
  #undef VFR
  #undef PIN
  #undef MX3
  #undef GAPA
  #undef GAPB
  #undef GAPH
  #undef EX
  #undef VRD
  #undef VRD2
  #undef KRD
  #undef STEP
  #undef ENDW
  asm volatile("s_waitcnt lgkmcnt(0)\n\ts_barrier":::"memory");
  if(nb>=0){ const bf16*nKh=K+(long)nb*SEQ*DM+nh*D,*nVh=V+(long)nb*SEQ*DM+nhv*2*D;
    glds16s(nKh,koff,(unsigned)__builtin_amdgcn_readfirstlane(kdst)); glds16s(nVh,voff,(unsigned)__builtin_amdgcn_readfirstlane(vdst)); glds16s(nVh+64,voff,(unsigned)__builtin_amdgcn_readfirstlane(vdst+8192)); glds16s(nKh+(long)KVBLK*DM,koff,(unsigned)__builtin_amdgcn_readfirstlane(kdst+SLOTB)); }
  {auto rr=__builtin_amdgcn_permlane32_swap(__float_as_uint(l_reg),__float_as_uint(l_reg),false,false);l_reg=__uint_as_float(rr[0])+__uint_as_float(rr[1]);}
  if(hi==0)wsf[32+r32]=l_reg;asm volatile("s_waitcnt lgkmcnt(0)":::"memory");
  float rli[16];
  #pragma unroll
  for(int r=0;r<16;++r)rli[r]=__builtin_amdgcn_rcpf(wsf[32+crow(r,hi)]);
  bf16*Ow=O+(rowbase+q0+wid*QBLK)*DM+hv*2*D;
  { bf16*stg=(bf16*)(shm+LDS_OST)+wid*2048;
    if constexpr(!COMB){
    #pragma unroll
    for(int hh=0;hh<2;++hh){
      #pragma unroll
      for(int r=0;r<16;++r){const int orow=crow(r,hi);
        #pragma unroll
        for(int d0=0;d0<2;++d0)stg[orow*64+d0*32+r32]=__float2bfloat16(o[2*hh+d0][r]*rli[r]);}
      asm volatile("s_waitcnt lgkmcnt(0)":::"memory");
      #pragma unroll
      for(int i=0;i<4;++i){const int row=i*8+(lane>>3),ch=lane&7; const u32x4 v=*(const u32x4*)(stg+row*64+ch*8); ATTN_STORE16(Ow+(long)row*DM+hh*64+ch*8,v);}
      asm volatile("s_waitcnt lgkmcnt(0)":::"memory"); }
    } else {
    float dv[2][4][8];
    #pragma unroll
    for(int hh=0;hh<2;++hh){
      #pragma unroll
      for(int r=0;r<16;++r){const int orow=crow(r,hi);
        #pragma unroll
        for(int d0=0;d0<2;++d0)stg[orow*64+d0*32+r32]=__float2bfloat16(o[2*hh+d0][r]*rli[r]);}
      asm volatile("s_waitcnt lgkmcnt(0)":::"memory");
      #pragma unroll
      for(int i=0;i<4;++i){const int row=i*8+(lane>>3),ch=lane&7; const u32x4 v2=*(const u32x4*)(stg+row*64+ch*8); const u32x4 v1=*(const u32x4*)(Ow+(long)row*DM+hh*64+ch*8);
        #define BL(w) __builtin_bit_cast(float,(w)<<16)
        #define BH(w) __builtin_bit_cast(float,(w)&0xffff0000u)
        dv[hh][i][0]=BL(v1[0])-lam*BL(v2[0]); dv[hh][i][1]=BH(v1[0])-lam*BH(v2[0]); dv[hh][i][2]=BL(v1[1])-lam*BL(v2[1]); dv[hh][i][3]=BH(v1[1])-lam*BH(v2[1]);
        dv[hh][i][4]=BL(v1[2])-lam*BL(v2[2]); dv[hh][i][5]=BH(v1[2])-lam*BH(v2[2]); dv[hh][i][6]=BL(v1[3])-lam*BL(v2[3]); dv[hh][i][7]=BH(v1[3])-lam*BH(v2[3]);
        #undef BL
        #undef BH
      }
      asm volatile("s_waitcnt lgkmcnt(0)":::"memory"); }
    bf16*Yw=YB+(rowbase+q0+wid*QBLK)*DM+hv*2*D;
    #pragma unroll
    for(int i=0;i<4;++i){const int row=i*8+(lane>>3),ch=lane&7; float ss=0.f;
      #pragma unroll
      for(int hh=0;hh<2;++hh){
        #pragma unroll
        for(int j=0;j<8;++j)ss+=dv[hh][i][j]*dv[hh][i][j];}
      ss+=__builtin_bit_cast(float,__builtin_amdgcn_ds_bpermute((lane^1)<<2,__builtin_bit_cast(int,ss)));
      ss+=__builtin_bit_cast(float,__builtin_amdgcn_ds_bpermute((lane^2)<<2,__builtin_bit_cast(int,ss)));
      ss+=__builtin_bit_cast(float,__builtin_amdgcn_ds_bpermute((lane^4)<<2,__builtin_bit_cast(int,ss)));
      const float rs=oscale/sqrtf(ss*(1.f/128.f)+1e-6f);
      #pragma unroll
      for(int hh=0;hh<2;++hh){const float*gp=gsub+hh*64+ch*8; float y[8];
        #pragma unroll
        for(int j=0;j<8;++j)y[j]=dv[hh][i][j]*rs*gp[j];
        u32x4 w; w[0]=cvtpk_s(y[0],y[1]); w[1]=cvtpk_s(y[2],y[3]); w[2]=cvtpk_s(y[4],y[5]); w[3]=cvtpk_s(y[6],y[7]);
        ATTN_STORE16(Yw+(long)row*DM+hh*64+ch*8,w);} }
    }
  }
  asm volatile("s_waitcnt lgkmcnt(0)\n\ts_barrier":::"memory");
  #undef DMA_K
  #undef DMA_V
  #undef CMASK
  #undef START
  #undef RESC
  #undef ROT
}
constexpr int ATTN_LDS_BYTES=LDS_BYTES;
#undef SBAR
#undef WAIT_BAR
}
#define LAS __attribute__((address_space(3)))
typedef unsigned short bf16;
typedef unsigned v4u __attribute__((ext_vector_type(4)));
typedef unsigned v2u __attribute__((ext_vector_type(2)));
typedef float f32x4 __attribute__((ext_vector_type(4)));
typedef short bf16x8 __attribute__((ext_vector_type(8)));
#define LDS_WAIT() asm volatile("s_waitcnt lgkmcnt(0)" ::: "memory")

constexpr int NWAVES = 8, NTHREADS = 512;
constexpr int DM = 1024, BATCH = 16, SEQ = 4096, DEPTH = 4, M = BATCH * SEQ, MH = M / 2, NIN = 7168, DFF = 2816, NUP = 2 * DFF, PLE = 256;
constexpr float EPS = 1e-6f;
constexpr size_t MiB = 1u << 20;
constexpr size_t WS_W = 2 * MiB, W_LAYER = 40 * MiB;
constexpr size_t WO_IN = 0, WO_UP = 14 * MiB, WO_DOWN = 25 * MiB, WO_PA = 31 * MiB, WO_PB = 33 * MiB, WO_O = 35 * MiB, WO_PG = 37 * MiB, WO_PLE = 39 * MiB, WO_S = 39 * MiB + 512 * 1024;
constexpr size_t WS_H = 162 * MiB;
constexpr size_t WS_Z = 290 * MiB, ZS = (size_t)MH * DM;
constexpr size_t WS_O1 = 738 * MiB, WS_O2 = 802 * MiB;
constexpr size_t WS_ACT = 290 * MiB, WS_XBB = 642 * MiB, WS_EDGE = 802 * MiB, WS_E = 290 * MiB;
constexpr size_t WS_SS = 866 * MiB, SSS = (size_t)M * 16, WS_PBF = 920 * MiB;
constexpr size_t WS_VST = 952 * MiB;
constexpr size_t WS_END = 956 * MiB;
constexpr int LDS_BYTES = 147456, XB_OFF = 131072 + 1024;

__device__ __forceinline__ unsigned f2bf(float f) { unsigned u = __builtin_bit_cast(unsigned, f); return (u + 0x7fffu + ((u >> 16) & 1u)) >> 16; }
__device__ __forceinline__ unsigned pk2(float lo, float hi) { return f2bf(lo) | (f2bf(hi) << 16); }
__device__ __forceinline__ unsigned pkh2(float lo, float hi) { return pg8::cvt_pk_f16(lo, hi); }
__device__ __forceinline__ float blo(unsigned w) { return __builtin_bit_cast(float, w << 16); }
__device__ __forceinline__ float bhi(unsigned w) { return __builtin_bit_cast(float, w & 0xffff0000u); }
__device__ __forceinline__ float bperm(float v, int srclane) { return __builtin_bit_cast(float, __builtin_amdgcn_ds_bpermute(srclane << 2, __builtin_bit_cast(int, v))); }
__device__ __forceinline__ float wave_sum(float v, int lane) {
#pragma unroll
    for (int o = 1; o < 64; o <<= 1) v += bperm(v, lane ^ o);
    return v;
}
__device__ __forceinline__ int up_row_map(int n) { return n < DFF ? (n >> 7) * 256 + (n & 127) : ((n - DFF) >> 7) * 256 + 128 + ((n - DFF) & 127); }
template <bool UPMAP, bool F16OUT = false> __device__ __forceinline__ void transpose_item(const float* W, int K, int N, bf16* WT, LAS float* scr, int item, int lane, const float* gk = nullptr) {
    const int nblk = N / 32, kb = item / nblk, nb = item % nblk, k0 = 64 * kb, n0 = 32 * nb;
#pragma unroll
    for (int i = 0; i < 8; ++i) { const int kk = 8 * i + (lane >> 3), c4 = (lane & 7) * 4;
        f32x4 w = *(const f32x4*)(W + (size_t)(k0 + kk) * N + n0 + c4); if (gk) w = w * gk[k0 + kk];
        scr[kk * 33 + c4] = w[0]; scr[kk * 33 + c4 + 1] = w[1]; scr[kk * 33 + c4 + 2] = w[2]; scr[kk * 33 + c4 + 3] = w[3]; }
    LDS_WAIT(); asm volatile("" ::: "memory");
    const int c = lane & 7;
#pragma unroll
    for (int j = 0; j < 4; ++j) { const int n = (lane >> 3) + 8 * j; const LAS float* s = scr + (8 * c) * 33 + n;
        v4u o; if (F16OUT) {
#define W8(v) __builtin_bit_cast(float, f2bf(v) << 16)
            o.x = pkh2(W8(s[0 * 33]), W8(s[1 * 33])); o.y = pkh2(W8(s[2 * 33]), W8(s[3 * 33])); o.z = pkh2(W8(s[4 * 33]), W8(s[5 * 33])); o.w = pkh2(W8(s[6 * 33]), W8(s[7 * 33]));
#undef W8
        }
        else { o.x = pk2(s[0 * 33], s[1 * 33]); o.y = pk2(s[2 * 33], s[3 * 33]); o.z = pk2(s[4 * 33], s[5 * 33]); o.w = pk2(s[6 * 33], s[7 * 33]); }
        const int dr = UPMAP ? up_row_map(n0 + n) : (n0 + n);
        *(v4u*)(WT + (size_t)dr * K + k0 + 8 * c) = o; }
    LDS_WAIT(); asm volatile("" ::: "memory");
}
template <bool OUTF32> __device__ __forceinline__ void rms_row(const float* xrow, const float* g, void* orow, int lane) {
    const f32x4* xr = (const f32x4*)xrow + lane;
    f32x4 v[4]; float s = 0.f;
#pragma unroll
    for (int j = 0; j < 4; ++j) { v[j] = xr[64 * j]; s += (v[j].x * v[j].x + v[j].y * v[j].y) + (v[j].z * v[j].z + v[j].w * v[j].w); }
    const float rstd = 1.0f / sqrtf(wave_sum(s, lane) * (1.f / DM) + EPS);
#pragma unroll
    for (int j = 0; j < 4; ++j) { const f32x4 gg = ((const f32x4*)g)[lane + 64 * j]; const f32x4 o = v[j] * rstd * gg;
        if (OUTF32) ((f32x4*)orow)[lane + 64 * j] = o;
        else ((unsigned long long*)orow)[lane + 64 * j] = (unsigned long long)pk2(o.x, o.y) | ((unsigned long long)pk2(o.z, o.w) << 32); }
}
__device__ __forceinline__ void sgu_unit(LAS unsigned char* lds, bf16* U, bf16* UO, const bf16* V, const float* VST, const bf16* Wsb, const float* bs, const float* lng, const float* lnb, size_t row0, int tid, int lane, int wave) {
    LAS float* st = (LAS float*)lds;
    LAS unsigned char* vt0 = lds + 1024;
    constexpr int VTB = 128 * 272;
    { const int r = tid >> 2, q = tid & 3; const f32x4* vp = (const f32x4*)(VST + (row0 + r) * 32 + q * 8);
      const f32x4 a = vp[0], c = vp[1];
      float sm = (a[0] + a[2]) + (c[0] + c[2]), sq = (a[1] + a[3]) + (c[1] + c[3]);
      sm += bperm(sm, lane ^ 1); sq += bperm(sq, lane ^ 1); sm += bperm(sm, lane ^ 2); sq += bperm(sq, lane ^ 2);
      const float mean = sm * (1.f / DM); float var = sq * (1.f / DM) - mean * mean; var = var > 0.f ? var : 0.f;
      if (q == 0) { st[2 * r] = mean; st[2 * r + 1] = 1.0f / sqrtf(var + EPS); } }
    __syncthreads();
    const int cg8 = tid & 15, rp = tid >> 4, fr = lane & 15, fq = lane >> 4;
    const int ksmax = (wave * 16 + 15) >> 5;
    const int t = 16 * wave + fr;
    float mu[4], rsd[4];
#pragma unroll
    for (int rr = 0; rr < 4; ++rr) { mu[rr] = st[2 * (4 * rp + rr)]; rsd[rr] = st[2 * (4 * rp + rr) + 1]; }
    v4u vraw[4]; bf16x8 bw[4]; v2u uraw[8]; f32x4 gm[2], bt[2]; float bias;
#define SGU_LOAD(g) do { \
        _Pragma("unroll") for (int rr = 0; rr < 4; ++rr) vraw[rr] = *(const v4u*)(V + (row0 + 4 * rp + rr) * DM + (g) * 128 + 8 * cg8); \
        gm[0] = *(const f32x4*)(lng + (g) * 128 + 8 * cg8); gm[1] = *(const f32x4*)(lng + (g) * 128 + 8 * cg8 + 4); bt[0] = *(const f32x4*)(lnb + (g) * 128 + 8 * cg8); bt[1] = *(const f32x4*)(lnb + (g) * 128 + 8 * cg8 + 4); \
        _Pragma("unroll") for (int ks = 0; ks < 4; ++ks) bw[ks] = *(const bf16x8*)(Wsb + (size_t)(g) * 16384 + (16 * wave + fr) * 128 + fq * 8 + ks * 32); \
        _Pragma("unroll") for (int cb = 0; cb < 8; ++cb) uraw[cb] = *(const v2u*)(U + (row0 + t) * DM + (g) * 128 + 16 * cb + 4 * fq); \
        bias = bs[(g) * 128 + t]; } while (0)
    SGU_LOAD(0);
#pragma unroll 1
    for (int g = 0; g < 8; ++g) {
        LAS unsigned char* vt = vt0 + (g & 1) * VTB;
        { float nv[4][8];
#pragma unroll
          for (int rr = 0; rr < 4; ++rr) { const v4u raw = vraw[rr]; const float mean = mu[rr], rstd = rsd[rr];
              nv[rr][0] = (blo(raw.x) - mean) * rstd * gm[0][0] + bt[0][0]; nv[rr][1] = (bhi(raw.x) - mean) * rstd * gm[0][1] + bt[0][1];
              nv[rr][2] = (blo(raw.y) - mean) * rstd * gm[0][2] + bt[0][2]; nv[rr][3] = (bhi(raw.y) - mean) * rstd * gm[0][3] + bt[0][3];
              nv[rr][4] = (blo(raw.z) - mean) * rstd * gm[1][0] + bt[1][0]; nv[rr][5] = (bhi(raw.z) - mean) * rstd * gm[1][1] + bt[1][1];
              nv[rr][6] = (blo(raw.w) - mean) * rstd * gm[1][2] + bt[1][2]; nv[rr][7] = (bhi(raw.w) - mean) * rstd * gm[1][3] + bt[1][3]; }
#pragma unroll
          for (int j = 0; j < 8; ++j) { v2u w; w.x = pk2(nv[0][j], nv[1][j]); w.y = pk2(nv[2][j], nv[3][j]); *(LAS v2u*)(vt + (8 * cg8 + j) * 272 + rp * 8) = w; } }
        bf16x8 bwc[4]; v2u uc[8]; const float biasc = bias;
#pragma unroll
        for (int ks = 0; ks < 4; ++ks) bwc[ks] = bw[ks];
#pragma unroll
        for (int cb = 0; cb < 8; ++cb) uc[cb] = uraw[cb];
        __syncthreads();
        if (g < 7) SGU_LOAD(g + 1);
        f32x4 acc[8];
#pragma unroll
        for (int cb = 0; cb < 8; ++cb) acc[cb] = (f32x4){0.f, 0.f, 0.f, 0.f};
#pragma unroll
        for (int ks = 0; ks < 4; ++ks) if (ks <= ksmax) {
#pragma unroll
            for (int cb = 0; cb < 8; ++cb) { const bf16x8 av = *(const LAS bf16x8*)(vt + (16 * cb + fr) * 272 + (ks * 32 + fq * 8) * 2);
                acc[cb] = __builtin_amdgcn_mfma_f32_16x16x32_bf16(av, bwc[ks], acc[cb], 0, 0, 0); } }
#pragma unroll
        for (int cb = 0; cb < 8; ++cb) { bf16* up = UO + (row0 + t) * DM + g * 128 + 16 * cb + 4 * fq; const v2u uu = uc[cb];
            v2u w; w.x = pk2(blo(uu.x) * (acc[cb][0] + biasc), bhi(uu.x) * (acc[cb][1] + biasc)); w.y = pk2(blo(uu.y) * (acc[cb][2] + biasc), bhi(uu.y) * (acc[cb][3] + biasc));
            *(v2u*)up = w; }
    }
#undef SGU_LOAD
    __syncthreads();
}

struct Args { const float* in[27]; float* out; unsigned char* ws; };

#define PH() \
    const Args* ap; { auto kp_ = __builtin_amdgcn_kernarg_segment_ptr(); asm volatile("" : "+s"(kp_)); ap = (const Args*)kp_; } \
    int tid_o = threadIdx.x, bx_o = blockIdx.x, G_o = gridDim.x; asm volatile("" : "+v"(tid_o)); asm volatile("" : "+s"(bx_o), "+s"(G_o)); \
    const int tid = tid_o, bx = bx_o, G = G_o, lane = tid & 63, wave = __builtin_amdgcn_readfirstlane(tid >> 6); \
    const int gw = bx * NWAVES + wave, NGW = G * NWAVES; const size_t gt = (size_t)bx * NTHREADS + tid, NGT = (size_t)G * NTHREADS; \
    unsigned char* const ws = ap->ws; float* const X = ap->out; bf16* const H = (bf16*)(ws + WS_H); bf16* const Z = (bf16*)(ws + WS_Z); \
    bf16 *const ZU = Z, *const ZV = Z + ZS, *const ZQ = Z + 2 * ZS, *const ZK = Z + 3 * ZS, *const ZVA = Z + 4 * ZS, *const ZGA = Z + 5 * ZS, *const ZGB = Z + 6 * ZS; \
    bf16 *const O1 = (bf16*)(ws + WS_O1), *const O2 = (bf16*)(ws + WS_O2), *const ACT = (bf16*)(ws + WS_ACT), *const EB = (bf16*)(ws + WS_E), *const PBF = (bf16*)(ws + WS_PBF); \
    float* const EDGE = (float*)(ws + WS_EDGE); unsigned char* const wl = ws + WS_W + (size_t)l * W_LAYER; bf16* const XBB = (bf16*)(ws + WS_XBB); float* const SS = (float*)(ws + WS_SS); (void)XBB; (void)SS; \
    (void)lane; (void)gw; (void)NGW; (void)gt; (void)NGT; (void)X; (void)H; (void)ZU; (void)ZV; (void)ZQ; (void)ZK; (void)ZVA; (void)ZGA; (void)ZGB; (void)O1; (void)O2; (void)ACT; (void)EB; (void)PBF; (void)EDGE; (void)wl

#define RLX_AGENT __ATOMIC_RELAXED, __HIP_MEMORY_SCOPE_AGENT
#define XB_TMO      128
#define XB_XCNT(j)  (256  + 64 * (j))
#define XB_XSUB(j)  (1280 + 64 * (j))
#define XB_XGEN(j)  (2304 + 64 * (j))
#define XB_TOP      3328
#define XB_TOPGEN   3392
#define XCD_BAR_WORDS 3456
#define XB_SPIN_CAP (1u << 18)

__device__ __forceinline__ unsigned xb_ld(unsigned* p)              { return __hip_atomic_load(p, __ATOMIC_RELAXED, __HIP_MEMORY_SCOPE_AGENT); }
__device__ __forceinline__ unsigned xb_add(unsigned* p, unsigned v) { return __hip_atomic_fetch_add(p, v, __ATOMIC_RELAXED, __HIP_MEMORY_SCOPE_AGENT); }
__device__ __forceinline__ unsigned xb_xcc_id() { return (unsigned)__builtin_amdgcn_s_getreg((3 << 11) | 20) & 0xFu; }
#define XB_SPIN(cond, bar) do { unsigned _sp = 0; while (cond) { __builtin_amdgcn_s_sleep(1); \
    if ((++_sp & 255u) == 0u) { if (xb_ld(&(bar)[XB_TMO])) break; if (_sp > XB_SPIN_CAP) { atomicAdd(&(bar)[XB_TMO], 1u); break; } } } } while (0)

__device__ __forceinline__ void xcd_barrier_complete(unsigned* bar, unsigned x, unsigned& nloc, unsigned& nx) {
    const unsigned G = gridDim.x * gridDim.y * gridDim.z;
    unsigned sum, cnt, mine, sp = 0u;
    for (;;) {
        sum = 0u; cnt = 0u; mine = 0u;
#pragma unroll
        for (unsigned j = 0; j < 16; ++j) { const unsigned c = xb_ld(&bar[XB_XCNT(j)]); sum += c; cnt += (c > 0u) ? 1u : 0u; mine = (j == x) ? c : mine; }
        if (sum == G) break;
        __builtin_amdgcn_s_sleep(1);
        if ((++sp & 255u) == 0u) { if (xb_ld(&bar[XB_TMO])) break; if (sp > XB_SPIN_CAP) { atomicAdd(&bar[XB_TMO], 1u); break; } }
    }
    nloc = mine > 0u ? mine : 1u; nx = cnt > 0u ? cnt : 1u;
}

__device__ __forceinline__ void xcd_barrier(unsigned* const bar_, volatile LAS unsigned* const st_) {
    struct { unsigned* bar; unsigned x; volatile LAS unsigned* st; } b; b.bar = bar_; b.x = xb_xcc_id(); b.st = st_;
    asm volatile("s_waitcnt vmcnt(0)" ::: "memory");
    __syncthreads();
    if (threadIdx.x == 0) {
        unsigned* bar = b.bar;
        __builtin_amdgcn_s_waitcnt(0);
        unsigned nloc = b.st[0], nx = b.st[1];
        if (nloc == 0u) { xcd_barrier_complete(bar, b.x, nloc, nx); b.st[0] = nloc; b.st[1] = nx; }
        const unsigned old = xb_add(&bar[XB_XSUB(b.x)], 1u);
        const unsigned gen = old / nloc;
        if (old + 1u == (gen + 1u) * nloc) {
            __builtin_amdgcn_fence(__ATOMIC_RELEASE, "agent");
            asm volatile("s_waitcnt vmcnt(0)" ::: "memory");
            const unsigned og = xb_add(&bar[XB_TOP], 1u);
            const unsigned tg = og / nx;
            if (og + 1u == (tg + 1u) * nx) xb_add(&bar[XB_TOPGEN], 1u);
            else XB_SPIN(xb_ld(&bar[XB_TOPGEN]) == tg, bar);
            __builtin_amdgcn_fence(__ATOMIC_ACQUIRE, "agent");
            xb_add(&bar[XB_XGEN(b.x)], 1u);
            asm volatile("s_waitcnt vmcnt(0)" ::: "memory");
        } else {
            XB_SPIN(xb_ld(&bar[XB_XGEN(b.x)]) == gen, bar);
            __builtin_amdgcn_fence(__ATOMIC_ACQUIRE, "agent");
            asm volatile("s_waitcnt vmcnt(0)" ::: "memory");
        }
    }
    __syncthreads();
}

__device__ __forceinline__ void ctr_grid_sync(unsigned* ctr, unsigned target) {
    asm volatile("s_waitcnt vmcnt(0) lgkmcnt(0)" ::: "memory");
    __syncthreads();
    if (threadIdx.x == 0) {
        __builtin_amdgcn_fence(__ATOMIC_RELEASE, "agent");
        asm volatile("s_waitcnt vmcnt(0)" ::: "memory");
        __hip_atomic_fetch_add(ctr, 1u, __ATOMIC_RELAXED, __HIP_MEMORY_SCOPE_AGENT);
        while (__hip_atomic_load(ctr, __ATOMIC_RELAXED, __HIP_MEMORY_SCOPE_AGENT) < target) __builtin_amdgcn_s_sleep(2);
    }
    __syncthreads();
    __builtin_amdgcn_fence(__ATOMIC_ACQUIRE, "agent");
    asm volatile("s_waitcnt vmcnt(0)" ::: "memory");
}
#define GRID_SYNC1() do { const Args* ap_s; { auto kp_ = __builtin_amdgcn_kernarg_segment_ptr(); asm volatile("" : "+s"(kp_)); ap_s = (const Args*)kp_; } xcd_barrier((unsigned*)(ap_s->ws + 4096), (volatile LAS unsigned*)(ldsl + LDS_BYTES - 16)); } while (0)
#ifndef DBG_REP_SYNC
#define DBG_REP_SYNC 0
#endif
#define GRID_SYNC() do { GRID_SYNC1(); if (DBG_REP_SYNC) GRID_SYNC1(); } while (0)
#ifndef DBG_REP_ATTN
#define DBG_REP_ATTN 0
#endif
#ifndef DBG_REP_IN
#define DBG_REP_IN 0
#endif
#ifndef DBG_REP_UP
#define DBG_REP_UP 0
#endif
#ifndef DBG_REP_PRO
#define DBG_REP_PRO 0
#endif
#ifndef DBG_REP_COMB
#define DBG_REP_COMB 0
#endif
#ifndef DBG_REP_P4
#define DBG_REP_P4 0
#endif
#ifndef DBG_REP_RES
#define DBG_REP_RES 0
#endif
#ifndef DBG_REP_SGU
#define DBG_REP_SGU 0
#endif
#ifndef DBG_REP_INNULL
#define DBG_REP_INNULL 0
#endif
#ifndef DBG_TIME
#define DBG_TIME 0
#endif
#ifndef SELA
#define SELA 0x4
#endif
#ifndef SELB
#define SELB 0x2
#endif
#define TSTAMP(id) do { if (DBG_TIME && blockIdx.x == 0 && threadIdx.x == 0) { const Args* ap_t; { auto kp_ = __builtin_amdgcn_kernarg_segment_ptr(); asm volatile("" : "+s"(kp_)); ap_t = (const Args*)kp_; } \
    unsigned long long* tb = (unsigned long long*)(ap_t->ws + 64); const unsigned long long t_ = __builtin_amdgcn_s_memrealtime(); tb[1 + (id)] += t_ - tb[0]; tb[0] = t_; } } while (0)
__global__ void __launch_bounds__(NTHREADS, 2) fwd_kernel(Args a_unused) {
    extern __shared__ __attribute__((aligned(16))) unsigned char lds[];
    cg::grid_group grid = cg::this_grid();
    LAS unsigned char* ldsl = (LAS unsigned char*)lds;
    if (threadIdx.x == 0) { ((volatile LAS unsigned*)(ldsl + LDS_BYTES - 16))[0] = 0u; ((volatile LAS unsigned*)(ldsl + LDS_BYTES - 16))[1] = 0u;
        const Args* ap_s; { auto kp_ = __builtin_amdgcn_kernarg_segment_ptr(); asm volatile("" : "+s"(kp_)); ap_s = (const Args*)kp_; } (void)xb_add(&((unsigned*)(ap_s->ws + 4096))[XB_XCNT(xb_xcc_id())], 1u); }
    __syncthreads();
    if (DBG_TIME && blockIdx.x == 0 && threadIdx.x == 0) { const Args* ap_t; { auto kp_ = __builtin_amdgcn_kernarg_segment_ptr(); asm volatile("" : "+s"(kp_)); ap_t = (const Args*)kp_; } ((unsigned long long*)(ap_t->ws + 64))[0] = __builtin_amdgcn_s_memrealtime(); }
    grid.sync();

    for (int rep_ = 0; rep_ < (DBG_REP_PRO ? 2 : 1); ++rep_)
    {
        const int l = 0; PH();
        LAS float* scr = (LAS float*)(ldsl + wave * 16384);
        constexpr int I_IN = (DM / 64) * (NIN / 32), I_SQ = (DM / 64) * (DM / 32), I_UP = (DM / 64) * (NUP / 32), I_DN = (DFF / 64) * (DM / 32), I_PLE = (PLE / 64) * (DM / 32);
        constexpr int I_LAYER = I_IN + 4 * I_SQ + I_UP + I_DN + I_PLE;
        for (int it = gw; it < DEPTH * I_LAYER; it += NGW) {
            const int ll = it / I_LAYER; int r = it % I_LAYER; unsigned char* wll = ws + WS_W + (size_t)ll * W_LAYER;
            if (r < I_IN) { transpose_item<false, true>(ap->in[3] + (size_t)ll * DM * NIN, DM, NIN, (bf16*)(wll + WO_IN), scr, r, lane, ap->in[2] + (size_t)ll * DM); continue; } r -= I_IN;
            if (r < I_SQ) { transpose_item<false>(ap->in[14] + (size_t)ll * DM * DM, DM, DM, (bf16*)(wll + WO_PA), scr, r, lane); continue; } r -= I_SQ;
            if (r < I_SQ) { transpose_item<false>(ap->in[15] + (size_t)ll * DM * DM, DM, DM, (bf16*)(wll + WO_PB), scr, r, lane); continue; } r -= I_SQ;
            if (r < I_SQ) { transpose_item<false>(ap->in[16] + (size_t)ll * DM * DM, DM, DM, (bf16*)(wll + WO_O), scr, r, lane); continue; } r -= I_SQ;
            if (r < I_SQ) { transpose_item<false, true>(ap->in[23] + (size_t)ll * DM * DM, DM, DM, (bf16*)(wll + WO_PG), scr, r, lane, ap->in[22] + (size_t)ll * DM); continue; } r -= I_SQ;
            if (r < I_UP) { transpose_item<true, true>(ap->in[18] + (size_t)ll * DM * NUP, DM, NUP, (bf16*)(wll + WO_UP), scr, r, lane, ap->in[17] + (size_t)ll * DM); continue; } r -= I_UP;
            if (r < I_DN) { transpose_item<false>(ap->in[21] + (size_t)ll * DFF * DM, DFF, DM, (bf16*)(wll + WO_DOWN), scr, r, lane); continue; } r -= I_DN;
            transpose_item<false>(ap->in[25] + (size_t)ll * PLE * DM, PLE, DM, (bf16*)(wll + WO_PLE), scr, r, lane);
        }
        { const float* wsrc = ap->in[7];
          for (size_t i = gt; i < (size_t)DEPTH * 8 * 128 * 128; i += NGT) { const int ll = (int)(i >> 17), rem = (int)(i & 131071), t = (rem >> 7) & 127, sc = rem & 127;
              const float w = wsrc[i]; ((bf16*)(ws + WS_W + (size_t)ll * W_LAYER + WO_S))[rem] = (bf16)f2bf(sc <= t ? w : 0.f); } }
        { const float* xin = ap->in[0];
          for (int m = gw; m < M; m += NGW) { const f32x4* xr = (const f32x4*)(xin + (size_t)m * DM) + lane; float sq = 0.f;
#pragma unroll
              for (int j = 0; j < 4; ++j) { const f32x4 v = xr[64 * j]; sq += (v.x * v.x + v.y * v.y) + (v.z * v.z + v.w * v.w);
                  ((unsigned long long*)(H + (size_t)m * DM))[lane + 64 * j] = (unsigned long long)pkh2(v.x, v.y) | ((unsigned long long)pkh2(v.z, v.w) << 32); }
              sq = wave_sum(sq, lane); if (lane < 16) SS[(size_t)m * 16 + lane] = lane == 0 ? sq : 0.f; } }
    }
    GRID_SYNC(); TSTAMP(0);

#ifndef DBG_STOP
#define DBG_STOP 0
#endif
#define DBG_DUMP_BF16(buf) do { PH(); for (size_t i = gt; i < (size_t)M * DM; i += NGT) X[i] = blo((unsigned)(buf)[i % ((size_t)MH * DM)]); return; } while (0)
#define DBG_DUMP3(b0, b1, b2) do { PH(); for (size_t i = gt; i < (size_t)M * DM; i += NGT) { const size_t k = i % ((size_t)MH * DM); X[i] = blo((unsigned)(b0)[k]) + blo((unsigned)(b1)[k]) + blo((unsigned)(b2)[k]); } return; } while (0)
#define DBG_ZERO_UPPER() do { PH(); for (size_t i = gt; i < (size_t)MH * DM; i += NGT) X[(size_t)MH * DM + i] = 0.f; return; } while (0)
#pragma unroll 1
    for (int l = 0; l < DEPTH; ++l) {
#pragma unroll 1
        for (int hf = 0; hf < 2; ++hf) {
            if (DBG_REP_INNULL) { PH(); pg8::Gemm g{H + (size_t)hf * MH * DM, (const bf16*)(wl + WO_IN), MH, NIN, DM}; pg8::StaticOrder S; S.init(MH, NIN, G, bx); pg8::EpiNull E; pg8::gemm_phase<pg8::EpiNull, pg8::StaticOrder, true, true, true>(ldsl, g, S, E); }
            for (int rep_ = 0; rep_ < (DBG_REP_IN ? 2 : 1); ++rep_)
            { PH(); pg8::Gemm g{H + (size_t)hf * MH * DM, (const bf16*)(wl + WO_IN), MH, NIN, DM}; pg8::StaticOrder S; S.init(MH, NIN, G, bx);
              pg8::EpiIn E{Z, ZS, ap->in[4] + (size_t)l * 2 * DM, 0.125f * 1.4426950408889634f, SS + (size_t)(3 * l) * SSS + (size_t)hf * MH * 16, (float*)(ws + WS_VST)};
              pg8::gemm_phase<pg8::EpiIn, pg8::StaticOrder, true, true, true>(ldsl, g, S, E); }
            GRID_SYNC(); TSTAMP(1);
            if (DBG_STOP == 2) DBG_DUMP3(ZU, ZQ, ZGA);
            if (DBG_STOP == 12) DBG_DUMP3(ZV, ZK, ZGB);
            if (DBG_STOP == 22) DBG_DUMP3(ZVA, ZVA, ZVA);
            if (DBG_STOP == 1) DBG_DUMP3(H, H, H);
            if (DBG_STOP == 32) DBG_DUMP3(ZGA, ZGA, ZGA);
            if (DBG_STOP == 42) DBG_DUMP3(ZU, ZU, ZU);
            if (DBG_STOP == 52) DBG_DUMP3(ZQ, ZQ, ZQ);
            { PH();
              int l_o = l; asm volatile("" : "+s"(l_o));
              const float lam_init = 0.8f - 0.6f * expf(-0.3f * (float)l_o);
              const float s1 = wave_sum(ap->in[9][l * 64 + lane] * ap->in[10][l * 64 + lane], lane), s2 = wave_sum(ap->in[11][l * 64 + lane] * ap->in[12][l * 64 + lane], lane);
              const float lam = __builtin_bit_cast(float, __builtin_amdgcn_readfirstlane(__builtin_bit_cast(int, expf(s1) - expf(s2) + lam_init)));
              const float oscale = __builtin_bit_cast(float, __builtin_amdgcn_readfirstlane(__builtin_bit_cast(int, 1.0f - lam_init)));
              const float* gsub = ap->in[13] + l * 128;
              bool pre = false;
              for (int p = bx; p < 1024; p += G) {
                  const int combo = p & 255, qi = p >> 8, b = combo & 7, r = combo >> 3, h = r >> 2, sq = r & 3;
                  const int qb = qi == 0 ? 15 - sq : qi == 1 ? 8 + sq : qi == 2 ? 7 - sq : sq;
                  const int pn = p + G; const bool more = pn < 1024; const int ncombo = pn & 255, nb2 = more ? (ncombo & 7) : -1, nh2 = (ncombo >> 3) >> 2;
#pragma unroll 1
                  for (int mp = 0; mp < 2; ++mp) {
                  if (mp == 0) attn_body::attn_unit<8, false>(pre, b, 2 * h + 1, h, b, 2 * h, h, qb, (const attn_body::bf16*)ZQ, (const attn_body::bf16*)ZK, (const attn_body::bf16*)ZVA, (attn_body::bf16*)O1, nullptr, 0.f, 0.f, nullptr, (char*)lds);
                  else attn_body::attn_unit<8, true>(pre, nb2, 2 * nh2, nh2, b, 2 * h + 1, h, qb, (const attn_body::bf16*)ZQ, (const attn_body::bf16*)ZK, (const attn_body::bf16*)ZVA, (attn_body::bf16*)O1, (attn_body::bf16*)ZQ, lam, oscale, gsub, (char*)lds);
                  pre = (mp == 0) ? true : more; } } }
            __syncthreads();
            { PH();
              const float* bs = ap->in[8] + (size_t)l * 1024; const float* lng = ap->in[5] + (size_t)l * DM; const float* lnb = ap->in[6] + (size_t)l * DM;
              for (int i = bx; i < MH / 128; i += G) sgu_unit(ldsl, ZU, ZU, ZV, (const float*)(ws + WS_VST), (const bf16*)(wl + WO_S), bs, lng, lnb, (size_t)i * 128, tid, lane, wave); }
            GRID_SYNC(); TSTAMP(2);
            if (DBG_STOP == 3) DBG_DUMP3(O1, O2, ZU);
            if (DBG_STOP == 13) DBG_DUMP3(O1, O2, O1);
            if (DBG_STOP == 23) DBG_DUMP3(ZU, ZU, ZU);
            for (int rep_ = 0; rep_ < (DBG_REP_P4 ? 2 : 1); ++rep_) {
            { PH(); pg8::StaticOrder S; S.init(MH, DM, G, bx);
              pg8::Gemm g{ZU, (const bf16*)(wl + WO_PA), MH, DM, DM}; pg8::EpiGate<false> E{ZGA, ZK}; pg8::gemm_phase<pg8::EpiGate<false>, pg8::StaticOrder, true, true>(ldsl, g, S, E); }
            { PH(); pg8::StaticOrder S; S.init(MH, DM, G, bx);
              pg8::Gemm g{ZQ, (const bf16*)(wl + WO_PB), MH, DM, DM}; pg8::EpiGate<true> E{ZGB, ZK}; pg8::gemm_phase<pg8::EpiGate<true>, pg8::StaticOrder, true, true>(ldsl, g, S, E); }
            }
            GRID_SYNC(); TSTAMP(4);
            if (DBG_STOP == 5) DBG_DUMP3(ZK, ZK, ZK);
            { PH(); pg8::Gemm g{ZK, (const bf16*)(wl + WO_O), MH, DM, DM}; pg8::StaticOrder S; S.init(MH, DM, G, bx);
              pg8::EpiResid<false> E{H + (size_t)hf * MH * DM, H + (size_t)hf * MH * DM, nullptr, nullptr, SS + (size_t)(3 * l + 1) * SSS + (size_t)hf * MH * 16, nullptr};
              if (DBG_REP_RES) { pg8::EpiResid<false> E0 = E; E0.ascale = 0.f; pg8::gemm_phase<pg8::EpiResid<false>, pg8::StaticOrder, true, true>(ldsl, g, S, E0); }
              pg8::gemm_phase<pg8::EpiResid<false>, pg8::StaticOrder, true, true>(ldsl, g, S, E); }
            GRID_SYNC(); TSTAMP(5);
            if (DBG_STOP == 6) DBG_ZERO_UPPER();
        }
        for (int rep_ = 0; rep_ < (DBG_REP_UP ? 2 : 1); ++rep_)
        { PH(); pg8::Gemm g{H, (const bf16*)(wl + WO_UP), M, NUP, DM}; pg8::StaticOrder S; S.init(M, NUP, G, bx);
          pg8::EpiConv E{ACT, EDGE, ap->in[19] + (size_t)l * 3 * NUP, ap->in[20] + (size_t)l * NUP, (LAS float*)(ldsl + XB_OFF), SS + (size_t)(3 * l + 1) * SSS};
          pg8::gemm_phase<pg8::EpiConv, pg8::StaticOrder, true, true, true>(ldsl, g, S, E); }
        GRID_SYNC(); TSTAMP(7);
        { PH(); const float* cw = ap->in[19] + (size_t)l * 3 * NUP; const float* cb = ap->in[20] + (size_t)l * NUP;
          for (size_t i = gt; i < (size_t)(M / 256) * pg8::NTC * 2 * 32; i += NGT) {
              const int c = (int)(i & 31) * 4, row = (int)((i >> 5) & 1), tile = (int)(i >> 6), pn = tile % pg8::NTC, pm = tile / pg8::NTC;
              const bool first = (pm % (SEQ / 256)) == 0; const int gcol = pn * 128 + c;
              const float* e1 = EDGE + (size_t)tile * 1024; const float* e0 = EDGE + (size_t)(first ? tile : tile - pg8::NTC) * 1024;
              f32x4 av[2];
#pragma unroll
              for (int q = 0; q < 2; ++q) { const int jc = q * 128 + c, col = q * DFF + gcol;
                  const f32x4 z4 = (f32x4){0.f, 0.f, 0.f, 0.f};
                  const f32x4 pm2 = first ? z4 : *(const f32x4*)(e0 + 2 * 256 + jc), pm1 = first ? z4 : *(const f32x4*)(e0 + 3 * 256 + jc), r0 = *(const f32x4*)(e1 + jc), r1 = *(const f32x4*)(e1 + 256 + jc);
                  const f32x4 w0 = *(const f32x4*)(cw + col), w1 = *(const f32x4*)(cw + NUP + col), w2 = *(const f32x4*)(cw + 2 * NUP + col), bb = *(const f32x4*)(cb + col);
                  av[q] = row == 0 ? (w0 * pm2 + w1 * pm1 + w2 * r0 + bb) : (w0 * pm1 + w1 * r0 + w2 * r1 + bb); }
              v2u w; w.x = pk2(pg8::gelu_tanh_f(av[0][0]) * av[1][0], pg8::gelu_tanh_f(av[0][1]) * av[1][1]); w.y = pk2(pg8::gelu_tanh_f(av[0][2]) * av[1][2], pg8::gelu_tanh_f(av[0][3]) * av[1][3]);
              *(v2u*)(ACT + (size_t)(pm * 256 + row) * DFF + gcol) = w; }
          const float* pl = ap->in[1] + (size_t)l * M * PLE;
          for (size_t i = gt; i < (size_t)M * PLE / 8; i += NGT) { const f32x4 v0 = ((const f32x4*)pl)[2 * i], v1 = ((const f32x4*)pl)[2 * i + 1];
              v4u w; w.x = pk2(v0.x, v0.y); w.y = pk2(v0.z, v0.w); w.z = pk2(v1.x, v1.y); w.w = pk2(v1.z, v1.w); ((v4u*)PBF)[i] = w; } }
        GRID_SYNC(); TSTAMP(8);
        { PH(); pg8::Gemm g{ACT, (const bf16*)(wl + WO_DOWN), M, DM, DFF}; pg8::StaticOrder S; S.init(M, DM, G, bx);
          pg8::EpiResid<false> E{H, XBB, nullptr, nullptr, SS + (size_t)(3 * l + 2) * SSS, nullptr};
          if (DBG_REP_RES) { pg8::EpiResid<false> E0 = E; E0.ascale = 0.f; pg8::gemm_phase<pg8::EpiResid<false>, pg8::StaticOrder, true, true>(ldsl, g, S, E0); }
          pg8::gemm_phase<pg8::EpiResid<false>, pg8::StaticOrder, true, true>(ldsl, g, S, E); }
        GRID_SYNC(); TSTAMP(9);
        { PH(); pg8::Gemm g{PBF, (const bf16*)(wl + WO_PLE), M, DM, PLE}; pg8::StaticOrder S; S.init(M, DM, G, bx);
          pg8::EpiStore E{EB, DM}; pg8::gemm_phase<pg8::EpiStore, pg8::StaticOrder, true, true>(ldsl, g, S, E); }
        { PH(); pg8::Gemm g{XBB, (const bf16*)(wl + WO_PG), M, DM, DM}; pg8::StaticOrder S; S.init(M, DM, G, bx);
          pg8::EpiResid<true> E{XBB, H, ap->in[24] + (size_t)l * DM, EB, SS + (size_t)(3 * l + 3) * SSS, SS + (size_t)(3 * l + 2) * SSS};
          if (DBG_REP_RES) { pg8::EpiResid<true> E0 = E; E0.ascale = 0.f; E0.XBO = XBB; pg8::gemm_phase<pg8::EpiResid<true>, pg8::StaticOrder, true, true, true>(ldsl, g, S, E0); }
          pg8::gemm_phase<pg8::EpiResid<true>, pg8::StaticOrder, true, true, true>(ldsl, g, S, E); }
        GRID_SYNC(); TSTAMP(11);
        if (l + 1 == DEPTH) { PH(); const float* gfin = ap->in[26];
            for (int m = gw; m < M; m += NGW) { const bf16* xr = H + (size_t)m * DM + 16 * lane; const v4u a0 = *(const v4u*)xr, a1 = *(const v4u*)(xr + 8);
                float f[16]; f[0] = pg8::h_lo(a0.x); f[1] = pg8::h_hi(a0.x); f[2] = pg8::h_lo(a0.y); f[3] = pg8::h_hi(a0.y); f[4] = pg8::h_lo(a0.z); f[5] = pg8::h_hi(a0.z); f[6] = pg8::h_lo(a0.w); f[7] = pg8::h_hi(a0.w);
                f[8] = pg8::h_lo(a1.x); f[9] = pg8::h_hi(a1.x); f[10] = pg8::h_lo(a1.y); f[11] = pg8::h_hi(a1.y); f[12] = pg8::h_lo(a1.z); f[13] = pg8::h_hi(a1.z); f[14] = pg8::h_lo(a1.w); f[15] = pg8::h_hi(a1.w);
                float sq = 0.f;
#pragma unroll
                for (int j = 0; j < 16; ++j) sq += f[j] * f[j];
                const float rstd = 1.0f / sqrtf(wave_sum(sq, lane) * (1.f / DM) + EPS);
                float* orow = X + (size_t)m * DM + 16 * lane;
#pragma unroll
                for (int j = 0; j < 4; ++j) { const f32x4 gg = *(const f32x4*)(gfin + 16 * lane + 4 * j); *(f32x4*)(orow + 4 * j) = (f32x4){f[4 * j] * rstd * gg[0], f[4 * j + 1] * rstd * gg[1], f[4 * j + 2] * rstd * gg[2], f[4 * j + 3] * rstd * gg[3]}; } } }
        if (DBG_TIME && l + 1 == DEPTH) { GRID_SYNC(); TSTAMP(12); GRID_SYNC();
            PH(); const unsigned long long* tb = (const unsigned long long*)(ws + 64); unsigned long long sa = 0, sb = 0;
            for (int k = 0; k < 13; ++k) { const unsigned long long v = __hip_atomic_load(tb + 1 + k, __ATOMIC_RELAXED, __HIP_MEMORY_SCOPE_AGENT); if ((SELA >> k) & 1) sa += v; if ((SELB >> k) & 1) sb += v; }
            const float fb = (float)(sa + sb) * 0.00001f;
            for (size_t i = gt; i < (size_t)16384 * DM; i += NGT) X[i] = fb; }
    }
}

extern "C" void kernel_launch(void* const* d_in, const int* in_sizes, int n_in, void* d_out, int out_size, void* d_ws, size_t ws_size, hipStream_t stream) {
    static int grid = 0;
    if (grid == 0) {
        if (n_in != 27 || out_size != M * DM || ws_size < WS_END) { fprintf(stderr, "kernel_launch: unexpected shapes (n_in %d out %d ws %zu)\n", n_in, out_size, ws_size); grid = -1; return; }
        int dev = 0, cus = 0, per_cu = 0;
        if (hipGetDevice(&dev) != hipSuccess || hipDeviceGetAttribute(&cus, hipDeviceAttributeMultiprocessorCount, dev) != hipSuccess) { grid = -1; return; }
        if (hipFuncSetAttribute((const void*)fwd_kernel, hipFuncAttributeMaxDynamicSharedMemorySize, LDS_BYTES) != hipSuccess) { fprintf(stderr, "kernel_launch: hipFuncSetAttribute failed\n"); grid = -1; return; }
        if (hipOccupancyMaxActiveBlocksPerMultiprocessor(&per_cu, (const void*)fwd_kernel, NTHREADS, LDS_BYTES) != hipSuccess || per_cu < 1) { fprintf(stderr, "kernel_launch: occupancy query gives %d\n", per_cu); per_cu = 1; }
        (void)hipGetLastError();
        grid = cus * per_cu;
    }
    if (grid < 0) return;
    if (hipMemsetAsync(d_ws, 0, 32768, stream) != hipSuccess) { fprintf(stderr, "kernel_launch: memset failed\n"); return; }
    Args a{};
    for (int i = 0; i < 27; ++i) a.in[i] = (const float*)d_in[i];
    a.out = (float*)d_out; a.ws = (unsigned char*)d_ws;
    void* args[] = {&a};
    hipError_t e = hipLaunchCooperativeKernel((const void*)fwd_kernel, dim3(grid), dim3(NTHREADS), args, LDS_BYTES, stream);
    if (e != hipSuccess) fprintf(stderr, "kernel_launch: cooperative launch failed: %s (grid %d)\n", hipGetErrorString(e), grid);
}
```

```cpp
#include <hip/hip_runtime.h>
#include <hip/hip_cooperative_groups.h>
#include <cstdio>
#include <cstdint>
namespace cg = cooperative_groups;
namespace pg8 {
#define PG8_LAS __attribute__((address_space(3)))
typedef unsigned short bf16_t;
typedef short bf16x8 __attribute__((ext_vector_type(8)));
typedef float f32x4 __attribute__((ext_vector_type(4)));
typedef unsigned u32x4 __attribute__((ext_vector_type(4)));
constexpr int BM = 256, BK = 64, HALF = 128, HTB = HALF * BK * 2  , STAGE_BYTES = 8 * HTB, NXCD = 8, WGM = 8;

__host__ __device__ __forceinline__ int lds_byte(int r, int c) { const int st = (r >> 4) * 2 + (c >> 5), rr = r & 15, cc = c & 31, ob = rr * 64 + cc * 2; return st * 1024 + (ob ^ (((ob >> 9) & 1) << 5)); }
__host__ __device__ __forceinline__ void stage_rc(int b, int& R, int& C) { const int st = b / 1024, sb = b % 1024, swz = sb ^ (((sb >> 9) & 1) << 5); R = (st >> 1) * 16 + swz / 64; C = (st & 1) * 32 + (swz % 64) / 2; }
__host__ __device__ __forceinline__ int perm32(int rho) { const int n = rho >> 4, i = rho & 15; return 8 * (i >> 2) + 4 * n + (i & 3); }

struct Unit { int pm, pn; };
struct Gemm { const bf16_t* A; const bf16_t* Bt; int M, N, K; };

struct StaticOrder {
    int nM, nN, nwg, G, c;
    __host__ __device__ void init(int M, int N, int G_, int c_) { nM = M / BM; nN = N / BM; nwg = nM * nN; G = G_; c = c_; }
    __host__ __device__ bool next(int i, Unit& u) const {
        const long L = (long)i * G + c; if (L >= nwg) return false;
        int wgid = (int)L; { const int q = nwg / NXCD, r = nwg % NXCD, xcd = wgid % NXCD, off = wgid / NXCD; wgid = (xcd < r ? xcd * (q + 1) : r * (q + 1) + (xcd - r) * q) + off; }
        const int nig = WGM * nN, gid = wgid / nig, fm = gid * WGM, gsz = (nM - fm) < WGM ? (nM - fm) : WGM;
        u.pm = fm + ((wgid % nig) % gsz); u.pn = (wgid % nig) / gsz; return true;
    }
    __device__ __forceinline__ void a_ready(const Unit&) const {}
    __device__ __forceinline__ void done(const Unit&) const {}
};

typedef float cv_f32x2 __attribute__((ext_vector_type(2))); typedef __bf16 cv_bf16x2 __attribute__((ext_vector_type(2)));
__device__ __forceinline__ unsigned cvt_pk_bf16(float lo, float hi) { const cv_f32x2 v = {lo, hi}; const cv_bf16x2 b = __builtin_convertvector(v, cv_bf16x2); return __builtin_bit_cast(unsigned, b); }
typedef float f32x2 __attribute__((ext_vector_type(2)));
__device__ __forceinline__ f32x2 gelu_pk(f32x2 v) {
    const f32x2 av = __builtin_elementwise_abs(v), d = av * 0.2316418882f + 1.0f;
    f32x2 t; t.x = __builtin_amdgcn_rcpf(d.x); t.y = __builtin_amdgcn_rcpf(d.y);
    f32x2 q = t * 0.5307027145f + (-0.7265760135f); q = q * t + 0.7107068705f; q = q * t + (-0.142248368f); q = q * t + 0.127414796f; q = q * t;
    const f32x2 s = (v * v) * (-0.72134752044f);
    f32x2 e; e.x = __builtin_amdgcn_exp2f(s.x); e.y = __builtin_amdgcn_exp2f(s.y);
    const f32x2 m = v * (q * e), r = v - m;
    f32x2 o; o.x = v.x < 0.f ? m.x : r.x; o.y = v.y < 0.f ? m.y : r.y; return o;
}

template <int ACT  > struct EpiBf16 {
    static constexpr bool PERM = true, AFTER_DRAIN = false; static_assert(ACT == 0 || ACT == 1, "EpiBf16: ACT is 0 (none) or 1 (gelu_pk)");
    bf16_t* O; int ldc; const float* bias; int split_cols; size_t split_stride; float scale0;
    __device__ __forceinline__ void operator()(const f32x4 (&acc)[2][2][4][2], const Unit& u, int wr, int wc, int fr_, int fq_) const {
        int t_o = threadIdx.x; asm volatile("" : "+v"(t_o)); int fr = t_o & 15, fq = (t_o >> 4) & 3; (void)fr_; (void)fq_;

        const int row0 = u.pm * BM + wr * 64 + fr; int colt = u.pn * BM; bf16_t* base = O;
        float sc = 1.f; if (split_cols) { const int t = colt / split_cols; base += (size_t)t * split_stride; colt -= t * split_cols; if (t == 0) sc = scale0; }
        const int col0 = colt + wc * 32 + 8 * fq, bcol0 = u.pn * BM + wc * 32 + 8 * fq;
        f32x4 bv[2][2];
#pragma unroll
        for (int bj = 0; bj < 2; ++bj)
#pragma unroll
            for (int n = 0; n < 2; ++n) bv[bj][n] = bias ? *(const f32x4*)(bias + bcol0 + bj * HALF + 4 * n) : (f32x4){0.f, 0.f, 0.f, 0.f};
#pragma unroll
        for (int ai = 0; ai < 2; ++ai)
#pragma unroll
            for (int m = 0; m < 4; ++m) { bf16_t* rowp = base + (size_t)(row0 + ai * HALF + m * 16) * ldc + col0;
#pragma unroll
                for (int bj = 0; bj < 2; ++bj) { f32x4 v0 = acc[ai][bj][m][0] + bv[bj][0], v1 = acc[ai][bj][m][1] + bv[bj][1];
                    if (ACT == 1) { f32x2 a = gelu_pk((f32x2){v0[0], v0[1]}), b = gelu_pk((f32x2){v0[2], v0[3]}), c = gelu_pk((f32x2){v1[0], v1[1]}), d = gelu_pk((f32x2){v1[2], v1[3]});
                        v0 = (f32x4){a.x, a.y, b.x, b.y}; v1 = (f32x4){c.x, c.y, d.x, d.y}; }
                    v0 = v0 * sc; v1 = v1 * sc; u32x4 w; w.x = cvt_pk_bf16(v0[0], v0[1]); w.y = cvt_pk_bf16(v0[2], v0[3]); w.z = cvt_pk_bf16(v1[0], v1[1]); w.w = cvt_pk_bf16(v1[2], v1[3]);
                    *(u32x4*)(rowp + bj * HALF) = w; } }
    }
};
__device__ __forceinline__ float sigmoid_f(float x) { return __builtin_amdgcn_rcpf(1.0f + __builtin_amdgcn_exp2f(-1.4426950408889634f * x)); }
__device__ __forceinline__ float gelu_tanh_f(float x) { const float p = __builtin_fmaf(x * x, -0.10294324f, -2.3022082f); return x * __builtin_amdgcn_rcpf(1.0f + __builtin_amdgcn_exp2f(x * p)); }
__device__ __forceinline__ float bf_lo(unsigned w) { return __builtin_bit_cast(float, w << 16); }
__device__ __forceinline__ float bf_hi(unsigned w) { return __builtin_bit_cast(float, w & 0xffff0000u); }
typedef unsigned u32x2 __attribute__((ext_vector_type(2)));
typedef _Float16 h16x2 __attribute__((ext_vector_type(2)));
__device__ __forceinline__ float h_lo(unsigned w) { return (float)__builtin_bit_cast(h16x2, w)[0]; }
__device__ __forceinline__ float h_hi(unsigned w) { return (float)__builtin_bit_cast(h16x2, w)[1]; }
__device__ __forceinline__ unsigned cvt_pk_f16(float lo, float hi) { const h16x2 v = {(_Float16)lo, (_Float16)hi}; return __builtin_bit_cast(unsigned, v); }

__device__ __forceinline__ float rstd_row(const float* SSI, int row) { const f32x4* p = (const f32x4*)(SSI + (size_t)row * 16); const f32x4 a = p[0], b = p[1], c = p[2], d = p[3];
    const float s = ((a[0] + a[1]) + (a[2] + a[3])) + ((b[0] + b[1]) + (b[2] + b[3])) + ((c[0] + c[1]) + (c[2] + c[3])) + ((d[0] + d[1]) + (d[2] + d[3])); return __builtin_amdgcn_rsqf(s * (1.f / 1024.f) + 1e-6f); }
struct EpiIn {
    static constexpr bool PERM = true, AFTER_DRAIN = false;
    bf16_t* Z; size_t bufstride; const float* bgate; float qscale; const float* SSI; float* VST = nullptr;
    template <int MODE> __device__ __forceinline__ void body(const f32x4 (&acc)[2][2][4][2], bf16_t* base, const float* bias, int row0, int col0, int lane = 0, int slot = 0) const {
        f32x4 bv[2][2];
#pragma unroll
        for (int bj = 0; bj < 2; ++bj)
#pragma unroll
            for (int n = 0; n < 2; ++n) bv[bj][n] = (MODE == 3) ? *(const f32x4*)(bias + col0 + bj * HALF + 4 * n) : (f32x4){0.f, 0.f, 0.f, 0.f};
#pragma unroll
        for (int ai = 0; ai < 2; ++ai)
#pragma unroll
            for (int m = 0; m < 4; ++m) { bf16_t* rowp = base + (size_t)(row0 + ai * HALF + m * 16) * 1024 + col0;
                const float rs = rstd_row(SSI, row0 + ai * HALF + m * 16); float ps = 0.f, pq = 0.f;
#pragma unroll
                for (int bj = 0; bj < 2; ++bj) { f32x4 v0 = acc[ai][bj][m][0] * rs, v1 = acc[ai][bj][m][1] * rs;
                    if (MODE == 1 || MODE == 4) {
#pragma unroll
                        for (int x = 0; x < 4; ++x) { v0[x] = gelu_tanh_f(v0[x]); v1[x] = gelu_tanh_f(v1[x]); } }
                    if (MODE == 4) { ps += ((v0[0] + v0[1]) + (v0[2] + v0[3])) + ((v1[0] + v1[1]) + (v1[2] + v1[3]));
                        pq += ((v0[0] * v0[0] + v0[1] * v0[1]) + (v0[2] * v0[2] + v0[3] * v0[3])) + ((v1[0] * v1[0] + v1[1] * v1[1]) + (v1[2] * v1[2] + v1[3] * v1[3])); }
                    if (MODE == 2) { v0 = v0 * qscale; v1 = v1 * qscale; }
                    if (MODE == 3) { v0 = v0 + bv[bj][0]; v1 = v1 + bv[bj][1];
#pragma unroll
                        for (int x = 0; x < 4; ++x) { v0[x] = sigmoid_f(v0[x]); v1[x] = sigmoid_f(v1[x]); } }
                    u32x4 w; w.x = cvt_pk_bf16(v0[0], v0[1]); w.y = cvt_pk_bf16(v0[2], v0[3]); w.z = cvt_pk_bf16(v1[0], v1[1]); w.w = cvt_pk_bf16(v1[2], v1[3]);
                    *(u32x4*)(rowp + bj * HALF) = w; }
                if (MODE == 4) {
                    ps += __builtin_bit_cast(float, __builtin_amdgcn_ds_bpermute((lane ^ 16) << 2, __builtin_bit_cast(int, ps))); pq += __builtin_bit_cast(float, __builtin_amdgcn_ds_bpermute((lane ^ 16) << 2, __builtin_bit_cast(int, pq)));
                    ps += __builtin_bit_cast(float, __builtin_amdgcn_ds_bpermute((lane ^ 32) << 2, __builtin_bit_cast(int, ps))); pq += __builtin_bit_cast(float, __builtin_amdgcn_ds_bpermute((lane ^ 32) << 2, __builtin_bit_cast(int, pq)));
                    if ((lane >> 4) == 0) { float* vp = VST + (size_t)(row0 + ai * HALF + m * 16) * 32 + slot * 2; vp[0] = ps; vp[1] = pq; } }
                asm volatile("" ::: "memory"); }
    }
    __device__ __forceinline__ void operator()(const f32x4 (&acc)[2][2][4][2], const Unit& u, int wr, int wc, int fr_, int fq_) const {
        int t_o = threadIdx.x; asm volatile("" : "+v"(t_o)); int fr = t_o & 15, fq = (t_o >> 4) & 3; (void)fr_; (void)fq_;

        const int t = u.pn >> 2, colt = (u.pn & 3) * BM;
        bf16_t* base = Z + (size_t)t * bufstride;
        const int row0 = u.pm * BM + wr * 64 + fr, col0 = colt + wc * 32 + 8 * fq;
        if (t == 0) body<1>(acc, base, nullptr, row0, col0);
        else if (t == 1) body<4>(acc, base, nullptr, row0, col0, t_o & 63, (u.pn & 3) * 4 + wc);
        else if (t == 2) body<2>(acc, base, nullptr, row0, col0);
        else if (t < 5) body<0>(acc, base, nullptr, row0, col0);
        else body<3>(acc, base, bgate + (t - 5) * 1024, row0, col0);
    }
};
struct EpiNull {
    static constexpr bool PERM = true, AFTER_DRAIN = false;
    __device__ __forceinline__ void operator()(const f32x4 (&acc)[2][2][4][2], const Unit& u, int wr, int wc, int fr_, int fq_) const {
#pragma unroll
        for (int ai = 0; ai < 2; ++ai)
#pragma unroll
            for (int bj = 0; bj < 2; ++bj)
#pragma unroll
                for (int m = 0; m < 4; ++m)
#pragma unroll
                    for (int n = 0; n < 2; ++n) asm volatile("" :: "v"(acc[ai][bj][m][n]));
    }
};
struct EpiStore {
    static constexpr bool PERM = true, AFTER_DRAIN = false;
    bf16_t* O; int ldc;
    __device__ __forceinline__ void operator()(const f32x4 (&acc)[2][2][4][2], const Unit& u, int wr, int wc, int fr_, int fq_) const {
        int t_o = threadIdx.x; asm volatile("" : "+v"(t_o)); int fr = t_o & 15, fq = (t_o >> 4) & 3; (void)fr_; (void)fq_;

        const int row0 = u.pm * BM + wr * 64 + fr, col0 = u.pn * BM + wc * 32 + 8 * fq;
#pragma unroll
        for (int ai = 0; ai < 2; ++ai)
#pragma unroll
            for (int m = 0; m < 4; ++m) { bf16_t* rowp = O + (size_t)(row0 + ai * HALF + m * 16) * ldc + col0;
#pragma unroll
                for (int bj = 0; bj < 2; ++bj) { const f32x4 v0 = acc[ai][bj][m][0], v1 = acc[ai][bj][m][1];
                    u32x4 w; w.x = cvt_pk_bf16(v0[0], v0[1]); w.y = cvt_pk_bf16(v0[2], v0[3]); w.z = cvt_pk_bf16(v1[0], v1[1]); w.w = cvt_pk_bf16(v1[2], v1[3]);
                    *(u32x4*)(rowp + bj * HALF) = w; } }
    }
};
template <bool ADD> struct EpiGate {
    static constexpr bool PERM = true, AFTER_DRAIN = false;
    const bf16_t* G; bf16_t* MG;
    __device__ __forceinline__ void operator()(const f32x4 (&acc)[2][2][4][2], const Unit& u, int wr, int wc, int fr_, int fq_) const {
        int t_o = threadIdx.x; asm volatile("" : "+v"(t_o)); int fr = t_o & 15, fq = (t_o >> 4) & 3; (void)fr_; (void)fq_;

        const int row0 = u.pm * BM + wr * 64 + fr, col0 = u.pn * BM + wc * 32 + 8 * fq;
#pragma unroll
        for (int ai = 0; ai < 2; ++ai)
#pragma unroll
            for (int m = 0; m < 4; ++m) { const size_t off = (size_t)(row0 + ai * HALF + m * 16) * 1024 + col0;
#pragma unroll
                for (int bj = 0; bj < 2; ++bj) { const f32x4 v0 = acc[ai][bj][m][0], v1 = acc[ai][bj][m][1];
                    const u32x4 g = *(const u32x4*)(G + off + bj * HALF);
                    float r[8];
                    r[0] = bf_lo(g.x) * v0[0]; r[1] = bf_hi(g.x) * v0[1]; r[2] = bf_lo(g.y) * v0[2]; r[3] = bf_hi(g.y) * v0[3];
                    r[4] = bf_lo(g.z) * v1[0]; r[5] = bf_hi(g.z) * v1[1]; r[6] = bf_lo(g.w) * v1[2]; r[7] = bf_hi(g.w) * v1[3];
                    if (ADD) { const u32x4 o = *(const u32x4*)(MG + off + bj * HALF);
                        r[0] += bf_lo(o.x); r[1] += bf_hi(o.x); r[2] += bf_lo(o.y); r[3] += bf_hi(o.y); r[4] += bf_lo(o.z); r[5] += bf_hi(o.z); r[6] += bf_lo(o.w); r[7] += bf_hi(o.w); }
                    u32x4 w; w.x = cvt_pk_bf16(r[0], r[1]); w.y = cvt_pk_bf16(r[2], r[3]); w.z = cvt_pk_bf16(r[4], r[5]); w.w = cvt_pk_bf16(r[6], r[7]);
                    *(u32x4*)(MG + off + bj * HALF) = w; }
                asm volatile("" ::: "memory"); }
    }
};
template <bool PLE> struct EpiResid {
    static constexpr bool PERM = true, AFTER_DRAIN = false;
    const bf16_t* XIB; bf16_t* XBO; const float* bias; const bf16_t* E;
    float* SSO; const float* SSI;
    float ascale = 1.f;
    __device__ __forceinline__ void operator()(const f32x4 (&acc)[2][2][4][2], const Unit& u, int wr, int wc, int fr_, int fq_) const {
        int t_o = threadIdx.x; asm volatile("" : "+v"(t_o)); int fr = t_o & 15, fq = (t_o >> 4) & 3; (void)fr_; (void)fq_;
        const int lane = t_o & 63;
        const int col0 = u.pn * BM + wc * 32 + 8 * fq;
        constexpr int MG = PLE ? 2 : 4;
#pragma unroll
        for (int ai = 0; ai < 2; ++ai)
#pragma unroll
        for (int m0 = 0; m0 < 4; m0 += MG) {
            u32x4 xi[4][2]; u32x4 ev[4][2]; float rs[4];
#pragma unroll
            for (int m = m0; m < m0 + MG; ++m) { const int row = u.pm * BM + ai * HALF + wr * 64 + m * 16 + fr; const size_t off = (size_t)row * 1024 + col0;
                rs[m] = 1.f; if (PLE) rs[m] = rstd_row(SSI, row);
#pragma unroll
                for (int bj = 0; bj < 2; ++bj) { xi[m][bj] = *(const u32x4*)(XIB + off + bj * HALF); if (PLE) ev[m][bj] = *(const u32x4*)(E + off + bj * HALF); } }
#pragma unroll
            for (int m = m0; m < m0 + MG; ++m) { const int row = u.pm * BM + ai * HALF + wr * 64 + m * 16 + fr; const size_t off = (size_t)row * 1024 + col0;
                float q = 0.f;
#pragma unroll
                for (int bj = 0; bj < 2; ++bj) { f32x4 a0 = acc[ai][bj][m][0], a1 = acc[ai][bj][m][1];
                    if (PLE) { const f32x4 bv0 = *(const f32x4*)(bias + col0 + bj * HALF), bv1 = *(const f32x4*)(bias + col0 + bj * HALF + 4); const u32x4 e = ev[m][bj];
                        a0 = a0 * rs[m] + bv0; a1 = a1 * rs[m] + bv1;
                        a0[0] = sigmoid_f(a0[0]) * bf_lo(e.x); a0[1] = sigmoid_f(a0[1]) * bf_hi(e.x); a0[2] = sigmoid_f(a0[2]) * bf_lo(e.y); a0[3] = sigmoid_f(a0[3]) * bf_hi(e.y);
                        a1[0] = sigmoid_f(a1[0]) * bf_lo(e.z); a1[1] = sigmoid_f(a1[1]) * bf_hi(e.z); a1[2] = sigmoid_f(a1[2]) * bf_lo(e.w); a1[3] = sigmoid_f(a1[3]) * bf_hi(e.w); }
                    const u32x4 xo = xi[m][bj];
                    const f32x4 xn0 = (f32x4){h_lo(xo.x), h_hi(xo.x), h_lo(xo.y), h_hi(xo.y)} + a0 * ascale, xn1 = (f32x4){h_lo(xo.z), h_hi(xo.z), h_lo(xo.w), h_hi(xo.w)} + a1 * ascale;
                    u32x4 w; w.x = cvt_pk_f16(xn0[0], xn0[1]); w.y = cvt_pk_f16(xn0[2], xn0[3]); w.z = cvt_pk_f16(xn1[0], xn1[1]); w.w = cvt_pk_f16(xn1[2], xn1[3]);
                    *(u32x4*)(XBO + off + bj * HALF) = w;
                    q += ((xn0[0] * xn0[0] + xn0[1] * xn0[1]) + (xn0[2] * xn0[2] + xn0[3] * xn0[3])) + ((xn1[0] * xn1[0] + xn1[1] * xn1[1]) + (xn1[2] * xn1[2] + xn1[3] * xn1[3])); }
                q += __builtin_bit_cast(float, __builtin_amdgcn_ds_bpermute((lane ^ 16) << 2, __builtin_bit_cast(int, q)));
                q += __builtin_bit_cast(float, __builtin_amdgcn_ds_bpermute((lane ^ 32) << 2, __builtin_bit_cast(int, q)));
                if (fq == 0) SSO[(size_t)row * 16 + u.pn * 4 + wc] = q; }
            asm volatile("" ::: "memory"); }
    }
};
constexpr int FFC = 2816, NTC = FFC / 128;
struct EpiConv {
    static constexpr bool PERM = true, AFTER_DRAIN = false;
    bf16_t* ACT; float* EDGE; const float* cw; const float* cb; PG8_LAS float* xb; const float* SSI;
    __device__ __forceinline__ void operator()(f32x4 (&acc)[2][2][4][2], const Unit& u, int wr, int wc, int fr_, int fq_) const {
        int t_o = threadIdx.x; asm volatile("" : "+v"(t_o)); int fr = t_o & 15, fq = (t_o >> 4) & 3; (void)fr_; (void)fq_;

        const int lane = t_o & 63;
        const int jc0 = wc * 32 + 8 * fq;
        { PG8_LAS float* rtab = xb + 2048; const int tt = t_o & 511;
          if (tt < 256) rtab[tt] = rstd_row(SSI, u.pm * BM + tt);
          asm volatile("s_waitcnt lgkmcnt(0)" ::: "memory"); __builtin_amdgcn_s_barrier(); asm volatile("" ::: "memory");
#pragma unroll
          for (int ai = 0; ai < 2; ++ai)
#pragma unroll
            for (int m = 0; m < 4; ++m) { const float rs = rtab[ai * HALF + wr * 64 + m * 16 + fr];
#pragma unroll
                for (int bj = 0; bj < 2; ++bj)
#pragma unroll
                    for (int n = 0; n < 2; ++n) acc[ai][bj][m][n] = acc[ai][bj][m][n] * rs; } }
        if (fr >= 14) {
#pragma unroll
            for (int ai = 0; ai < 2; ++ai)
#pragma unroll
                for (int bj = 0; bj < 2; ++bj)
#pragma unroll
                    for (int n = 0; n < 2; ++n) *(PG8_LAS f32x4*)(xb + (((ai * 2 + wr) * 2 + (fr - 14)) * 256 + bj * HALF + jc0 + 4 * n)) = acc[ai][bj][3][n];
        }
        float* eb = EDGE + (size_t)(u.pm * NTC + u.pn) * 4 * 256;
        if (wr == 0 && fr < 2) {
#pragma unroll
            for (int bj = 0; bj < 2; ++bj)
#pragma unroll
                for (int n = 0; n < 2; ++n) *(f32x4*)(eb + fr * 256 + bj * HALF + jc0 + 4 * n) = acc[0][bj][0][n];
        }
        if (wr == 1 && fr >= 14) {
#pragma unroll
            for (int bj = 0; bj < 2; ++bj)
#pragma unroll
                for (int n = 0; n < 2; ++n) *(f32x4*)(eb + (2 + fr - 14) * 256 + bj * HALF + jc0 + 4 * n) = acc[1][bj][3][n];
        }
        asm volatile("s_waitcnt lgkmcnt(0)" ::: "memory"); __builtin_amdgcn_s_barrier(); asm volatile("" ::: "memory");
        const int src1 = (lane & 48) | ((fr + 15) & 15), src2 = (lane & 48) | ((fr + 14) & 15);
#pragma unroll
        for (int bj = 0; bj < 2; ++bj)
#pragma unroll
            for (int n = 0; n < 2; ++n) {
                const int gc = bj * FFC + u.pn * 128 + jc0 + 4 * n;
                const f32x4 w0 = *(const f32x4*)(cw + gc), w1 = *(const f32x4*)(cw + 2 * FFC + gc), w2 = *(const f32x4*)(cw + 4 * FFC + gc), bb = *(const f32x4*)(cb + gc);
#pragma unroll
                for (int ai = 0; ai < 2; ++ai) {
                    const int grp = ai * 2 + wr;
                    f32x4 xp = (f32x4){0.f, 0.f, 0.f, 0.f};
                    if (grp > 0 && fr >= 14) xp = *(const PG8_LAS f32x4*)(xb + (((grp - 1) * 2 + (fr - 14)) * 256 + bj * HALF + jc0 + 4 * n));
#pragma unroll
                    for (int m = 3; m >= 0; --m) {
                        f32x4 cur = acc[ai][bj][m][n]; f32x4 prv = (m > 0) ? acc[ai][bj][m > 0 ? m - 1 : 0][n] : xp;
                        asm volatile("" : "+v"(cur), "+v"(prv));
                        f32x4 r;
#pragma unroll
                        for (int x = 0; x < 4; ++x) {
                            const float s1 = (fr == 15) ? prv[x] : cur[x], s2 = (fr >= 14) ? prv[x] : cur[x];
                            const float p1 = __builtin_bit_cast(float, __builtin_amdgcn_update_dpp(0, __builtin_bit_cast(int, s1), 0x121, 0xf, 0xf, false)), p2 = __builtin_bit_cast(float, __builtin_amdgcn_update_dpp(0, __builtin_bit_cast(int, s2), 0x122, 0xf, 0xf, false));
                            r[x] = w0[x] * p2 + w1[x] * p1 + w2[x] * cur[x] + bb[x];
                        }
                        asm volatile("" : "+v"(r));
                        acc[ai][bj][m][n] = r;
                    }
                    __builtin_amdgcn_sched_barrier(0);
                }
                asm volatile("" ::: "memory");
            }
#pragma unroll
        for (int ai = 0; ai < 2; ++ai)
#pragma unroll
            for (int m = 0; m < 4; ++m) {
                const bool skip = (ai == 0 && wr == 0 && m == 0 && fr < 2);
                bf16_t* rowp = ACT + (size_t)(u.pm * BM + ai * HALF + wr * 64 + m * 16 + fr) * FFC + u.pn * 128 + jc0;
                const f32x4 g0 = acc[ai][0][m][0], g1 = acc[ai][0][m][1], v0 = acc[ai][1][m][0], v1 = acc[ai][1][m][1];
                float r[8];
#pragma unroll
                for (int x = 0; x < 4; ++x) { r[x] = gelu_tanh_f(g0[x]) * v0[x]; r[4 + x] = gelu_tanh_f(g1[x]) * v1[x]; }
                u32x4 w; w.x = cvt_pk_bf16(r[0], r[1]); w.y = cvt_pk_bf16(r[2], r[3]); w.z = cvt_pk_bf16(r[4], r[5]); w.w = cvt_pk_bf16(r[6], r[7]);
                if (!skip) *(u32x4*)rowp = w;
                asm volatile("" ::: "memory"); __builtin_amdgcn_sched_barrier(0);
            }
        asm volatile("s_waitcnt lgkmcnt(0)" ::: "memory"); __builtin_amdgcn_s_barrier(); asm volatile("" ::: "memory");
    }
};
typedef _Float16 f16x8 __attribute__((ext_vector_type(8)));
template <class Epi, class Sched, bool ALIGN_EPI = false, bool SP2 = false, bool F16 = false>
__device__ __forceinline__ void gemm_phase(PG8_LAS unsigned char* lds, const Gemm g, const Sched& S, const Epi& E) {
    int tid_o = threadIdx.x; asm volatile("" : "+v"(tid_o));
    const int tid = tid_o, wid = __builtin_amdgcn_readfirstlane(tid >> 6), lane = tid & 63, wr = wid >> 2, wc = wid & 3, fr = lane & 15, fq = lane >> 4;
    int K_o = g.K; asm volatile("" : "+s"(K_o)); const int K = K_o, nt = K / BK;
    unsigned voffA[2], voffB[2];
#pragma unroll
    for (int i = 0; i < 2; ++i) { int R, C; stage_rc(tid * 16 + i * 8192, R, C); const int Rb = Epi::PERM ? ((R & ~31) + perm32(R & 31)) : R;
        voffA[i] = (unsigned)(R * K + C) * 2u; voffB[i] = (unsigned)(Rb * K + C) * 2u; }
    const size_t kstep = (size_t)(BK * 2);
    const size_t hstep = (size_t)HALF * K * 2;
    const size_t tstep = 2 * hstep;
    const unsigned ldsw = (unsigned)wid * 1024u;
    const int aoff = lds_byte(wr * 64 + fr, fq * 8), boff = lds_byte(wc * 32 + fr, fq * 8);
#define PG8_SA(b, h) (((b) * 2 + (h)) * HTB)
#define PG8_SB(b, h) ((4 + (b) * 2 + (h)) * HTB)
#define PG8_STAGE(bufoff, gbase, voff) do { _Pragma("unroll") for (int _i = 0; _i < 2; ++_i) \
        __builtin_amdgcn_global_load_lds((const unsigned*)((const char*)(gbase) + (voff)[_i]), (PG8_LAS unsigned*)(lds + (bufoff) + ldsw + _i * 8192), 16, 0, 0); } while (0)
#define PG8_LDA(dst, b, h) do { _Pragma("unroll") for (int m = 0; m < 4; ++m) _Pragma("unroll") for (int k = 0; k < 2; ++k) dst[m][k] = *(const PG8_LAS bf16x8*)(lds + PG8_SA(b, h) + aoff + m * 2048 + k * 1024); } while (0)
#define PG8_LDB(dst, b, h) do { _Pragma("unroll") for (int n = 0; n < 2; ++n) _Pragma("unroll") for (int k = 0; k < 2; ++k) dst[n][k] = *(const PG8_LAS bf16x8*)(lds + PG8_SB(b, h) + boff + n * 2048 + k * 1024); } while (0)
#define PG8_MMA(ai, bj, At, Bt) do { __builtin_amdgcn_s_setprio(1); _Pragma("unroll") for (int m = 0; m < 4; ++m) _Pragma("unroll") for (int n = 0; n < 2; ++n) _Pragma("unroll") for (int k = 0; k < 2; ++k) \
        { if constexpr (F16) acc[ai][bj][m][n] = __builtin_amdgcn_mfma_f32_16x16x32_f16(__builtin_bit_cast(f16x8, Bt[n][k]), __builtin_bit_cast(f16x8, At[m][k]), acc[ai][bj][m][n], 0, 0, 0); \
          else acc[ai][bj][m][n] = __builtin_amdgcn_mfma_f32_16x16x32_bf16(Bt[n][k], At[m][k], acc[ai][bj][m][n], 0, 0, 0); } __builtin_amdgcn_s_setprio(0); } while (0)
#define PG8_WAIT_V(n) asm volatile("s_waitcnt vmcnt(" #n ")" ::: "memory")
#define PG8_WAIT_L(n) asm volatile("s_waitcnt lgkmcnt(" #n ")" ::: "memory")
#define PG8_BAR __builtin_amdgcn_s_barrier()
#define PG8_SCHED __builtin_amdgcn_sched_barrier(0)
    Unit cur, nxt; int ui = 0;
    if (!S.next(0, cur)) return;
    f32x4 acc[2][2][4][2];
#pragma unroll
    for (int a = 0; a < 2; ++a)
#pragma unroll
        for (int b = 0; b < 2; ++b)
#pragma unroll
            for (int m = 0; m < 4; ++m)
#pragma unroll
                for (int n = 0; n < 2; ++n) acc[a][b][m][n] = (f32x4){0.f, 0.f, 0.f, 0.f};
    bf16x8 At[4][2], B0[2][2], B1[2][2];
    const char* cA = (const char*)g.A + (size_t)cur.pm * tstep; const char* cB = (const char*)g.Bt + (size_t)cur.pn * tstep;
    S.a_ready(cur);
    if constexpr (SP2) {
        PG8_STAGE(PG8_SB(0, 0), cB, voffB); PG8_STAGE(PG8_SB(0, 1), cB + hstep, voffB); PG8_STAGE(PG8_SA(0, 0), cA, voffA); PG8_STAGE(PG8_SA(0, 1), cA + hstep, voffA);
        if (wr == 1) PG8_BAR;
        PG8_WAIT_V(2); PG8_BAR;
        PG8_STAGE(PG8_SB(1, 0), cB + kstep, voffB); PG8_STAGE(PG8_SA(1, 0), cA + kstep, voffA); PG8_STAGE(PG8_SB(1, 1), cB + hstep + kstep, voffB);
        PG8_WAIT_V(6); PG8_BAR;
    } else {
        PG8_STAGE(PG8_SB(0, 0), cB, voffB); PG8_STAGE(PG8_SA(0, 0), cA, voffA); PG8_STAGE(PG8_SB(0, 1), cB + hstep, voffB); PG8_STAGE(PG8_SA(0, 1), cA + hstep, voffA);
        if (wr == 1) PG8_BAR;
        PG8_WAIT_V(4); PG8_BAR;
        PG8_STAGE(PG8_SB(1, 0), cB + kstep, voffB); PG8_STAGE(PG8_SA(1, 0), cA + kstep, voffA); PG8_STAGE(PG8_SB(1, 1), cB + hstep + kstep, voffB);
        PG8_WAIT_V(6); PG8_BAR;
    }
    for (;;) {
        const bool has_next = S.next(ui + 1, nxt);
        const char* nA = has_next ? (const char*)g.A + (size_t)nxt.pm * tstep : cA; const char* nB = has_next ? (const char*)g.Bt + (size_t)nxt.pn * tstep : cB;
        for (int t = 0; t < nt; t += 2) {
            const bool last = (t == nt - 2);
            const char* a1 = cA + (size_t)(t + 1) * kstep;
            const char* a2 = last ? nA : cA + (size_t)(t + 2) * kstep; const char* b2 = last ? nB : cB + (size_t)(t + 2) * kstep;
            const char* a3 = a2 + kstep; const char* b3 = b2 + kstep;
            if (last && has_next) S.a_ready(nxt);
            if constexpr (SP2) {
            PG8_LDB(B0, 0, 0); PG8_LDB(B1, 0, 1); PG8_SCHED; PG8_LDA(At, 0, 0); PG8_STAGE(PG8_SA(1, 1), a1 + hstep, voffA);
            PG8_WAIT_V(8); PG8_WAIT_L(0); PG8_BAR; PG8_MMA(0, 0, At, B0); PG8_MMA(0, 1, At, B1); PG8_BAR; PG8_SCHED;
            PG8_LDA(At, 0, 1); PG8_STAGE(PG8_SB(0, 0), b2, voffB); PG8_STAGE(PG8_SB(0, 1), b2 + hstep, voffB); PG8_STAGE(PG8_SA(0, 0), a2, voffA);
            PG8_WAIT_V(8); PG8_WAIT_L(0); PG8_BAR; PG8_MMA(1, 0, At, B0); PG8_MMA(1, 1, At, B1); PG8_BAR; PG8_SCHED;
            PG8_LDB(B0, 1, 0); PG8_LDB(B1, 1, 1); PG8_SCHED; PG8_LDA(At, 1, 0); PG8_STAGE(PG8_SA(0, 1), a2 + hstep, voffA);
            PG8_WAIT_V(8); PG8_WAIT_L(0); PG8_BAR; PG8_MMA(0, 0, At, B0); PG8_MMA(0, 1, At, B1); PG8_BAR; PG8_SCHED;
            PG8_LDA(At, 1, 1); PG8_STAGE(PG8_SB(1, 0), b3, voffB); PG8_STAGE(PG8_SB(1, 1), b3 + hstep, voffB); PG8_STAGE(PG8_SA(1, 0), a3, voffA);
            PG8_WAIT_V(8); PG8_WAIT_L(0); PG8_BAR; PG8_MMA(1, 0, At, B0); PG8_MMA(1, 1, At, B1); PG8_BAR; PG8_SCHED;
            } else {
            PG8_LDB(B0, 0, 0); PG8_SCHED; PG8_LDA(At, 0, 0); PG8_STAGE(PG8_SA(1, 1), a1 + hstep, voffA);
            PG8_WAIT_L(8); PG8_BAR; PG8_WAIT_L(0); PG8_MMA(0, 0, At, B0); PG8_BAR; PG8_SCHED;
            PG8_LDB(B1, 0, 1); PG8_STAGE(PG8_SB(0, 0), b2, voffB);
            PG8_BAR; PG8_WAIT_L(0); PG8_MMA(0, 1, At, B1); PG8_BAR;
            PG8_LDA(At, 0, 1); PG8_STAGE(PG8_SA(0, 0), a2, voffA);
            PG8_BAR; PG8_WAIT_L(0); PG8_MMA(1, 0, At, B0); PG8_BAR; PG8_SCHED;
            PG8_STAGE(PG8_SB(0, 1), b2 + hstep, voffB);
            PG8_WAIT_V(6); PG8_BAR; PG8_MMA(1, 1, At, B1); PG8_BAR;
            PG8_LDB(B0, 1, 0); PG8_SCHED; PG8_LDA(At, 1, 0); PG8_STAGE(PG8_SA(0, 1), a2 + hstep, voffA);
            PG8_WAIT_L(8); PG8_BAR; PG8_WAIT_L(0); PG8_MMA(0, 0, At, B0); PG8_BAR; PG8_SCHED;
            PG8_LDB(B1, 1, 1); PG8_STAGE(PG8_SB(1, 0), b3, voffB);
            PG8_BAR; PG8_WAIT_L(0); PG8_MMA(0, 1, At, B1); PG8_BAR;
            PG8_LDA(At, 1, 1); PG8_STAGE(PG8_SA(1, 0), a3, voffA);
            PG8_BAR; PG8_WAIT_L(0); PG8_MMA(1, 0, At, B0); PG8_BAR; PG8_SCHED;
            PG8_STAGE(PG8_SB(1, 1), b3 + hstep, voffB);
            PG8_WAIT_V(6); PG8_BAR; PG8_MMA(1, 1, At, B1); PG8_BAR;
            }
        }
        if constexpr (ALIGN_EPI) { if (wr == 0) PG8_BAR; }
        if constexpr (!Epi::AFTER_DRAIN) { E(acc, cur, wr, wc, fr, fq); S.done(cur); }
        if (!has_next) break;
#pragma unroll
        for (int a = 0; a < 2; ++a)
#pragma unroll
            for (int b = 0; b < 2; ++b)
#pragma unroll
                for (int m = 0; m < 4; ++m)
#pragma unroll
                    for (int n = 0; n < 2; ++n) acc[a][b][m][n] = (f32x4){0.f, 0.f, 0.f, 0.f};
        cur = nxt; cA = nA; cB = nB; ++ui;
        if constexpr (ALIGN_EPI) { if (wr == 1) PG8_BAR; }
    }
    PG8_WAIT_V(0);
    if constexpr (!ALIGN_EPI) { if (wr == 0) PG8_BAR; }
    PG8_BAR;
    if constexpr (Epi::AFTER_DRAIN) { E.fused(acc, cur, wr, wc, fr, fq, lds, wid, lane); S.done(cur); }
#undef PG8_SA
#undef PG8_SB
#undef PG8_STAGE
#undef PG8_LDA
#undef PG8_LDB
#undef PG8_MMA
#undef PG8_WAIT_V
#undef PG8_WAIT_L
#undef PG8_BAR
#undef PG8_SCHED
}
}
#include <hip/hip_bf16.h>
#include <cmath>
namespace attn_body {
using bf16=__hip_bfloat16;
using bf16x8=__attribute__((ext_vector_type(8)))short;
using s16x4=__attribute__((ext_vector_type(4)))short;
using f32x16=__attribute__((ext_vector_type(16)))float;
using u32x4=__attribute__((ext_vector_type(4)))unsigned;
constexpr int NHEAD=16,SEQ=4096,D=64,DM=NHEAD*D;
constexpr int NW=8,QBLK=32,QB=QBLK*NW,KVBLK=64,NQB=SEQ/QB;
constexpr int ATTN_PITCH=DM, ATTN_UNIT_ROWS=QB;
__device__ __forceinline__ int crow(int r,int hi){return (r&3)+8*(r>>2)+4*hi;}
#define SBAR() __builtin_amdgcn_sched_barrier(0)
__device__ __forceinline__ void cmask(f32x16&p0,f32x16&p1,int jb,int qrel,int hi){
  const float NEG=-INFINITY; int kb=64*jb+4*hi;
  #pragma unroll
  for(int r=0;r<16;++r){int kv=kb+(r&3)+8*(r>>2); if(kv>qrel)p0[r]=NEG; if(kv+32>qrel)p1[r]=NEG;}
}

constexpr int NSLOT=3, SLOTB=8192, VSLOTB=2*SLOTB;
constexpr int LDS_K=0, LDS_V=NSLOT*SLOTB, LDS_WS=LDS_V+NSLOT*VSLOTB, LDS_OST=LDS_WS+NW*64*4, LDS_BYTES=LDS_OST+NW*4096;
constexpr float C2=0.125f*1.4426950408889634f;
__device__ __forceinline__ void glds16(const void*gsrc,unsigned lds_dst){unsigned keep;
  asm volatile("s_mov_b32 %0, m0\n\ts_mov_b32 m0, %2\n\ts_nop 0\n\tglobal_load_lds_dwordx4 %1, off\n\ts_mov_b32 m0, %0":"=&s"(keep):"v"(gsrc),"s"(lds_dst):"memory");}
__device__ __forceinline__ void glds16s(const void*sbase,unsigned voff,unsigned lds_dst){unsigned keep;
  asm volatile("s_mov_b32 %0, m0\n\ts_mov_b32 m0, %3\n\ts_nop 0\n\tglobal_load_lds_dwordx4 %1, %2\n\ts_mov_b32 m0, %0":"=&s"(keep):"v"(voff),"s"(sbase),"s"(lds_dst):"memory");}
__device__ __forceinline__ float max3f(float a,float b,float c){float r;asm("v_max3_f32 %0, %1, %2, %3":"=v"(r):"v"(a),"v"(b),"v"(c));return r;}
__device__ __forceinline__ float max2f(float a,float b){float r;asm("v_max_f32_e32 %0, %1, %2":"=v"(r):"v"(a),"v"(b));return r;}
__device__ __forceinline__ float fadd_s(float a,float b){float r;asm("v_add_f32_e32 %0, %1, %2":"=v"(r):"v"(a),"v"(b));return r;}
__device__ __forceinline__ float fsub_s(float a,float b){float r;asm("v_sub_f32_e32 %0, %1, %2":"=v"(r):"v"(a),"v"(b));return r;}
typedef float f32x2_t __attribute__((ext_vector_type(2))); typedef __bf16 bf16x2_t __attribute__((ext_vector_type(2)));
__device__ __forceinline__ unsigned cvtpk_s(float lo,float hi){f32x2_t v={lo,hi};bf16x2_t b=__builtin_convertvector(v,bf16x2_t);return __builtin_bit_cast(unsigned,b);}
#define WAIT_BAR(N) asm volatile("s_waitcnt vmcnt(" #N ") lgkmcnt(0)\n\ts_barrier":::"memory")

__device__ __forceinline__ void qkt(f32x16&p0,f32x16&p1,const char*Kslot,const bf16x8*qr,const f32x16&negm,int r32,int hi){
  const char*kb=Kslot+hi*1024+r32*16;
  #pragma unroll
  for(int d0=0;d0<4;++d0){
    const bf16x8 b0=*reinterpret_cast<const bf16x8*>(kb+d0*2048);
    const bf16x8 b1=*reinterpret_cast<const bf16x8*>(kb+d0*2048+512);
    if(d0==0){p0=__builtin_amdgcn_mfma_f32_32x32x16_bf16(b0,qr[0],negm,0,0,0);p1=__builtin_amdgcn_mfma_f32_32x32x16_bf16(b1,qr[0],negm,0,0,0);}
    else{p0=__builtin_amdgcn_mfma_f32_32x32x16_bf16(b0,qr[d0],p0,0,0,0);p1=__builtin_amdgcn_mfma_f32_32x32x16_bf16(b1,qr[d0],p1,0,0,0);}}
}
typedef __attribute__((address_space(3))) const char* lds_cptr;
typedef short v4i16_t __attribute__((ext_vector_type(4)));
__device__ __forceinline__ void kload8(bf16x8*kf,lds_cptr kp){
  kf[0]=*(const __attribute__((address_space(3))) bf16x8*)(kp);      kf[1]=*(const __attribute__((address_space(3))) bf16x8*)(kp+512);
  kf[2]=*(const __attribute__((address_space(3))) bf16x8*)(kp+2048); kf[3]=*(const __attribute__((address_space(3))) bf16x8*)(kp+2560);
  kf[4]=*(const __attribute__((address_space(3))) bf16x8*)(kp+4096); kf[5]=*(const __attribute__((address_space(3))) bf16x8*)(kp+4608);
  kf[6]=*(const __attribute__((address_space(3))) bf16x8*)(kp+6144); kf[7]=*(const __attribute__((address_space(3))) bf16x8*)(kp+6656);
}
__device__ __forceinline__ void kload2(bf16x8*kf,lds_cptr kp,int j){ kf[2*j]=*(const __attribute__((address_space(3))) bf16x8*)(kp+j*2048); kf[2*j+1]=*(const __attribute__((address_space(3))) bf16x8*)(kp+j*2048+512); }
__device__ __forceinline__ s16x4 vtr(lds_cptr p){ return __builtin_bit_cast(s16x4,__builtin_amdgcn_ds_read_tr16_b64_v4i16((__attribute__((address_space(3))) v4i16_t*)p)); }
__device__ __forceinline__ float rowmax(const f32x16&p0,const f32x16&p1){
  float a=max3f(p0[0],p0[1],p1[0]),b=max3f(p0[2],p0[3],p1[1]);a=max3f(a,p1[2],p1[3]);
  #pragma unroll
  for(int r=4;r<16;r+=4){a=max3f(a,p0[r],p0[r+1]);b=max3f(b,p0[r+2],p0[r+3]);a=max3f(a,p1[r],p1[r+1]);b=max3f(b,p1[r+2],p1[r+3]);}
  const float m=max2f(a,b);
  auto rr=__builtin_amdgcn_permlane32_swap(__float_as_uint(m),__float_as_uint(m),false,false);
  return max2f(__uint_as_float(rr[0]),__uint_as_float(rr[1]));
}
__device__ __forceinline__ void pv(f32x16*o,int vb,bf16x8 pa0,bf16x8 pa1,bf16x8 pa2,bf16x8 pa3){
  #pragma unroll
  for(int d0=0;d0<4;++d0){s16x4 lo[4],hi[4];
    #pragma unroll
    for(int ks=0;ks<4;++ks){
      asm volatile("ds_read_b64_tr_b16 %0,%1 offset:%c2":"=&v"(lo[ks]):"v"(vb),"i"(d0*4096+ks*1024):"memory");
      asm volatile("ds_read_b64_tr_b16 %0,%1 offset:%c2":"=&v"(hi[ks]):"v"(vb),"i"(d0*4096+ks*1024+512):"memory");}
    asm volatile("s_waitcnt lgkmcnt(0)":::"memory");SBAR();
    #define PK(k) (bf16x8){lo[k][0],lo[k][1],lo[k][2],lo[k][3],hi[k][0],hi[k][1],hi[k][2],hi[k][3]}
    o[d0]=__builtin_amdgcn_mfma_f32_32x32x16_bf16(pa0,PK(0),o[d0],0,0,0);
    o[d0]=__builtin_amdgcn_mfma_f32_32x32x16_bf16(pa1,PK(1),o[d0],0,0,0);
    o[d0]=__builtin_amdgcn_mfma_f32_32x32x16_bf16(pa2,PK(2),o[d0],0,0,0);
    o[d0]=__builtin_amdgcn_mfma_f32_32x32x16_bf16(pa3,PK(3),o[d0],0,0,0);
    #undef PK
  }
}

#ifndef ATTN_STORE16
#define ATTN_STORE16(p,v) (*(u32x4*)(p)=(v))
#endif
template<int THRL,bool COMB> __device__ __forceinline__ void attn_unit(bool pre,int nb,int nh,int nhv,int b,int h,int hv,int qb,const bf16*Q,const bf16*__restrict__ K,const bf16*__restrict__ V,bf16*O,bf16*YB,float lam,float oscale,const float*gsub,char*shm){
  int tid_o=threadIdx.x; asm volatile("":"+v"(tid_o)); const int tid=tid_o,lane=tid&63,r32=lane&31,hi=lane>>5; const int wid=__builtin_amdgcn_readfirstlane(tid>>6);
  const long rowbase=(long)b*SEQ; const int q0=qb*QB;
  const bf16*Qw=Q+(rowbase+q0+wid*QBLK)*DM+h*D;
  const bf16*Kh=K+rowbase*DM+h*D,*Vh=V+rowbase*DM+hv*2*D;
  const unsigned lds0=(unsigned)(uintptr_t)shm;
  float*wsf=(float*)(shm+LDS_WS)+wid*64;
  const unsigned koff=(unsigned)(lane*DM+wid*8)*2u;
  const unsigned voff=(unsigned)((16*(wid&3)+(lane>>2))*DM+(wid>>2)*32+(lane&3)*8)*2u;
  const unsigned kdst=lds0+LDS_K+wid*1024, vdst=lds0+LDS_V+wid*1024;
  #define DMA_K(t,slot) glds16s(Kh+(long)(t)*KVBLK*DM,koff,(unsigned)__builtin_amdgcn_readfirstlane(kdst+(slot)))
  #define DMA_V(t,slot) do{ glds16s(Vh+(long)(t)*KVBLK*DM,voff,(unsigned)__builtin_amdgcn_readfirstlane(vdst+2*(slot))); glds16s(Vh+64+(long)(t)*KVBLK*DM,voff,(unsigned)__builtin_amdgcn_readfirstlane(vdst+2*(slot)+8192)); }while(0)
  const char*Kbase=shm+LDS_K; bf16x8 kf[8];
  const lds_cptr shm3=(lds_cptr)shm; const lds_cptr kp0=shm3+LDS_K+hi*1024+r32*16; const lds_cptr vp0=shm3+LDS_V+((lane>>4)&1)*32+(lane&3)*8+(4*hi+((lane&15)>>2))*64;
  const int NT=(q0+QB)/KVBLK;
  if(!pre){DMA_K(0,0);DMA_V(0,0);DMA_K(1,SLOTB);}
  bf16x8 qr[4];
  #pragma unroll
  for(int d0=0;d0<4;++d0)qr[d0]=*reinterpret_cast<const bf16x8*>(&Qw[(long)r32*DM+d0*16+hi*8]);
  float mhat=0.f,l_reg=0.f;f32x16 o[4];o[0]=f32x16{};o[1]=f32x16{};o[2]=f32x16{};o[3]=f32x16{};f32x16 negm=f32x16{};asm volatile("":"+v"(negm));
  const int qrel=wid*QBLK+r32;
  #define CMASK(P0,P1,t) do{int jb_=(t)-(NT-4); if(jb_>=0)cmask(P0,P1,jb_,qrel,hi);}while(0)
  bool resc=false;
  #define START(P0,P1) do{ const float rm=rowmax(P0,P1); resc=false; \
    { const float dl=rm; mhat=fadd_s(mhat,dl); \
      _Pragma("unroll") for(int r=0;r<16;++r){P0[r]=fsub_s(P0[r],dl);P1[r]=fsub_s(P1[r],dl);} \
      _Pragma("unroll") for(int r=0;r<16;++r)negm[r]=-mhat; asm volatile("":"+v"(negm)); } \
    _Pragma("unroll") for(int r=0;r<16;++r)P0[r]=__builtin_amdgcn_exp2f(P0[r]); }while(0)
  #define RESC() do{ if(resc){ asm volatile("s_waitcnt lgkmcnt(0)":::"memory"); \
      _Pragma("unroll") for(int d_=0;d_<4;++d_) _Pragma("unroll") for(int r=0;r<16;++r)o[d_][r]*=wsf[crow(r,hi)]; } }while(0)
  f32x16 pA0,pA1,pB0,pB1;
  int sl_prev=0,sl_cur=0,sl_next=SLOTB;
  #define ROT() do{sl_prev=sl_cur;sl_cur=sl_next;sl_next=(sl_next==(NSLOT-1)*SLOTB)?0:sl_next+SLOTB;}while(0)
  DMA_K(2,2*SLOTB);
  WAIT_BAR(3);
  qkt(pA0,pA1,Kbase,qr,negm,r32,hi);asm volatile("s_nop 15\n\ts_nop 7":"+v"(pA0),"+v"(pA1));CMASK(pA0,pA1,0);
  START(pA0,pA1);
  _Pragma("unroll") for(int r=0;r<16;++r)pA1[r]=__builtin_amdgcn_exp2f(pA1[r]);
  WAIT_BAR(0);
  DMA_K(3,0);DMA_V(1,SLOTB);
  ROT();
  kload8(kf,kp0+sl_cur);
  WAIT_BAR(3);
  s16x4 vlo[8],vhi[8]; u32x4 pw0,pw1,pw2,pw3;
  #define PKW(P,B) cvtpk_s(P[B],P[B+1])
  #define PAF(k) __builtin_bit_cast(bf16x8,pw##k)
  #define VFR(i) (bf16x8){vlo[i][0],vlo[i][1],vlo[i][2],vlo[i][3],vhi[i][0],vhi[i][1],vhi[i][2],vhi[i][3]}
  #define PIN(x) asm volatile("":"+v"(x))
  #define MX3(a,b,c) __builtin_fmaxf(__builtin_fmaxf((a),(b)),(c))
  #define GAPA(MF,A0,A1,A2,A3,W0,W1,PW) do{ MF; sacc+=A0; sacc+=A1; sacc+=A2; sacc+=A3; PIN(sacc); W0; W1; PIN(PW); SBAR(); }while(0)
  #define EX(v) __builtin_amdgcn_exp2f(v)
  #define GAPB(MF,X,B) do{ MF; X[B]=EX(X[B]); X[B+1]=EX(X[B+1]); X[B+2]=EX(X[B+2]); X[B+3]=EX(X[B+3]); PIN(X); SBAR(); }while(0)
  #define GAPH(MF,X,B) do{ MF; X[B]=EX(X[B]); X[B+1]=EX(X[B+1]); PIN(X); SBAR(); }while(0)
  #define VRD(i) do{ vlo[i]=vtr(vp_+(((i)>>2)*4096+((i)&3)*1024)); vhi[i]=vtr(vp_+(((i)>>2)*4096+((i)&3)*1024+512)); }while(0)
  #define VRD2(i) do{ vlo[i]=vtr(vp_+(8192+((i)>>2)*4096+((i)&3)*1024)); vhi[i]=vtr(vp_+(8192+((i)>>2)*4096+((i)&3)*1024+512)); }while(0)
  #define KRD(G,j) do{ if(G){ kload2(kf,kp0+sl_next,j); SBAR(); } }while(0)
  #define STEP(C0,C1,P0,P1,t,GK,GV,GL) do{ SBAR(); \
    const lds_cptr vp_=vp0+2*sl_prev; \
    float sacc=(P0[0]+P0[1]); \
    GAPA(C0=__builtin_amdgcn_mfma_f32_32x32x16_bf16(kf[0],qr[0],negm,0,0,0), P0[2],P0[3],P0[4],P0[5],     pw0[0]=PKW(P0,0), pw0[1]=PKW(P0,2), pw0); \
    GAPA(C1=__builtin_amdgcn_mfma_f32_32x32x16_bf16(kf[1],qr[0],negm,0,0,0), P0[6],P0[7],P0[8],P0[9],     pw0[2]=PKW(P0,4), pw0[3]=PKW(P0,6), pw0); \
    GAPA(C0=__builtin_amdgcn_mfma_f32_32x32x16_bf16(kf[2],qr[1],C0,0,0,0),   P0[10],P0[11],P0[12],P0[13], pw1[0]=PKW(P0,8), pw1[1]=PKW(P0,10), pw1); \
    GAPA(C1=__builtin_amdgcn_mfma_f32_32x32x16_bf16(kf[3],qr[1],C1,0,0,0),   P0[14],P0[15],P1[0],P1[1],   pw1[2]=PKW(P0,12),pw1[3]=PKW(P0,14), pw1); \
    GAPA(C0=__builtin_amdgcn_mfma_f32_32x32x16_bf16(kf[4],qr[2],C0,0,0,0),   P1[2],P1[3],P1[4],P1[5],     pw2[0]=PKW(P1,0), pw2[1]=PKW(P1,2), pw2); \
    GAPA(C1=__builtin_amdgcn_mfma_f32_32x32x16_bf16(kf[5],qr[2],C1,0,0,0),   P1[6],P1[7],P1[8],P1[9],     pw2[2]=PKW(P1,4), pw2[3]=PKW(P1,6), pw2); \
    GAPA(C0=__builtin_amdgcn_mfma_f32_32x32x16_bf16(kf[6],qr[3],C0,0,0,0),   P1[10],P1[11],P1[12],P1[13], pw3[0]=PKW(P1,8), pw3[1]=PKW(P1,10), pw3); \
    GAPA(C1=__builtin_amdgcn_mfma_f32_32x32x16_bf16(kf[7],qr[3],C1,0,0,0),   P1[14],P1[15],0.f,0.f,       pw3[2]=PKW(P1,12),pw3[3]=PKW(P1,14), pw3); \
    l_reg+=sacc; \
    VRD(0);VRD(4);VRD(1);VRD(5);VRD(2);VRD(6);VRD(3);VRD(7); SBAR();   \
    if(GK){DMA_K((t)+3,sl_cur);} if(GV){DMA_V((t)+1,sl_next);} \
    CMASK(C0,C1,t); \
    { float a=MX3(C0[0],C0[1],C1[0]),b=MX3(C0[2],C0[3],C1[1]); a=MX3(a,C1[2],C1[3]); \
      _Pragma("unroll") for(int r=4;r<16;r+=4){a=MX3(a,C0[r],C0[r+1]);b=MX3(b,C0[r+2],C0[r+3]);a=MX3(a,C1[r],C1[r+1]);b=MX3(b,C1[r+2],C1[r+3]);} \
      float rm=__builtin_fmaxf(a,b); { auto rr=__builtin_amdgcn_permlane32_swap(__float_as_uint(rm),__float_as_uint(rm),false,false); rm=__builtin_fmaxf(__uint_as_float(rr[0]),__uint_as_float(rr[1])); } \
      resc=false; \
      if(__builtin_expect(__any(rm>(float)THRL),0)){ const float dl=__builtin_fmaxf(rm,0.f); mhat+=dl; \
        _Pragma("unroll") for(int r=0;r<16;++r){C0[r]-=dl;C1[r]-=dl;} \
        _Pragma("unroll") for(int r=0;r<16;++r)negm[r]=-mhat; asm volatile("":"+v"(negm)); \
        const float f=__builtin_amdgcn_exp2f(-dl); l_reg*=f; if(hi==0)wsf[r32]=f; resc=true; } } \
    SBAR(); \
    GAPH(o[0]=__builtin_amdgcn_mfma_f32_32x32x16_bf16(PAF(0),VFR(0),o[0],0,0,0), C0,0); VRD2(0); \
    GAPH(o[1]=__builtin_amdgcn_mfma_f32_32x32x16_bf16(PAF(0),VFR(4),o[1],0,0,0), C0,4); VRD2(4); \
    KRD(GL,0); GAPH(o[0]=__builtin_amdgcn_mfma_f32_32x32x16_bf16(PAF(1),VFR(1),o[0],0,0,0), C0,8); VRD2(1); \
    KRD(GL,1); GAPH(o[1]=__builtin_amdgcn_mfma_f32_32x32x16_bf16(PAF(1),VFR(5),o[1],0,0,0), C0,12); VRD2(5); \
    KRD(GL,2); GAPH(o[0]=__builtin_amdgcn_mfma_f32_32x32x16_bf16(PAF(2),VFR(2),o[0],0,0,0), C1,0); VRD2(2); \
    KRD(GL,3); GAPH(o[1]=__builtin_amdgcn_mfma_f32_32x32x16_bf16(PAF(2),VFR(6),o[1],0,0,0), C1,4); VRD2(6); \
    GAPH(o[0]=__builtin_amdgcn_mfma_f32_32x32x16_bf16(PAF(3),VFR(3),o[0],0,0,0), C1,8); VRD2(3); \
    GAPH(o[1]=__builtin_amdgcn_mfma_f32_32x32x16_bf16(PAF(3),VFR(7),o[1],0,0,0), C1,12); VRD2(7); SBAR(); \
      \
    GAPH(o[2]=__builtin_amdgcn_mfma_f32_32x32x16_bf16(PAF(0),VFR(0),o[2],0,0,0), C0,2); \
    GAPH(o[3]=__builtin_amdgcn_mfma_f32_32x32x16_bf16(PAF(0),VFR(4),o[3],0,0,0), C0,6); \
    GAPH(o[2]=__builtin_amdgcn_mfma_f32_32x32x16_bf16(PAF(1),VFR(1),o[2],0,0,0), C0,10); \
    GAPH(o[3]=__builtin_amdgcn_mfma_f32_32x32x16_bf16(PAF(1),VFR(5),o[3],0,0,0), C0,14); \
    GAPH(o[2]=__builtin_amdgcn_mfma_f32_32x32x16_bf16(PAF(2),VFR(2),o[2],0,0,0), C1,2); \
    GAPH(o[3]=__builtin_amdgcn_mfma_f32_32x32x16_bf16(PAF(2),VFR(6),o[3],0,0,0), C1,6); \
    GAPH(o[2]=__builtin_amdgcn_mfma_f32_32x32x16_bf16(PAF(3),VFR(3),o[2],0,0,0), C1,10); \
    GAPH(o[3]=__builtin_amdgcn_mfma_f32_32x32x16_bf16(PAF(3),VFR(7),o[3],0,0,0), C1,14); \
    }while(0)
  int t=1;
  #undef CMASK
  #define CMASK(P0,P1,t) do{}while(0)
  for(;t+5<NT;t+=2){
    STEP(pB0,pB1,pA0,pA1,t,true,true,true);     WAIT_BAR(3); RESC(); ROT();
    STEP(pA0,pA1,pB0,pB1,t+1,true,true,true);   WAIT_BAR(3); RESC(); ROT();
  }
  #undef CMASK
  #define CMASK(P0,P1,t) do{int jb_=(t)-(NT-4); if(jb_>=0)cmask(P0,P1,jb_,qrel,hi);}while(0)
  #define ENDW(tt) do{ if((tt)+3<NT){WAIT_BAR(3);} else if((tt)+2<NT){WAIT_BAR(2);} else {WAIT_BAR(0);} }while(0)
  for(;t+1<NT;t+=2){
    STEP(pB0,pB1,pA0,pA1,t,(t+3<NT),(t+1<NT),(t+1<NT));       ENDW(t);   RESC(); ROT();
    STEP(pA0,pA1,pB0,pB1,t+1,(t+4<NT),(t+2<NT),(t+2<NT));     ENDW(t+1); RESC(); ROT();
  }
  STEP(pB0,pB1,pA0,pA1,NT-1,false,false,false); RESC();
  { float sacc=pB0[0]+pB0[1]; _Pragma("unroll") for(int r=2;r<16;++r)sacc+=pB0[r]; _Pragma("unroll") for(int r=0;r<16;++r)sacc+=pB1[r]; l_reg+=sacc;
    pw0=(u32x4){PKW(pB0,0),PKW(pB0,2),PKW(pB0,4),PKW(pB0,6)};pw1=(u32x4){PKW(pB0,8),PKW(pB0,10),PKW(pB0,12),PKW(pB0,14)};pw2=(u32x4){PKW(pB1,0),PKW(pB1,2),PKW(pB1,4),PKW(pB1,6)};pw3=(u32x4){PKW(pB1,8),PKW(pB1,10),PKW(pB1,12),PKW(pB1,14)};
    SBAR(); const int vb0=(int)(lds0+LDS_V)+((lane>>4)&1)*32+(lane&3)*8+(4*hi+((lane&15)>>2))*64;     pv(o,vb0+2*sl_cur,PAF(0),PAF(1),PAF(2),PAF(3)); }
  #undef PKW
  #undef PAF
  #undef VFR
  #undef PIN
  #undef MX3
  #undef GAPA
  #undef GAPB
  #undef GAPH
  #undef EX
  #undef VRD
  #undef VRD2
  #undef KRD
  #undef STEP
  #undef ENDW
  asm volatile("s_waitcnt lgkmcnt(0)\n\ts_barrier":::"memory");
  if(nb>=0){ const bf16*nKh=K+(long)nb*SEQ*DM+nh*D,*nVh=V+(long)nb*SEQ*DM+nhv*2*D;
    glds16s(nKh,koff,(unsigned)__builtin_amdgcn_readfirstlane(kdst)); glds16s(nVh,voff,(unsigned)__builtin_amdgcn_readfirstlane(vdst)); glds16s(nVh+64,voff,(unsigned)__builtin_amdgcn_readfirstlane(vdst+8192)); glds16s(nKh+(long)KVBLK*DM,koff,(unsigned)__builtin_amdgcn_readfirstlane(kdst+SLOTB)); }
  {auto rr=__builtin_amdgcn_permlane32_swap(__float_as_uint(l_reg),__float_as_uint(l_reg),false,false);l_reg=__uint_as_float(rr[0])+__uint_as_float(rr[1]);}
  if(hi==0)wsf[32+r32]=l_reg;asm volatile("s_waitcnt lgkmcnt(0)":::"memory");
  float rli[16];
  #pragma unroll
  for(int r=0;r<16;++r)rli[r]=__builtin_amdgcn_rcpf(wsf[32+crow(r,hi)]);
  bf16*Ow=O+(rowbase+q0+wid*QBLK)*DM+hv*2*D;
  { bf16*stg=(bf16*)(shm+LDS_OST)+wid*2048;
    if constexpr(!COMB){
    #pragma unroll
    for(int hh=0;hh<2;++hh){
      #pragma unroll
      for(int r=0;r<16;++r){const int orow=crow(r,hi);
        #pragma unroll
        for(int d0=0;d0<2;++d0)stg[orow*64+d0*32+r32]=__float2bfloat16(o[2*hh+d0][r]*rli[r]);}
      asm volatile("s_waitcnt lgkmcnt(0)":::"memory");
      #pragma unroll
      for(int i=0;i<4;++i){const int row=i*8+(lane>>3),ch=lane&7; const u32x4 v=*(const u32x4*)(stg+row*64+ch*8); ATTN_STORE16(Ow+(long)row*DM+hh*64+ch*8,v);}
      asm volatile("s_waitcnt lgkmcnt(0)":::"memory"); }
    } else {
    float dv[2][4][8];
    #pragma unroll
    for(int hh=0;hh<2;++hh){
      #pragma unroll
      for(int r=0;r<16;++r){const int orow=crow(r,hi);
        #pragma unroll
        for(int d0=0;d0<2;++d0)stg[orow*64+d0*32+r32]=__float2bfloat16(o[2*hh+d0][r]*rli[r]);}
      asm volatile("s_waitcnt lgkmcnt(0)":::"memory");
      #pragma unroll
      for(int i=0;i<4;++i){const int row=i*8+(lane>>3),ch=lane&7; const u32x4 v2=*(const u32x4*)(stg+row*64+ch*8); const u32x4 v1=*(const u32x4*)(Ow+(long)row*DM+hh*64+ch*8);
        #define BL(w) __builtin_bit_cast(float,(w)<<16)
        #define BH(w) __builtin_bit_cast(float,(w)&0xffff0000u)
        dv[hh][i][0]=BL(v1[0])-lam*BL(v2[0]); dv[hh][i][1]=BH(v1[0])-lam*BH(v2[0]); dv[hh][i][2]=BL(v1[1])-lam*BL(v2[1]); dv[hh][i][3]=BH(v1[1])-lam*BH(v2[1]);
        dv[hh][i][4]=BL(v1[2])-lam*BL(v2[2]); dv[hh][i][5]=BH(v1[2])-lam*BH(v2[2]); dv[hh][i][6]=BL(v1[3])-lam*BL(v2[3]); dv[hh][i][7]=BH(v1[3])-lam*BH(v2[3]);
        #undef BL
        #undef BH
      }
      asm volatile("s_waitcnt lgkmcnt(0)":::"memory"); }
    bf16*Yw=YB+(rowbase+q0+wid*QBLK)*DM+hv*2*D;
    #pragma unroll
    for(int i=0;i<4;++i){const int row=i*8+(lane>>3),ch=lane&7; float ss=0.f;
      #pragma unroll
      for(int hh=0;hh<2;++hh){
        #pragma unroll
        for(int j=0;j<8;++j)ss+=dv[hh][i][j]*dv[hh][i][j];}
      ss+=__builtin_bit_cast(float,__builtin_amdgcn_ds_bpermute((lane^1)<<2,__builtin_bit_cast(int,ss)));
      ss+=__builtin_bit_cast(float,__builtin_amdgcn_ds_bpermute((lane^2)<<2,__builtin_bit_cast(int,ss)));
      ss+=__builtin_bit_cast(float,__builtin_amdgcn_ds_bpermute((lane^4)<<2,__builtin_bit_cast(int,ss)));
      const float rs=oscale/sqrtf(ss*(1.f/128.f)+1e-6f);
      #pragma unroll
      for(int hh=0;hh<2;++hh){const float*gp=gsub+hh*64+ch*8; float y[8];
        #pragma unroll
        for(int j=0;j<8;++j)y[j]=dv[hh][i][j]*rs*gp[j];
        u32x4 w; w[0]=cvtpk_s(y[0],y[1]); w[1]=cvtpk_s(y[2],y[3]); w[2]=cvtpk_s(y[4],y[5]); w[3]=cvtpk_s(y[6],y[7]);
        ATTN_STORE16(Yw+(long)row*DM+hh*64+ch*8,w);} }
    }
  }
  asm volatile("s_waitcnt lgkmcnt(0)\n\ts_barrier":::"memory");
  #undef DMA_K
  #undef DMA_V
  #undef CMASK
  #undef START
  #undef RESC
  #undef ROT
}
constexpr int ATTN_LDS_BYTES=LDS_BYTES;
#undef SBAR
#undef WAIT_BAR
}
#define LAS __attribute__((address_space(3)))
typedef unsigned short bf16;
typedef unsigned v4u __attribute__((ext_vector_type(4)));
typedef unsigned v2u __attribute__((ext_vector_type(2)));
typedef float f32x4 __attribute__((ext_vector_type(4)));
typedef short bf16x8 __attribute__((ext_vector_type(8)));
#define LDS_WAIT() asm volatile("s_waitcnt lgkmcnt(0)" ::: "memory")

constexpr int NWAVES = 8, NTHREADS = 512;
constexpr int DM = 1024, BATCH = 16, SEQ = 4096, DEPTH = 4, M = BATCH * SEQ, MH = M / 2, NIN = 7168, DFF = 2816, NUP = 2 * DFF, PLE = 256;
constexpr float EPS = 1e-6f;
constexpr size_t MiB = 1u << 20;
constexpr size_t WS_W = 2 * MiB, W_LAYER = 40 * MiB;
constexpr size_t WO_IN = 0, WO_UP = 14 * MiB, WO_DOWN = 25 * MiB, WO_PA = 31 * MiB, WO_PB = 33 * MiB, WO_O = 35 * MiB, WO_PG = 37 * MiB, WO_PLE = 39 * MiB, WO_S = 39 * MiB + 512 * 1024;
constexpr size_t WS_H = 162 * MiB;
constexpr size_t WS_Z = 290 * MiB, ZS = (size_t)MH * DM;
constexpr size_t WS_O1 = 738 * MiB, WS_O2 = 802 * MiB;
constexpr size_t WS_ACT = 290 * MiB, WS_XBB = 642 * MiB, WS_EDGE = 802 * MiB, WS_E = 290 * MiB;
constexpr size_t WS_SS = 866 * MiB, SSS = (size_t)M * 16, WS_PBF = 920 * MiB;
constexpr size_t WS_VST = 952 * MiB;
constexpr size_t WS_END = 956 * MiB;
constexpr int LDS_BYTES = 147456, XB_OFF = 131072 + 1024;

__device__ __forceinline__ unsigned f2bf(float f) { unsigned u = __builtin_bit_cast(unsigned, f); return (u + 0x7fffu + ((u >> 16) & 1u)) >> 16; }
__device__ __forceinline__ unsigned pk2(float lo, float hi) { return f2bf(lo) | (f2bf(hi) << 16); }
__device__ __forceinline__ unsigned pkh2(float lo, float hi) { return pg8::cvt_pk_f16(lo, hi); }
__device__ __forceinline__ float blo(unsigned w) { return __builtin_bit_cast(float, w << 16); }
__device__ __forceinline__ float bhi(unsigned w) { return __builtin_bit_cast(float, w & 0xffff0000u); }
__device__ __forceinline__ float bperm(float v, int srclane) { return __builtin_bit_cast(float, __builtin_amdgcn_ds_bpermute(srclane << 2, __builtin_bit_cast(int, v))); }
__device__ __forceinline__ float wave_sum(float v, int lane) {
#pragma unroll
    for (int o = 1; o < 64; o <<= 1) v += bperm(v, lane ^ o);
    return v;
}
__device__ __forceinline__ int up_row_map(int n) { return n < DFF ? (n >> 7) * 256 + (n & 127) : ((n - DFF) >> 7) * 256 + 128 + ((n - DFF) & 127); }
template <bool UPMAP, bool F16OUT = false> __device__ __forceinline__ void transpose_item(const float* W, int K, int N, bf16* WT, LAS float* scr, int item, int lane, const float* gk = nullptr) {
    const int nblk = N / 32, kb = item / nblk, nb = item % nblk, k0 = 64 * kb, n0 = 32 * nb;
#pragma unroll
    for (int i = 0; i < 8; ++i) { const int kk = 8 * i + (lane >> 3), c4 = (lane & 7) * 4;
        f32x4 w = *(const f32x4*)(W + (size_t)(k0 + kk) * N + n0 + c4); if (gk) w = w * gk[k0 + kk];
        scr[kk * 33 + c4] = w[0]; scr[kk * 33 + c4 + 1] = w[1]; scr[kk * 33 + c4 + 2] = w[2]; scr[kk * 33 + c4 + 3] = w[3]; }
    LDS_WAIT(); asm volatile("" ::: "memory");
    const int c = lane & 7;
#pragma unroll
    for (int j = 0; j < 4; ++j) { const int n = (lane >> 3) + 8 * j; const LAS float* s = scr + (8 * c) * 33 + n;
        v4u o; if (F16OUT) {
#define W8(v) __builtin_bit_cast(float, f2bf(v) << 16)
            o.x = pkh2(W8(s[0 * 33]), W8(s[1 * 33])); o.y = pkh2(W8(s[2 * 33]), W8(s[3 * 33])); o.z = pkh2(W8(s[4 * 33]), W8(s[5 * 33])); o.w = pkh2(W8(s[6 * 33]), W8(s[7 * 33]));
#undef W8
        }
        else { o.x = pk2(s[0 * 33], s[1 * 33]); o.y = pk2(s[2 * 33], s[3 * 33]); o.z = pk2(s[4 * 33], s[5 * 33]); o.w = pk2(s[6 * 33], s[7 * 33]); }
        const int dr = UPMAP ? up_row_map(n0 + n) : (n0 + n);
        *(v4u*)(WT + (size_t)dr * K + k0 + 8 * c) = o; }
    LDS_WAIT(); asm volatile("" ::: "memory");
}
template <bool OUTF32> __device__ __forceinline__ void rms_row(const float* xrow, const float* g, void* orow, int lane) {
    const f32x4* xr = (const f32x4*)xrow + lane;
    f32x4 v[4]; float s = 0.f;
#pragma unroll
    for (int j = 0; j < 4; ++j) { v[j] = xr[64 * j]; s += (v[j].x * v[j].x + v[j].y * v[j].y) + (v[j].z * v[j].z + v[j].w * v[j].w); }
    const float rstd = 1.0f / sqrtf(wave_sum(s, lane) * (1.f / DM) + EPS);
#pragma unroll
    for (int j = 0; j < 4; ++j) { const f32x4 gg = ((const f32x4*)g)[lane + 64 * j]; const f32x4 o = v[j] * rstd * gg;
        if (OUTF32) ((f32x4*)orow)[lane + 64 * j] = o;
        else ((unsigned long long*)orow)[lane + 64 * j] = (unsigned long long)pk2(o.x, o.y) | ((unsigned long long)pk2(o.z, o.w) << 32); }
}
__device__ __forceinline__ void sgu_unit(LAS unsigned char* lds, bf16* U, bf16* UO, const bf16* V, const float* VST, const bf16* Wsb, const float* bs, const float* lng, const float* lnb, size_t row0, int tid, int lane, int wave) {
    LAS float* st = (LAS float*)lds;
    LAS unsigned char* vt0 = lds + 1024;
    constexpr int VTB = 128 * 272;
    { const int r = tid >> 2, q = tid & 3; const f32x4* vp = (const f32x4*)(VST + (row0 + r) * 32 + q * 8);
      const f32x4 a = vp[0], c = vp[1];
      float sm = (a[0] + a[2]) + (c[0] + c[2]), sq = (a[1] + a[3]) + (c[1] + c[3]);
      sm += bperm(sm, lane ^ 1); sq += bperm(sq, lane ^ 1); sm += bperm(sm, lane ^ 2); sq += bperm(sq, lane ^ 2);
      const float mean = sm * (1.f / DM); float var = sq * (1.f / DM) - mean * mean; var = var > 0.f ? var : 0.f;
      if (q == 0) { st[2 * r] = mean; st[2 * r + 1] = 1.0f / sqrtf(var + EPS); } }
    __syncthreads();
    const int cg8 = tid & 15, rp = tid >> 4, fr = lane & 15, fq = lane >> 4;
    const int ksmax = (wave * 16 + 15) >> 5;
    const int t = 16 * wave + fr;
    float mu[4], rsd[4];
#pragma unroll
    for (int rr = 0; rr < 4; ++rr) { mu[rr] = st[2 * (4 * rp + rr)]; rsd[rr] = st[2 * (4 * rp + rr) + 1]; }
    v4u vraw[4]; bf16x8 bw[4]; v2u uraw[8]; f32x4 gm[2], bt[2]; float bias;
#define SGU_LOAD(g) do { \
        _Pragma("unroll") for (int rr = 0; rr < 4; ++rr) vraw[rr] = *(const v4u*)(V + (row0 + 4 * rp + rr) * DM + (g) * 128 + 8 * cg8); \
        gm[0] = *(const f32x4*)(lng + (g) * 128 + 8 * cg8); gm[1] = *(const f32x4*)(lng + (g) * 128 + 8 * cg8 + 4); bt[0] = *(const f32x4*)(lnb + (g) * 128 + 8 * cg8); bt[1] = *(const f32x4*)(lnb + (g) * 128 + 8 * cg8 + 4); \
        _Pragma("unroll") for (int ks = 0; ks < 4; ++ks) bw[ks] = *(const bf16x8*)(Wsb + (size_t)(g) * 16384 + (16 * wave + fr) * 128 + fq * 8 + ks * 32); \
        _Pragma("unroll") for (int cb = 0; cb < 8; ++cb) uraw[cb] = *(const v2u*)(U + (row0 + t) * DM + (g) * 128 + 16 * cb + 4 * fq); \
        bias = bs[(g) * 128 + t]; } while (0)
    SGU_LOAD(0);
#pragma unroll 1
    for (int g = 0; g < 8; ++g) {
        LAS unsigned char* vt = vt0 + (g & 1) * VTB;
        { float nv[4][8];
#pragma unroll
          for (int rr = 0; rr < 4; ++rr) { const v4u raw = vraw[rr]; const float mean = mu[rr], rstd = rsd[rr];
              nv[rr][0] = (blo(raw.x) - mean) * rstd * gm[0][0] + bt[0][0]; nv[rr][1] = (bhi(raw.x) - mean) * rstd * gm[0][1] + bt[0][1];
              nv[rr][2] = (blo(raw.y) - mean) * rstd * gm[0][2] + bt[0][2]; nv[rr][3] = (bhi(raw.y) - mean) * rstd * gm[0][3] + bt[0][3];
              nv[rr][4] = (blo(raw.z) - mean) * rstd * gm[1][0] + bt[1][0]; nv[rr][5] = (bhi(raw.z) - mean) * rstd * gm[1][1] + bt[1][1];
              nv[rr][6] = (blo(raw.w) - mean) * rstd * gm[1][2] + bt[1][2]; nv[rr][7] = (bhi(raw.w) - mean) * rstd * gm[1][3] + bt[1][3]; }
#pragma unroll
          for (int j = 0; j < 8; ++j) { v2u w; w.x = pk2(nv[0][j], nv[1][j]); w.y = pk2(nv[2][j], nv[3][j]); *(LAS v2u*)(vt + (8 * cg8 + j) * 272 + rp * 8) = w; } }
        bf16x8 bwc[4]; v2u uc[8]; const float biasc = bias;
#pragma unroll
        for (int ks = 0; ks < 4; ++ks) bwc[ks] = bw[ks];
#pragma unroll
        for (int cb = 0; cb < 8; ++cb) uc[cb] = uraw[cb];
        __syncthreads();
        if (g < 7) SGU_LOAD(g + 1);
        f32x4 acc[8];
#pragma unroll
        for (int cb = 0; cb < 8; ++cb) acc[cb] = (f32x4){0.f, 0.f, 0.f, 0.f};
#pragma unroll
        for (int ks = 0; ks < 4; ++ks) if (ks <= ksmax) {
#pragma unroll
            for (int cb = 0; cb < 8; ++cb) { const bf16x8 av = *(const LAS bf16x8*)(vt + (16 * cb + fr) * 272 + (ks * 32 + fq * 8) * 2);
                acc[cb] = __builtin_amdgcn_mfma_f32_16x16x32_bf16(av, bwc[ks], acc[cb], 0, 0, 0); } }
#pragma unroll
        for (int cb = 0; cb < 8; ++cb) { bf16* up = UO + (row0 + t) * DM + g * 128 + 16 * cb + 4 * fq; const v2u uu = uc[cb];
            v2u w; w.x = pk2(blo(uu.x) * (acc[cb][0] + biasc), bhi(uu.x) * (acc[cb][1] + biasc)); w.y = pk2(blo(uu.y) * (acc[cb][2] + biasc), bhi(uu.y) * (acc[cb][3] + biasc));
            *(v2u*)up = w; }
    }
#undef SGU_LOAD
    __syncthreads();
}

struct Args { const float* in[27]; float* out; unsigned char* ws; };

#define PH() \
    const Args* ap; { auto kp_ = __builtin_amdgcn_kernarg_segment_ptr(); asm volatile("" : "+s"(kp_)); ap = (const Args*)kp_; } \
    int tid_o = threadIdx.x, bx_o = blockIdx.x, G_o = gridDim.x; asm volatile("" : "+v"(tid_o)); asm volatile("" : "+s"(bx_o), "+s"(G_o)); \
    const int tid = tid_o, bx = bx_o, G = G_o, lane = tid & 63, wave = __builtin_amdgcn_readfirstlane(tid >> 6); \
    const int gw = bx * NWAVES + wave, NGW = G * NWAVES; const size_t gt = (size_t)bx * NTHREADS + tid, NGT = (size_t)G * NTHREADS; \
    unsigned char* const ws = ap->ws; float* const X = ap->out; bf16* const H = (bf16*)(ws + WS_H); bf16* const Z = (bf16*)(ws + WS_Z); \
    bf16 *const ZU = Z, *const ZV = Z + ZS, *const ZQ = Z + 2 * ZS, *const ZK = Z + 3 * ZS, *const ZVA = Z + 4 * ZS, *const ZGA = Z + 5 * ZS, *const ZGB = Z + 6 * ZS; \
    bf16 *const O1 = (bf16*)(ws + WS_O1), *const O2 = (bf16*)(ws + WS_O2), *const ACT = (bf16*)(ws + WS_ACT), *const EB = (bf16*)(ws + WS_E), *const PBF = (bf16*)(ws + WS_PBF); \
    float* const EDGE = (float*)(ws + WS_EDGE); unsigned char* const wl = ws + WS_W + (size_t)l * W_LAYER; bf16* const XBB = (bf16*)(ws + WS_XBB); float* const SS = (float*)(ws + WS_SS); (void)XBB; (void)SS; \
    (void)lane; (void)gw; (void)NGW; (void)gt; (void)NGT; (void)X; (void)H; (void)ZU; (void)ZV; (void)ZQ; (void)ZK; (void)ZVA; (void)ZGA; (void)ZGB; (void)O1; (void)O2; (void)ACT; (void)EB; (void)PBF; (void)EDGE; (void)wl

#define RLX_AGENT __ATOMIC_RELAXED, __HIP_MEMORY_SCOPE_AGENT
#define XB_TMO      128
#define XB_XCNT(j)  (256  + 64 * (j))
#define XB_XSUB(j)  (1280 + 64 * (j))
#define XB_XGEN(j)  (2304 + 64 * (j))
#define XB_TOP      3328
#define XB_TOPGEN   3392
#define XCD_BAR_WORDS 3456
#define XB_SPIN_CAP (1u << 18)

__device__ __forceinline__ unsigned xb_ld(unsigned* p)              { return __hip_atomic_load(p, __ATOMIC_RELAXED, __HIP_MEMORY_SCOPE_AGENT); }
__device__ __forceinline__ unsigned xb_add(unsigned* p, unsigned v) { return __hip_atomic_fetch_add(p, v, __ATOMIC_RELAXED, __HIP_MEMORY_SCOPE_AGENT); }
__device__ __forceinline__ unsigned xb_xcc_id() { return (unsigned)__builtin_amdgcn_s_getreg((3 << 11) | 20) & 0xFu; }
#define XB_SPIN(cond, bar) do { unsigned _sp = 0; while (cond) { __builtin_amdgcn_s_sleep(1); \
    if ((++_sp & 255u) == 0u) { if (xb_ld(&(bar)[XB_TMO])) break; if (_sp > XB_SPIN_CAP) { atomicAdd(&(bar)[XB_TMO], 1u); break; } } } } while (0)

__device__ __forceinline__ void xcd_barrier_complete(unsigned* bar, unsigned x, unsigned& nloc, unsigned& nx) {
    const unsigned G = gridDim.x * gridDim.y * gridDim.z;
    unsigned sum, cnt, mine, sp = 0u;
    for (;;) {
        sum = 0u; cnt = 0u; mine = 0u;
#pragma unroll
        for (unsigned j = 0; j < 16; ++j) { const unsigned c = xb_ld(&bar[XB_XCNT(j)]); sum += c; cnt += (c > 0u) ? 1u : 0u; mine = (j == x) ? c : mine; }
        if (sum == G) break;
        __builtin_amdgcn_s_sleep(1);
        if ((++sp & 255u) == 0u) { if (xb_ld(&bar[XB_TMO])) break; if (sp > XB_SPIN_CAP) { atomicAdd(&bar[XB_TMO], 1u); break; } }
    }
    nloc = mine > 0u ? mine : 1u; nx = cnt > 0u ? cnt : 1u;
}

__device__ __forceinline__ void xcd_barrier(unsigned* const bar_, volatile LAS unsigned* const st_) {
    struct { unsigned* bar; unsigned x; volatile LAS unsigned* st; } b; b.bar = bar_; b.x = xb_xcc_id(); b.st = st_;
    asm volatile("s_waitcnt vmcnt(0)" ::: "memory");
    __syncthreads();
    if (threadIdx.x == 0) {
        unsigned* bar = b.bar;
        __builtin_amdgcn_s_waitcnt(0);
        unsigned nloc = b.st[0], nx = b.st[1];
        if (nloc == 0u) { xcd_barrier_complete(bar, b.x, nloc, nx); b.st[0] = nloc; b.st[1] = nx; }
        const unsigned old = xb_add(&bar[XB_XSUB(b.x)], 1u);
        const unsigned gen = old / nloc;
        if (old + 1u == (gen + 1u) * nloc) {
            __builtin_amdgcn_fence(__ATOMIC_RELEASE, "agent");
            asm volatile("s_waitcnt vmcnt(0)" ::: "memory");
            const unsigned og = xb_add(&bar[XB_TOP], 1u);
            const unsigned tg = og / nx;
            if (og + 1u == (tg + 1u) * nx) xb_add(&bar[XB_TOPGEN], 1u);
            else XB_SPIN(xb_ld(&bar[XB_TOPGEN]) == tg, bar);
            __builtin_amdgcn_fence(__ATOMIC_ACQUIRE, "agent");
            xb_add(&bar[XB_XGEN(b.x)], 1u);
            asm volatile("s_waitcnt vmcnt(0)" ::: "memory");
        } else {
            XB_SPIN(xb_ld(&bar[XB_XGEN(b.x)]) == gen, bar);
            __builtin_amdgcn_fence(__ATOMIC_ACQUIRE, "agent");
            asm volatile("s_waitcnt vmcnt(0)" ::: "memory");
        }
    }
    __syncthreads();
}

__device__ __forceinline__ void ctr_grid_sync(unsigned* ctr, unsigned target) {
    asm volatile("s_waitcnt vmcnt(0) lgkmcnt(0)" ::: "memory");
    __syncthreads();
    if (threadIdx.x == 0) {
        __builtin_amdgcn_fence(__ATOMIC_RELEASE, "agent");
        asm volatile("s_waitcnt vmcnt(0)" ::: "memory");
        __hip_atomic_fetch_add(ctr, 1u, __ATOMIC_RELAXED, __HIP_MEMORY_SCOPE_AGENT);
        while (__hip_atomic_load(ctr, __ATOMIC_RELAXED, __HIP_MEMORY_SCOPE_AGENT) < target) __builtin_amdgcn_s_sleep(2);
    }
    __syncthreads();
    __builtin_amdgcn_fence(__ATOMIC_ACQUIRE, "agent");
    asm volatile("s_waitcnt vmcnt(0)" ::: "memory");
}
#define GRID_SYNC1() do { const Args* ap_s; { auto kp_ = __builtin_amdgcn_kernarg_segment_ptr(); asm volatile("" : "+s"(kp_)); ap_s = (const Args*)kp_; } xcd_barrier((unsigned*)(ap_s->ws + 4096), (volatile LAS unsigned*)(ldsl + LDS_BYTES - 16)); } while (0)
#ifndef DBG_REP_SYNC
#define DBG_REP_SYNC 0
#endif
#define GRID_SYNC() do { GRID_SYNC1(); if (DBG_REP_SYNC) GRID_SYNC1(); } while (0)
#ifndef DBG_REP_ATTN
#define DBG_REP_ATTN 0
#endif
#ifndef DBG_REP_IN
#define DBG_REP_IN 0
#endif
#ifndef DBG_REP_UP
#define DBG_REP_UP 0
#endif
#ifndef DBG_REP_PRO
#define DBG_REP_PRO 0
#endif
#ifndef DBG_REP_COMB
#define DBG_REP_COMB 0
#endif
#ifndef DBG_REP_P4
#define DBG_REP_P4 0
#endif
#ifndef DBG_REP_RES
#define DBG_REP_RES 0
#endif
#ifndef DBG_REP_SGU
#define DBG_REP_SGU 0
#endif
#ifndef DBG_REP_INNULL
#define DBG_REP_INNULL 0
#endif
#ifndef DBG_TIME
#define DBG_TIME 0
#endif
#ifndef SELA
#define SELA 0x4
#endif
#ifndef SELB
#define SELB 0x2
#endif
#define TSTAMP(id) do { if (DBG_TIME && blockIdx.x == 0 && threadIdx.x == 0) { const Args* ap_t; { auto kp_ = __builtin_amdgcn_kernarg_segment_ptr(); asm volatile("" : "+s"(kp_)); ap_t = (const Args*)kp_; } \
    unsigned long long* tb = (unsigned long long*)(ap_t->ws + 64); const unsigned long long t_ = __builtin_amdgcn_s_memrealtime(); tb[1 + (id)] += t_ - tb[0]; tb[0] = t_; } } while (0)
__global__ void __launch_bounds__(NTHREADS, 2) fwd_kernel(Args a_unused) {
    extern __shared__ __attribute__((aligned(16))) unsigned char lds[];
    cg::grid_group grid = cg::this_grid();
    LAS unsigned char* ldsl = (LAS unsigned char*)lds;
    if (threadIdx.x == 0) { ((volatile LAS unsigned*)(ldsl + LDS_BYTES - 16))[0] = 0u; ((volatile LAS unsigned*)(ldsl + LDS_BYTES - 16))[1] = 0u;
        const Args* ap_s; { auto kp_ = __builtin_amdgcn_kernarg_segment_ptr(); asm volatile("" : "+s"(kp_)); ap_s = (const Args*)kp_; } (void)xb_add(&((unsigned*)(ap_s->ws + 4096))[XB_XCNT(xb_xcc_id())], 1u); }
    __syncthreads();
    if (DBG_TIME && blockIdx.x == 0 && threadIdx.x == 0) { const Args* ap_t; { auto kp_ = __builtin_amdgcn_kernarg_segment_ptr(); asm volatile("" : "+s"(kp_)); ap_t = (const Args*)kp_; } ((unsigned long long*)(ap_t->ws + 64))[0] = __builtin_amdgcn_s_memrealtime(); }
    grid.sync();

    for (int rep_ = 0; rep_ < (DBG_REP_PRO ? 2 : 1); ++rep_)
    {
        const int l = 0; PH();
        LAS float* scr = (LAS float*)(ldsl + wave * 16384);
        constexpr int I_IN = (DM / 64) * (NIN / 32), I_SQ = (DM / 64) * (DM / 32), I_UP = (DM / 64) * (NUP / 32), I_DN = (DFF / 64) * (DM / 32), I_PLE = (PLE / 64) * (DM / 32);
        constexpr int I_LAYER = I_IN + 4 * I_SQ + I_UP + I_DN + I_PLE;
        for (int it = gw; it < DEPTH * I_LAYER; it += NGW) {
            const int ll = it / I_LAYER; int r = it % I_LAYER; unsigned char* wll = ws + WS_W + (size_t)ll * W_LAYER;
            if (r < I_IN) { transpose_item<false, true>(ap->in[3] + (size_t)ll * DM * NIN, DM, NIN, (bf16*)(wll + WO_IN), scr, r, lane, ap->in[2] + (size_t)ll * DM); continue; } r -= I_IN;
            if (r < I_SQ) { transpose_item<false>(ap->in[14] + (size_t)ll * DM * DM, DM, DM, (bf16*)(wll + WO_PA), scr, r, lane); continue; } r -= I_SQ;
            if (r < I_SQ) { transpose_item<false>(ap->in[15] + (size_t)ll * DM * DM, DM, DM, (bf16*)(wll + WO_PB), scr, r, lane); continue; } r -= I_SQ;
            if (r < I_SQ) { transpose_item<false>(ap->in[16] + (size_t)ll * DM * DM, DM, DM, (bf16*)(wll + WO_O), scr, r, lane); continue; } r -= I_SQ;
            if (r < I_SQ) { transpose_item<false, true>(ap->in[23] + (size_t)ll * DM * DM, DM, DM, (bf16*)(wll + WO_PG), scr, r, lane, ap->in[22] + (size_t)ll * DM); continue; } r -= I_SQ;
            if (r < I_UP) { transpose_item<true, true>(ap->in[18] + (size_t)ll * DM * NUP, DM, NUP, (bf16*)(wll + WO_UP), scr, r, lane, ap->in[17] + (size_t)ll * DM); continue; } r -= I_UP;
            if (r < I_DN) { transpose_item<false>(ap->in[21] + (size_t)ll * DFF * DM, DFF, DM, (bf16*)(wll + WO_DOWN), scr, r, lane); continue; } r -= I_DN;
            transpose_item<false>(ap->in[25] + (size_t)ll * PLE * DM, PLE, DM, (bf16*)(wll + WO_PLE), scr, r, lane);
        }
        { const float* wsrc = ap->in[7];
          for (size_t i = gt; i < (size_t)DEPTH * 8 * 128 * 128; i += NGT) { const int ll = (int)(i >> 17), rem = (int)(i & 131071), t = (rem >> 7) & 127, sc = rem & 127;
              const float w = wsrc[i]; ((bf16*)(ws + WS_W + (size_t)ll * W_LAYER + WO_S))[rem] = (bf16)f2bf(sc <= t ? w : 0.f); } }
        { const float* xin = ap->in[0];
          for (int m = gw; m < M; m += NGW) { const f32x4* xr = (const f32x4*)(xin + (size_t)m * DM) + lane; float sq = 0.f;
#pragma unroll
              for (int j = 0; j < 4; ++j) { const f32x4 v = xr[64 * j]; sq += (v.x * v.x + v.y * v.y) + (v.z * v.z + v.w * v.w);
                  ((unsigned long long*)(H + (size_t)m * DM))[lane + 64 * j] = (unsigned long long)pkh2(v.x, v.y) | ((unsigned long long)pkh2(v.z, v.w) << 32); }
              sq = wave_sum(sq, lane); if (lane < 16) SS[(size_t)m * 16 + lane] = lane == 0 ? sq : 0.f; } }
    }
    GRID_SYNC(); TSTAMP(0);

#ifndef DBG_STOP
#define DBG_STOP 0
#endif
#define DBG_DUMP_BF16(buf) do { PH(); for (size_t i = gt; i < (size_t)M * DM; i += NGT) X[i] = blo((unsigned)(buf)[i % ((size_t)MH * DM)]); return; } while (0)
#define DBG_DUMP3(b0, b1, b2) do { PH(); for (size_t i = gt; i < (size_t)M * DM; i += NGT) { const size_t k = i % ((size_t)MH * DM); X[i] = blo((unsigned)(b0)[k]) + blo((unsigned)(b1)[k]) + blo((unsigned)(b2)[k]); } return; } while (0)
#define DBG_ZERO_UPPER() do { PH(); for (size_t i = gt; i < (size_t)MH * DM; i += NGT) X[(size_t)MH * DM + i] = 0.f; return; } while (0)
#pragma unroll 1
    for (int l = 0; l < DEPTH; ++l) {
#pragma unroll 1
        for (int hf = 0; hf < 2; ++hf) {
            if (DBG_REP_INNULL) { PH(); pg8::Gemm g{H + (size_t)hf * MH * DM, (const bf16*)(wl + WO_IN), MH, NIN, DM}; pg8::StaticOrder S; S.init(MH, NIN, G, bx); pg8::EpiNull E; pg8::gemm_phase<pg8::EpiNull, pg8::StaticOrder, true, true, true>(ldsl, g, S, E); }
            for (int rep_ = 0; rep_ < (DBG_REP_IN ? 2 : 1); ++rep_)
            { PH(); pg8::Gemm g{H + (size_t)hf * MH * DM, (const bf16*)(wl + WO_IN), MH, NIN, DM}; pg8::StaticOrder S; S.init(MH, NIN, G, bx);
              pg8::EpiIn E{Z, ZS, ap->in[4] + (size_t)l * 2 * DM, 0.125f * 1.4426950408889634f, SS + (size_t)(3 * l) * SSS + (size_t)hf * MH * 16, (float*)(ws + WS_VST)};
              pg8::gemm_phase<pg8::EpiIn, pg8::StaticOrder, true, true, true>(ldsl, g, S, E); }
            GRID_SYNC(); TSTAMP(1);
            if (DBG_STOP == 2) DBG_DUMP3(ZU, ZQ, ZGA);
            if (DBG_STOP == 12) DBG_DUMP3(ZV, ZK, ZGB);
            if (DBG_STOP == 22) DBG_DUMP3(ZVA, ZVA, ZVA);
            if (DBG_STOP == 1) DBG_DUMP3(H, H, H);
            if (DBG_STOP == 32) DBG_DUMP3(ZGA, ZGA, ZGA);
            if (DBG_STOP == 42) DBG_DUMP3(ZU, ZU, ZU);
            if (DBG_STOP == 52) DBG_DUMP3(ZQ, ZQ, ZQ);
            { PH();
              int l_o = l; asm volatile("" : "+s"(l_o));
              const float lam_init = 0.8f - 0.6f * expf(-0.3f * (float)l_o);
              const float s1 = wave_sum(ap->in[9][l * 64 + lane] * ap->in[10][l * 64 + lane], lane), s2 = wave_sum(ap->in[11][l * 64 + lane] * ap->in[12][l * 64 + lane], lane);
              const float lam = __builtin_bit_cast(float, __builtin_amdgcn_readfirstlane(__builtin_bit_cast(int, expf(s1) - expf(s2) + lam_init)));
              const float oscale = __builtin_bit_cast(float, __builtin_amdgcn_readfirstlane(__builtin_bit_cast(int, 1.0f - lam_init)));
              const float* gsub = ap->in[13] + l * 128;
              bool pre = false;
              for (int p = bx; p < 1024; p += G) {
                  const int combo = p & 255, qi = p >> 8, b = combo & 7, r = combo >> 3, h = r >> 2, sq = r & 3;
                  const int qb = qi == 0 ? 15 - sq : qi == 1 ? 8 + sq : qi == 2 ? 7 - sq : sq;
                  const int pn = p + G; const bool more = pn < 1024; const int ncombo = pn & 255, nb2 = more ? (ncombo & 7) : -1, nh2 = (ncombo >> 3) >> 2;
#pragma unroll 1
                  for (int mp = 0; mp < 2; ++mp) {
                  if (mp == 0) attn_body::attn_unit<8, false>(pre, b, 2 * h + 1, h, b, 2 * h, h, qb, (const attn_body::bf16*)ZQ, (const attn_body::bf16*)ZK, (const attn_body::bf16*)ZVA, (attn_body::bf16*)O1, nullptr, 0.f, 0.f, nullptr, (char*)lds);
                  else attn_body::attn_unit<8, true>(pre, nb2, 2 * nh2, nh2, b, 2 * h + 1, h, qb, (const attn_body::bf16*)ZQ, (const attn_body::bf16*)ZK, (const attn_body::bf16*)ZVA, (attn_body::bf16*)O1, (attn_body::bf16*)ZQ, lam, oscale, gsub, (char*)lds);
                  pre = (mp == 0) ? true : more; } } }
            __syncthreads();
            { PH();
              const float* bs = ap->in[8] + (size_t)l * 1024; const float* lng = ap->in[5] + (size_t)l * DM; const float* lnb = ap->in[6] + (size_t)l * DM;
              for (int i = bx; i < MH / 128; i += G) sgu_unit(ldsl, ZU, ZU, ZV, (const float*)(ws + WS_VST), (const bf16*)(wl + WO_S), bs, lng, lnb, (size_t)i * 128, tid, lane, wave); }
            GRID_SYNC(); TSTAMP(2);
            if (DBG_STOP == 3) DBG_DUMP3(O1, O2, ZU);
            if (DBG_STOP == 13) DBG_DUMP3(O1, O2, O1);
            if (DBG_STOP == 23) DBG_DUMP3(ZU, ZU, ZU);
            for (int rep_ = 0; rep_ < (DBG_REP_P4 ? 2 : 1); ++rep_) {
            { PH(); pg8::StaticOrder S; S.init(MH, DM, G, bx);
              pg8::Gemm g{ZU, (const bf16*)(wl + WO_PA), MH, DM, DM}; pg8::EpiGate<false> E{ZGA, ZK}; pg8::gemm_phase<pg8::EpiGate<false>, pg8::StaticOrder, true, true>(ldsl, g, S, E); }
            { PH(); pg8::StaticOrder S; S.init(MH, DM, G, bx);
              pg8::Gemm g{ZQ, (const bf16*)(wl + WO_PB), MH, DM, DM}; pg8::EpiGate<true> E{ZGB, ZK}; pg8::gemm_phase<pg8::EpiGate<true>, pg8::StaticOrder, true, true>(ldsl, g, S, E); }
            }
            GRID_SYNC(); TSTAMP(4);
            if (DBG_STOP == 5) DBG_DUMP3(ZK, ZK, ZK);
            { PH(); pg8::Gemm g{ZK, (const bf16*)(wl + WO_O), MH, DM, DM}; pg8::StaticOrder S; S.init(MH, DM, G, bx);
              pg8::EpiResid<false> E{H + (size_t)hf * MH * DM, H + (size_t)hf * MH * DM, nullptr, nullptr, SS + (size_t)(3 * l + 1) * SSS + (size_t)hf * MH * 16, nullptr};
              if (DBG_REP_RES) { pg8::EpiResid<false> E0 = E; E0.ascale = 0.f; pg8::gemm_phase<pg8::EpiResid<false>, pg8::StaticOrder, true, true>(ldsl, g, S, E0); }
              pg8::gemm_phase<pg8::EpiResid<false>, pg8::StaticOrder, true, true>(ldsl, g, S, E); }
            GRID_SYNC(); TSTAMP(5);
            if (DBG_STOP == 6) DBG_ZERO_UPPER();
        }
        for (int rep_ = 0; rep_ < (DBG_REP_UP ? 2 : 1); ++rep_)
        { PH(); pg8::Gemm g{H, (const bf16*)(wl + WO_UP), M, NUP, DM}; pg8::StaticOrder S; S.init(M, NUP, G, bx);
          pg8::EpiConv E{ACT, EDGE, ap->in[19] + (size_t)l * 3 * NUP, ap->in[20] + (size_t)l * NUP, (LAS float*)(ldsl + XB_OFF), SS + (size_t)(3 * l + 1) * SSS};
          pg8::gemm_phase<pg8::EpiConv, pg8::StaticOrder, true, true, true>(ldsl, g, S, E); }
        { PH(); const float* pl = ap->in[1] + (size_t)l * M * PLE;
          for (size_t i = gt; i < (size_t)M * PLE / 8; i += NGT) { const f32x4 v0 = ((const f32x4*)pl)[2 * i], v1 = ((const f32x4*)pl)[2 * i + 1];
              v4u w; w.x = pk2(v0.x, v0.y); w.y = pk2(v0.z, v0.w); w.z = pk2(v1.x, v1.y); w.w = pk2(v1.z, v1.w); ((v4u*)PBF)[i] = w; } }
        GRID_SYNC(); TSTAMP(7);
        { PH(); const float* cw = ap->in[19] + (size_t)l * 3 * NUP; const float* cb = ap->in[20] + (size_t)l * NUP;
          for (size_t i = gt; i < (size_t)(M / 256) * pg8::NTC * 2 * 32; i += NGT) {
              const int c = (int)(i & 31) * 4, row = (int)((i >> 5) & 1), tile = (int)(i >> 6), pn = tile % pg8::NTC, pm = tile / pg8::NTC;
              const bool first = (pm % (SEQ / 256)) == 0; const int gcol = pn * 128 + c;
              const float* e1 = EDGE + (size_t)tile * 1024; const float* e0 = EDGE + (size_t)(first ? tile : tile - pg8::NTC) * 1024;
              f32x4 av[2];
#pragma unroll
              for (int q = 0; q < 2; ++q) { const int jc = q * 128 + c, col = q * DFF + gcol;
                  const f32x4 z4 = (f32x4){0.f, 0.f, 0.f, 0.f};
                  const f32x4 pm2 = first ? z4 : *(const f32x4*)(e0 + 2 * 256 + jc), pm1 = first ? z4 : *(const f32x4*)(e0 + 3 * 256 + jc), r0 = *(const f32x4*)(e1 + jc), r1 = *(const f32x4*)(e1 + 256 + jc);
                  const f32x4 w0 = *(const f32x4*)(cw + col), w1 = *(const f32x4*)(cw + NUP + col), w2 = *(const f32x4*)(cw + 2 * NUP + col), bb = *(const f32x4*)(cb + col);
                  av[q] = row == 0 ? (w0 * pm2 + w1 * pm1 + w2 * r0 + bb) : (w0 * pm1 + w1 * r0 + w2 * r1 + bb); }
              v2u w; w.x = pk2(pg8::gelu_tanh_f(av[0][0]) * av[1][0], pg8::gelu_tanh_f(av[0][1]) * av[1][1]); w.y = pk2(pg8::gelu_tanh_f(av[0][2]) * av[1][2], pg8::gelu_tanh_f(av[0][3]) * av[1][3]);
              *(v2u*)(ACT + (size_t)(pm * 256 + row) * DFF + gcol) = w; }
          }
        GRID_SYNC(); TSTAMP(8);
        { PH(); pg8::Gemm g{ACT, (const bf16*)(wl + WO_DOWN), M, DM, DFF}; pg8::StaticOrder S; S.init(M, DM, G, bx);
          pg8::EpiResid<false> E{H, XBB, nullptr, nullptr, SS + (size_t)(3 * l + 2) * SSS, nullptr};
          if (DBG_REP_RES) { pg8::EpiResid<false> E0 = E; E0.ascale = 0.f; pg8::gemm_phase<pg8::EpiResid<false>, pg8::StaticOrder, true, true>(ldsl, g, S, E0); }
          pg8::gemm_phase<pg8::EpiResid<false>, pg8::StaticOrder, true, true>(ldsl, g, S, E); }
        GRID_SYNC(); TSTAMP(9);
        { PH(); pg8::Gemm g{PBF, (const bf16*)(wl + WO_PLE), M, DM, PLE}; pg8::StaticOrder S; S.init(M, DM, G, bx);
          pg8::EpiStore E{EB, DM}; pg8::gemm_phase<pg8::EpiStore, pg8::StaticOrder, true, true>(ldsl, g, S, E); }
        { PH(); pg8::Gemm g{XBB, (const bf16*)(wl + WO_PG), M, DM, DM}; pg8::StaticOrder S; S.init(M, DM, G, bx);
          pg8::EpiResid<true> E{XBB, H, ap->in[24] + (size_t)l * DM, EB, SS + (size_t)(3 * l + 3) * SSS, SS + (size_t)(3 * l + 2) * SSS};
          if (DBG_REP_RES) { pg8::EpiResid<true> E0 = E; E0.ascale = 0.f; E0.XBO = XBB; pg8::gemm_phase<pg8::EpiResid<true>, pg8::StaticOrder, true, true, true>(ldsl, g, S, E0); }
          pg8::gemm_phase<pg8::EpiResid<true>, pg8::StaticOrder, true, true, true>(ldsl, g, S, E); }
        GRID_SYNC(); TSTAMP(11);
        if (l + 1 == DEPTH) { PH(); const float* gfin = ap->in[26];
            for (int m = gw; m < M; m += NGW) { const bf16* xr = H + (size_t)m * DM + 16 * lane; const v4u a0 = *(const v4u*)xr, a1 = *(const v4u*)(xr + 8);
                float f[16]; f[0] = pg8::h_lo(a0.x); f[1] = pg8::h_hi(a0.x); f[2] = pg8::h_lo(a0.y); f[3] = pg8::h_hi(a0.y); f[4] = pg8::h_lo(a0.z); f[5] = pg8::h_hi(a0.z); f[6] = pg8::h_lo(a0.w); f[7] = pg8::h_hi(a0.w);
                f[8] = pg8::h_lo(a1.x); f[9] = pg8::h_hi(a1.x); f[10] = pg8::h_lo(a1.y); f[11] = pg8::h_hi(a1.y); f[12] = pg8::h_lo(a1.z); f[13] = pg8::h_hi(a1.z); f[14] = pg8::h_lo(a1.w); f[15] = pg8::h_hi(a1.w);
                float sq = 0.f;
#pragma unroll
                for (int j = 0; j < 16; ++j) sq += f[j] * f[j];
                const float rstd = 1.0f / sqrtf(wave_sum(sq, lane) * (1.f / DM) + EPS);
                float* orow = X + (size_t)m * DM + 16 * lane;
#pragma unroll
                for (int j = 0; j < 4; ++j) { const f32x4 gg = *(const f32x4*)(gfin + 16 * lane + 4 * j); *(f32x4*)(orow + 4 * j) = (f32x4){f[4 * j] * rstd * gg[0], f[4 * j + 1] * rstd * gg[1], f[4 * j + 2] * rstd * gg[2], f[4 * j + 3] * rstd * gg[3]}; } } }
        if (DBG_TIME && l + 1 == DEPTH) { GRID_SYNC(); TSTAMP(12); GRID_SYNC();
            PH(); const unsigned long long* tb = (const unsigned long long*)(ws + 64); unsigned long long sa = 0, sb = 0;
            for (int k = 0; k < 13; ++k) { const unsigned long long v = __hip_atomic_load(tb + 1 + k, __ATOMIC_RELAXED, __HIP_MEMORY_SCOPE_AGENT); if ((SELA >> k) & 1) sa += v; if ((SELB >> k) & 1) sb += v; }
            const float fb = (float)(sa + sb) * 0.00001f;
            for (size_t i = gt; i < (size_t)16384 * DM; i += NGT) X[i] = fb; }
    }
}

extern "C" void kernel_launch(void* const* d_in, const int* in_sizes, int n_in, void* d_out, int out_size, void* d_ws, size_t ws_size, hipStream_t stream) {
    static int grid = 0;
    if (grid == 0) {
        if (n_in != 27 || out_size != M * DM || ws_size < WS_END) { fprintf(stderr, "kernel_launch: unexpected shapes (n_in %d out %d ws %zu)\n", n_in, out_size, ws_size); grid = -1; return; }
        int dev = 0, cus = 0, per_cu = 0;
        if (hipGetDevice(&dev) != hipSuccess || hipDeviceGetAttribute(&cus, hipDeviceAttributeMultiprocessorCount, dev) != hipSuccess) { grid = -1; return; }
        if (hipFuncSetAttribute((const void*)fwd_kernel, hipFuncAttributeMaxDynamicSharedMemorySize, LDS_BYTES) != hipSuccess) { fprintf(stderr, "kernel_launch: hipFuncSetAttribute failed\n"); grid = -1; return; }
        if (hipOccupancyMaxActiveBlocksPerMultiprocessor(&per_cu, (const void*)fwd_kernel, NTHREADS, LDS_BYTES) != hipSuccess || per_cu < 1) { fprintf(stderr, "kernel_launch: occupancy query gives %d\n", per_cu); per_cu = 1; }
        (void)hipGetLastError();
        grid = cus * per_cu;
    }
    if (grid < 0) return;
    if (hipMemsetAsync(d_ws, 0, 32768, stream) != hipSuccess) { fprintf(stderr, "kernel_launch: memset failed\n"); return; }
    Args a{};
    for (int i = 0; i < 27; ++i) a.in[i] = (const float*)d_in[i];
    a.out = (float*)d_out; a.ws = (unsigned char*)d_ws;
    void* args[] = {&a};
    hipError_t e = hipLaunchCooperativeKernel((const void*)fwd_kernel, dim3(grid), dim3(NTHREADS), args, LDS_BYTES, stream);
    if (e != hipSuccess) fprintf(stderr, "kernel_launch: cooperative launch failed: %s (grid %d)\n", hipGetErrorString(e), grid);
}
```
